# Optimizing an MI355X kernel written in HIP

```python
import math
import jax, jax.numpy as jnp
from jax import lax
import numpy as np


D_MODEL = 2048
BATCH = 8
SEQ = 2048
DEPTH = 2

GRID_W = 64
CTX_LEN = 256
EPS = 1e-6
ROPE_THETA = 10000.0
Q_BLOCK = 128
D_FF = 5632
N_MOD = 9
ADA_STD = 0.5

MLA_HEADS = 8
MLA_Q_RANK = 512
MLA_KV_RANK = 256
MLA_NOPE = 128
MLA_ROPE = 64
MLA_V = 128
MLA_SCALE = (MLA_NOPE + MLA_ROPE) ** -0.5

DIFF_HEADS = 4
DIFF_QK = 64
DIFF_V = 2 * DIFF_QK
DIFF_SCALE = DIFF_QK ** -0.5
DIFF_LAMBDA_STD = 0.1

FOURIER_GROUPS = 4
FOURIER_CH = 128

MLA_WIDTH = MLA_HEADS * MLA_V
DIFF_WIDTH = DIFF_HEADS * DIFF_V
FOURIER_WIDTH = FOURIER_GROUPS * FOURIER_CH
MIX_WIDTH = MLA_WIDTH + DIFF_WIDTH + FOURIER_WIDTH

OFF_KV_LAT = 0
OFF_K_ROPE = OFF_KV_LAT + MLA_KV_RANK
OFF_DK = OFF_K_ROPE + MLA_ROPE
OFF_DV = OFF_DK + 2 * DIFF_HEADS * DIFF_QK
KV_COLS = OFF_DV + DIFF_HEADS * DIFF_V
OFF_Q_LAT = 0
OFF_DQ = OFF_Q_LAT + MLA_Q_RANK
OFF_FOUR = OFF_DQ + 2 * DIFF_HEADS * DIFF_QK
Q_COLS = OFF_FOUR + FOURIER_WIDTH
IN_COLS = KV_COLS + Q_COLS

kernel_name = 'hybrid_mla_diff_fourier_macaron_dit'


def rmsnorm(x, g):
    xf = x.astype(jnp.float32)
    y = xf * lax.rsqrt(jnp.mean(xf * xf, axis=-1, keepdims=True) + EPS)
    return y.astype(x.dtype) * g


def modulate(x, g, shift, scale):
    return rmsnorm(x, g) * (1 + scale) + shift


def swiglu(h, wg, wu, wd):
    return (jax.nn.silu(h @ wg) * (h @ wu)) @ wd


def ffn_sublayer(z, shift, scale, gate, g, wg, wu, wd):
    return z + 0.5 * gate * swiglu(modulate(z, g, shift, scale), wg, wu, wd)


def rope_1d(x, pos):
    d = x.shape[-1]
    half = d // 2
    inv = ROPE_THETA ** (-2.0 * jnp.arange(half, dtype=jnp.float32) / d)
    ang = pos.astype(jnp.float32)[:, None] * inv[None, :]
    cos = jnp.cos(ang)[:, None, :].astype(x.dtype)
    sin = jnp.sin(ang)[:, None, :].astype(x.dtype)
    x1, x2 = x[..., :half], x[..., half:]
    return jnp.concatenate([x1 * cos - x2 * sin, x1 * sin + x2 * cos], axis=-1)


def rope_2d(x, pos):
    if pos is None:
        return x
    row, col = pos
    half = x.shape[-1] // 2
    return jnp.concatenate([rope_1d(x[..., :half], row), rope_1d(x[..., half:], col)], axis=-1)


def kv_side(pk, kv_norm, w_ukv, pos):
    B, S = pk.shape[:2]
    c_kv = pk[..., OFF_KV_LAT:OFF_K_ROPE]
    k_rope = pk[..., OFF_K_ROPE:OFF_DK]
    dk = pk[..., OFF_DK:OFF_DV]
    dv = pk[..., OFF_DV:KV_COLS]
    kv = (rmsnorm(c_kv, kv_norm) @ w_ukv).reshape(B, S, MLA_HEADS, MLA_NOPE + MLA_V)
    k_nope, mla_v = kv[..., :MLA_NOPE], kv[..., MLA_NOPE:]
    k_rope = rope_2d(k_rope[:, :, None, :], pos)
    mla_k = jnp.concatenate([k_nope, jnp.broadcast_to(k_rope, (B, S, MLA_HEADS, MLA_ROPE))], axis=-1)
    dk = rope_2d(dk.reshape(B, S, 2 * DIFF_HEADS, DIFF_QK), pos).reshape(B, S, DIFF_HEADS, 2, DIFF_QK)
    dv = dv.reshape(B, S, DIFF_HEADS, DIFF_V)
    return (mla_k, mla_v, dk[..., 0, :], dk[..., 1, :], dv)


def q_side(pq, q_norm, w_uq, pos):
    B, S = pq.shape[:2]
    c_q = pq[..., OFF_Q_LAT:OFF_DQ]
    dq = pq[..., OFF_DQ:OFF_FOUR]
    u = pq[..., OFF_FOUR:Q_COLS]
    q = (rmsnorm(c_q, q_norm) @ w_uq).reshape(B, S, MLA_HEADS, MLA_NOPE + MLA_ROPE)
    mla_q = jnp.concatenate([q[..., :MLA_NOPE], rope_2d(q[..., MLA_NOPE:], pos)], axis=-1)
    dq = rope_2d(dq.reshape(B, S, 2 * DIFF_HEADS, DIFF_QK), pos).reshape(B, S, DIFF_HEADS, 2, DIFF_QK)
    return (mla_q, dq[..., 0, :], dq[..., 1, :], u)


def softmax_f32(s):
    return jax.nn.softmax(s.astype(jnp.float32), axis=-1)


def mla_block(q, k, v):
    s = jnp.einsum('bqhd,bkhd->bhqk', q, k) * MLA_SCALE
    p = softmax_f32(s).astype(v.dtype)
    return jnp.einsum('bhqk,bkhd->bqhd', p, v)


def diff_block(q1, q2, k1, k2, v, lam):
    s1 = jnp.einsum('bqhd,bkhd->bhqk', q1, k1) * DIFF_SCALE
    s2 = jnp.einsum('bqhd,bkhd->bhqk', q2, k2) * DIFF_SCALE
    p = (softmax_f32(s1) - lam * softmax_f32(s2)).astype(v.dtype)
    return jnp.einsum('bhqk,bkhd->bqhd', p, v)


def over_query_blocks(fn, qs):
    B, S = qs[0].shape[:2]
    blk = min(Q_BLOCK, S)
    nb = S // blk
    xs = tuple(jnp.swapaxes(q.reshape(B, nb, blk, *q.shape[2:]), 0, 1) for q in qs)
    out = lax.map(lambda t: fn(*t), xs)
    return jnp.swapaxes(out, 0, 1).reshape(B, S, *out.shape[3:])


def fourier_mix(u):
    B, S = u.shape[:2]
    g = u.reshape(B, S, FOURIER_GROUPS, FOURIER_CH).astype(jnp.float32)
    f = jnp.fft.fft2(g, axes=(1, 3), norm='ortho').real
    return f.reshape(B, S, FOURIER_WIDTH).astype(u.dtype)


def token_mix(qp, kvp, lam, lam_init, subln, w_out):
    mla_q, dq1, dq2, u = qp
    mla_k, mla_v, dk1, dk2, dv = kvp
    B, S = u.shape[:2]
    o_mla = over_query_blocks(lambda q: mla_block(q, mla_k, mla_v), (mla_q,))
    o_diff = over_query_blocks(lambda a, b: diff_block(a, b, dk1, dk2, dv, lam), (dq1, dq2))
    o_diff = rmsnorm(o_diff, subln) * (1.0 - lam_init)
    o = jnp.concatenate([o_mla.reshape(B, S, MLA_WIDTH), o_diff.reshape(B, S, DIFF_WIDTH), fourier_mix(u)], axis=-1)
    return o @ w_out


def setup_inputs(seed: int = 0) -> dict:
    key = jax.random.key(seed)
    ks = jax.random.split(key, 20)

    def nrm(k, shape, std):
        return jax.random.normal(k, shape, jnp.float32) * std

    return {
        'x': nrm(ks[0], (BATCH, SEQ, D_MODEL), 1.0),
        'c': nrm(ks[1], (BATCH, D_MODEL), 1.0),
        'ctx': nrm(ks[2], (BATCH, CTX_LEN, D_MODEL), 1.0),
        'c_ctx': nrm(ks[3], (D_MODEL,), 1.0),
        'ada_w': nrm(ks[4], (DEPTH, D_MODEL, N_MOD * D_MODEL), ADA_STD * D_MODEL ** -0.5),
        'ada_b': nrm(ks[5], (DEPTH, N_MOD * D_MODEL), 0.02),
        'norm_g': 1.0 + nrm(ks[6], (DEPTH, 3, D_MODEL), 0.02),
        'ffn_wg': nrm(ks[7], (DEPTH, 2, D_MODEL, D_FF), D_MODEL ** -0.5),
        'ffn_wu': nrm(ks[8], (DEPTH, 2, D_MODEL, D_FF), D_MODEL ** -0.5),
        'ffn_wd': nrm(ks[9], (DEPTH, 2, D_FF, D_MODEL), D_FF ** -0.5),
        'w_in': nrm(ks[10], (DEPTH, D_MODEL, IN_COLS), D_MODEL ** -0.5),
        'mla_q_norm': 1.0 + nrm(ks[11], (DEPTH, MLA_Q_RANK), 0.02),
        'mla_kv_norm': 1.0 + nrm(ks[12], (DEPTH, MLA_KV_RANK), 0.02),
        'mla_w_uq': nrm(ks[13], (DEPTH, MLA_Q_RANK, MLA_HEADS * (MLA_NOPE + MLA_ROPE)), MLA_Q_RANK ** -0.5),
        'mla_w_ukv': nrm(ks[14], (DEPTH, MLA_KV_RANK, MLA_HEADS * (MLA_NOPE + MLA_V)), MLA_KV_RANK ** -0.5),
        'diff_lambda': nrm(ks[15], (DEPTH, 4, DIFF_QK), DIFF_LAMBDA_STD),
        'diff_subln': 1.0 + nrm(ks[16], (DEPTH, DIFF_V), 0.02),
        'w_out': nrm(ks[17], (DEPTH, MIX_WIDTH, D_MODEL), MIX_WIDTH ** -0.5),
        'final_norm': 1.0 + nrm(ks[18], (D_MODEL,), 0.02),
    }


def reference(x, c, ctx, c_ctx, ada_w, ada_b, norm_g, ffn_wg, ffn_wu, ffn_wd, w_in,
              mla_q_norm, mla_kv_norm, mla_w_uq, mla_w_ukv, diff_lambda, diff_subln,
              w_out, final_norm):
    B, n, D = x.shape
    rows = n // GRID_W
    pos = (jnp.repeat(jnp.arange(rows), GRID_W), jnp.tile(jnp.arange(GRID_W), rows))
    xc = ctx
    s_lat = jax.nn.silu(c)
    s_ctx = jax.nn.silu(c_ctx)[None, :]
    for l in range(DEPTH):
        last = l == DEPTH - 1
        lam_init = 0.8 - 0.6 * math.exp(-0.3 * l)
        lf = diff_lambda[l].astype(jnp.float32)
        lam = jnp.exp(jnp.sum(lf[0] * lf[1])) - jnp.exp(jnp.sum(lf[2] * lf[3])) + lam_init
        m = (s_lat @ ada_w[l] + ada_b[l]).reshape(B, N_MOD, 1, D)
        mc = (s_ctx @ ada_w[l] + ada_b[l]).reshape(1, N_MOD, 1, D)

        x = ffn_sublayer(x, m[:, 0], m[:, 1], m[:, 2], norm_g[l, 0], ffn_wg[l, 0], ffn_wu[l, 0], ffn_wd[l, 0])
        xc = ffn_sublayer(xc, mc[:, 0], mc[:, 1], mc[:, 2], norm_g[l, 0], ffn_wg[l, 0], ffn_wu[l, 0], ffn_wd[l, 0])

        h = modulate(x, norm_g[l, 1], m[:, 3], m[:, 4])
        hc = modulate(xc, norm_g[l, 1], mc[:, 3], mc[:, 4])
        p = h @ w_in[l]
        if last:
            pc_kv = hc @ w_in[l][:, :KV_COLS]
        else:
            pc = hc @ w_in[l]
            pc_kv = pc[..., :KV_COLS]
        ctx_kv = kv_side(pc_kv, mla_kv_norm[l], mla_w_ukv[l], None)
        lat_kv = kv_side(p[..., :KV_COLS], mla_kv_norm[l], mla_w_ukv[l], pos)
        full_kv = tuple(jnp.concatenate([a, b], axis=1) for a, b in zip(ctx_kv, lat_kv))
        lat_q = q_side(p[..., KV_COLS:], mla_q_norm[l], mla_w_uq[l], pos)
        x = x + m[:, 5] * token_mix(lat_q, full_kv, lam, lam_init, diff_subln[l], w_out[l])
        if not last:
            ctx_q = q_side(pc[..., KV_COLS:], mla_q_norm[l], mla_w_uq[l], None)
            xc = xc + mc[:, 5] * token_mix(ctx_q, ctx_kv, lam, lam_init, diff_subln[l], w_out[l])

        x = ffn_sublayer(x, m[:, 6], m[:, 7], m[:, 8], norm_g[l, 2], ffn_wg[l, 1], ffn_wu[l, 1], ffn_wd[l, 1])
        if not last:
            xc = ffn_sublayer(xc, mc[:, 6], mc[:, 7], mc[:, 8], norm_g[l, 2], ffn_wg[l, 1], ffn_wu[l, 1], ffn_wd[l, 1])
    return rmsnorm(x, final_norm)
```

```cpp
#include <hip/hip_runtime.h>
#include <cstdio>
#include <cstdint>
namespace pg8 {
#define PG8_LAS __attribute__((address_space(3)))
typedef unsigned short bf16_t;
typedef short bf16x8 __attribute__((ext_vector_type(8)));
typedef float f32x4 __attribute__((ext_vector_type(4)));
typedef float f32x2 __attribute__((ext_vector_type(2)));
typedef unsigned u32x4 __attribute__((ext_vector_type(4)));
typedef unsigned u32x2 __attribute__((ext_vector_type(2)));
constexpr int BM = 256, BK = 64, HALF = 128, HTB = HALF * BK * 2  , STAGE_BYTES = 8 * HTB, NXCD = 8, WGM = 8;

__host__ __device__ __forceinline__ int lds_byte(int r, int c) { const int st = (r >> 4) * 2 + (c >> 5), rr = r & 15, cc = c & 31, ob = rr * 64 + cc * 2; return st * 1024 + (ob ^ (((ob >> 9) & 1) << 5)); }
__host__ __device__ __forceinline__ void stage_rc(int b, int& R, int& C) { const int st = b / 1024, sb = b % 1024, swz = sb ^ (((sb >> 9) & 1) << 5); R = (st >> 1) * 16 + swz / 64; C = (st & 1) * 32 + (swz % 64) / 2; }
__host__ __device__ __forceinline__ int perm32(int rho) { const int n = rho >> 4, i = rho & 15; return 8 * (i >> 2) + 4 * n + (i & 3); }

struct Unit { int pm, pn; };
struct Gemm { const bf16_t* A; const bf16_t* Bt; int M, N, K, lda, ldb; };

struct StaticOrder {
    int nM, nN, nwg, G, c;
    __host__ __device__ void init(int M, int N, int G_, int c_) { nM = M / BM; nN = N / BM; nwg = nM * nN; G = G_; c = c_; }
    __host__ __device__ bool next(int i, Unit& u) const {
        const long L = (long)i * G + c; if (L >= nwg) return false;
        int wgid = (int)L; { const int q = nwg / NXCD, r = nwg % NXCD, xcd = wgid % NXCD, off = wgid / NXCD; wgid = (xcd < r ? xcd * (q + 1) : r * (q + 1) + (xcd - r) * q) + off; }
        const int nig = WGM * nN, gid = wgid / nig, fm = gid * WGM, gsz = (nM - fm) < WGM ? (nM - fm) : WGM;
        u.pm = fm + ((wgid % nig) % gsz); u.pn = (wgid % nig) / gsz; return true;
    }
    __device__ __forceinline__ void a_ready(const Unit&) const {}
    __device__ __forceinline__ void done(const Unit&) const {}
};

__device__ __forceinline__ unsigned cvt_pk_bf16(float lo, float hi) { unsigned r; asm volatile("v_cvt_pk_bf16_f32 %0, %1, %2" : "=v"(r) : "v"(lo), "v"(hi)); return r; }
__device__ __forceinline__ float silu_f(float x) { return x * __builtin_amdgcn_rcpf(1.0f + __builtin_amdgcn_exp2f(-1.4426950408889634f * x)); }

constexpr int E_DM = 2048, E_MLAT = 16384, E_MODROW = 9 * 2048;

struct EpiSwiglu {
    static constexpr bool PERM = true, AFTER_DRAIN = false;
    bf16_t* O; int ldc;
    __device__ __forceinline__ void operator()(const f32x4 (&acc)[2][2][4][2], const Unit& u, int wr, int wc, int fr, int fq) const {
        const int row0 = u.pm * BM + wr * 64 + fr, col0 = u.pn * HALF + wc * 32 + 8 * fq;
#pragma unroll
        for (int ai = 0; ai < 2; ++ai)
#pragma unroll
            for (int m = 0; m < 4; ++m) { bf16_t* rowp = O + (size_t)(row0 + ai * HALF + m * 16) * ldc + col0;
                const f32x4 g0 = acc[ai][0][m][0], g1 = acc[ai][0][m][1], u0 = acc[ai][1][m][0], u1 = acc[ai][1][m][1];
                u32x4 w; w.x = cvt_pk_bf16(silu_f(g0[0]) * u0[0], silu_f(g0[1]) * u0[1]); w.y = cvt_pk_bf16(silu_f(g0[2]) * u0[2], silu_f(g0[3]) * u0[3]);
                w.z = cvt_pk_bf16(silu_f(g1[0]) * u1[0], silu_f(g1[1]) * u1[1]); w.w = cvt_pk_bf16(silu_f(g1[2]) * u1[2], silu_f(g1[3]) * u1[3]);
                *(u32x4*)rowp = w; }
    }
};
struct EpiResid {
    static constexpr bool PERM = false, AFTER_DRAIN = false;
    const float* in_lat; const float* in_ctx; float* X; const float* gate; float coef;
    __device__ __forceinline__ void operator()(const f32x4 (&acc)[2][2][4][2], const Unit& u, int wr, int wc, int fr, int fq) const {
        const int mi = u.pm < 64 ? (u.pm >> 3) : 8;
        const float* in = u.pm < 64 ? in_lat + (size_t)u.pm * BM * E_DM : in_ctx + (size_t)(u.pm - 64) * BM * E_DM;
        float* out = X + (size_t)u.pm * BM * E_DM;
        const int r0 = wr * 64 + fr, col0 = u.pn * BM + wc * 32 + 4 * fq;
        f32x4 gv[2][2];
#pragma unroll
        for (int bj = 0; bj < 2; ++bj)
#pragma unroll
            for (int n = 0; n < 2; ++n) gv[bj][n] = *(const f32x4*)(gate + (size_t)mi * E_MODROW + col0 + bj * HALF + n * 16) * coef;
#pragma unroll
        for (int ai = 0; ai < 2; ++ai)
#pragma unroll
            for (int m = 0; m < 4; ++m) { const size_t off = (size_t)(r0 + ai * HALF + m * 16) * E_DM + col0;
#pragma unroll
                for (int bj = 0; bj < 2; ++bj)
#pragma unroll
                    for (int n = 0; n < 2; ++n) { const f32x4 b = *(const f32x4*)(in + off + bj * HALF + n * 16); *(f32x4*)(out + off + bj * HALF + n * 16) = b + gv[bj][n] * acc[ai][bj][m][n]; } }
    }
};
struct EpiStoreBf16 {
    static constexpr bool PERM = true, AFTER_DRAIN = false;
    bf16_t* O; int ldc;
    __device__ __forceinline__ void operator()(const f32x4 (&acc)[2][2][4][2], const Unit& u, int wr, int wc, int fr, int fq) const {
        const int row0 = u.pm * BM + wr * 64 + fr, col0 = u.pn * BM + wc * 32 + 8 * fq;
#pragma unroll
        for (int ai = 0; ai < 2; ++ai)
#pragma unroll
            for (int m = 0; m < 4; ++m) { bf16_t* rowp = O + (size_t)(row0 + ai * HALF + m * 16) * ldc + col0;
#pragma unroll
                for (int bj = 0; bj < 2; ++bj) { const f32x4 v0 = acc[ai][bj][m][0], v1 = acc[ai][bj][m][1];
                    u32x4 w; w.x = cvt_pk_bf16(v0[0], v0[1]); w.y = cvt_pk_bf16(v0[2], v0[3]); w.z = cvt_pk_bf16(v1[0], v1[1]); w.w = cvt_pk_bf16(v1[2], v1[3]);
                    *(u32x4*)(rowp + bj * HALF) = w; } }
    }
};
struct EpiF1 {
    static constexpr bool PERM = true, AFTER_DRAIN = false;
    bf16_t* Ct; bf16_t* Ctc;
    __device__ __forceinline__ void operator()(const f32x4 (&acc)[2][2][4][2], const Unit& u, int wr, int wc, int fr, int fq) const {
        const int row0 = u.pm * BM + wr * 64 + fr, cw = wc * 32 + 8 * fq;
#pragma unroll
        for (int ai = 0; ai < 2; ++ai)
#pragma unroll
            for (int m = 0; m < 4; ++m) { const int mr = row0 + ai * HALF + m * 16, type = mr >> 9, n = mr & 511;
                bf16_t* rowp = u.pn < 64 ? Ct + (((size_t)((u.pn >> 3) * 512 + n)) * 2 + type) * 2048 + (u.pn & 7) * 256 + cw
                                         : Ctc + (((size_t)((u.pn - 64) * 512 + n)) * 2 + type) * 256 + cw;
#pragma unroll
                for (int bj = 0; bj < 2; ++bj) { const f32x4 v0 = acc[ai][bj][m][0], v1 = acc[ai][bj][m][1];
                    u32x4 w; w.x = cvt_pk_bf16(v0[0], v0[1]); w.y = cvt_pk_bf16(v0[2], v0[3]); w.z = cvt_pk_bf16(v1[0], v1[1]); w.w = cvt_pk_bf16(v1[2], v1[3]);
                    *(u32x4*)(rowp + bj * HALF) = w; } }
    }
};
struct EpiF2 {
    static constexpr bool PERM = true, AFTER_DRAIN = false;
    bf16_t* O; int rowbase, rows_per_b;
    __device__ __forceinline__ void operator()(const f32x4 (&acc)[2][2][4][2], const Unit& u, int wr, int wc, int fr, int fq) const {
        const int row0 = rowbase + (u.pn >> 1) * rows_per_b + u.pm * BM + wr * 64 + fr, col0 = 1536 + (u.pn & 1) * 256 + wc * 32 + 8 * fq;
#pragma unroll
        for (int ai = 0; ai < 2; ++ai)
#pragma unroll
            for (int m = 0; m < 4; ++m) { bf16_t* rowp = O + (size_t)(row0 + ai * HALF + m * 16) * E_DM + col0;
#pragma unroll
                for (int bj = 0; bj < 2; ++bj) { const f32x4 v0 = acc[ai][bj][m][0], v1 = acc[ai][bj][m][1];
                    u32x4 w; w.x = cvt_pk_bf16(v0[0], v0[1]); w.y = cvt_pk_bf16(v0[2], v0[3]); w.z = cvt_pk_bf16(v1[0], v1[1]); w.w = cvt_pk_bf16(v1[2], v1[3]);
                    *(u32x4*)(rowp + bj * HALF) = w; } }
    }
};
struct EpiRopeQ {
    static constexpr bool PERM = false, AFTER_DRAIN = false;
    bf16_t* Q; int ldc; const float* rope;
    __device__ __forceinline__ void operator()(const f32x4 (&acc)[2][2][4][2], const Unit& u, int wr, int wc, int fr, int fq) const {
        const int row0 = u.pm * BM + wr * 64 + fr;
#pragma unroll
        for (int bj = 0; bj < 2; ++bj) { const int cg = u.pn * BM + bj * HALF + wc * 32, within = cg % 192; const bool roped = within >= 128 && u.pm < 64; const int half = (within - 128) >> 5;
#pragma unroll
            for (int ai = 0; ai < 2; ++ai)
#pragma unroll
                for (int m = 0; m < 4; ++m) { const int row = row0 + ai * HALF + m * 16, s = row & 2047, pos = half ? (s & 63) : (s >> 6);
                    f32x4 x1 = acc[ai][bj][m][0], x2 = acc[ai][bj][m][1];
                    if (roped) { const f32x4 cs = *(const f32x4*)(rope + pos * 32 + 4 * fq), sn = *(const f32x4*)(rope + pos * 32 + 16 + 4 * fq);
                        const f32x4 o1 = x1 * cs - x2 * sn, o2 = x1 * sn + x2 * cs; x1 = o1; x2 = o2; }
                    bf16_t* p = Q + (size_t)row * ldc + cg + 4 * fq;
                    u32x2 w1, w2; w1.x = cvt_pk_bf16(x1[0], x1[1]); w1.y = cvt_pk_bf16(x1[2], x1[3]); w2.x = cvt_pk_bf16(x2[0], x2[1]); w2.y = cvt_pk_bf16(x2[2], x2[3]);
                    *(u32x2*)p = w1; *(u32x2*)(p + 16) = w2; } }
    }
};

template <class Epi, class Sched, bool ALIGN_EPI = false, bool SP2 = false>
__device__ __forceinline__ void gemm_phase(PG8_LAS unsigned char* lds, const Gemm g, const Sched& S, const Epi& E) {
    int tid_ = threadIdx.x; asm volatile("" : "+v"(tid_));
    const int tid = tid_, wid = __builtin_amdgcn_readfirstlane(tid >> 6), lane = tid & 63, wr = wid >> 2, wc = wid & 3, fr = lane & 15, fq = lane >> 4;
    const int K = g.K, nt = K / BK;
    unsigned voffA[2], voffB[2];
#pragma unroll
    for (int i = 0; i < 2; ++i) { int R, C; stage_rc(tid * 16 + i * 8192, R, C); const int Rb = Epi::PERM ? ((R & ~31) + perm32(R & 31)) : R;
        voffA[i] = (unsigned)(R * g.lda + C) * 2u; voffB[i] = (unsigned)(Rb * g.ldb + C) * 2u; }
    const size_t kstep = (size_t)(BK * 2);
    const size_t hstepA = (size_t)HALF * g.lda * 2, hstepB = (size_t)HALF * g.ldb * 2;
    const size_t tstepA = 2 * hstepA, tstepB = 2 * hstepB;
    const unsigned ldsw = (unsigned)wid * 1024u;
    const int aoff = lds_byte(wr * 64 + fr, fq * 8), boff = lds_byte(wc * 32 + fr, fq * 8);
#define PG8_SA(b, h) (((b) * 2 + (h)) * HTB)
#define PG8_SB(b, h) ((4 + (b) * 2 + (h)) * HTB)
#define PG8_STAGE(bufoff, gbase, voff) do { _Pragma("unroll") for (int _i = 0; _i < 2; ++_i) \
        __builtin_amdgcn_global_load_lds((const unsigned*)((const char*)(gbase) + (voff)[_i]), (PG8_LAS unsigned*)(lds + (bufoff) + ldsw + _i * 8192), 16, 0, 0); } while (0)
#define PG8_LDA(dst, b, h) do { _Pragma("unroll") for (int m = 0; m < 4; ++m) _Pragma("unroll") for (int k = 0; k < 2; ++k) dst[m][k] = *(const PG8_LAS bf16x8*)(lds + PG8_SA(b, h) + aoff + m * 2048 + k * 1024); } while (0)
#define PG8_LDB(dst, b, h) do { _Pragma("unroll") for (int n = 0; n < 2; ++n) _Pragma("unroll") for (int k = 0; k < 2; ++k) dst[n][k] = *(const PG8_LAS bf16x8*)(lds + PG8_SB(b, h) + boff + n * 2048 + k * 1024); } while (0)
#define PG8_MMA(ai, bj, At, Bt) do { __builtin_amdgcn_s_setprio(1); _Pragma("unroll") for (int m = 0; m < 4; ++m) _Pragma("unroll") for (int n = 0; n < 2; ++n) _Pragma("unroll") for (int k = 0; k < 2; ++k) \
        acc[ai][bj][m][n] = __builtin_amdgcn_mfma_f32_16x16x32_bf16(Bt[n][k], At[m][k], acc[ai][bj][m][n], 0, 0, 0); __builtin_amdgcn_s_setprio(0); } while (0)
#define PG8_WAIT_V(n) asm volatile("s_waitcnt vmcnt(" #n ")" ::: "memory")
#define PG8_WAIT_L(n) asm volatile("s_waitcnt lgkmcnt(" #n ")" ::: "memory")
#define PG8_BAR __builtin_amdgcn_s_barrier()
#define PG8_SCHED __builtin_amdgcn_sched_barrier(0)
    Unit cur, nxt; int ui = 0;
    if (!S.next(0, cur)) return;
    f32x4 acc[2][2][4][2];
#pragma unroll
    for (int a = 0; a < 2; ++a)
#pragma unroll
        for (int b = 0; b < 2; ++b)
#pragma unroll
            for (int m = 0; m < 4; ++m)
#pragma unroll
                for (int n = 0; n < 2; ++n) acc[a][b][m][n] = (f32x4){0.f, 0.f, 0.f, 0.f};
    bf16x8 At[4][2], B0[2][2], B1[2][2];
    const char* cA = (const char*)g.A + (size_t)cur.pm * tstepA; const char* cB = (const char*)g.Bt + (size_t)cur.pn * tstepB;
    S.a_ready(cur);
    if constexpr (SP2) {
        PG8_STAGE(PG8_SB(0, 0), cB, voffB); PG8_STAGE(PG8_SB(0, 1), cB + hstepB, voffB); PG8_STAGE(PG8_SA(0, 0), cA, voffA); PG8_STAGE(PG8_SA(0, 1), cA + hstepA, voffA);
        if (wr == 1) PG8_BAR;
        PG8_WAIT_V(2); PG8_BAR;
        PG8_STAGE(PG8_SB(1, 0), cB + kstep, voffB); PG8_STAGE(PG8_SA(1, 0), cA + kstep, voffA); PG8_STAGE(PG8_SB(1, 1), cB + hstepB + kstep, voffB);
        PG8_WAIT_V(6); PG8_BAR;
    } else {
        PG8_STAGE(PG8_SB(0, 0), cB, voffB); PG8_STAGE(PG8_SA(0, 0), cA, voffA); PG8_STAGE(PG8_SB(0, 1), cB + hstepB, voffB); PG8_STAGE(PG8_SA(0, 1), cA + hstepA, voffA);
        if (wr == 1) PG8_BAR;
        PG8_WAIT_V(4); PG8_BAR;
        PG8_STAGE(PG8_SB(1, 0), cB + kstep, voffB); PG8_STAGE(PG8_SA(1, 0), cA + kstep, voffA); PG8_STAGE(PG8_SB(1, 1), cB + hstepB + kstep, voffB);
        PG8_WAIT_V(6); PG8_BAR;
    }
    for (;;) {
        const bool has_next = S.next(ui + 1, nxt);
        const char* nA = has_next ? (const char*)g.A + (size_t)nxt.pm * tstepA : cA; const char* nB = has_next ? (const char*)g.Bt + (size_t)nxt.pn * tstepB : cB;
#pragma nounroll
        for (int t = 0; t < nt; t += 2) {
            const bool last = (t == nt - 2);
            const char* a1 = cA + (size_t)(t + 1) * kstep;
            const char* a2 = last ? nA : cA + (size_t)(t + 2) * kstep; const char* b2 = last ? nB : cB + (size_t)(t + 2) * kstep;
            const char* a3 = a2 + kstep; const char* b3 = b2 + kstep;
            if (last && has_next) S.a_ready(nxt);
            if constexpr (SP2) {
            PG8_LDB(B0, 0, 0); PG8_LDB(B1, 0, 1); PG8_SCHED; PG8_LDA(At, 0, 0); PG8_STAGE(PG8_SA(1, 1), a1 + hstepA, voffA);
            PG8_WAIT_V(8); PG8_WAIT_L(0); PG8_BAR; PG8_MMA(0, 0, At, B0); PG8_MMA(0, 1, At, B1); PG8_BAR; PG8_SCHED;
            PG8_LDA(At, 0, 1); PG8_STAGE(PG8_SB(0, 0), b2, voffB); PG8_STAGE(PG8_SB(0, 1), b2 + hstepB, voffB); PG8_STAGE(PG8_SA(0, 0), a2, voffA);
            PG8_WAIT_V(8); PG8_WAIT_L(0); PG8_BAR; PG8_MMA(1, 0, At, B0); PG8_MMA(1, 1, At, B1); PG8_BAR; PG8_SCHED;
            PG8_LDB(B0, 1, 0); PG8_LDB(B1, 1, 1); PG8_SCHED; PG8_LDA(At, 1, 0); PG8_STAGE(PG8_SA(0, 1), a2 + hstepA, voffA);
            PG8_WAIT_V(8); PG8_WAIT_L(0); PG8_BAR; PG8_MMA(0, 0, At, B0); PG8_MMA(0, 1, At, B1); PG8_BAR; PG8_SCHED;
            PG8_LDA(At, 1, 1); PG8_STAGE(PG8_SB(1, 0), b3, voffB); PG8_STAGE(PG8_SB(1, 1), b3 + hstepB, voffB); PG8_STAGE(PG8_SA(1, 0), a3, voffA);
            PG8_WAIT_V(8); PG8_WAIT_L(0); PG8_BAR; PG8_MMA(1, 0, At, B0); PG8_MMA(1, 1, At, B1); PG8_BAR; PG8_SCHED;
            } else {
            PG8_LDB(B0, 0, 0); PG8_SCHED; PG8_LDA(At, 0, 0); PG8_STAGE(PG8_SA(1, 1), a1 + hstepA, voffA);
            PG8_WAIT_L(8); PG8_BAR; PG8_WAIT_L(0); PG8_MMA(0, 0, At, B0); PG8_BAR; PG8_SCHED;
            PG8_LDB(B1, 0, 1); PG8_STAGE(PG8_SB(0, 0), b2, voffB);
            PG8_BAR; PG8_WAIT_L(0); PG8_MMA(0, 1, At, B1); PG8_BAR;
            PG8_LDA(At, 0, 1); PG8_STAGE(PG8_SA(0, 0), a2, voffA);
            PG8_BAR; PG8_WAIT_L(0); PG8_MMA(1, 0, At, B0); PG8_BAR; PG8_SCHED;
            PG8_STAGE(PG8_SB(0, 1), b2 + hstepB, voffB);
            PG8_WAIT_V(6); PG8_BAR; PG8_MMA(1, 1, At, B1); PG8_BAR;
            PG8_LDB(B0, 1, 0); PG8_SCHED; PG8_LDA(At, 1, 0); PG8_STAGE(PG8_SA(0, 1), a2 + hstepA, voffA);
            PG8_WAIT_L(8); PG8_BAR; PG8_WAIT_L(0); PG8_MMA(0, 0, At, B0); PG8_BAR; PG8_SCHED;
            PG8_LDB(B1, 1, 1); PG8_STAGE(PG8_SB(1, 0), b3, voffB);
            PG8_BAR; PG8_WAIT_L(0); PG8_MMA(0, 1, At, B1); PG8_BAR;
            PG8_LDA(At, 1, 1); PG8_STAGE(PG8_SA(1, 0), a3, voffA);
            PG8_BAR; PG8_WAIT_L(0); PG8_MMA(1, 0, At, B0); PG8_BAR; PG8_SCHED;
            PG8_STAGE(PG8_SB(1, 1), b3 + hstepB, voffB);
            PG8_WAIT_V(6); PG8_BAR; PG8_MMA(1, 1, At, B1); PG8_BAR;
            }
        }
        if constexpr (ALIGN_EPI) { if (wr == 0) PG8_BAR; }
        if constexpr (!Epi::AFTER_DRAIN) { E(acc, cur, wr, wc, fr, fq); S.done(cur); }
        if (!has_next) break;
#pragma unroll
        for (int a = 0; a < 2; ++a)
#pragma unroll
            for (int b = 0; b < 2; ++b)
#pragma unroll
                for (int m = 0; m < 4; ++m)
#pragma unroll
                    for (int n = 0; n < 2; ++n) acc[a][b][m][n] = (f32x4){0.f, 0.f, 0.f, 0.f};
        cur = nxt; cA = nA; cB = nB; ++ui;
        if constexpr (ALIGN_EPI) { if (wr == 1) PG8_BAR; }
    }
    PG8_WAIT_V(0);
    if constexpr (!ALIGN_EPI) { if (wr == 0) PG8_BAR; }
    PG8_BAR;
    if constexpr (Epi::AFTER_DRAIN) { E.fused(acc, cur, wr, wc, fr, fq, lds, wid, lane); S.done(cur); }
#undef PG8_SA
#undef PG8_SB
#undef PG8_STAGE
#undef PG8_LDA
#undef PG8_LDB
#undef PG8_MMA
#undef PG8_WAIT_V
#undef PG8_WAIT_L
#undef PG8_BAR
#undef PG8_SCHED
}
}

#define GAS __attribute__((address_space(1)))
#define LAS __attribute__((address_space(3)))
typedef unsigned short bf16;
typedef unsigned v4u __attribute__((ext_vector_type(4)));
typedef float f32x4 __attribute__((ext_vector_type(4)));
typedef short bf16x8 __attribute__((ext_vector_type(8)));
typedef GAS unsigned gu32;
typedef GAS unsigned long long gu64;
#define RLX_AGENT __ATOMIC_RELAXED, __HIP_MEMORY_SCOPE_AGENT
#define LDS_WAIT() asm volatile("s_waitcnt lgkmcnt(0)" ::: "memory")
#define VM_WAIT() asm volatile("s_waitcnt vmcnt(0)" ::: "memory")
__device__ __forceinline__ unsigned long long rt() { return __builtin_amdgcn_s_memrealtime(); }
__device__ __forceinline__ unsigned f2bf(float f) { unsigned u = __builtin_bit_cast(unsigned, f); return (u + 0x7fffu + ((u >> 16) & 1u)) >> 16; }
__device__ __forceinline__ unsigned pk2(float lo, float hi) { return f2bf(lo) | (f2bf(hi) << 16); }

#define XB_TMO      128
#define XB_XCNT(j)  (256  + 64 * (j))
#define XB_XSUB(j)  (1280 + 64 * (j))
#define XB_XGEN(j)  (2304 + 64 * (j))
#define XB_TOP      3328
#define XB_TOPGEN   3392
#define XCD_BAR_WORDS 3456
#define XB_SPIN_CAP (1u << 18)

__device__ __forceinline__ unsigned xb_ld(unsigned* p)              { return __hip_atomic_load(p, __ATOMIC_RELAXED, __HIP_MEMORY_SCOPE_AGENT); }
__device__ __forceinline__ unsigned xb_add(unsigned* p, unsigned v) { return __hip_atomic_fetch_add(p, v, __ATOMIC_RELAXED, __HIP_MEMORY_SCOPE_AGENT); }
__device__ __forceinline__ unsigned xb_xcc_id() { return (unsigned)__builtin_amdgcn_s_getreg((3 << 11) | 20) & 0xFu; }
#define XB_SPIN(cond, bar) do { unsigned _sp = 0; while (cond) { __builtin_amdgcn_s_sleep(1); \
    if ((++_sp & 255u) == 0u) { if (xb_ld(&(bar)[XB_TMO])) break; if (_sp > XB_SPIN_CAP) { atomicAdd(&(bar)[XB_TMO], 1u); break; } } } } while (0)

struct XcdBarrier {
    unsigned* bar; unsigned x;
    volatile LAS unsigned* st;
};

__device__ __forceinline__ XcdBarrier xcd_barrier_post(unsigned* bar, volatile LAS unsigned* st) {
    XcdBarrier b; b.bar = bar; b.x = xb_xcc_id(); b.st = st;
    if (threadIdx.x == 0) (void)xb_add(&bar[XB_XCNT(b.x)], 1u);
    return b;
}
__device__ __forceinline__ void xcd_barrier_complete(unsigned* bar, unsigned x, unsigned& nloc, unsigned& nx) {
    const unsigned G = gridDim.x * gridDim.y * gridDim.z;
    unsigned sum, cnt, mine, sp = 0u;
    for (;;) {
        sum = 0u; cnt = 0u; mine = 0u;
#pragma unroll
        for (unsigned j = 0; j < 16; ++j) { const unsigned c = xb_ld(&bar[XB_XCNT(j)]); sum += c; cnt += (c > 0u) ? 1u : 0u; mine = (j == x) ? c : mine; }
        if (sum == G) break;
        __builtin_amdgcn_s_sleep(1);
        if ((++sp & 255u) == 0u) { if (xb_ld(&bar[XB_TMO])) break; if (sp > XB_SPIN_CAP) { atomicAdd(&bar[XB_TMO], 1u); break; } }
    }
    nloc = mine > 0u ? mine : 1u; nx = cnt > 0u ? cnt : 1u;
}

__device__ __forceinline__ void xcd_barrier(const XcdBarrier& b) {
    asm volatile("s_waitcnt vmcnt(0)" ::: "memory");
    __syncthreads();
    if (threadIdx.x == 0) {
        unsigned* bar = b.bar;
        __builtin_amdgcn_s_waitcnt(0);
        unsigned nloc = b.st[0], nx = b.st[1];
        if (nloc == 0u) { xcd_barrier_complete(bar, b.x, nloc, nx); b.st[0] = nloc; b.st[1] = nx; }
        const unsigned old = xb_add(&bar[XB_XSUB(b.x)], 1u);
        const unsigned gen = old / nloc;
        if (old + 1u == (gen + 1u) * nloc) {
            __builtin_amdgcn_fence(__ATOMIC_RELEASE, "agent");
            asm volatile("s_waitcnt vmcnt(0)" ::: "memory");
            const unsigned og = xb_add(&bar[XB_TOP], 1u);
            const unsigned tg = og / nx;
            if (og + 1u == (tg + 1u) * nx) xb_add(&bar[XB_TOPGEN], 1u);
            else XB_SPIN(xb_ld(&bar[XB_TOPGEN]) == tg, bar);
            __builtin_amdgcn_fence(__ATOMIC_ACQUIRE, "agent");
            xb_add(&bar[XB_XGEN(b.x)], 1u);
            asm volatile("s_waitcnt vmcnt(0)" ::: "memory");
        } else {
            XB_SPIN(xb_ld(&bar[XB_XGEN(b.x)]) == gen, bar);
            __builtin_amdgcn_fence(__ATOMIC_ACQUIRE, "agent");
            asm volatile("s_waitcnt vmcnt(0)" ::: "memory");
        }
    }
    __syncthreads();
}

constexpr int NWAVES = 8;
constexpr int DM = 2048, NB = 8, SEQ = 2048, CTXL = 256, DFF = 5632, NMOD = 9;
constexpr int MLAT = NB * SEQ, MCTX = NB * CTXL, MTOT = MLAT + MCTX;
constexpr int WIN_N = 2880;
constexpr int PC_CKV = 0, PC_KR = 256, PC_DK = 320, PC_DV = 832, PC_CQ = 1344, PC_DQ = 1856, PC_END = 2368, LDP = 2560;
constexpr int MODROW = NMOD * DM;
constexpr float EPS = 1e-6f;
constexpr float MLA_C = 0.07216878364870322f * 1.4426950408889634f;
constexpr float DIFF_C = 0.125f * 1.4426950408889634f;

constexpr size_t MiB = 1u << 20;
constexpr size_t WS_CTL = 0, CTL_ZERO_BYTES = 1 * MiB;
constexpr size_t WS_MOD = 1 * MiB;
constexpr size_t WS_TAB = 3 * MiB;
constexpr size_t WS_WGU = 4 * MiB;
constexpr size_t WS_WD = WS_WGU + 176 * MiB;
constexpr size_t WS_WIN = WS_WD + 88 * MiB;
constexpr size_t WS_WF1 = WS_WIN + 20 * MiB;
constexpr size_t WS_WUKV = WS_WF1 + 8 * MiB;
constexpr size_t WS_WUQ = WS_WUKV + 2 * MiB;
constexpr size_t WS_WOUT = WS_WUQ + 3 * MiB;
constexpr size_t WS_DFT = WS_WOUT + 16 * MiB;
constexpr size_t WS_DFTC = WS_DFT + 16 * MiB;
constexpr size_t WS_X = WS_DFTC + 1 * MiB;
constexpr size_t WS_H = WS_X + 144 * MiB;
constexpr size_t WS_O = WS_H + 72 * MiB;
constexpr size_t WS_ACT = WS_O + 72 * MiB;
constexpr size_t WS_OD = WS_ACT;
constexpr size_t WS_CT = WS_ACT + 72 * MiB;
constexpr size_t WS_CTC = WS_CT + 32 * MiB;
constexpr size_t WS_P = WS_ACT + 198 * MiB;
constexpr size_t WS_KV = WS_P + 90 * MiB;
constexpr size_t WS_Q = WS_KV + 72 * MiB;
constexpr size_t WS_END = WS_Q + 54 * MiB;
static_assert(WS_CTC + 4 * MiB <= WS_P && (size_t)MTOT * DFF * 2 <= 198 * MiB && (size_t)MTOT * LDP * 2 <= 90 * MiB, "ws map");
constexpr int CW_BAR = 4096;
constexpr int N_STEPS = 66;

constexpr int RING_BYTES = 131072;
constexpr int LDSCTL_OFF = RING_BYTES, MISC_OFF = LDSCTL_OFF + 320;
constexpr int LDS_BYTES = 147456;

typedef unsigned u32x2 __attribute__((ext_vector_type(2)));
typedef float f32x2 __attribute__((ext_vector_type(2)));
__device__ __forceinline__ float bf2f(unsigned short b) { return __builtin_bit_cast(float, ((unsigned)b) << 16); }
__device__ __forceinline__ float wave_sum(float v) {
#pragma unroll
    for (int o = 1; o < 64; o <<= 1) v += __shfl_xor(v, o);
    return v;
}
__device__ __forceinline__ float wave_max(float v) {
#pragma unroll
    for (int o = 1; o < 64; o <<= 1) v = fmaxf(v, __shfl_xor(v, o));
    return v;
}

__device__ __forceinline__ void transpose_item(const float* W, int N, bf16* WT, int ldt, int dest_row0, LAS float* scr, int k0, int n0, int lane) {
#pragma unroll 8
    for (int i = 0; i < 32; ++i) { const int kk = 2 * i + (lane >> 5); scr[kk * 33 + (lane & 31)] = W[(size_t)(k0 + kk) * N + n0 + (lane & 31)]; }
    LDS_WAIT(); asm volatile("" ::: "memory");
    const int c = lane & 7;
#pragma unroll
    for (int j = 0; j < 4; ++j) { const int n = (lane >> 3) + 8 * j; const LAS float* s = scr + (8 * c) * 33 + n;
        v4u o; o.x = pk2(s[0 * 33], s[1 * 33]); o.y = pk2(s[2 * 33], s[3 * 33]); o.z = pk2(s[4 * 33], s[5 * 33]); o.w = pk2(s[6 * 33], s[7 * 33]);
        *(GAS v4u*)(WT + (size_t)(dest_row0 + n) * ldt + k0 + 8 * c) = o; }
    LDS_WAIT(); asm volatile("" ::: "memory");
}

struct Args { const float* in[19]; float* out; unsigned char* ws; int st_lo, st_hi; };
enum { I_X = 0, I_C, I_CTX, I_CCTX, I_ADAW, I_ADAB, I_NORMG, I_WG, I_WU, I_WD, I_WIN, I_QN, I_KVN, I_WUQ, I_WUKV, I_LAM, I_SUBLN, I_WOUT, I_FN };

__device__ __forceinline__ void prologue(const Args& a, LAS unsigned char* lds, int tid, int lane, int wave) {
    asm volatile("" : "+v"(tid)); lane = tid & 63;
    unsigned char* ws = a.ws;
    const int G = gridDim.x, gw = blockIdx.x * NWAVES + wave, NGW = G * NWAVES;
    const int gt = blockIdx.x * (NWAVES * 64) + tid, NGT = G * NWAVES * 64;
    {
        LAS float* scr = (LAS float*)(lds + wave * 8704);
        constexpr int PER_LF = 3 * 5632, N_FFN = 4 * PER_LF, PER_L = 2368 + 256 + 384 + 2048, N_ITEMS = N_FFN + 2 * PER_L;
        for (int it = gw; it < N_ITEMS; it += NGW) {
            if (it < N_FFN) {
                const int lf = it / PER_LF, r = it % PER_LF, which = r / 5632, q = r % 5632;
                if (which < 2) { const int kb = q / 176, nb = q % 176, n0 = nb * 32;
                    const float* W = (which == 0 ? a.in[I_WG] : a.in[I_WU]) + (size_t)lf * DM * DFF;
                    bf16* WT = (bf16*)(ws + WS_WGU) + (size_t)lf * 2 * DFF * DM;
                    transpose_item(W, DFF, WT, DM, (n0 >> 7) * 256 + which * 128 + (n0 & 127), scr, kb * 64, n0, lane);
                } else { const int kb = q / 64, nb = q % 64;
                    transpose_item(a.in[I_WD] + (size_t)lf * DFF * DM, DM, (bf16*)(ws + WS_WD) + (size_t)lf * DM * DFF, DFF, nb * 32, scr, kb * 64, nb * 32, lane); }
            } else {
                int r = it - N_FFN; const int l = r / PER_L; r %= PER_L;
                if (r < 2368) { const int kb = r / 74, nb = r % 74; transpose_item(a.in[I_WIN] + (size_t)l * DM * WIN_N, WIN_N, (bf16*)(ws + WS_WIN) + (size_t)l * LDP * DM, DM, nb * 32, scr, kb * 64, nb * 32, lane); continue; }
                r -= 2368;
                if (r < 256) { const int kb = r / 64, nb = r % 64; transpose_item(a.in[I_WUKV] + (size_t)l * 256 * 2048, 2048, (bf16*)(ws + WS_WUKV) + (size_t)l * 2048 * 256, 256, nb * 32, scr, kb * 64, nb * 32, lane); continue; }
                r -= 256;
                if (r < 384) { const int kb = r / 48, nb = r % 48; transpose_item(a.in[I_WUQ] + (size_t)l * 512 * 1536, 1536, (bf16*)(ws + WS_WUQ) + (size_t)l * 1536 * 512, 512, nb * 32, scr, kb * 64, nb * 32, lane); continue; }
                r -= 384;
                { const int kb = r / 64, nb = r % 64; transpose_item(a.in[I_WOUT] + (size_t)l * DM * DM, DM, (bf16*)(ws + WS_WOUT) + (size_t)l * DM * DM, DM, nb * 32, scr, kb * 64, nb * 32, lane); }
            }
        }
        for (int i = gt; i < 2 * 192 * DM / 8; i += NGT) { const int l = i / (192 * DM / 8), r = i % (192 * DM / 8);
            *(GAS v4u*)((bf16*)(ws + WS_WIN) + (size_t)l * LDP * DM + (size_t)PC_END * DM + (size_t)r * 8) = (v4u){0u, 0u, 0u, 0u}; }
    }
    {
        float* rope = (float*)(ws + WS_TAB);
        if (gt < 1024) { const int pos = gt >> 4, i = gt & 15; const float inv = powf(10000.0f, -(float)i / 16.0f), ang = (float)pos * inv; rope[pos * 32 + i] = cosf(ang); rope[pos * 32 + 16 + i] = sinf(ang); }
        if (gt == 1024) { float* lamv = (float*)(ws + WS_TAB + 16384);
            for (int l = 0; l < 2; ++l) { const float* lf = a.in[I_LAM] + l * 256; float s1 = 0.f, s2 = 0.f;
                for (int i = 0; i < 64; ++i) { s1 += lf[i] * lf[64 + i]; s2 += lf[128 + i] * lf[192 + i]; }
                const float li = 0.8f - 0.6f * expf(-0.3f * (float)l); lamv[2 * l] = expf(s1) - expf(s2) + li; lamv[2 * l + 1] = 1.0f - li; } }
        bf16* dft = (bf16*)(ws + WS_DFT);
        for (int i = gt; i < 2048 * 512; i += NGT) { const int sp = i >> 9, k = (i & 511) * 8, type = k >> 11, s = k & 2047; unsigned w[4];
#pragma unroll
            for (int j = 0; j < 4; ++j) { float v[2];
#pragma unroll
                for (int e = 0; e < 2; ++e) { const int t = ((s + 2 * j + e) * sp) & 2047; float sn, cs; sincospif((float)t * (1.0f / 1024.0f), &sn, &cs); v[e] = (type ? -sn : cs) * (1.0f / 512.0f); }
                w[j] = pk2(v[0], v[1]); }
            *(GAS v4u*)(dft + (size_t)sp * 4096 + k) = (v4u){w[0], w[1], w[2], w[3]}; }
        bf16* dftc = (bf16*)(ws + WS_DFTC);
        for (int i = gt; i < 256 * 64; i += NGT) { const int sp = i >> 6, k = (i & 63) * 8, type = k >> 8, s = k & 255; unsigned w[4];
#pragma unroll
            for (int j = 0; j < 4; ++j) { float v[2];
#pragma unroll
                for (int e = 0; e < 2; ++e) { const int t = ((s + 2 * j + e) * sp) & 255; float sn, cs; sincospif((float)t * (1.0f / 128.0f), &sn, &cs); v[e] = (type ? -sn : cs) * 0.005524271728019903f; }
                w[j] = pk2(v[0], v[1]); }
            *(GAS v4u*)(dftc + (size_t)sp * 512 + k) = (v4u){w[0], w[1], w[2], w[3]}; }
    }
    __syncthreads();
    {
        LAS float* U = (LAS float*)lds;
        LAS float* T = (LAS float*)(lds + 64 * 129 * 4);
        if (tid < 128) { float sn, cs; sincospif((float)tid * (1.0f / 64.0f), &sn, &cs); T[tid] = cs; T[128 + tid] = sn; }
        for (int it = blockIdx.x; it < 2 * 4 * 32; it += G) { const int l = it >> 7, g = (it >> 5) & 3, k0 = (it & 31) * 64;
            __syncthreads();
            const float* src = a.in[I_WIN] + (size_t)l * DM * WIN_N + PC_END + g * 128;
            for (int i = tid; i < 64 * 128; i += NWAVES * 64) { const int r = i >> 7, c = i & 127; U[r * 129 + c] = src[(size_t)(k0 + r) * WIN_N + c]; }
            __syncthreads();
            float ac[16], as[16];
#pragma unroll
            for (int j = 0; j < 16; ++j) { ac[j] = 0.f; as[j] = 0.f; }
            const int cp0 = wave * 16;
            for (int c = 0; c < 128; ++c) { const float uv = U[lane * 129 + c];
#pragma unroll
                for (int j = 0; j < 16; ++j) { const int idx = (c * (cp0 + j)) & 127; ac[j] += uv * T[idx]; as[j] += uv * T[128 + idx]; } }
            bf16* wf = (bf16*)(ws + WS_WF1) + (size_t)l * 1024 * DM;
#pragma unroll
            for (int j = 0; j < 16; ++j) { wf[(size_t)(g * 128 + cp0 + j) * DM + k0 + lane] = (bf16)f2bf(ac[j]); wf[(size_t)(512 + g * 128 + cp0 + j) * DM + k0 + lane] = (bf16)f2bf(as[j]); }
        }
    }
    __syncthreads();
    {
        LAS float* S = (LAS float*)lds;
        LAS float* red = (LAS float*)(lds + 9 * 2048 * 4);
        for (int i = tid; i < 9 * 2048; i += NWAVES * 64) { const int r = i >> 11, k = i & 2047; const float c = r < 8 ? a.in[I_C][r * DM + k] : a.in[I_CCTX][k]; S[i] = c / (1.0f + expf(-c)); }
        __syncthreads();
        float* mod = (float*)(ws + WS_MOD);
        const int cg = tid & 31, ks = tid >> 5;
        for (int ch = blockIdx.x; ch < 2 * 144; ch += G) { const int l = ch / 144, col0 = (ch % 144) * 128;
            const float* W = a.in[I_ADAW] + (size_t)l * DM * MODROW + col0 + 4 * cg;
            f32x4 acc[9];
#pragma unroll
            for (int r = 0; r < 9; ++r) acc[r] = (f32x4){0.f, 0.f, 0.f, 0.f};
#pragma unroll 4
            for (int kk = 0; kk < 128; ++kk) { const int k = ks * 128 + kk; const f32x4 w = *(const f32x4*)(W + (size_t)k * MODROW);
#pragma unroll
                for (int r = 0; r < 9; ++r) acc[r] += w * S[r * 2048 + k]; }
#pragma unroll
            for (int p = 0; p < 3; ++p) {
                __syncthreads();
#pragma unroll
                for (int j = 0; j < 3; ++j) *(LAS f32x4*)(red + (size_t)tid * 12 + 4 * j) = acc[3 * p + j];
                __syncthreads();
                if (tid < 384) { const int cgo = tid / 12, j = tid % 12; float s = 0.f;
#pragma unroll
                    for (int q = 0; q < 16; ++q) s += red[(q * 32 + cgo) * 12 + j];
                    const int r = 3 * p + (j >> 2), col = col0 + 4 * cgo + (j & 3);
                    mod[((size_t)l * 9 + r) * MODROW + col] = s + a.in[I_ADAB][l * MODROW + col]; }
            }
        }
    }
    __syncthreads();
}

__device__ __forceinline__ void norm_mod_phase(const float* src_lat, const float* src_ctx, bf16* H, const float* g, const float* modl, int ish, int isc, int nrows, int gw, int NGW, int lane) {
    asm volatile("" : "+v"(lane));
    for (int r = gw; r < nrows; r += NGW) {
        const float* xr = r < MLAT ? src_lat + (size_t)r * DM : src_ctx + (size_t)(r - MLAT) * DM;
        const float* mr = modl + (size_t)(r < MLAT ? (r >> 11) : 8) * MODROW;
        f32x4 v[8]; float ss = 0.f;
#pragma unroll
        for (int j = 0; j < 8; ++j) { v[j] = ((const f32x4*)xr)[lane + 64 * j]; ss += (v[j].x * v[j].x + v[j].y * v[j].y) + (v[j].z * v[j].z + v[j].w * v[j].w); }
        const float rstd = rsqrtf(wave_sum(ss) * (1.0f / DM) + EPS);
        u32x2* o = (u32x2*)(H + (size_t)r * DM);
#pragma unroll
        for (int j = 0; j < 8; ++j) { const int c4 = lane + 64 * j; const f32x4 gg = ((const f32x4*)g)[c4], sc = ((const f32x4*)(mr + isc * DM))[c4], sh = ((const f32x4*)(mr + ish * DM))[c4];
            const f32x4 y = (v[j] * rstd) * gg * (sc + 1.0f) + sh; u32x2 w; w.x = pk2(y.x, y.y); w.y = pk2(y.z, y.w); o[c4] = w; }
    }
}
__device__ __forceinline__ void final_norm_phase(const float* X, float* out, const float* g, int gw, int NGW, int lane) {
    asm volatile("" : "+v"(lane));
    for (int r = gw; r < MLAT; r += NGW) {
        const f32x4* xr = (const f32x4*)(X + (size_t)r * DM); f32x4 v[8]; float ss = 0.f;
#pragma unroll
        for (int j = 0; j < 8; ++j) { v[j] = xr[lane + 64 * j]; ss += (v[j].x * v[j].x + v[j].y * v[j].y) + (v[j].z * v[j].z + v[j].w * v[j].w); }
        const float rstd = rsqrtf(wave_sum(ss) * (1.0f / DM) + EPS);
        f32x4* o = (f32x4*)(out + (size_t)r * DM);
#pragma unroll
        for (int j = 0; j < 8; ++j) o[lane + 64 * j] = (v[j] * rstd) * ((const f32x4*)g)[lane + 64 * j];
    }
}
__device__ __forceinline__ void postproj_phase(bf16* P, const float* kvn, const float* qn, const float* rope, int nrows, int gw, int NGW, int lane) {
    asm volatile("" : "+v"(lane));
    for (int r = gw; r < nrows; r += NGW) {
        bf16* pr = P + (size_t)r * LDP;
        { u32x2* p = (u32x2*)(pr + PC_CKV) + lane; const u32x2 w = *p; const float x0 = bf2f((unsigned short)(w.x & 0xffff)), x1 = bf2f((unsigned short)(w.x >> 16)), x2 = bf2f((unsigned short)(w.y & 0xffff)), x3 = bf2f((unsigned short)(w.y >> 16));
          const float rstd = rsqrtf(wave_sum((x0 * x0 + x1 * x1) + (x2 * x2 + x3 * x3)) * (1.0f / 256.0f) + EPS); const f32x4 g = ((const f32x4*)kvn)[lane];
          u32x2 o; o.x = pk2(x0 * rstd * g.x, x1 * rstd * g.y); o.y = pk2(x2 * rstd * g.z, x3 * rstd * g.w); *p = o; }
        { v4u* p = (v4u*)(pr + PC_CQ) + lane; const v4u w = *p; float x[8];
          x[0] = bf2f((unsigned short)(w.x & 0xffff)); x[1] = bf2f((unsigned short)(w.x >> 16)); x[2] = bf2f((unsigned short)(w.y & 0xffff)); x[3] = bf2f((unsigned short)(w.y >> 16));
          x[4] = bf2f((unsigned short)(w.z & 0xffff)); x[5] = bf2f((unsigned short)(w.z >> 16)); x[6] = bf2f((unsigned short)(w.w & 0xffff)); x[7] = bf2f((unsigned short)(w.w >> 16));
          float ss = 0.f;
#pragma unroll
          for (int j = 0; j < 8; ++j) ss += x[j] * x[j];
          const float rstd = rsqrtf(wave_sum(ss) * (1.0f / 512.0f) + EPS); const f32x4 g0 = ((const f32x4*)qn)[2 * lane], g1 = ((const f32x4*)qn)[2 * lane + 1];
          v4u o; o.x = pk2(x[0] * rstd * g0.x, x[1] * rstd * g0.y); o.y = pk2(x[2] * rstd * g0.z, x[3] * rstd * g0.w); o.z = pk2(x[4] * rstd * g1.x, x[5] * rstd * g1.y); o.w = pk2(x[6] * rstd * g1.z, x[7] * rstd * g1.w); *p = o; }
        if (r < MLAT) { const int s = r & 2047, prow = s >> 6, pcol = s & 63;
            for (int p = lane; p < 544; p += 64) { const int v = p >> 5, q = p & 31, half = q >> 4, i = q & 15;
                const int cb = v == 0 ? PC_KR : (v <= 8 ? PC_DK + (v - 1) * 64 : PC_DQ + (v - 9) * 64), ia = cb + half * 32 + i, pos = half ? pcol : prow;
                const float cs = rope[pos * 32 + i], sn = rope[pos * 32 + 16 + i], x1 = bf2f(pr[ia]), x2 = bf2f(pr[ia + 16]);
                pr[ia] = (bf16)f2bf(x1 * cs - x2 * sn); pr[ia + 16] = (bf16)f2bf(x1 * sn + x2 * cs); } }
    }
}
__device__ __forceinline__ void diff_combine_phase(const float* OD, bf16* O, const float* subln, float lam, float omli, int nrows, int gw, int NGW, int lane) {
    asm volatile("" : "+v"(lane));
    for (int it = gw; it < nrows * 4; it += NGW) { const int r = it >> 2, hh = it & 3;
        const f32x2 o1 = *(const f32x2*)(OD + (size_t)r * 1024 + (2 * hh) * 128 + 2 * lane), o2 = *(const f32x2*)(OD + (size_t)r * 1024 + (2 * hh + 1) * 128 + 2 * lane);
        const float v0 = o1.x - lam * o2.x, v1 = o1.y - lam * o2.y;
        const float rstd = rsqrtf(wave_sum(v0 * v0 + v1 * v1) * (1.0f / 128.0f) + EPS); const f32x2 g = *(const f32x2*)(subln + 2 * lane);
        *(unsigned*)(O + (size_t)r * DM + 1024 + hh * 128 + 2 * lane) = pk2(v0 * rstd * g.x * omli, v1 * rstd * g.y * omli); }
}

template <int DKA, bool HAS_B, bool OUT_BF16>
__device__ __forceinline__ void naive_attn_item(const bf16* Qp, int ldq, const bf16* Ka, int ldka, const bf16* Kb, int ldkb, const bf16* Vp, int ldv,
                                                int seg0_row, int seg0_n, int seg1_row, int seg1_n, float c_log2e, void* outp, int ldo, LAS float* qs, LAS float* ps, int lane) {
    constexpr int DQK = DKA + (HAS_B ? 64 : 0);
    for (int qi = 0; qi < 4; ++qi) for (int d = lane; d < DQK; d += 64) qs[qi * DQK + d] = bf2f(Qp[(size_t)qi * ldq + d]);
    __builtin_amdgcn_wave_barrier(); asm volatile("s_waitcnt lgkmcnt(0)" ::: "memory");
    float m[4], l[4], o0[4], o1[4];
#pragma unroll
    for (int qi = 0; qi < 4; ++qi) { m[qi] = -1e30f; l[qi] = 0.f; o0[qi] = 0.f; o1[qi] = 0.f; }
    for (int seg = 0; seg < 2; ++seg) { const int srow = seg ? seg1_row : seg0_row, sn = seg ? seg1_n : seg0_n;
        for (int t0 = 0; t0 < sn; t0 += 64) { const int krow = srow + t0 + lane; float s[4] = {0.f, 0.f, 0.f, 0.f};
            for (int c = 0; c < DKA / 8; ++c) { const v4u kw = *(const v4u*)(Ka + (size_t)krow * ldka + 8 * c); float kf[8];
                kf[0] = bf2f((unsigned short)(kw.x & 0xffff)); kf[1] = bf2f((unsigned short)(kw.x >> 16)); kf[2] = bf2f((unsigned short)(kw.y & 0xffff)); kf[3] = bf2f((unsigned short)(kw.y >> 16));
                kf[4] = bf2f((unsigned short)(kw.z & 0xffff)); kf[5] = bf2f((unsigned short)(kw.z >> 16)); kf[6] = bf2f((unsigned short)(kw.w & 0xffff)); kf[7] = bf2f((unsigned short)(kw.w >> 16));
#pragma unroll
                for (int qi = 0; qi < 4; ++qi) { const f32x4 qa = *(const LAS f32x4*)(qs + qi * DQK + 8 * c), qb = *(const LAS f32x4*)(qs + qi * DQK + 8 * c + 4);
                    s[qi] += (qa.x * kf[0] + qa.y * kf[1]) + (qa.z * kf[2] + qa.w * kf[3]) + (qb.x * kf[4] + qb.y * kf[5]) + (qb.z * kf[6] + qb.w * kf[7]); } }
            if (HAS_B) for (int c = 0; c < 8; ++c) { const v4u kw = *(const v4u*)(Kb + (size_t)krow * ldkb + 8 * c); float kf[8];
                kf[0] = bf2f((unsigned short)(kw.x & 0xffff)); kf[1] = bf2f((unsigned short)(kw.x >> 16)); kf[2] = bf2f((unsigned short)(kw.y & 0xffff)); kf[3] = bf2f((unsigned short)(kw.y >> 16));
                kf[4] = bf2f((unsigned short)(kw.z & 0xffff)); kf[5] = bf2f((unsigned short)(kw.z >> 16)); kf[6] = bf2f((unsigned short)(kw.w & 0xffff)); kf[7] = bf2f((unsigned short)(kw.w >> 16));
#pragma unroll
                for (int qi = 0; qi < 4; ++qi) { const f32x4 qa = *(const LAS f32x4*)(qs + qi * DQK + DKA + 8 * c), qb = *(const LAS f32x4*)(qs + qi * DQK + DKA + 8 * c + 4);
                    s[qi] += (qa.x * kf[0] + qa.y * kf[1]) + (qa.z * kf[2] + qa.w * kf[3]) + (qb.x * kf[4] + qb.y * kf[5]) + (qb.z * kf[6] + qb.w * kf[7]); } }
            f32x4 pv4;
#pragma unroll
            for (int qi = 0; qi < 4; ++qi) { const float sc = s[qi] * c_log2e, mn = fmaxf(m[qi], wave_max(sc)), alpha = __builtin_amdgcn_exp2f(m[qi] - mn), p = __builtin_amdgcn_exp2f(sc - mn);
                l[qi] = l[qi] * alpha + wave_sum(p); o0[qi] *= alpha; o1[qi] *= alpha; m[qi] = mn; pv4[qi] = p; }
            *(LAS f32x4*)(ps + 4 * lane) = pv4;
            __builtin_amdgcn_wave_barrier(); asm volatile("s_waitcnt lgkmcnt(0)" ::: "memory");
            const bf16* vb = Vp + (size_t)(srow + t0) * ldv + 2 * lane;
#pragma unroll 8
            for (int k = 0; k < 64; ++k) { const f32x4 p4 = *(const LAS f32x4*)(ps + 4 * k); const unsigned vw = *(const unsigned*)(vb + (size_t)k * ldv);
                const float v0 = bf2f((unsigned short)(vw & 0xffff)), v1 = bf2f((unsigned short)(vw >> 16));
#pragma unroll
                for (int qi = 0; qi < 4; ++qi) { o0[qi] += p4[qi] * v0; o1[qi] += p4[qi] * v1; } }
            __builtin_amdgcn_wave_barrier(); asm volatile("s_waitcnt lgkmcnt(0)" ::: "memory");
        } }
#pragma unroll
    for (int qi = 0; qi < 4; ++qi) { const float rl = 1.0f / l[qi];
        if (OUT_BF16) *(unsigned*)((bf16*)outp + (size_t)qi * ldo + 2 * lane) = pk2(o0[qi] * rl, o1[qi] * rl);
        else *(f32x2*)((float*)outp + (size_t)qi * ldo + 2 * lane) = (f32x2){o0[qi] * rl, o1[qi] * rl}; }
}
__device__ __forceinline__ void naive_attn_phase(unsigned char* ws, bool with_ctx, LAS unsigned char* lds, int gw, int NGW, int wave, int lane) {
    asm volatile("" : "+v"(lane));
    const bf16* P = (const bf16*)(ws + WS_P); const bf16* KV = (const bf16*)(ws + WS_KV); const bf16* Q = (const bf16*)(ws + WS_Q);
    bf16* O = (bf16*)(ws + WS_O); float* OD = (float*)(ws + WS_OD);
    LAS float* qs = (LAS float*)(lds + wave * 4096); LAS float* ps = qs + 768;
    const int n_lat = NB * 8 * (SEQ / 4), n_ctx = with_ctx ? NB * 8 * (CTXL / 4) : 0, total = 2 * n_lat + 2 * n_ctx;
    for (int it = gw; it < total; it += NGW) {
        int r = it, kind, isctx;
        if (r < n_lat) { kind = 0; isctx = 0; } else if ((r -= n_lat) < n_lat) { kind = 1; isctx = 0; } else if ((r -= n_lat) < n_ctx) { kind = 0; isctx = 1; } else { r -= n_ctx; kind = 1; isctx = 1; }
        const int per_bh = isctx ? CTXL / 4 : SEQ / 4, b = r / (8 * per_bh), h = (r / per_bh) & 7, q0 = (r % per_bh) * 4;
        const int row0 = isctx ? MLAT + b * CTXL + q0 : b * SEQ + q0;
        const int seg0 = MLAT + b * CTXL, seg1 = b * SEQ, seg1n = isctx ? 0 : SEQ;
        if (kind == 0) naive_attn_item<128, true, true>(Q + (size_t)row0 * 1536 + h * 192, 1536, KV + h * 256, DM, P + PC_KR, LDP, KV + h * 256 + 128, DM, seg0, CTXL, seg1, seg1n, MLA_C, O + (size_t)row0 * DM + h * 128, DM, qs, ps, lane);
        else naive_attn_item<64, false, false>(P + (size_t)row0 * LDP + PC_DQ + h * 64, LDP, P + PC_DK + h * 64, LDP, nullptr, 0, P + PC_DV + (h >> 1) * 128, LDP, seg0, CTXL, seg1, seg1n, DIFF_C, OD + (size_t)row0 * 1024 + h * 128, 1024, qs, ps, lane);
    }
}

#ifndef GSMASK
#define GSMASK 0xffffffffu
#endif
#define GS(n) ((GSMASK >> (n)) & 1u)
__global__ void __launch_bounds__(NWAVES * 64, 2) mega(Args a) {
    extern __shared__ __attribute__((aligned(16))) unsigned char lds_raw[];
    LAS unsigned char* lds = (LAS unsigned char*)lds_raw;
    volatile LAS unsigned* MISC = (volatile LAS unsigned*)(lds + MISC_OFF);
    const int tid = threadIdx.x, lane = tid & 63, wave = __builtin_amdgcn_readfirstlane(tid >> 6);
    const int G = gridDim.x, gw = blockIdx.x * NWAVES + wave, NGW = G * NWAVES;
    unsigned char* ws = a.ws;
    for (int u = tid; u < (LDS_BYTES - LDSCTL_OFF) / 4; u += NWAVES * 64) ((LAS unsigned*)(lds + LDSCTL_OFF))[u] = 0u;
    __syncthreads();
    const int lo = a.st_lo, hi = a.st_hi;
    XcdBarrier bar; bar.bar = (unsigned*)(ws + WS_CTL) + CW_BAR; bar.x = 0; bar.st = nullptr;
    if (hi - lo > 1) bar = xcd_barrier_post((unsigned*)(ws + WS_CTL) + CW_BAR, MISC + 8);
#define IN(k) (lo <= (k) && (k) < hi)
#define SEAM(k) do { if (hi > (k) + 1) xcd_barrier(bar); else __syncthreads(); } while (0)
    float* X = (float*)(ws + WS_X); bf16* H = (bf16*)(ws + WS_H); bf16* O = (bf16*)(ws + WS_O); bf16* ACT = (bf16*)(ws + WS_ACT); bf16* P = (bf16*)(ws + WS_P);
    bf16* KV = (bf16*)(ws + WS_KV); bf16* Q = (bf16*)(ws + WS_Q); float* OD = (float*)(ws + WS_OD); bf16* CT = (bf16*)(ws + WS_CT); bf16* CTC = (bf16*)(ws + WS_CTC);
    const float* MOD = (const float*)(ws + WS_MOD); const float* ROPE = (const float*)(ws + WS_TAB); const float* LAMV = (const float*)(ws + WS_TAB + 16384);
    LAS unsigned char* ring = lds;

#ifndef NO_PRO
    if (IN(0)) { prologue(a, lds, tid, lane, wave); SEAM(0); }
#endif

    for (int fi = 0; fi < 4; ++fi) {
        const int base = 1 + 16 * fi, l = fi >> 1, f = fi & 1;
        const int Mf = (fi == 3) ? MLAT : MTOT;
        const float* modl = MOD + (size_t)l * 9 * MODROW;
        const float* xin_lat = (fi == 0) ? a.in[I_X] : X; const float* xin_ctx = (fi == 0) ? a.in[I_CTX] : X + (size_t)MLAT * DM;
        if (IN(base + 0)) { norm_mod_phase(xin_lat, xin_ctx, H, a.in[I_NORMG] + (size_t)(l * 3 + 2 * f) * DM, modl, 6 * f + 0, 6 * f + 1, Mf, gw, NGW, lane); SEAM(base + 0); }
        if (IN(base + 1)) {
            pg8::Gemm g{H, (const bf16*)(ws + WS_WGU) + (size_t)fi * 2 * DFF * DM, Mf, 2 * DFF, DM, DM, DM}; pg8::StaticOrder S; S.init(Mf, 2 * DFF, G, (int)blockIdx.x);
            pg8::EpiSwiglu E{ACT, DFF};
            if (GS(1)) pg8::gemm_phase<pg8::EpiSwiglu, pg8::StaticOrder, true, true>(ring, g, S, E);
            SEAM(base + 1);
        }
        if (IN(base + 2)) {
            pg8::Gemm g{ACT, (const bf16*)(ws + WS_WD) + (size_t)fi * DM * DFF, Mf, DM, DFF, DFF, DFF}; pg8::StaticOrder S; S.init(Mf, DM, G, (int)blockIdx.x);
            pg8::EpiResid E{xin_lat, xin_ctx, X, modl + (6 * f + 2) * DM, 0.5f};
            if (GS(2)) pg8::gemm_phase<pg8::EpiResid, pg8::StaticOrder, true, true>(ring, g, S, E);
            SEAM(base + 2);
        }
        if (f == 0) {
            const int Mq = (l == 0) ? MTOT : MLAT;
            if (IN(base + 3)) { norm_mod_phase(X, X + (size_t)MLAT * DM, H, a.in[I_NORMG] + (size_t)(l * 3 + 1) * DM, modl, 3, 4, MTOT, gw, NGW, lane); SEAM(base + 3); }
            if (IN(base + 4)) {
                { pg8::Gemm g{H, (const bf16*)(ws + WS_WIN) + (size_t)l * LDP * DM, MTOT, LDP, DM, DM, DM}; pg8::StaticOrder S; S.init(MTOT, LDP, G, (int)blockIdx.x);
                  pg8::EpiStoreBf16 E{P, LDP};
                  if (GS(3)) pg8::gemm_phase<pg8::EpiStoreBf16, pg8::StaticOrder, true, true>(ring, g, S, E); }
                __syncthreads();
                { pg8::Gemm g{(const bf16*)(ws + WS_WF1) + (size_t)l * 1024 * DM, H, 1024, Mq, DM, DM, DM}; pg8::StaticOrder S; S.init(1024, Mq, G, (int)((blockIdx.x + 48) % G));
                  pg8::EpiF1 E{CT, CTC};
                  if (GS(4)) pg8::gemm_phase<pg8::EpiF1, pg8::StaticOrder, true, true>(ring, g, S, E); }
                SEAM(base + 4);
            }
            if (IN(base + 5)) { postproj_phase(P, a.in[I_KVN] + l * 256, a.in[I_QN] + l * 512, ROPE, MTOT, gw, NGW, lane); SEAM(base + 5); }
            if (IN(base + 6)) {
                { pg8::Gemm g{P + PC_CKV, (const bf16*)(ws + WS_WUKV) + (size_t)l * 2048 * 256, MTOT, 2048, 256, LDP, 256}; pg8::StaticOrder S; S.init(MTOT, 2048, G, (int)blockIdx.x);
                  pg8::EpiStoreBf16 E{KV, DM};
                  if (GS(5)) pg8::gemm_phase<pg8::EpiStoreBf16, pg8::StaticOrder, true, true>(ring, g, S, E); }
                __syncthreads();
                { pg8::Gemm g{P + PC_CQ, (const bf16*)(ws + WS_WUQ) + (size_t)l * 1536 * 512, Mq, 1536, 512, LDP, 512}; pg8::StaticOrder S; S.init(Mq, 1536, G, (int)((blockIdx.x + 64) % G));
                  pg8::EpiRopeQ E{Q, 1536, ROPE};
                  if (GS(6)) pg8::gemm_phase<pg8::EpiRopeQ, pg8::StaticOrder, true, true>(ring, g, S, E); }
                SEAM(base + 6);
            }
            if (IN(base + 7)) {
#ifndef NO_ATT
                naive_attn_phase(ws, l == 0, lds, gw, NGW, wave, lane);
#endif
                __syncthreads();
                { pg8::Gemm g{(const bf16*)(ws + WS_DFT), CT, SEQ, NB * 512, 4096, 4096, 4096}; pg8::StaticOrder S; S.init(SEQ, NB * 512, G, (int)blockIdx.x);
                  pg8::EpiF2 E{O, 0, SEQ};
                  if (GS(7)) pg8::gemm_phase<pg8::EpiF2, pg8::StaticOrder, true, true>(ring, g, S, E); }
                if (l == 0) {
                  __syncthreads();
                  pg8::Gemm g{(const bf16*)(ws + WS_DFTC), CTC, CTXL, NB * 512, 512, 512, 512}; pg8::StaticOrder S; S.init(CTXL, NB * 512, G, (int)((blockIdx.x + 128) % G));
                  pg8::EpiF2 E{O, MLAT, CTXL};
                  if (GS(8)) pg8::gemm_phase<pg8::EpiF2, pg8::StaticOrder, true, true>(ring, g, S, E); }
                SEAM(base + 7);
            }
            if (IN(base + 8)) { diff_combine_phase(OD, O, a.in[I_SUBLN] + l * 128, LAMV[2 * l], LAMV[2 * l + 1], Mq, gw, NGW, lane); SEAM(base + 8); }
            if (IN(base + 9)) {
                pg8::Gemm g{O, (const bf16*)(ws + WS_WOUT) + (size_t)l * DM * DM, Mq, DM, DM, DM, DM}; pg8::StaticOrder S; S.init(Mq, DM, G, (int)blockIdx.x);
                pg8::EpiResid E{X, X + (size_t)MLAT * DM, X, modl + 5 * DM, 1.0f};
                if (GS(9)) pg8::gemm_phase<pg8::EpiResid, pg8::StaticOrder, true, true>(ring, g, S, E);
                SEAM(base + 9);
            }
        }
    }
    if (IN(65)) final_norm_phase(X, a.out, a.in[I_FN], gw, NGW, lane);
#undef IN
#undef SEAM
}

extern "C" void kernel_launch(void* const* d_in, const int* in_sizes, int n_in, void* d_out, int out_size, void* d_ws, size_t ws_size, hipStream_t stream) {
    static int grid = 0;
    if (grid == 0) {
        if (n_in != 19 || out_size != MLAT * DM || ws_size < WS_END) { fprintf(stderr, "kernel_launch: unexpected shapes (n_in %d, out %d, ws %zu < %zu)\n", n_in, out_size, ws_size, (size_t)WS_END); grid = -1; return; }
        int dev = 0, cus = 0, per_cu = 0;
        if (hipGetDevice(&dev) != hipSuccess || hipDeviceGetAttribute(&cus, hipDeviceAttributeMultiprocessorCount, dev) != hipSuccess) { grid = -1; return; }
        if (hipFuncSetAttribute((const void*)mega, hipFuncAttributeMaxDynamicSharedMemorySize, LDS_BYTES) != hipSuccess) { fprintf(stderr, "kernel_launch: hipFuncSetAttribute failed\n"); grid = -1; return; }
        if (hipOccupancyMaxActiveBlocksPerMultiprocessor(&per_cu, (const void*)mega, NWAVES * 64, LDS_BYTES) != hipSuccess || per_cu < 1) { fprintf(stderr, "kernel_launch: occupancy query says %d\n", per_cu); }
        (void)hipGetLastError();
        grid = cus;
    }
    if (grid < 0) return;
    (void)hipMemsetAsync((char*)d_ws + WS_CTL, 0, CTL_ZERO_BYTES, stream);
    Args a{};
    for (int i = 0; i < 19; ++i) a.in[i] = (const float*)d_in[i];
    a.out = (float*)d_out; a.ws = (unsigned char*)d_ws;
#ifndef MK_ONE_LAUNCH
#define MK_ONE_LAUNCH 0
#endif
    if (MK_ONE_LAUNCH) { a.st_lo = 0; a.st_hi = N_STEPS; hipLaunchKernelGGL(mega, dim3(grid), dim3(NWAVES * 64), LDS_BYTES, stream, a); }
    else {
        int steps[64]; int ns = 0; steps[ns++] = 0;
        for (int fi = 0; fi < 4; ++fi) { const int base = 1 + 16 * fi; for (int k = 0; k < 3; ++k) steps[ns++] = base + k; if ((fi & 1) == 0) for (int k = 3; k < 10; ++k) steps[ns++] = base + k; }
        steps[ns++] = 65;
        for (int i = 0; i < ns; ++i) { a.st_lo = steps[i]; a.st_hi = steps[i] + 1; hipLaunchKernelGGL(mega, dim3(grid), dim3(NWAVES * 64), LDS_BYTES, stream, a); }
    }
    const hipError_t le = hipPeekAtLastError();
    if (le != hipSuccess) fprintf(stderr, "kernel_launch: launch failed: %s\n", hipGetErrorName(le));
}
```

```cpp
#include <hip/hip_runtime.h>
#include <cstdio>
#include <cstdint>
#ifndef DUPMASK
#define DUPMASK 0u
#endif
#define NREP(k) (1 + (int)((DUPMASK >> (k)) & 1u))
namespace pg8 {
#define PG8_LAS __attribute__((address_space(3)))
typedef unsigned short bf16_t;
typedef short bf16x8 __attribute__((ext_vector_type(8)));
typedef float f32x4 __attribute__((ext_vector_type(4)));
typedef float f32x2 __attribute__((ext_vector_type(2)));
typedef unsigned u32x4 __attribute__((ext_vector_type(4)));
typedef unsigned u32x2 __attribute__((ext_vector_type(2)));
constexpr int BM = 256, BK = 64, HALF = 128, HTB = HALF * BK * 2  , STAGE_BYTES = 8 * HTB, NXCD = 8, WGM = 8;

__host__ __device__ __forceinline__ int lds_byte(int r, int c) { const int st = (r >> 4) * 2 + (c >> 5), rr = r & 15, cc = c & 31, ob = rr * 64 + cc * 2; return st * 1024 + (ob ^ (((ob >> 9) & 1) << 5)); }
__host__ __device__ __forceinline__ void stage_rc(int b, int& R, int& C) { const int st = b / 1024, sb = b % 1024, swz = sb ^ (((sb >> 9) & 1) << 5); R = (st >> 1) * 16 + swz / 64; C = (st & 1) * 32 + (swz % 64) / 2; }
__host__ __device__ __forceinline__ int perm32(int rho) { const int n = rho >> 4, i = rho & 15; return 8 * (i >> 2) + 4 * n + (i & 3); }

struct Unit { int pm, pn, koA, koB, ks, nt; };
struct Gemm { const bf16_t* A; const bf16_t* Bt; int M, N, K, lda, ldb, ksA, ksB; size_t tsA, tsB; };
__host__ __device__ __forceinline__ Gemm mk_gemm(const bf16_t* A, const bf16_t* Bt, int M, int N, int K, int lda, int ldb) { return Gemm{A, Bt, M, N, K, lda, ldb, BK * 2, BK * 2, (size_t)BM * lda * 2, (size_t)BM * ldb * 2}; }

struct StaticOrder {
    int nM, nN, nwg, G, c;
    __host__ __device__ void init(int M, int N, int G_, int c_) { nM = M / BM; nN = N / BM; nwg = nM * nN; G = G_; c = c_; }
    __host__ __device__ bool next(int i, Unit& u) const {
        const long L = (long)i * G + c; if (L >= nwg) return false;
        int wgid = (int)L; { const int q = nwg / NXCD, r = nwg % NXCD, xcd = wgid % NXCD, off = wgid / NXCD; wgid = (xcd < r ? xcd * (q + 1) : r * (q + 1) + (xcd - r) * q) + off; }
        const int nig = WGM * nN, gid = wgid / nig, fm = gid * WGM, gsz = (nM - fm) < WGM ? (nM - fm) : WGM;
        u.pm = fm + ((wgid % nig) % gsz); u.pn = (wgid % nig) / gsz; u.koA = 0; u.koB = 0; u.ks = 0; u.nt = 0; return true;
    }
    __device__ __forceinline__ void a_ready(const Unit&) const {}
    __device__ __forceinline__ void done(const Unit&) const {}
};
struct SplitKOrder {
    int nM, nN, KS, G, c, kpartA, kpartB;
    __host__ __device__ void init(int M, int N, int KS_, int kpartA_, int kpartB_, int G_, int c_) { nM = M / BM; nN = N / BM; KS = KS_; kpartA = kpartA_; kpartB = kpartB_; G = G_; c = c_; }
    __host__ __device__ bool next(int i, Unit& u) const {
        const long L = (long)i * G + c; const int per = nM * nN; if (L >= (long)per * KS) return false;
        const int ks = (int)(L / per), r = (int)(L % per); u.pm = r % nM; u.pn = r / nM; u.ks = ks; u.koA = ks * kpartA; u.koB = ks * kpartB; u.nt = 0; return true;
    }
    __device__ __forceinline__ void a_ready(const Unit&) const {}
    __device__ __forceinline__ void done(const Unit&) const {}
};

struct PanelOrder {
    int nM, nN, G, c;
    __host__ __device__ void init(int M, int N, int G_, int c_) { nM = M / BM; nN = N / BM; G = G_; c = c_; }
    __host__ __device__ bool next(int i, Unit& u) const {
        const int per_x = G / NXCD, xcd = c % NXCD, idx = i * per_x + c / NXCD, pml = idx / nN;
        if (pml >= nM / NXCD) return false;
        u.pm = xcd * (nM / NXCD) + pml; u.pn = idx % nN; u.koA = 0; u.koB = 0; u.ks = 0; u.nt = 0; return true;
    }
    __device__ __forceinline__ void a_ready(const Unit&) const {}
    __device__ __forceinline__ void done(const Unit&) const {}
};
struct LatCtxOrder {
    PanelOrder lat; int G, c, n_lat_rounds, kpartA, kpartB, nt_part, with_ctx;
    __host__ __device__ void init(int G_, int c_, int kpartA_, int kpartB_, int nt_part_, int with_ctx_) { lat.init(16384, 2048, G_, c_); G = G_; c = c_; n_lat_rounds = (64 * 8 + G_ - 1) / G_; kpartA = kpartA_; kpartB = kpartB_; nt_part = nt_part_; with_ctx = with_ctx_; }
    __host__ __device__ bool next(int i, Unit& u) const {
        if (i < n_lat_rounds) { if (lat.next(i, u)) return true; }
        if (!with_ctx) return false;
        const long L = (long)(i - n_lat_rounds) * G + c; if (i < n_lat_rounds || L >= 256) return false;
        const int ks = (int)(L >> 6), r = (int)(L & 63); u.pm = 64 + (r & 7); u.pn = r >> 3; u.ks = ks; u.koA = ks * kpartA; u.koB = ks * kpartB; u.nt = nt_part; return true;
    }
    __device__ __forceinline__ void a_ready(const Unit&) const {}
    __device__ __forceinline__ void done(const Unit&) const {}
};
__device__ __forceinline__ unsigned cvt_pk_bf16(float lo, float hi) { unsigned r; asm volatile("v_cvt_pk_bf16_f32 %0, %1, %2" : "=v"(r) : "v"(lo), "v"(hi)); return r; }
__device__ __forceinline__ float silu_f(float x) { return x * __builtin_amdgcn_rcpf(1.0f + __builtin_amdgcn_exp2f(-1.4426950408889634f * x)); }

constexpr int E_DM = 2048, E_MLAT = 16384, E_MODROW = 9 * 2048;

struct EpiSwiglu {
    static constexpr bool PERM = true, AFTER_DRAIN = false;
    bf16_t* O; int nkt; int skip;
    __device__ __forceinline__ void operator()(const f32x4 (&acc)[2][2][4][2], const Unit& u, int wr, int wc, int fr, int fq) const {
        if (skip && acc[0][0][0][0][0] != 1.2345e30f) return;
        bf16_t* base = O + (((size_t)u.pm * nkt + 2 * u.pn + (wc >> 1)) * BM + wr * 64 + fr) * 64 + (wc & 1) * 32 + 8 * fq;
#pragma unroll
        for (int ai = 0; ai < 2; ++ai)
#pragma unroll
            for (int m = 0; m < 4; ++m) { bf16_t* rowp = base + (size_t)(ai * HALF + m * 16) * 64;
                const f32x4 g0 = acc[ai][0][m][0], g1 = acc[ai][0][m][1], u0 = acc[ai][1][m][0], u1 = acc[ai][1][m][1];
                u32x4 w; w.x = cvt_pk_bf16(silu_f(g0[0]) * u0[0], silu_f(g0[1]) * u0[1]); w.y = cvt_pk_bf16(silu_f(g0[2]) * u0[2], silu_f(g0[3]) * u0[3]);
                w.z = cvt_pk_bf16(silu_f(g1[0]) * u1[0], silu_f(g1[1]) * u1[1]); w.w = cvt_pk_bf16(silu_f(g1[2]) * u1[2], silu_f(g1[3]) * u1[3]);
                *(u32x4*)rowp = w; }
    }
};
struct EpiStoreBf16 {
    static constexpr bool PERM = true, AFTER_DRAIN = false;
    bf16_t* O; int ldc;
    __device__ __forceinline__ void operator()(const f32x4 (&acc)[2][2][4][2], const Unit& u, int wr, int wc, int fr, int fq) const {
        const int row0 = u.pm * BM + wr * 64 + fr, col0 = u.pn * BM + wc * 32 + 8 * fq;
#pragma unroll
        for (int ai = 0; ai < 2; ++ai)
#pragma unroll
            for (int m = 0; m < 4; ++m) { bf16_t* rowp = O + (size_t)(row0 + ai * HALF + m * 16) * ldc + col0;
#pragma unroll
                for (int bj = 0; bj < 2; ++bj) { const f32x4 v0 = acc[ai][bj][m][0], v1 = acc[ai][bj][m][1];
                    u32x4 w; w.x = cvt_pk_bf16(v0[0], v0[1]); w.y = cvt_pk_bf16(v0[2], v0[3]); w.z = cvt_pk_bf16(v1[0], v1[1]); w.w = cvt_pk_bf16(v1[2], v1[3]);
                    *(u32x4*)(rowp + bj * HALF) = w; } }
    }
};
struct EpiDelta {
    static constexpr bool PERM = true, AFTER_DRAIN = false;
    bf16_t* D; const float* gate; float coef; int first;
    __device__ __forceinline__ void operator()(const f32x4 (&acc)[2][2][4][2], const Unit& u, int wr, int wc, int fr, int fq) const {
        const int row0 = u.pm * BM + wr * 64 + fr, col0 = u.pn * BM + wc * 32 + 8 * fq; const float* gp = gate + (size_t)(u.pm >> 3) * E_MODROW + col0;
        f32x4 gv[2][2];
#pragma unroll
        for (int bj = 0; bj < 2; ++bj)
#pragma unroll
            for (int n = 0; n < 2; ++n) gv[bj][n] = *(const f32x4*)(gp + bj * HALF + 4 * n) * coef;
#pragma unroll
        for (int ai = 0; ai < 2; ++ai) { u32x4 old[4][2];
            if (!first) {
#pragma unroll
                for (int m = 0; m < 4; ++m)
#pragma unroll
                    for (int bj = 0; bj < 2; ++bj) old[m][bj] = *(const u32x4*)(D + (size_t)(row0 + ai * HALF + m * 16) * E_DM + col0 + bj * HALF);
                asm volatile("" ::: "memory"); }
#pragma unroll
            for (int m = 0; m < 4; ++m) { bf16_t* rowp = D + (size_t)(row0 + ai * HALF + m * 16) * E_DM + col0;
#pragma unroll
                for (int bj = 0; bj < 2; ++bj) { f32x4 v0 = acc[ai][bj][m][0] * gv[bj][0], v1 = acc[ai][bj][m][1] * gv[bj][1];
                    if (!first) { const u32x4 o = old[m][bj];
                        v0[0] += __builtin_bit_cast(float, o.x << 16); v0[1] += __builtin_bit_cast(float, o.x & 0xffff0000u); v0[2] += __builtin_bit_cast(float, o.y << 16); v0[3] += __builtin_bit_cast(float, o.y & 0xffff0000u);
                        v1[0] += __builtin_bit_cast(float, o.z << 16); v1[1] += __builtin_bit_cast(float, o.z & 0xffff0000u); v1[2] += __builtin_bit_cast(float, o.w << 16); v1[3] += __builtin_bit_cast(float, o.w & 0xffff0000u); }
                    u32x4 w; w.x = cvt_pk_bf16(v0[0], v0[1]); w.y = cvt_pk_bf16(v0[2], v0[3]); w.z = cvt_pk_bf16(v1[0], v1[1]); w.w = cvt_pk_bf16(v1[2], v1[3]);
                    *(u32x4*)(rowp + bj * HALF) = w; } }
            asm volatile("" ::: "memory"); }
    }
};
struct EpiPartial {
    static constexpr bool PERM = true, AFTER_DRAIN = false;
    bf16_t* part; int rows;
    __device__ __forceinline__ void operator()(const f32x4 (&acc)[2][2][4][2], const Unit& u, int wr, int wc, int fr, int fq) const {
        bf16_t* out = part + ((size_t)u.ks * rows + (size_t)u.pm * BM + wr * 64 + fr) * E_DM + u.pn * BM + wc * 32 + 8 * fq;
#pragma unroll
        for (int ai = 0; ai < 2; ++ai)
#pragma unroll
            for (int m = 0; m < 4; ++m) { bf16_t* rowp = out + (size_t)(ai * HALF + m * 16) * E_DM;
#pragma unroll
                for (int bj = 0; bj < 2; ++bj) { const f32x4 v0 = acc[ai][bj][m][0], v1 = acc[ai][bj][m][1];
                    u32x4 w; w.x = cvt_pk_bf16(v0[0], v0[1]); w.y = cvt_pk_bf16(v0[2], v0[3]); w.z = cvt_pk_bf16(v1[0], v1[1]); w.w = cvt_pk_bf16(v1[2], v1[3]);
                    *(u32x4*)(rowp + bj * HALF) = w; } }
    }
};
struct EpiLatCtx {
    static constexpr bool PERM = true, AFTER_DRAIN = false;
    EpiDelta lat; EpiPartial ctx;
    __device__ __forceinline__ void operator()(const f32x4 (&acc)[2][2][4][2], const Unit& u, int wr, int wc, int fr, int fq) const {
        if (u.pm < 64) lat(acc, u, wr, wc, fr, fq);
        else { Unit v = u; v.pm = u.pm - 64; ctx(acc, v, wr, wc, fr, fq); }
    }
};
struct EpiF1 {
    static constexpr bool PERM = true, AFTER_DRAIN = false;
    bf16_t* Ct; bf16_t* Ctc;
    __device__ __forceinline__ void operator()(const f32x4 (&acc)[2][2][4][2], const Unit& u, int wr, int wc, int fr, int fq) const {
        const int row0 = u.pm * BM + wr * 64 + fr, cw = wc * 32 + 8 * fq;
#pragma unroll
        for (int ai = 0; ai < 2; ++ai)
#pragma unroll
            for (int m = 0; m < 4; ++m) { const int mr = row0 + ai * HALF + m * 16, type = mr >> 9, n = mr & 511;
                bf16_t* rowp = u.pn < 64 ? Ct + (((size_t)((u.pn >> 3) * 512 + n)) * 2 + type) * 2048 + (u.pn & 7) * 256 + cw
                                         : Ctc + (((size_t)((u.pn - 64) * 512 + n)) * 2 + type) * 256 + cw;
#pragma unroll
                for (int bj = 0; bj < 2; ++bj) { const f32x4 v0 = acc[ai][bj][m][0], v1 = acc[ai][bj][m][1];
                    u32x4 w; w.x = cvt_pk_bf16(v0[0], v0[1]); w.y = cvt_pk_bf16(v0[2], v0[3]); w.z = cvt_pk_bf16(v1[0], v1[1]); w.w = cvt_pk_bf16(v1[2], v1[3]);
                    *(u32x4*)(rowp + bj * HALF) = w; } }
    }
};
struct EpiF2 {
    static constexpr bool PERM = true, AFTER_DRAIN = false;
    bf16_t* O; int rowbase, rows_per_b;
    __device__ __forceinline__ void operator()(const f32x4 (&acc)[2][2][4][2], const Unit& u, int wr, int wc, int fr, int fq) const {
        const int row0 = rowbase + (u.pn >> 1) * rows_per_b + u.pm * BM + wr * 64 + fr, col0 = 1536 + (u.pn & 1) * 256 + wc * 32 + 8 * fq;
#pragma unroll
        for (int ai = 0; ai < 2; ++ai)
#pragma unroll
            for (int m = 0; m < 4; ++m) { bf16_t* rowp = O + (size_t)(row0 + ai * HALF + m * 16) * E_DM + col0;
#pragma unroll
                for (int bj = 0; bj < 2; ++bj) { const f32x4 v0 = acc[ai][bj][m][0], v1 = acc[ai][bj][m][1];
                    u32x4 w; w.x = cvt_pk_bf16(v0[0], v0[1]); w.y = cvt_pk_bf16(v0[2], v0[3]); w.z = cvt_pk_bf16(v1[0], v1[1]); w.w = cvt_pk_bf16(v1[2], v1[3]);
                    *(u32x4*)(rowp + bj * HALF) = w; } }
    }
};
struct EpiRopeQ {
    static constexpr bool PERM = false, AFTER_DRAIN = false;
    bf16_t* Q; int ldc; const float* rope;
    __device__ __forceinline__ void operator()(const f32x4 (&acc)[2][2][4][2], const Unit& u, int wr, int wc, int fr, int fq) const {
        const int row0 = u.pm * BM + wr * 64 + fr;
#pragma unroll
        for (int bj = 0; bj < 2; ++bj) { const int cg = u.pn * BM + bj * HALF + wc * 32, within = cg % 192; const bool roped = within >= 128 && u.pm < 64; const int half = (within - 128) >> 5;
#pragma unroll
            for (int ai = 0; ai < 2; ++ai)
#pragma unroll
                for (int m = 0; m < 4; ++m) { const int row = row0 + ai * HALF + m * 16, s = row & 2047, pos = half ? (s & 63) : (s >> 6);
                    f32x4 x1 = acc[ai][bj][m][0], x2 = acc[ai][bj][m][1];
                    if (roped) { const f32x4 cs = *(const f32x4*)(rope + pos * 32 + 4 * fq), sn = *(const f32x4*)(rope + pos * 32 + 16 + 4 * fq);
                        const f32x4 o1 = x1 * cs - x2 * sn, o2 = x1 * sn + x2 * cs; x1 = o1; x2 = o2; }
                    bf16_t* p = Q + (size_t)row * ldc + cg + 4 * fq;
                    u32x2 w1, w2; w1.x = cvt_pk_bf16(x1[0], x1[1]); w1.y = cvt_pk_bf16(x1[2], x1[3]); w2.x = cvt_pk_bf16(x2[0], x2[1]); w2.y = cvt_pk_bf16(x2[2], x2[3]);
                    *(u32x2*)p = w1; *(u32x2*)(p + 16) = w2; } }
    }
};

template <class Epi, class Sched, bool ALIGN_EPI = false, bool SP2 = false>
__device__ __forceinline__ void gemm_phase(PG8_LAS unsigned char* lds, const Gemm g, const Sched& S, const Epi& E) {
    int tid_ = threadIdx.x; asm volatile("" : "+v"(tid_));
    const int tid = tid_, wid = __builtin_amdgcn_readfirstlane(tid >> 6), lane = tid & 63, wr = wid >> 2, wc = wid & 3, fr = lane & 15, fq = lane >> 4;
    const int K = g.K, nt0 = K / BK;
    unsigned voffA[2], voffB[2];
#pragma unroll
    for (int i = 0; i < 2; ++i) { int R, C; stage_rc(tid * 16 + i * 8192, R, C); const int Rb = Epi::PERM ? ((R & ~31) + perm32(R & 31)) : R;
        voffA[i] = (unsigned)(R * g.lda + C) * 2u; voffB[i] = (unsigned)(Rb * g.ldb + C) * 2u; }
    const size_t kstepA = (size_t)g.ksA, kstepB = (size_t)g.ksB;
    const size_t hstepA = (size_t)HALF * g.lda * 2, hstepB = (size_t)HALF * g.ldb * 2;
    const size_t tstepA = g.tsA, tstepB = g.tsB;
    const unsigned ldsw = (unsigned)wid * 1024u;
    const int aoff = lds_byte(wr * 64 + fr, fq * 8), boff = lds_byte(wc * 32 + fr, fq * 8);
#define PG8_SA(b, h) (((b) * 2 + (h)) * HTB)
#define PG8_SB(b, h) ((4 + (b) * 2 + (h)) * HTB)
#define PG8_STAGE(bufoff, gbase, voff) do { _Pragma("unroll") for (int _i = 0; _i < 2; ++_i) \
        __builtin_amdgcn_global_load_lds((const unsigned*)((const char*)(gbase) + (voff)[_i]), (PG8_LAS unsigned*)(lds + (bufoff) + ldsw + _i * 8192), 16, 0, 0); } while (0)
#define PG8_LDA(dst, b, h) do { _Pragma("unroll") for (int m = 0; m < 4; ++m) _Pragma("unroll") for (int k = 0; k < 2; ++k) dst[m][k] = *(const PG8_LAS bf16x8*)(lds + PG8_SA(b, h) + aoff + m * 2048 + k * 1024); } while (0)
#define PG8_LDB(dst, b, h) do { _Pragma("unroll") for (int n = 0; n < 2; ++n) _Pragma("unroll") for (int k = 0; k < 2; ++k) dst[n][k] = *(const PG8_LAS bf16x8*)(lds + PG8_SB(b, h) + boff + n * 2048 + k * 1024); } while (0)
#define PG8_MMA(ai, bj, At, Bt) do { __builtin_amdgcn_s_setprio(1); _Pragma("unroll") for (int m = 0; m < 4; ++m) _Pragma("unroll") for (int n = 0; n < 2; ++n) _Pragma("unroll") for (int k = 0; k < 2; ++k) \
        acc[ai][bj][m][n] = __builtin_amdgcn_mfma_f32_16x16x32_bf16(Bt[n][k], At[m][k], acc[ai][bj][m][n], 0, 0, 0); __builtin_amdgcn_s_setprio(0); } while (0)
#define PG8_WAIT_V(n) asm volatile("s_waitcnt vmcnt(" #n ")" ::: "memory")
#define PG8_WAIT_L(n) asm volatile("s_waitcnt lgkmcnt(" #n ")" ::: "memory")
#define PG8_BAR __builtin_amdgcn_s_barrier()
#define PG8_SCHED __builtin_amdgcn_sched_barrier(0)
    Unit cur, nxt; int ui = 0;
    if (!S.next(0, cur)) return;
    f32x4 acc[2][2][4][2];
#pragma unroll
    for (int a = 0; a < 2; ++a)
#pragma unroll
        for (int b = 0; b < 2; ++b)
#pragma unroll
            for (int m = 0; m < 4; ++m)
#pragma unroll
                for (int n = 0; n < 2; ++n) acc[a][b][m][n] = (f32x4){0.f, 0.f, 0.f, 0.f};
    bf16x8 At[4][2], B0[2][2], B1[2][2];
    const char* cA = (const char*)g.A + (size_t)cur.pm * tstepA + cur.koA; const char* cB = (const char*)g.Bt + (size_t)cur.pn * tstepB + cur.koB;
    S.a_ready(cur);
    if constexpr (SP2) {
        PG8_STAGE(PG8_SB(0, 0), cB, voffB); PG8_STAGE(PG8_SB(0, 1), cB + hstepB, voffB); PG8_STAGE(PG8_SA(0, 0), cA, voffA); PG8_STAGE(PG8_SA(0, 1), cA + hstepA, voffA);
        if (wr == 1) PG8_BAR;
        PG8_WAIT_V(2); PG8_BAR;
        PG8_STAGE(PG8_SB(1, 0), cB + kstepB, voffB); PG8_STAGE(PG8_SA(1, 0), cA + kstepA, voffA); PG8_STAGE(PG8_SB(1, 1), cB + hstepB + kstepB, voffB);
        PG8_WAIT_V(6); PG8_BAR;
    } else {
        PG8_STAGE(PG8_SB(0, 0), cB, voffB); PG8_STAGE(PG8_SA(0, 0), cA, voffA); PG8_STAGE(PG8_SB(0, 1), cB + hstepB, voffB); PG8_STAGE(PG8_SA(0, 1), cA + hstepA, voffA);
        if (wr == 1) PG8_BAR;
        PG8_WAIT_V(4); PG8_BAR;
        PG8_STAGE(PG8_SB(1, 0), cB + kstepB, voffB); PG8_STAGE(PG8_SA(1, 0), cA + kstepA, voffA); PG8_STAGE(PG8_SB(1, 1), cB + hstepB + kstepB, voffB);
        PG8_WAIT_V(6); PG8_BAR;
    }
    for (;;) {
        const bool has_next = S.next(ui + 1, nxt);
        const char* nA = has_next ? (const char*)g.A + (size_t)nxt.pm * tstepA + nxt.koA : cA; const char* nB = has_next ? (const char*)g.Bt + (size_t)nxt.pn * tstepB + nxt.koB : cB;
        const int nt = cur.nt ? cur.nt : nt0;
#pragma nounroll
        for (int t = 0; t < nt; t += 2) {
            const bool last = (t == nt - 2);
            const char* a1 = cA + (size_t)(t + 1) * kstepA;
            const char* a2 = last ? nA : cA + (size_t)(t + 2) * kstepA; const char* b2 = last ? nB : cB + (size_t)(t + 2) * kstepB;
            const char* a3 = a2 + kstepA; const char* b3 = b2 + kstepB;
            if (last && has_next) S.a_ready(nxt);
            if constexpr (SP2) {
            PG8_LDB(B0, 0, 0); PG8_LDB(B1, 0, 1); PG8_SCHED; PG8_LDA(At, 0, 0); PG8_STAGE(PG8_SA(1, 1), a1 + hstepA, voffA);
            PG8_WAIT_V(8); PG8_WAIT_L(0); PG8_BAR; PG8_MMA(0, 0, At, B0); PG8_MMA(0, 1, At, B1); PG8_BAR; PG8_SCHED;
            PG8_LDA(At, 0, 1); PG8_STAGE(PG8_SB(0, 0), b2, voffB); PG8_STAGE(PG8_SB(0, 1), b2 + hstepB, voffB); PG8_STAGE(PG8_SA(0, 0), a2, voffA);
            PG8_WAIT_V(8); PG8_WAIT_L(0); PG8_BAR; PG8_MMA(1, 0, At, B0); PG8_MMA(1, 1, At, B1); PG8_BAR; PG8_SCHED;
            PG8_LDB(B0, 1, 0); PG8_LDB(B1, 1, 1); PG8_SCHED; PG8_LDA(At, 1, 0); PG8_STAGE(PG8_SA(0, 1), a2 + hstepA, voffA);
            PG8_WAIT_V(8); PG8_WAIT_L(0); PG8_BAR; PG8_MMA(0, 0, At, B0); PG8_MMA(0, 1, At, B1); PG8_BAR; PG8_SCHED;
            PG8_LDA(At, 1, 1); PG8_STAGE(PG8_SB(1, 0), b3, voffB); PG8_STAGE(PG8_SB(1, 1), b3 + hstepB, voffB); PG8_STAGE(PG8_SA(1, 0), a3, voffA);
            PG8_WAIT_V(8); PG8_WAIT_L(0); PG8_BAR; PG8_MMA(1, 0, At, B0); PG8_MMA(1, 1, At, B1); PG8_BAR; PG8_SCHED;
            } else {
            PG8_LDB(B0, 0, 0); PG8_SCHED; PG8_LDA(At, 0, 0); PG8_STAGE(PG8_SA(1, 1), a1 + hstepA, voffA);
            PG8_WAIT_L(8); PG8_BAR; PG8_WAIT_L(0); PG8_MMA(0, 0, At, B0); PG8_BAR; PG8_SCHED;
            PG8_LDB(B1, 0, 1); PG8_STAGE(PG8_SB(0, 0), b2, voffB);
            PG8_BAR; PG8_WAIT_L(0); PG8_MMA(0, 1, At, B1); PG8_BAR;
            PG8_LDA(At, 0, 1); PG8_STAGE(PG8_SA(0, 0), a2, voffA);
            PG8_BAR; PG8_WAIT_L(0); PG8_MMA(1, 0, At, B0); PG8_BAR; PG8_SCHED;
            PG8_STAGE(PG8_SB(0, 1), b2 + hstepB, voffB);
            PG8_WAIT_V(6); PG8_BAR; PG8_MMA(1, 1, At, B1); PG8_BAR;
            PG8_LDB(B0, 1, 0); PG8_SCHED; PG8_LDA(At, 1, 0); PG8_STAGE(PG8_SA(0, 1), a2 + hstepA, voffA);
            PG8_WAIT_L(8); PG8_BAR; PG8_WAIT_L(0); PG8_MMA(0, 0, At, B0); PG8_BAR; PG8_SCHED;
            PG8_LDB(B1, 1, 1); PG8_STAGE(PG8_SB(1, 0), b3, voffB);
            PG8_BAR; PG8_WAIT_L(0); PG8_MMA(0, 1, At, B1); PG8_BAR;
            PG8_LDA(At, 1, 1); PG8_STAGE(PG8_SA(1, 0), a3, voffA);
            PG8_BAR; PG8_WAIT_L(0); PG8_MMA(1, 0, At, B0); PG8_BAR; PG8_SCHED;
            PG8_STAGE(PG8_SB(1, 1), b3 + hstepB, voffB);
            PG8_WAIT_V(6); PG8_BAR; PG8_MMA(1, 1, At, B1); PG8_BAR;
            }
        }
        if constexpr (ALIGN_EPI) { if (wr == 0) PG8_BAR; }
        if constexpr (!Epi::AFTER_DRAIN) { E(acc, cur, wr, wc, fr, fq); S.done(cur); }
        if (!has_next) break;
#pragma unroll
        for (int a = 0; a < 2; ++a)
#pragma unroll
            for (int b = 0; b < 2; ++b)
#pragma unroll
                for (int m = 0; m < 4; ++m)
#pragma unroll
                    for (int n = 0; n < 2; ++n) acc[a][b][m][n] = (f32x4){0.f, 0.f, 0.f, 0.f};
        cur = nxt; cA = nA; cB = nB; ++ui;
        if constexpr (ALIGN_EPI) { if (wr == 1) PG8_BAR; }
    }
    PG8_WAIT_V(0);
    if constexpr (!ALIGN_EPI) { if (wr == 0) PG8_BAR; }
    PG8_BAR;
    if constexpr (Epi::AFTER_DRAIN) { E.fused(acc, cur, wr, wc, fr, fq, lds, wid, lane); S.done(cur); }
#undef PG8_SA
#undef PG8_SB
#undef PG8_STAGE
#undef PG8_LDA
#undef PG8_LDB
#undef PG8_MMA
#undef PG8_WAIT_V
#undef PG8_WAIT_L
#undef PG8_BAR
#undef PG8_SCHED
}
}

#define GAS __attribute__((address_space(1)))
#define LAS __attribute__((address_space(3)))
typedef unsigned short bf16;
typedef unsigned v4u __attribute__((ext_vector_type(4)));
typedef float f32x4 __attribute__((ext_vector_type(4)));
typedef short bf16x8 __attribute__((ext_vector_type(8)));
typedef GAS unsigned gu32;
typedef GAS unsigned long long gu64;
#define RLX_AGENT __ATOMIC_RELAXED, __HIP_MEMORY_SCOPE_AGENT
#define LDS_WAIT() asm volatile("s_waitcnt lgkmcnt(0)" ::: "memory")
#define VM_WAIT() asm volatile("s_waitcnt vmcnt(0)" ::: "memory")
__device__ __forceinline__ unsigned long long rt() { return __builtin_amdgcn_s_memrealtime(); }
__device__ __forceinline__ unsigned f2bf(float f) { unsigned u = __builtin_bit_cast(unsigned, f); return (u + 0x7fffu + ((u >> 16) & 1u)) >> 16; }
__device__ __forceinline__ unsigned pk2(float lo, float hi) { return f2bf(lo) | (f2bf(hi) << 16); }

#define XB_TMO      128
#define XB_XCNT(j)  (256  + 64 * (j))
#define XB_XSUB(j)  (1280 + 64 * (j))
#define XB_XGEN(j)  (2304 + 64 * (j))
#define XB_TOP      3328
#define XB_TOPGEN   3392
#define XCD_BAR_WORDS 3456
#define XB_SPIN_CAP (1u << 18)

__device__ __forceinline__ unsigned xb_ld(unsigned* p)              { return __hip_atomic_load(p, __ATOMIC_RELAXED, __HIP_MEMORY_SCOPE_AGENT); }
__device__ __forceinline__ unsigned xb_add(unsigned* p, unsigned v) { return __hip_atomic_fetch_add(p, v, __ATOMIC_RELAXED, __HIP_MEMORY_SCOPE_AGENT); }
__device__ __forceinline__ unsigned xb_xcc_id() { return (unsigned)__builtin_amdgcn_s_getreg((3 << 11) | 20) & 0xFu; }
#define XB_SPIN(cond, bar) do { unsigned _sp = 0; while (cond) { __builtin_amdgcn_s_sleep(1); \
    if ((++_sp & 255u) == 0u) { if (xb_ld(&(bar)[XB_TMO])) break; if (_sp > XB_SPIN_CAP) { atomicAdd(&(bar)[XB_TMO], 1u); break; } } } } while (0)

struct XcdBarrier {
    unsigned* bar; unsigned x;
    volatile LAS unsigned* st;
};

__device__ __forceinline__ XcdBarrier xcd_barrier_post(unsigned* bar, volatile LAS unsigned* st) {
    XcdBarrier b; b.bar = bar; b.x = xb_xcc_id(); b.st = st;
    if (threadIdx.x == 0) st[2] = xb_add(&bar[XB_XCNT(b.x)], 1u);
    return b;
}
__device__ __forceinline__ void xcd_barrier_complete(unsigned* bar, unsigned x, unsigned& nloc, unsigned& nx) {
    const unsigned G = gridDim.x * gridDim.y * gridDim.z;
    unsigned sum, cnt, mine, sp = 0u;
    for (;;) {
        sum = 0u; cnt = 0u; mine = 0u;
#pragma unroll
        for (unsigned j = 0; j < 16; ++j) { const unsigned c = xb_ld(&bar[XB_XCNT(j)]); sum += c; cnt += (c > 0u) ? 1u : 0u; mine = (j == x) ? c : mine; }
        if (sum == G) break;
        __builtin_amdgcn_s_sleep(1);
        if ((++sp & 255u) == 0u) { if (xb_ld(&bar[XB_TMO])) break; if (sp > XB_SPIN_CAP) { atomicAdd(&bar[XB_TMO], 1u); break; } }
    }
    nloc = mine > 0u ? mine : 1u; nx = cnt > 0u ? cnt : 1u;
}

__device__ __forceinline__ void xcd_barrier(const XcdBarrier& b) {
    asm volatile("s_waitcnt vmcnt(0)" ::: "memory");
    __syncthreads();
    if (threadIdx.x == 0) {
        unsigned* bar = b.bar; asm volatile("" : "+s"(bar));
        __builtin_amdgcn_s_waitcnt(0);
        unsigned nloc = b.st[0], nx = b.st[1];
        if (nloc == 0u) { xcd_barrier_complete(bar, b.x, nloc, nx); b.st[0] = nloc; b.st[1] = nx; }
        const unsigned old = xb_add(&bar[XB_XSUB(b.x)], 1u);
        const unsigned gen = old / nloc;
        if (old + 1u == (gen + 1u) * nloc) {
            __builtin_amdgcn_fence(__ATOMIC_RELEASE, "agent");
            asm volatile("s_waitcnt vmcnt(0)" ::: "memory");
            const unsigned og = xb_add(&bar[XB_TOP], 1u);
            const unsigned tg = og / nx;
            if (og + 1u == (tg + 1u) * nx) xb_add(&bar[XB_TOPGEN], 1u);
            else XB_SPIN(xb_ld(&bar[XB_TOPGEN]) == tg, bar);
            __builtin_amdgcn_fence(__ATOMIC_ACQUIRE, "agent");
            xb_add(&bar[XB_XGEN(b.x)], 1u);
            asm volatile("s_waitcnt vmcnt(0)" ::: "memory");
        } else {
            XB_SPIN(xb_ld(&bar[XB_XGEN(b.x)]) == gen, bar);
            __builtin_amdgcn_fence(__ATOMIC_ACQUIRE, "agent");
            asm volatile("s_waitcnt vmcnt(0)" ::: "memory");
        }
    }
    __syncthreads();
}

namespace fa {
using bf16 = unsigned short;
using bf16x8 = __attribute__((ext_vector_type(8))) short;
using s16x4  = __attribute__((ext_vector_type(4))) short;
using f32x16 = __attribute__((ext_vector_type(16))) float;
using u32x4  = __attribute__((ext_vector_type(4))) unsigned;
constexpr int NW = 8, QBLK = 32, KVBLK = 64;
constexpr float THR = 8.f;
constexpr int SHM_V = KVBLK * 128 * 2, SHM_KN = KVBLK * 128 * 2, SHM_KR = KVBLK * 64 * 2;
constexpr int OFF_V = 0, OFF_KN = 2 * SHM_V, OFF_KR = OFF_KN + 2 * SHM_KN, OFF_WS = OFF_KR + 2 * SHM_KR, OFF_QR = OFF_WS + NW * 64 * 4, ATTN_LDS = OFF_QR + NW * 4096;
#define FA_KNSWZ(row, colB) ((row) * 256 + ((colB) ^ (((row) & 15) << 4)))
#define FA_KRSWZ(row, c) ((row) * 128 + ((((c) ^ ((row) >> 1)) & 7) << 4))
#define FA_SBAR() __builtin_amdgcn_sched_barrier(0)
__device__ __forceinline__ int crow(int r, int hi) { return (r & 3) + 8 * (r >> 2) + 4 * hi; }
__device__ __forceinline__ unsigned cvtpk(float lo, float hi) { unsigned r; asm volatile("v_cvt_pk_bf16_f32 %0, %1, %2" : "=v"(r) : "v"(lo), "v"(hi)); return r; }

template <int DQK> __device__ __forceinline__ void partialSM(f32x16& p0, f32x16& p1, float& m_reg, float& mn, float& alpha) {
  constexpr float SCALE = (DQK == 192) ? 0.07216878364870322f : 0.125f;
  constexpr float C = SCALE * 1.4426950408889634f;
  float pmax = p0[0];
#pragma unroll
  for (int r = 1; r < 16; ++r) pmax = fmaxf(pmax, p0[r]);
#pragma unroll
  for (int r = 0; r < 16; ++r) pmax = fmaxf(pmax, p1[r]);
  { auto rr = __builtin_amdgcn_permlane32_swap(__float_as_uint(pmax), __float_as_uint(pmax), false, false);
    pmax = fmaxf(__uint_as_float(rr[0]), __uint_as_float(rr[1])); }
  if (__builtin_expect(__all(pmax - m_reg <= THR / SCALE), 1)) { mn = m_reg; alpha = 1.f; }
  else { mn = fmaxf(m_reg, pmax); alpha = __builtin_amdgcn_exp2f((m_reg - mn) * C); m_reg = mn; }
  const float mnC = -mn * C;
#pragma unroll
  for (int r = 0; r < 16; ++r) p0[r] = fmaf(p0[r], C, mnC);
#pragma unroll
  for (int r = 0; r < 16; ++r) p1[r] = fmaf(p1[r], C, mnC);
#pragma unroll
  for (int r = 0; r < 16; ++r) p0[r] = __builtin_amdgcn_exp2f(p0[r]);
}
__device__ __forceinline__ void finishSM(f32x16& p0, f32x16& p1, float alpha, float& l_reg, bf16x8& pa0, bf16x8& pa1, bf16x8& pa2, bf16x8& pa3) {
#pragma unroll
  for (int r = 0; r < 16; ++r) p1[r] = __builtin_amdgcn_exp2f(p1[r]);
  float ps = 0;
#pragma unroll
  for (int r = 0; r < 16; ++r) ps += p0[r];
#pragma unroll
  for (int r = 0; r < 16; ++r) ps += p1[r];
  { auto rr = __builtin_amdgcn_permlane32_swap(__float_as_uint(ps), __float_as_uint(ps), false, false);
    ps = __uint_as_float(rr[0]) + __uint_as_float(rr[1]); }
  l_reg = l_reg * alpha + ps;
#define FA_PK4(P, BASE, OUT) do { unsigned a0 = cvtpk(P[BASE + 0], P[BASE + 1]), a1 = cvtpk(P[BASE + 2], P[BASE + 3]);   \
    unsigned b0 = cvtpk(P[BASE + 4], P[BASE + 5]), b1 = cvtpk(P[BASE + 6], P[BASE + 7]);                              \
    auto r0 = __builtin_amdgcn_permlane32_swap(a0, b0, false, false); auto r1 = __builtin_amdgcn_permlane32_swap(a1, b1, false, false); \
    u32x4 w = {r0[0], r1[0], r0[1], r1[1]}; OUT = *reinterpret_cast<bf16x8*>(&w); } while (0)
  FA_PK4(p0, 0, pa0); FA_PK4(p0, 8, pa1); FA_PK4(p1, 0, pa2); FA_PK4(p1, 8, pa3);
#undef FA_PK4
}
template <int DQK> __device__ __forceinline__ void qkt(f32x16& p0, f32x16& p1, const char* Kn, const char* Kr, const bf16x8* qr, const char* Kn_qbase, int qoff, int r32, int hi) {
  p0 = f32x16{}; p1 = f32x16{};
  constexpr int NKN = (DQK == 192) ? 8 : 0;
#pragma unroll
  for (int d0 = 0; d0 < NKN; ++d0) { const int cb = (d0 * 16 + hi * 8) * 2;
    const bf16x8 b0 = *reinterpret_cast<const bf16x8*>(Kn + FA_KNSWZ(r32, cb));
    const bf16x8 b1 = *reinterpret_cast<const bf16x8*>(Kn + FA_KNSWZ(32 + r32, cb));
    p0 = __builtin_amdgcn_mfma_f32_32x32x16_bf16(b0, qr[d0], p0, 0, 0, 0);
    p1 = __builtin_amdgcn_mfma_f32_32x32x16_bf16(b1, qr[d0], p1, 0, 0, 0); }
  int qo = qoff; asm volatile("" : "+v"(qo));
#pragma unroll
  for (int d0 = 0; d0 < 4; ++d0) { const int c = 2 * d0 + hi;
    const bf16x8 b0 = *reinterpret_cast<const bf16x8*>(Kr + FA_KRSWZ(r32, c));
    const bf16x8 b1 = *reinterpret_cast<const bf16x8*>(Kr + FA_KRSWZ(32 + r32, c));
    bf16x8 q; if constexpr (NKN) q = *reinterpret_cast<const bf16x8*>(Kn_qbase + qo + d0 * 1024); else q = qr[d0];
    p0 = __builtin_amdgcn_mfma_f32_32x32x16_bf16(b0, q, p0, 0, 0, 0);
    p1 = __builtin_amdgcn_mfma_f32_32x32x16_bf16(b1, q, p1, 0, 0, 0); }
}
template <int DQK> __device__ __forceinline__ void qkt_r(f32x16& p0, f32x16& p1, const char* Kn, const char* Kr, const bf16x8* qr, int r32, int hi) {
  p0 = f32x16{}; p1 = f32x16{};
  constexpr int NKN = (DQK == 192) ? 8 : 0;
#pragma unroll
  for (int d0 = 0; d0 < NKN; ++d0) { const int cb = (d0 * 16 + hi * 8) * 2;
    const bf16x8 b0 = *reinterpret_cast<const bf16x8*>(Kn + FA_KNSWZ(r32, cb));
    const bf16x8 b1 = *reinterpret_cast<const bf16x8*>(Kn + FA_KNSWZ(32 + r32, cb));
    p0 = __builtin_amdgcn_mfma_f32_32x32x16_bf16(b0, qr[d0], p0, 0, 0, 0);
    p1 = __builtin_amdgcn_mfma_f32_32x32x16_bf16(b1, qr[d0], p1, 0, 0, 0); }
#pragma unroll
  for (int d0 = 0; d0 < 4; ++d0) { const int c = 2 * d0 + hi;
    const bf16x8 b0 = *reinterpret_cast<const bf16x8*>(Kr + FA_KRSWZ(r32, c));
    const bf16x8 b1 = *reinterpret_cast<const bf16x8*>(Kr + FA_KRSWZ(32 + r32, c));
    p0 = __builtin_amdgcn_mfma_f32_32x32x16_bf16(b0, qr[NKN + d0], p0, 0, 0, 0);
    p1 = __builtin_amdgcn_mfma_f32_32x32x16_bf16(b1, qr[NKN + d0], p1, 0, 0, 0); }
}
__device__ __forceinline__ int v_st(int k, int c) { const int kk = (k & ~0xC) | ((k & 4) << 1) | ((k & 8) >> 1); return ((kk >> 3) * 4 + (c >> 5)) * 512 + ((kk & 7) * 32 + (c & 31)) * 2; }
__device__ __forceinline__ int v_rd_base(int lane) { return ((lane & 3) << 3) | (((lane >> 2) & 3) << 6) | (((lane >> 4) & 1) << 5) | (((lane >> 5) & 1) << 8); }
constexpr int v_rd_off(int d0, int ks, int half) { return d0 * 512 + ks * 4096 + half * 2048; }
template <int OFF> __device__ __forceinline__ s16x4 tr_read(int vb) {
  s16x4 r; asm volatile("ds_read_b64_tr_b16 %0, %1 offset:%2" : "=&v"(r) : "v"(vb), "i"(OFF) : "memory"); return r;
}
template <int D0> __device__ __forceinline__ void pv_one(f32x16& od, int vb, bf16x8 pa0, bf16x8 pa1, bf16x8 pa2, bf16x8 pa3) {
  const s16x4 l0 = tr_read<v_rd_off(D0, 0, 0)>(vb), h0 = tr_read<v_rd_off(D0, 0, 1)>(vb), l1 = tr_read<v_rd_off(D0, 1, 0)>(vb), h1 = tr_read<v_rd_off(D0, 1, 1)>(vb);
  const s16x4 l2 = tr_read<v_rd_off(D0, 2, 0)>(vb), h2 = tr_read<v_rd_off(D0, 2, 1)>(vb), l3 = tr_read<v_rd_off(D0, 3, 0)>(vb), h3 = tr_read<v_rd_off(D0, 3, 1)>(vb);
  asm volatile("s_waitcnt lgkmcnt(0)" ::: "memory"); FA_SBAR();
#define FA_PK(L, H) (bf16x8){L[0], L[1], L[2], L[3], H[0], H[1], H[2], H[3]}
  od = __builtin_amdgcn_mfma_f32_32x32x16_bf16(pa0, FA_PK(l0, h0), od, 0, 0, 0);
  od = __builtin_amdgcn_mfma_f32_32x32x16_bf16(pa1, FA_PK(l1, h1), od, 0, 0, 0);
  od = __builtin_amdgcn_mfma_f32_32x32x16_bf16(pa2, FA_PK(l2, h2), od, 0, 0, 0);
  od = __builtin_amdgcn_mfma_f32_32x32x16_bf16(pa3, FA_PK(l3, h3), od, 0, 0, 0);
#undef FA_PK
}
#define FA_TRLOAD(D0, L0, H0, L1, H1, L2, H2, L3, H3) do { L0 = tr_read<v_rd_off(D0, 0, 0)>(vb); H0 = tr_read<v_rd_off(D0, 0, 1)>(vb); L1 = tr_read<v_rd_off(D0, 1, 0)>(vb); H1 = tr_read<v_rd_off(D0, 1, 1)>(vb); \
    L2 = tr_read<v_rd_off(D0, 2, 0)>(vb); H2 = tr_read<v_rd_off(D0, 2, 1)>(vb); L3 = tr_read<v_rd_off(D0, 3, 0)>(vb); H3 = tr_read<v_rd_off(D0, 3, 1)>(vb); } while (0)
#define FA_PKV(L, H) (bf16x8){L[0], L[1], L[2], L[3], H[0], H[1], H[2], H[3]}
#define FA_PVMMA(OD, L0, H0, L1, H1, L2, H2, L3, H3) do { OD = __builtin_amdgcn_mfma_f32_32x32x16_bf16(pa0, FA_PKV(L0, H0), OD, 0, 0, 0); OD = __builtin_amdgcn_mfma_f32_32x32x16_bf16(pa1, FA_PKV(L1, H1), OD, 0, 0, 0); \
    OD = __builtin_amdgcn_mfma_f32_32x32x16_bf16(pa2, FA_PKV(L2, H2), OD, 0, 0, 0); OD = __builtin_amdgcn_mfma_f32_32x32x16_bf16(pa3, FA_PKV(L3, H3), OD, 0, 0, 0); } while (0)
__device__ __forceinline__ void pv_d0_piped(f32x16* o, int vb, bf16x8 pa0, bf16x8 pa1, bf16x8 pa2, bf16x8 pa3) {
  s16x4 al0, ah0, al1, ah1, al2, ah2, al3, ah3, bl0, bh0, bl1, bh1, bl2, bh2, bl3, bh3;
  FA_TRLOAD(0, al0, ah0, al1, ah1, al2, ah2, al3, ah3);
  FA_TRLOAD(1, bl0, bh0, bl1, bh1, bl2, bh2, bl3, bh3);
  asm volatile("s_waitcnt lgkmcnt(8)" ::: "memory"); FA_SBAR();
  FA_PVMMA(o[0], al0, ah0, al1, ah1, al2, ah2, al3, ah3); FA_SBAR();
  FA_TRLOAD(2, al0, ah0, al1, ah1, al2, ah2, al3, ah3);
  asm volatile("s_waitcnt lgkmcnt(8)" ::: "memory"); FA_SBAR();
  FA_PVMMA(o[1], bl0, bh0, bl1, bh1, bl2, bh2, bl3, bh3); FA_SBAR();
  FA_TRLOAD(3, bl0, bh0, bl1, bh1, bl2, bh2, bl3, bh3);
  asm volatile("s_waitcnt lgkmcnt(8)" ::: "memory"); FA_SBAR();
  FA_PVMMA(o[2], al0, ah0, al1, ah1, al2, ah2, al3, ah3); FA_SBAR();
  asm volatile("s_waitcnt lgkmcnt(0)" ::: "memory"); FA_SBAR();
  FA_PVMMA(o[3], bl0, bh0, bl1, bh1, bl2, bh2, bl3, bh3);
}
#undef FA_TRLOAD
#undef FA_PVMMA
#undef FA_PKV
__device__ __forceinline__ void pv_d0(f32x16* o, int vb, bf16x8 pa0, bf16x8 pa1, bf16x8 pa2, bf16x8 pa3) {
  pv_one<0>(o[0], vb, pa0, pa1, pa2, pa3); pv_one<1>(o[1], vb, pa0, pa1, pa2, pa3); pv_one<2>(o[2], vb, pa0, pa1, pa2, pa3); pv_one<3>(o[3], vb, pa0, pa1, pa2, pa3);
}
template <int DQK> __device__ __forceinline__ void pv_sm(f32x16* o, int vb, bf16x8 pa0, bf16x8 pa1, bf16x8 pa2, bf16x8 pa3, f32x16& p0, f32x16& p1, float& m_reg, float& mn, float& alpha) {
  constexpr float SCALE = (DQK == 192) ? 0.07216878364870322f : 0.125f;
  constexpr float C = SCALE * 1.4426950408889634f;
#define FA_PKV2(L, H) (bf16x8){L[0], L[1], L[2], L[3], H[0], H[1], H[2], H[3]}
#define FA_PVBLK(D0, SLICE) do { \
    const s16x4 l0 = tr_read<v_rd_off(D0, 0, 0)>(vb), h0 = tr_read<v_rd_off(D0, 0, 1)>(vb), l1 = tr_read<v_rd_off(D0, 1, 0)>(vb), h1 = tr_read<v_rd_off(D0, 1, 1)>(vb); \
    const s16x4 l2 = tr_read<v_rd_off(D0, 2, 0)>(vb), h2 = tr_read<v_rd_off(D0, 2, 1)>(vb), l3 = tr_read<v_rd_off(D0, 3, 0)>(vb), h3 = tr_read<v_rd_off(D0, 3, 1)>(vb); \
    SLICE \
    asm volatile("s_waitcnt lgkmcnt(0)" ::: "memory"); FA_SBAR(); \
    o[D0] = __builtin_amdgcn_mfma_f32_32x32x16_bf16(pa0, FA_PKV2(l0, h0), o[D0], 0, 0, 0); o[D0] = __builtin_amdgcn_mfma_f32_32x32x16_bf16(pa1, FA_PKV2(l1, h1), o[D0], 0, 0, 0); \
    o[D0] = __builtin_amdgcn_mfma_f32_32x32x16_bf16(pa2, FA_PKV2(l2, h2), o[D0], 0, 0, 0); o[D0] = __builtin_amdgcn_mfma_f32_32x32x16_bf16(pa3, FA_PKV2(l3, h3), o[D0], 0, 0, 0); } while (0)
  float pmax, mnC;
  FA_PVBLK(0, { pmax = p0[0]; _Pragma("unroll") for (int r = 1; r < 16; ++r) pmax = fmaxf(pmax, p0[r]); _Pragma("unroll") for (int r = 0; r < 16; ++r) pmax = fmaxf(pmax, p1[r]);
      auto rr = __builtin_amdgcn_permlane32_swap(__float_as_uint(pmax), __float_as_uint(pmax), false, false); pmax = fmaxf(__uint_as_float(rr[0]), __uint_as_float(rr[1])); });
  FA_PVBLK(1, { if (__builtin_expect(__all(pmax - m_reg <= THR / SCALE), 1)) { mn = m_reg; alpha = 1.f; } else { mn = fmaxf(m_reg, pmax); alpha = __builtin_amdgcn_exp2f((m_reg - mn) * C); m_reg = mn; }
      mnC = -mn * C; _Pragma("unroll") for (int r = 0; r < 16; ++r) p0[r] = fmaf(p0[r], C, mnC); });
  FA_PVBLK(2, { _Pragma("unroll") for (int r = 0; r < 16; ++r) p1[r] = fmaf(p1[r], C, mnC); _Pragma("unroll") for (int r = 0; r < 8; ++r) p0[r] = __builtin_amdgcn_exp2f(p0[r]); });
  FA_PVBLK(3, { _Pragma("unroll") for (int r = 8; r < 16; ++r) p0[r] = __builtin_amdgcn_exp2f(p0[r]); });
#undef FA_PVBLK
#undef FA_PKV2
}
struct Src {
  const bf16* Q; int ldq;
  const bf16* Kn; int ldkn;
  const bf16* Kr; int ldkr;
  const bf16* V; int ldv;
  int seg0, seg1, nkeys;
  void* O; int ldo;
  float lam, omli; const float* subln;
};
template <int DQK, int SDEPTH, int MODE>
__device__ __forceinline__ void attn_unit(const Src& S, char* lds) {
  int tid_ = threadIdx.x; asm volatile("" : "+v"(tid_));
  const int tid = tid_, wid = tid >> 6, lane = tid & 63, r32 = lane & 31, hi = lane >> 5;
  constexpr int NKN = (DQK == 192) ? 8 : 0, NQ = DQK / 16;
  char* V_lds = lds + OFF_V; char* Kn_lds = lds + OFF_KN; char* Kr_lds = lds + OFF_KR;
  float* wsf = (float*)(lds + OFF_WS) + wid * 64; float* li_l = wsf; float* al_l = wsf + 32;
  constexpr int NQR = NKN ? NKN : 4;
  float m_reg = -1e30f, l_reg = 0; f32x16 o[4] = {}; bf16x8 qr[NQR];
  const bf16* Qw = S.Q + (long)(wid * QBLK + r32) * S.ldq + hi * 8;
  const char* Qr_lds = lds + OFF_QR; const int qoff = wid * 4096 + lane * 16;
#pragma unroll
  for (int d0 = 0; d0 < NQR; ++d0) qr[d0] = *reinterpret_cast<const bf16x8*>(Qw + d0 * 16);
  if constexpr (NKN) {
#pragma unroll
    for (int d0 = 0; d0 < 4; ++d0) *(bf16x8*)(lds + OFF_QR + qoff + d0 * 1024) = *reinterpret_cast<const bf16x8*>(Qw + (NKN + d0) * 16);
  }
  const int sr = tid >> 4, sc = (tid & 15) * 8, vst0 = v_st(sr, sc), vst1 = v_st(32 + sr, sc);
  const int krr = tid >> 3, krc = tid & 7;
  const int vb0 = (int)(uintptr_t)V_lds + v_rd_base(lane);
  struct { bf16x8 vs0, vs1, kn0, kn1, kr; } st_[SDEPTH];
#define FA_ROW(k0) ((k0) < 256 ? S.seg0 + (k0) : S.seg1 + ((k0) - 256))
#define FA_SLOAD(i, k0) do { const long R_ = FA_ROW(k0); \
    st_[i].vs0 = *reinterpret_cast<const bf16x8*>(S.V + (R_ + sr) * S.ldv + sc); st_[i].vs1 = *reinterpret_cast<const bf16x8*>(S.V + (R_ + 32 + sr) * S.ldv + sc); \
    if constexpr (NKN) { st_[i].kn0 = *reinterpret_cast<const bf16x8*>(S.Kn + (R_ + sr) * S.ldkn + sc); st_[i].kn1 = *reinterpret_cast<const bf16x8*>(S.Kn + (R_ + 32 + sr) * S.ldkn + sc); } \
    st_[i].kr = *reinterpret_cast<const bf16x8*>(S.Kr + (R_ + krr) * S.ldkr + krc * 8); } while (0)
#define FA_SWRITE(b, i) do { *(bf16x8*)(V_lds + (b) * SHM_V + vst0) = st_[i].vs0; *(bf16x8*)(V_lds + (b) * SHM_V + vst1) = st_[i].vs1; \
    if constexpr (NKN) { *(bf16x8*)(Kn_lds + (b) * SHM_KN + FA_KNSWZ(sr, sc * 2)) = st_[i].kn0; *(bf16x8*)(Kn_lds + (b) * SHM_KN + FA_KNSWZ(32 + sr, sc * 2)) = st_[i].kn1; } \
    *(bf16x8*)(Kr_lds + (b) * SHM_KR + FA_KRSWZ(krr, krc)) = st_[i].kr; } while (0)
#define FA_SWAIT() do { if constexpr (SDEPTH == 2) { if constexpr (NKN) asm volatile("s_waitcnt vmcnt(5)" ::: "memory"); else asm volatile("s_waitcnt vmcnt(3)" ::: "memory"); } \
    else asm volatile("s_waitcnt vmcnt(0)" ::: "memory"); } while (0)
#define FA_RESC(a) do { if (__any((a) < 1.f)) { if (hi == 0) al_l[r32] = (a); asm volatile("s_waitcnt lgkmcnt(0)" ::: "memory"); \
    _Pragma("unroll") for (int d = 0; d < 4; ++d) _Pragma("unroll") for (int r = 0; r < 16; ++r) o[d][r] *= al_l[crow(r, hi)]; } } while (0)
  f32x16 pA0, pA1, pB0, pB1; float mnA, mnB, alA, alB; bf16x8 pa0, pa1, pa2, pa3; const int NT = S.nkeys / KVBLK;
  constexpr int SE = 0, SO = SDEPTH - 1;
  FA_SLOAD(SE, 0); asm volatile("s_waitcnt vmcnt(0)" ::: "memory"); FA_SWRITE(0, SE); __syncthreads();
  qkt<DQK>(pA0, pA1, Kn_lds, Kr_lds, qr, Qr_lds, qoff, r32, hi); partialSM<DQK>(pA0, pA1, m_reg, mnA, alA);
  FA_SLOAD(SO, KVBLK); if constexpr (SDEPTH == 2) { if (2 < NT) FA_SLOAD(SE, 2 * KVBLK); }
  FA_SWAIT(); FA_SWRITE(1, SO); __syncthreads();
  for (int j = 1; j + 1 < NT; j += 2) {
    FA_SBAR(); qkt<DQK>(pB0, pB1, Kn_lds + SHM_KN, Kr_lds + SHM_KR, qr, Qr_lds, qoff, r32, hi);
    finishSM(pA0, pA1, alA, l_reg, pa0, pa1, pa2, pa3); FA_SBAR();
    FA_SLOAD(SO, (j + SDEPTH) * KVBLK); FA_SBAR();
    if constexpr (DQK == 64) pv_d0_piped(o, vb0, pa0, pa1, pa2, pa3); else pv_d0(o, vb0, pa0, pa1, pa2, pa3); partialSM<DQK>(pB0, pB1, m_reg, mnB, alB);
    __syncthreads(); FA_SWAIT(); FA_SWRITE(0, SE);
    FA_RESC(alB); __syncthreads();
    FA_SBAR(); qkt<DQK>(pA0, pA1, Kn_lds, Kr_lds, qr, Qr_lds, qoff, r32, hi);
    finishSM(pB0, pB1, alB, l_reg, pa0, pa1, pa2, pa3); FA_SBAR();
    if (SDEPTH == 1 || j + 3 < NT) FA_SLOAD(SE, (j + 1 + SDEPTH) * KVBLK); FA_SBAR();
    if constexpr (DQK == 64) pv_d0_piped(o, vb0 + SHM_V, pa0, pa1, pa2, pa3); else pv_d0(o, vb0 + SHM_V, pa0, pa1, pa2, pa3); partialSM<DQK>(pA0, pA1, m_reg, mnA, alA);
    __syncthreads(); FA_SWAIT(); FA_SWRITE(1, SO);
    FA_RESC(alA); __syncthreads();
  }
  FA_SBAR(); qkt<DQK>(pB0, pB1, Kn_lds + SHM_KN, Kr_lds + SHM_KR, qr, Qr_lds, qoff, r32, hi);
  finishSM(pA0, pA1, alA, l_reg, pa0, pa1, pa2, pa3); FA_SBAR();
  if constexpr (DQK == 64) pv_d0_piped(o, vb0, pa0, pa1, pa2, pa3); else pv_d0(o, vb0, pa0, pa1, pa2, pa3); partialSM<DQK>(pB0, pB1, m_reg, mnB, alB);
  __syncthreads(); FA_RESC(alB);
  finishSM(pB0, pB1, alB, l_reg, pa0, pa1, pa2, pa3); FA_SBAR();
  if constexpr (DQK == 64) pv_d0_piped(o, vb0 + SHM_V, pa0, pa1, pa2, pa3); else pv_d0(o, vb0 + SHM_V, pa0, pa1, pa2, pa3);
  if (hi == 0) li_l[r32] = l_reg; asm volatile("s_waitcnt lgkmcnt(0)" ::: "memory");
  float rli[16];
#pragma unroll
  for (int r = 0; r < 16; ++r) rli[r] = __builtin_amdgcn_rcpf(li_l[crow(r, hi)]);
  if constexpr (MODE == 0) {
    bf16* Ow = (bf16*)S.O + (long)(wid * QBLK) * S.ldo;
#pragma unroll
    for (int r = 0; r < 16; ++r) { const int orow = crow(r, hi);
#pragma unroll
      for (int d0 = 0; d0 < 4; ++d0) { const float v = o[d0][r] * rli[r]; const float nb = __int_as_float(__builtin_amdgcn_update_dpp(0, __float_as_int(v), 0xB1, 0xF, 0xF, true));
        if ((lane & 1) == 0) *(unsigned*)(Ow + (long)orow * S.ldo + d0 * 32 + r32) = cvtpk(v, nb); } }
  } else if constexpr (MODE == 1) {
    static_assert(DQK == 64, "the parking area overlays the DQK = 192 buffers");
    char* pk = lds + OFF_KN + tid * 64; char* pq = lds + OFF_QR + tid * 64;
#pragma unroll
    for (int d0 = 0; d0 < 4; ++d0) { u32x4 w0, w1;
      w0[0] = cvtpk(o[d0][0] * rli[0], o[d0][1] * rli[1]); w0[1] = cvtpk(o[d0][2] * rli[2], o[d0][3] * rli[3]); w0[2] = cvtpk(o[d0][4] * rli[4], o[d0][5] * rli[5]); w0[3] = cvtpk(o[d0][6] * rli[6], o[d0][7] * rli[7]);
      w1[0] = cvtpk(o[d0][8] * rli[8], o[d0][9] * rli[9]); w1[1] = cvtpk(o[d0][10] * rli[10], o[d0][11] * rli[11]); w1[2] = cvtpk(o[d0][12] * rli[12], o[d0][13] * rli[13]); w1[3] = cvtpk(o[d0][14] * rli[14], o[d0][15] * rli[15]);
      char* p = (d0 < 2 ? pk : pq) + (d0 & 1) * 32; *(u32x4*)p = w0; *(u32x4*)(p + 16) = w1; }
  } else {
    const char* pk = lds + OFF_KN + tid * 64; const char* pq = lds + OFF_QR + tid * 64;
    float ss[16];
#pragma unroll
    for (int r = 0; r < 16; ++r) ss[r] = 0.f;
#pragma unroll
    for (int d0 = 0; d0 < 4; ++d0) { const char* p = (d0 < 2 ? pk : pq) + (d0 & 1) * 32; const u32x4 w0 = *(const u32x4*)p, w1 = *(const u32x4*)(p + 16);
#pragma unroll
      for (int r = 0; r < 16; ++r) { const unsigned w = (r < 8 ? w0[r >> 1] : w1[(r - 8) >> 1]); const float o1 = __uint_as_float((r & 1) ? (w & 0xffff0000u) : (w << 16));
        const float v = o1 - S.lam * (o[d0][r] * rli[r]); o[d0][r] = v; ss[r] += v * v; } }
#pragma unroll
    for (int r = 0; r < 16; ++r) {
#pragma unroll
      for (int sft = 1; sft < 32; sft <<= 1) ss[r] += __shfl_xor(ss[r], sft);
      ss[r] = rsqrtf(ss[r] * (1.0f / 128.0f) + 1e-6f) * S.omli; }
    bf16* Ow = (bf16*)S.O + (long)(wid * QBLK) * S.ldo;
#pragma unroll
    for (int d0 = 0; d0 < 4; ++d0) { const float gsub = S.subln[d0 * 32 + r32];
#pragma unroll
      for (int r = 0; r < 16; ++r) { const int orow = crow(r, hi); const float v = o[d0][r] * ss[r] * gsub; const float nb = __int_as_float(__builtin_amdgcn_update_dpp(0, __float_as_int(v), 0xB1, 0xF, 0xF, true));
        if ((lane & 1) == 0) *(unsigned*)(Ow + (long)orow * S.ldo + d0 * 32 + r32) = cvtpk(v, nb); } }
  }
  __syncthreads();
#undef FA_ROW
#undef FA_SLOAD
#undef FA_SWRITE
#undef FA_SWAIT
#undef FA_RESC
}
template <int DQK, int MODE>
__device__ __forceinline__ void attn_unit_dma(const Src& S, char* lds, __attribute__((address_space(3))) unsigned char* ldsl) {
  int tid_ = threadIdx.x; asm volatile("" : "+v"(tid_));
  const int tid = tid_, wid = __builtin_amdgcn_readfirstlane(tid >> 6), lane = tid & 63, r32 = lane & 31, hi = lane >> 5;
  constexpr int NKN = (DQK == 192) ? 8 : 0, NQ = DQK / 16;
  char* V_lds = lds + OFF_V; char* Kn_lds = lds + OFF_KN; char* Kr_lds = lds + OFF_KR;
  float* wsf = (float*)(lds + OFF_WS) + wid * 64; float* li_l = wsf; float* al_l = wsf + 32;
  constexpr int NQR = NQ;
  float m_reg = -1e30f, l_reg = 0; f32x16 o[4] = {}; bf16x8 qr[NQR];
  const bf16* Qw = S.Q + (long)(wid * QBLK + r32) * S.ldq + hi * 8;
  const char* Qr_lds = lds + OFF_QR; const int qoff = wid * 4096 + lane * 16;
#pragma unroll
  for (int d0 = 0; d0 < NQR; ++d0) qr[d0] = *reinterpret_cast<const bf16x8*>(Qw + d0 * 16);
  const int vb0 = (int)(uintptr_t)V_lds + v_rd_base(lane);
  long offV[2], offKn[2], offKr;
#pragma unroll
  for (int i = 0; i < 2; ++i) { const int sub = 2 * (2 * wid + i) + (lane >> 5), kk = (sub >> 2) * 8 + ((lane & 31) >> 2), key = (kk & ~0xC) | ((kk & 4) << 1) | ((kk & 8) >> 1), c = (sub & 3) * 32 + (lane & 3) * 8;
    offV[i] = (long)key * S.ldv + c;
    const int r = 4 * (2 * wid + i) + (lane >> 4), c16 = (lane & 15) ^ (r & 15); offKn[i] = (long)r * S.ldkn + c16 * 8; }
  { const int r = 8 * wid + (lane >> 3), c = (lane & 7) ^ ((r >> 1) & 7); offKr = (long)r * S.ldkr + c * 8; }
#define FA_ROW(k0) ((k0) < 256 ? S.seg0 + (k0) : S.seg1 + ((k0) - 256))
#define FA_GLDS(gp, off) __builtin_amdgcn_global_load_lds((const unsigned*)(gp), (__attribute__((address_space(3))) unsigned*)(ldsl + (off)), 16, 0, 0)
#define FA_DMA_K(t, b) do { const int t_ = (t) < NT ? (t) : NT - 1; const long R_ = FA_ROW(t_ * KVBLK); \
    if constexpr (NKN) { FA_GLDS(S.Kn + R_ * S.ldkn + offKn[0], OFF_KN + (b) * SHM_KN + (2 * wid) * 1024); FA_GLDS(S.Kn + R_ * S.ldkn + offKn[1], OFF_KN + (b) * SHM_KN + (2 * wid + 1) * 1024); } \
    FA_GLDS(S.Kr + R_ * S.ldkr + offKr, OFF_KR + (b) * SHM_KR + wid * 1024); } while (0)
#define FA_DMA_V(t, b) do { const int t_ = (t) < NT ? (t) : NT - 1; const long R_ = FA_ROW(t_ * KVBLK); \
    FA_GLDS(S.V + R_ * S.ldv + offV[0], OFF_V + (b) * SHM_V + (2 * wid) * 1024); FA_GLDS(S.V + R_ * S.ldv + offV[1], OFF_V + (b) * SHM_V + (2 * wid + 1) * 1024); } while (0)
#define FA_WBAR() do { asm volatile("s_waitcnt vmcnt(0)" ::: "memory"); __builtin_amdgcn_s_barrier(); asm volatile("" ::: "memory"); } while (0)
#define FA_RESC(a) do { if (__any((a) < 1.f)) { if (hi == 0) al_l[r32] = (a); asm volatile("s_waitcnt lgkmcnt(0)" ::: "memory"); \
    _Pragma("unroll") for (int d = 0; d < 4; ++d) _Pragma("unroll") for (int r = 0; r < 16; ++r) o[d][r] *= al_l[crow(r, hi)]; } } while (0)
#define FA_PV(vb) do { if constexpr (DQK == 64) pv_d0_piped(o, vb, pa0, pa1, pa2, pa3); else pv_d0(o, vb, pa0, pa1, pa2, pa3); } while (0)
  f32x16 pA0, pA1, pB0, pB1; float mnA, mnB, alA, alB; bf16x8 pa0, pa1, pa2, pa3; const int NT = S.nkeys / KVBLK;
  FA_DMA_K(0, 0); FA_DMA_V(0, 0); FA_DMA_K(1, 1);
  FA_WBAR();
  qkt_r<DQK>(pA0, pA1, Kn_lds, Kr_lds, qr, r32, hi); partialSM<DQK>(pA0, pA1, m_reg, mnA, alA);
  FA_WBAR(); FA_DMA_V(1, 1); FA_DMA_K(2, 0);
  for (int j = 1; j + 1 < NT; j += 2) {
    FA_SBAR(); qkt_r<DQK>(pB0, pB1, Kn_lds + SHM_KN, Kr_lds + SHM_KR, qr, r32, hi);
    finishSM(pA0, pA1, alA, l_reg, pa0, pa1, pa2, pa3);
    pv_sm<DQK>(o, vb0, pa0, pa1, pa2, pa3, pB0, pB1, m_reg, mnB, alB);
    FA_WBAR(); FA_DMA_V(j + 1, 0); FA_DMA_K(j + 2, 1); FA_RESC(alB);
    FA_SBAR(); qkt_r<DQK>(pA0, pA1, Kn_lds, Kr_lds, qr, r32, hi);
    finishSM(pB0, pB1, alB, l_reg, pa0, pa1, pa2, pa3);
    pv_sm<DQK>(o, vb0 + SHM_V, pa0, pa1, pa2, pa3, pA0, pA1, m_reg, mnA, alA);
    FA_WBAR(); FA_DMA_V(j + 2, 1); FA_DMA_K(j + 3, 0); FA_RESC(alA);
  }
  FA_SBAR(); qkt_r<DQK>(pB0, pB1, Kn_lds + SHM_KN, Kr_lds + SHM_KR, qr, r32, hi);
  finishSM(pA0, pA1, alA, l_reg, pa0, pa1, pa2, pa3); FA_SBAR();
  pv_sm<DQK>(o, vb0, pa0, pa1, pa2, pa3, pB0, pB1, m_reg, mnB, alB);
  FA_WBAR(); FA_RESC(alB);
  finishSM(pB0, pB1, alB, l_reg, pa0, pa1, pa2, pa3); FA_SBAR();
  FA_PV(vb0 + SHM_V);
  if (hi == 0) li_l[r32] = l_reg; asm volatile("s_waitcnt lgkmcnt(0)" ::: "memory");
  float rli[16];
#pragma unroll
  for (int r = 0; r < 16; ++r) rli[r] = __builtin_amdgcn_rcpf(li_l[crow(r, hi)]);
  if constexpr (MODE == 0) {
    bf16* Ow = (bf16*)S.O + (long)(wid * QBLK) * S.ldo;
#pragma unroll
    for (int r = 0; r < 16; ++r) { const int orow = crow(r, hi);
#pragma unroll
      for (int d0 = 0; d0 < 4; ++d0) { const float v = o[d0][r] * rli[r]; const float nb = __int_as_float(__builtin_amdgcn_update_dpp(0, __float_as_int(v), 0xB1, 0xF, 0xF, true));
        if ((lane & 1) == 0) *(unsigned*)(Ow + (long)orow * S.ldo + d0 * 32 + r32) = cvtpk(v, nb); } }
  } else if constexpr (MODE == 1) {
    static_assert(DQK == 64, "the parking area overlays the DQK = 192 buffers");
    char* pk = lds + OFF_KN + tid * 64; char* pq = lds + OFF_QR + tid * 64;
#pragma unroll
    for (int d0 = 0; d0 < 4; ++d0) { u32x4 w0, w1;
      w0[0] = cvtpk(o[d0][0] * rli[0], o[d0][1] * rli[1]); w0[1] = cvtpk(o[d0][2] * rli[2], o[d0][3] * rli[3]); w0[2] = cvtpk(o[d0][4] * rli[4], o[d0][5] * rli[5]); w0[3] = cvtpk(o[d0][6] * rli[6], o[d0][7] * rli[7]);
      w1[0] = cvtpk(o[d0][8] * rli[8], o[d0][9] * rli[9]); w1[1] = cvtpk(o[d0][10] * rli[10], o[d0][11] * rli[11]); w1[2] = cvtpk(o[d0][12] * rli[12], o[d0][13] * rli[13]); w1[3] = cvtpk(o[d0][14] * rli[14], o[d0][15] * rli[15]);
      char* p = (d0 < 2 ? pk : pq) + (d0 & 1) * 32; *(u32x4*)p = w0; *(u32x4*)(p + 16) = w1; }
  } else {
    const char* pk = lds + OFF_KN + tid * 64; const char* pq = lds + OFF_QR + tid * 64;
    float ss[16];
#pragma unroll
    for (int r = 0; r < 16; ++r) ss[r] = 0.f;
#pragma unroll
    for (int d0 = 0; d0 < 4; ++d0) { const char* p = (d0 < 2 ? pk : pq) + (d0 & 1) * 32; const u32x4 w0 = *(const u32x4*)p, w1 = *(const u32x4*)(p + 16);
#pragma unroll
      for (int r = 0; r < 16; ++r) { const unsigned w = (r < 8 ? w0[r >> 1] : w1[(r - 8) >> 1]); const float o1 = __uint_as_float((r & 1) ? (w & 0xffff0000u) : (w << 16));
        const float v = o1 - S.lam * (o[d0][r] * rli[r]); o[d0][r] = v; ss[r] += v * v; } }
#pragma unroll
    for (int r = 0; r < 16; ++r) {
#pragma unroll
      for (int sft = 1; sft < 32; sft <<= 1) ss[r] += __shfl_xor(ss[r], sft);
      ss[r] = rsqrtf(ss[r] * (1.0f / 128.0f) + 1e-6f) * S.omli; }
    bf16* Ow = (bf16*)S.O + (long)(wid * QBLK) * S.ldo;
#pragma unroll
    for (int d0 = 0; d0 < 4; ++d0) { const float gsub = S.subln[d0 * 32 + r32];
#pragma unroll
      for (int r = 0; r < 16; ++r) { const int orow = crow(r, hi); const float v = o[d0][r] * ss[r] * gsub; const float nb = __int_as_float(__builtin_amdgcn_update_dpp(0, __float_as_int(v), 0xB1, 0xF, 0xF, true));
        if ((lane & 1) == 0) *(unsigned*)(Ow + (long)orow * S.ldo + d0 * 32 + r32) = cvtpk(v, nb); } }
  }
  __syncthreads();
#undef FA_ROW
#undef FA_GLDS
#undef FA_DMA_K
#undef FA_DMA_V
#undef FA_WBAR
#undef FA_RESC
#undef FA_PV
}
}

constexpr int NWAVES = 8;
constexpr int DM = 2048, NB = 8, SEQ = 2048, CTXL = 256, DFF = 5632, NMOD = 9;
constexpr int DFFP = DFF + 64;
constexpr int MLAT = NB * SEQ, MCTX = NB * CTXL, MTOT = MLAT + MCTX;
constexpr int WIN_N = 2880;
constexpr int PC_CKV = 0, PC_KR = 256, PC_DK = 320, PC_DV = 832, PC_CQ = 1344, PC_DQ = 1856, PC_END = 2368, LDP = 2560;
constexpr int MODROW = NMOD * DM;
constexpr float EPS = 1e-6f;
constexpr float MLA_C = 0.07216878364870322f * 1.4426950408889634f;
constexpr float DIFF_C = 0.125f * 1.4426950408889634f;

constexpr size_t MiB = 1u << 20;
constexpr size_t WS_CTL = 0, CTL_ZERO_BYTES = 32768;
constexpr size_t WS_MOD = 1 * MiB;
constexpr size_t WS_TAB = 3 * MiB;
constexpr size_t WS_WGU = 4 * MiB;
constexpr size_t WS_WD = WS_WGU + 176 * MiB;
constexpr size_t WS_WIN = WS_WD + 90 * MiB;
constexpr size_t WS_WF1 = WS_WIN + 20 * MiB;
constexpr size_t WS_WUKV = WS_WF1 + 8 * MiB;
constexpr size_t WS_WUQ = WS_WUKV + 2 * MiB;
constexpr size_t WS_WOUT = WS_WUQ + 3 * MiB;
constexpr size_t WS_DFT = WS_WOUT + 16 * MiB;
constexpr size_t WS_DFTC = WS_DFT + 16 * MiB;
constexpr size_t WS_X = WS_DFTC + 1 * MiB;
constexpr size_t WS_S = WS_X + 16 * MiB;
constexpr size_t WS_H = WS_X + 144 * MiB;
constexpr size_t WS_O = WS_H + 72 * MiB;
constexpr size_t WS_ACT = WS_O + 72 * MiB;
constexpr size_t WS_OD = WS_ACT;
constexpr size_t WS_CT = WS_ACT + 72 * MiB;
constexpr size_t WS_CTC = WS_CT + 32 * MiB;
constexpr size_t WS_P = WS_ACT + 202 * MiB;
constexpr size_t WS_KV = WS_P + 90 * MiB;
constexpr size_t WS_Q = WS_KV + 72 * MiB;
constexpr size_t WS_PART = WS_Q + 54 * MiB;
constexpr size_t WS_END = WS_PART + 64 * MiB;
static_assert(WS_CTC + 4 * MiB <= WS_P && (size_t)MTOT * DFFP * 2 <= 202 * MiB && (size_t)MTOT * LDP * 2 <= 90 * MiB, "ws map");
constexpr int CW_BAR = 4096;
constexpr int N_STEPS = 66;

constexpr int RING_BYTES = 131072;
constexpr int LDSCTL_OFF = RING_BYTES, MISC_OFF = LDSCTL_OFF + 320;
constexpr int LDS_BYTES = 147456;

typedef unsigned u32x2 __attribute__((ext_vector_type(2)));
typedef float f32x2 __attribute__((ext_vector_type(2)));
__device__ __forceinline__ float bf2f(unsigned short b) { return __builtin_bit_cast(float, ((unsigned)b) << 16); }
__device__ __forceinline__ float wave_sum(float v) {
#pragma unroll
    for (int o = 1; o < 64; o <<= 1) v += __shfl_xor(v, o);
    return v;
}
__device__ __forceinline__ float wave_max(float v) {
#pragma unroll
    for (int o = 1; o < 64; o <<= 1) v = fmaxf(v, __shfl_xor(v, o));
    return v;
}

__device__ __forceinline__ void transpose_item(const float* W, int N, bf16* WT, int ldt, int dest_row0, LAS float* scr, int k0, int n0, int lane) {
    float tv[32];
#pragma unroll
    for (int i = 0; i < 32; ++i) tv[i] = W[(size_t)(k0 + 2 * i + (lane >> 5)) * N + n0 + (lane & 31)];
    asm volatile("" ::: "memory");
#pragma unroll
    for (int i = 0; i < 32; ++i) scr[(2 * i + (lane >> 5)) * 33 + (lane & 31)] = tv[i];
    LDS_WAIT(); asm volatile("" ::: "memory");
    const int c = lane & 7;
#pragma unroll
    for (int j = 0; j < 4; ++j) { const int n = (lane >> 3) + 8 * j; const LAS float* s = scr + (8 * c) * 33 + n;
        v4u o; o.x = pk2(s[0 * 33], s[1 * 33]); o.y = pk2(s[2 * 33], s[3 * 33]); o.z = pk2(s[4 * 33], s[5 * 33]); o.w = pk2(s[6 * 33], s[7 * 33]);
        *(GAS v4u*)(WT + (size_t)(dest_row0 + n) * ldt + k0 + 8 * c) = o; }
    LDS_WAIT(); asm volatile("" ::: "memory");
}

struct Args { const float* in[19]; float* out; unsigned char* ws; int st_lo, st_hi; };
enum { I_X = 0, I_C, I_CTX, I_CCTX, I_ADAW, I_ADAB, I_NORMG, I_WG, I_WU, I_WD, I_WIN, I_QN, I_KVN, I_WUQ, I_WUKV, I_LAM, I_SUBLN, I_WOUT, I_FN };

__device__ __forceinline__ void transpose_set(const Args& a, LAS unsigned char* lds, int set, int widx, int nw) {
    unsigned char* ws = a.ws; int lane, wave; { int t_ = threadIdx.x; asm volatile("" : "+v"(t_)); lane = t_ & 63; wave = __builtin_amdgcn_readfirstlane(t_ >> 6); }
    {
        LAS float* scr = (LAS float*)(lds + wave * 8704);
        constexpr int PER_LF = 3 * 5632, N_FFN = 4 * PER_LF, PER_L = 2368 + 256 + 384 + 2048; const int nv = (set == 0) ? PER_LF + 2 * PER_L : PER_LF;
        struct TI { const float* src; bf16* dst; int N, ldt; };
        auto decode = [&](int v) -> TI { TI t; const int it = (set == 0) ? (v < PER_LF ? v : v - PER_LF + N_FFN) : set * PER_LF + v;
            if (it < N_FFN) { const int lf = it / PER_LF, r = it % PER_LF, which = r / 5632, q = r % 5632;
                if (which < 2) { const int kb = q / 176, nb = q % 176, n0 = nb * 32;
                    t.src = (which == 0 ? a.in[I_WG] : a.in[I_WU]) + (size_t)lf * DM * DFF + (size_t)(kb * 64) * DFF + n0; t.N = DFF;
                    t.dst = (bf16*)(ws + WS_WGU) + (size_t)lf * 2 * DFF * DM + ((size_t)((n0 >> 7) * 32 + kb) * 256 + which * 128 + (n0 & 127)) * 64; t.ldt = 64;
                } else { const int kb = q / 64, nb = q % 64;
                    t.src = a.in[I_WD] + (size_t)lf * DFF * DM + (size_t)(kb * 64) * DM + nb * 32; t.N = DM;
                    t.dst = (bf16*)(ws + WS_WD) + (size_t)lf * DM * DFFP + (size_t)(nb * 32) * DFFP + kb * 64; t.ldt = DFFP; }
            } else { int r = it - N_FFN; const int l = r / PER_L; r %= PER_L;
                if (r < 2368) { const int kb = r / 74, nb = r % 74; t.src = a.in[I_WIN] + (size_t)l * DM * WIN_N + (size_t)(kb * 64) * WIN_N + nb * 32; t.N = WIN_N; t.dst = (bf16*)(ws + WS_WIN) + (size_t)l * LDP * DM + (size_t)(nb * 32) * DM + kb * 64; t.ldt = DM; }
                else if ((r -= 2368) < 256) { const int kb = r / 64, nb = r % 64; t.src = a.in[I_WUKV] + (size_t)l * 256 * 2048 + (size_t)(kb * 64) * 2048 + nb * 32; t.N = 2048; t.dst = (bf16*)(ws + WS_WUKV) + (size_t)l * 2048 * 256 + (size_t)(nb * 32) * 256 + kb * 64; t.ldt = 256; }
                else if ((r -= 256) < 384) { const int kb = r / 48, nb = r % 48; t.src = a.in[I_WUQ] + (size_t)l * 512 * 1536 + (size_t)(kb * 64) * 1536 + nb * 32; t.N = 1536; t.dst = (bf16*)(ws + WS_WUQ) + (size_t)l * 1536 * 512 + (size_t)(nb * 32) * 512 + kb * 64; t.ldt = 512; }
                else { r -= 384; const int kb = r / 64, nb = r % 64; t.src = a.in[I_WOUT] + (size_t)l * DM * DM + (size_t)(kb * 64) * DM + nb * 32; t.N = DM; t.dst = (bf16*)(ws + WS_WOUT) + (size_t)l * DM * DM + (size_t)(nb * 32) * DM + kb * 64; t.ldt = DM; } }
            return t; };
#define TR_LOAD(t, tv) do { _Pragma("unroll") for (int i_ = 0; i_ < 32; ++i_) tv[i_] = (t).src[(size_t)(2 * i_ + (lane >> 5)) * (t).N + (lane & 31)]; } while (0)
#define TR_PROC(t, tv) do { _Pragma("unroll") for (int i_ = 0; i_ < 32; ++i_) scr[(2 * i_ + (lane >> 5)) * 33 + (lane & 31)] = tv[i_]; \
            LDS_WAIT(); asm volatile("" ::: "memory"); const int c_ = lane & 7; \
            _Pragma("unroll") for (int j_ = 0; j_ < 4; ++j_) { const int n_ = (lane >> 3) + 8 * j_; const LAS float* s_ = scr + (8 * c_) * 33 + n_; \
                v4u o_; o_.x = pk2(s_[0 * 33], s_[1 * 33]); o_.y = pk2(s_[2 * 33], s_[3 * 33]); o_.z = pk2(s_[4 * 33], s_[5 * 33]); o_.w = pk2(s_[6 * 33], s_[7 * 33]); \
                *(GAS v4u*)((t).dst + (size_t)n_ * (t).ldt + 8 * c_) = o_; } \
            LDS_WAIT(); asm volatile("" ::: "memory"); } while (0)
        float tvA[32], tvB[32]; TI d0, d1; int it = widx;
        if (it < nv) { d0 = decode(it); TR_LOAD(d0, tvA); }
        while (it < nv) {
            const int it1 = it + nw, it2 = it1 + nw;
            if (it1 < nv) { d1 = decode(it1); TR_LOAD(d1, tvB); }
            TR_PROC(d0, tvA);
            if (it1 < nv) { if (it2 < nv) { d0 = decode(it2); TR_LOAD(d0, tvA); } TR_PROC(d1, tvB); }
            it = it2;
        }
#undef TR_LOAD
#undef TR_PROC
    }
}
__device__ __forceinline__ void prologue(const Args& a, LAS unsigned char* lds, int tid, int lane, int wave) {
    tid = threadIdx.x; asm volatile("" : "+v"(tid)); lane = tid & 63;
    unsigned char* ws = a.ws;
    const int G = gridDim.x, gw = blockIdx.x * NWAVES + wave, NGW = G * NWAVES;
    const int gt = blockIdx.x * (NWAVES * 64) + tid, NGT = G * NWAVES * 64;
    {
        for (int rp = 0; rp < NREP(13); ++rp) transpose_set(a, lds, 0, gw, NGW);
        for (int i = gt; i < 2 * 192 * DM / 8; i += NGT) { const int l = i / (192 * DM / 8), r = i % (192 * DM / 8);
            *(GAS v4u*)((bf16*)(ws + WS_WIN) + (size_t)l * LDP * DM + (size_t)PC_END * DM + (size_t)r * 8) = (v4u){0u, 0u, 0u, 0u}; }
    }
    for (int rpb = 0; rpb < NREP(20); ++rpb) {
        float* rope = (float*)(ws + WS_TAB);
        if (gt < 1024) { const int pos = gt >> 4, i = gt & 15; const float inv = powf(10000.0f, -(float)i / 16.0f), ang = (float)pos * inv; rope[pos * 32 + i] = cosf(ang); rope[pos * 32 + 16 + i] = sinf(ang); }
        if (blockIdx.x == 2 && wave == 0) { float* lamv = (float*)(ws + WS_TAB + 16384);
            for (int l = 0; l < 2; ++l) { const float* lf = a.in[I_LAM] + l * 256;
                const float s1 = wave_sum(lf[lane] * lf[64 + lane]), s2 = wave_sum(lf[128 + lane] * lf[192 + lane]);
                const float li = 0.8f - 0.6f * expf(-0.3f * (float)l); if (lane == 0) { lamv[2 * l] = expf(s1) - expf(s2) + li; lamv[2 * l + 1] = 1.0f - li; } } }
        bf16* dft = (bf16*)(ws + WS_DFT);
        for (int rp = 0; rp < NREP(16); ++rp)
        for (int i = gt; i < 2048 * 512; i += NGT) { const int sp = i >> 9, k = (i & 511) * 8, type = k >> 11, s = k & 2047; unsigned w[4];
#pragma unroll
            for (int j = 0; j < 4; ++j) { float v[2];
#pragma unroll
                for (int e = 0; e < 2; ++e) { const int t = ((s + 2 * j + e) * sp) & 2047; float sn, cs; sincospif((float)t * (1.0f / 1024.0f), &sn, &cs); v[e] = (type ? -sn : cs) * (1.0f / 512.0f); }
                w[j] = pk2(v[0], v[1]); }
            *(GAS v4u*)(dft + (size_t)sp * 4096 + k) = (v4u){w[0], w[1], w[2], w[3]}; }
        bf16* dftc = (bf16*)(ws + WS_DFTC);
        for (int i = gt; i < 256 * 64; i += NGT) { const int sp = i >> 6, k = (i & 63) * 8, type = k >> 8, s = k & 255; unsigned w[4];
#pragma unroll
            for (int j = 0; j < 4; ++j) { float v[2];
#pragma unroll
                for (int e = 0; e < 2; ++e) { const int t = ((s + 2 * j + e) * sp) & 255; float sn, cs; sincospif((float)t * (1.0f / 128.0f), &sn, &cs); v[e] = (type ? -sn : cs) * 0.005524271728019903f; }
                w[j] = pk2(v[0], v[1]); }
            *(GAS v4u*)(dftc + (size_t)sp * 512 + k) = (v4u){w[0], w[1], w[2], w[3]}; }
    }
    __syncthreads();
    {
        LAS float* U = (LAS float*)lds;
        LAS float* T = (LAS float*)(lds + 64 * 129 * 4);
        if (tid < 128) { float sn, cs; sincospif((float)tid * (1.0f / 64.0f), &sn, &cs); T[tid] = cs; T[128 + tid] = sn; }
        for (int rp = 0; rp < NREP(14); ++rp)
        for (int it = blockIdx.x; it < 2 * 4 * 32; it += G) { const int l = it >> 7, g = (it >> 5) & 3, k0 = (it & 31) * 64;
            __syncthreads();
            const float* src = a.in[I_WIN] + (size_t)l * DM * WIN_N + PC_END + g * 128;
            for (int i = tid; i < 64 * 128; i += NWAVES * 64) { const int r = i >> 7, c = i & 127; U[r * 129 + c] = src[(size_t)(k0 + r) * WIN_N + c]; }
            __syncthreads();
            typedef short bx8 __attribute__((ext_vector_type(8))); typedef float fx16 __attribute__((ext_vector_type(16)));
            const int r32 = lane & 31, hi = lane >> 5, cpr = (wave & 3) * 32 + r32; const LAS float* Tt = T + (wave >> 2) * 128;
            fx16 acc0 = {}, acc1 = {};
#pragma unroll 2
            for (int st = 0; st < 8; ++st) { const int c0 = 16 * st + 8 * hi; unsigned aw0[4], aw1[4], bw[4];
#pragma unroll
                for (int e = 0; e < 4; ++e) { aw0[e] = pk2(U[r32 * 129 + c0 + 2 * e], U[r32 * 129 + c0 + 2 * e + 1]); aw1[e] = pk2(U[(32 + r32) * 129 + c0 + 2 * e], U[(32 + r32) * 129 + c0 + 2 * e + 1]);
                    bw[e] = pk2(Tt[((c0 + 2 * e) * cpr) & 127], Tt[((c0 + 2 * e + 1) * cpr) & 127]); }
                const bx8 A0 = __builtin_bit_cast(bx8, (v4u){aw0[0], aw0[1], aw0[2], aw0[3]}), A1 = __builtin_bit_cast(bx8, (v4u){aw1[0], aw1[1], aw1[2], aw1[3]}), B = __builtin_bit_cast(bx8, (v4u){bw[0], bw[1], bw[2], bw[3]});
                acc0 = __builtin_amdgcn_mfma_f32_32x32x16_bf16(A0, B, acc0, 0, 0, 0); acc1 = __builtin_amdgcn_mfma_f32_32x32x16_bf16(A1, B, acc1, 0, 0, 0); }
            bf16* wrow = (bf16*)(ws + WS_WF1) + (size_t)l * 1024 * DM + (size_t)((wave >> 2) * 512 + g * 128 + cpr) * DM + k0 + 4 * hi;
#pragma unroll
            for (int q = 0; q < 4; ++q) { u32x2 w0, w1; w0.x = pk2(acc0[4 * q], acc0[4 * q + 1]); w0.y = pk2(acc0[4 * q + 2], acc0[4 * q + 3]); w1.x = pk2(acc1[4 * q], acc1[4 * q + 1]); w1.y = pk2(acc1[4 * q + 2], acc1[4 * q + 3]);
                *(u32x2*)(wrow + 8 * q) = w0; *(u32x2*)(wrow + 32 + 8 * q) = w1; }
        }
    }
    __syncthreads();
    {
        LAS float* S = (LAS float*)lds;
        LAS float* red = (LAS float*)(lds + 9 * 2048 * 4);
        for (int rps = 0; rps < NREP(21); ++rps)
        for (int i = tid; i < 9 * 2048; i += NWAVES * 64) { const int r = i >> 11, k = i & 2047; const float c = r < 8 ? a.in[I_C][r * DM + k] : a.in[I_CCTX][k]; S[i] = c / (1.0f + expf(-c)); }
        __syncthreads();
        float* mod = (float*)(ws + WS_MOD);
        const int cg = tid % 36, ks = tid / 36;
        for (int rp = 0; rp < NREP(15); ++rp)
        for (int ch = blockIdx.x; ch < 256; ch += G) { const int l = ch >> 7, col0 = (ch & 127) * 144;
            f32x4 acc[9];
#pragma unroll
            for (int r = 0; r < 9; ++r) acc[r] = (f32x4){0.f, 0.f, 0.f, 0.f};
            if (tid < 504) { const float* W = a.in[I_ADAW] + (size_t)l * DM * MODROW + col0 + 4 * cg; const int kbeg = ks * 147, kend = kbeg + 147 < 2048 ? kbeg + 147 : 2048;
#pragma unroll 8
                for (int k = kbeg; k < kend; ++k) { const f32x4 w = *(const f32x4*)(W + (size_t)k * MODROW);
#pragma unroll
                    for (int r = 0; r < 9; ++r) acc[r] += w * S[r * 2048 + k]; } }
#pragma unroll
            for (int p = 0; p < 3; ++p) {
                __syncthreads();
                if (tid < 504) {
#pragma unroll
                    for (int j = 0; j < 3; ++j) *(LAS f32x4*)(red + (size_t)tid * 12 + 4 * j) = acc[3 * p + j]; }
                __syncthreads();
                if (tid < 432) { const int cgo = tid / 12, j = tid % 12; float s = 0.f;
#pragma unroll
                    for (int q = 0; q < 14; ++q) s += red[(q * 36 + cgo) * 12 + j];
                    const int r = 3 * p + (j >> 2), col = col0 + 4 * cgo + (j & 3);
                    mod[((size_t)l * 9 + r) * MODROW + col] = s + a.in[I_ADAB][l * MODROW + col]; }
            }
        }
    }
    __syncthreads();
}

__device__ __forceinline__ void norm_mod_phase(const float* src_lat, const float* src_ctx, bf16* H, const float* g, const float* modl, int ish, int isc, int nrows,
                                               const bf16* dlat, bf16* xb, const bf16* pend, const float* pgate, float pcoef, float* xout_ctx, int gw, int NGW, int lane) {
    { int t_ = threadIdx.x; asm volatile("" : "+v"(t_)); lane = t_ & 63; }
#define NM_LOAD(r, raw) do { \
        if ((r) < MLAT) { \
            if (dlat != nullptr) { const u32x2* dr_ = (const u32x2*)(dlat + (size_t)(r) * DM); const u32x2* xbr_ = (const u32x2*)(xb + (size_t)(r) * DM); \
                _Pragma("unroll") for (int j = 0; j < 8; ++j) { const u32x2 x_ = xbr_[lane + 64 * j], d_ = dr_[lane + 64 * j]; raw[j] = (v4u){x_.x, x_.y, d_.x, d_.y}; } }     \
            else { const v4u* xr_ = (const v4u*)(src_lat + (size_t)(r) * DM); _Pragma("unroll") for (int j = 0; j < 8; ++j) raw[j] = xr_[lane + 64 * j]; } \
        } else { const v4u* xr_ = (const v4u*)(src_ctx + (size_t)((r) - MLAT) * DM); _Pragma("unroll") for (int j = 0; j < 8; ++j) raw[j] = xr_[lane + 64 * j]; } } while (0)
#define NM_FINISH(r, raw) do { f32x4 v[8]; \
        const float* mr_ = modl + (size_t)((r) < MLAT ? ((r) >> 11) : 8) * MODROW; \
        u32x2* o_ = (u32x2*)(H + (((size_t)((r) >> 8) * 32 + (lane >> 4)) * 256 + ((r) & 255)) * 64 + 4 * (lane & 15));     \
        if ((r) < MLAT) { \
            if (dlat != nullptr) { _Pragma("unroll") for (int j = 0; j < 8; ++j) { const v4u w_ = raw[j]; \
                v[j].x = __builtin_bit_cast(float, w_.x << 16) + __builtin_bit_cast(float, w_.z << 16); v[j].y = __builtin_bit_cast(float, w_.x & 0xffff0000u) + __builtin_bit_cast(float, w_.z & 0xffff0000u); \
                v[j].z = __builtin_bit_cast(float, w_.y << 16) + __builtin_bit_cast(float, w_.w << 16); v[j].w = __builtin_bit_cast(float, w_.y & 0xffff0000u) + __builtin_bit_cast(float, w_.w & 0xffff0000u); } } \
            else { _Pragma("unroll") for (int j = 0; j < 8; ++j) v[j] = __builtin_bit_cast(f32x4, raw[j]); } \
            if (dlat == nullptr && xb != nullptr) { u32x2* xbw_ = (u32x2*)(xb + (size_t)(r) * DM); _Pragma("unroll") for (int j = 0; j < 8; ++j) { u32x2 w_; w_.x = pk2(v[j].x, v[j].y); w_.y = pk2(v[j].z, v[j].w); xbw_[lane + 64 * j] = w_; } } \
        } else { _Pragma("unroll") for (int j = 0; j < 8; ++j) v[j] = __builtin_bit_cast(f32x4, raw[j]); if (pend != nullptr) { const size_t ro_ = (size_t)((r) - MLAT) * DM; \
            _Pragma("unroll") for (int j = 0; j < 8; ++j) { const int c4 = lane + 64 * j; f32x4 p_ = (f32x4){0.f, 0.f, 0.f, 0.f}; \
                _Pragma("unroll") for (int q = 0; q < 4; ++q) { const u32x2 e_ = ((const u32x2*)(pend + (size_t)q * MCTX * DM + ro_))[c4]; \
                    p_.x += __builtin_bit_cast(float, e_.x << 16); p_.y += __builtin_bit_cast(float, e_.x & 0xffff0000u); p_.z += __builtin_bit_cast(float, e_.y << 16); p_.w += __builtin_bit_cast(float, e_.y & 0xffff0000u); } \
                v[j] = v[j] + (((const f32x4*)pgate)[c4] * pcoef) * p_; ((f32x4*)(xout_ctx + ro_))[c4] = v[j]; } } } \
        float ss_ = 0.f; \
        _Pragma("unroll") for (int j = 0; j < 8; ++j) ss_ += (v[j].x * v[j].x + v[j].y * v[j].y) + (v[j].z * v[j].z + v[j].w * v[j].w); \
        const float rstd_ = rsqrtf(wave_sum(ss_) * (1.0f / DM) + EPS); \
        _Pragma("unroll") for (int j = 0; j < 8; ++j) { const int c4 = lane + 64 * j; const f32x4 gg_ = ((const f32x4*)g)[c4], sc_ = ((const f32x4*)(mr_ + isc * DM))[c4], sh_ = ((const f32x4*)(mr_ + ish * DM))[c4]; \
            const f32x4 y_ = (v[j] * rstd_) * gg_ * (sc_ + 1.0f) + sh_; u32x2 w_; w_.x = pk2(y_.x, y_.y); w_.y = pk2(y_.z, y_.w); o_[(size_t)j * (4 * 256 * 64 / 4)] = w_; } } while (0)
    v4u rawA[8], rawB[8];
    int r = gw;
    if (r < nrows) NM_LOAD(r, rawA);
    while (r < nrows) {
        const int r1 = r + NGW, r2 = r1 + NGW;
        if (r1 < nrows) NM_LOAD(r1, rawB);
        asm volatile("" ::: "memory");
        NM_FINISH(r, rawA);
        if (r1 < nrows) { if (r2 < nrows) NM_LOAD(r2, rawA); asm volatile("" ::: "memory"); NM_FINISH(r1, rawB); }
        r = r2;
    }
#undef NM_LOAD
#undef NM_FINISH
}
__device__ __forceinline__ void final_norm_phase(const float* X, const bf16* D, float* out, const float* g, int gw, int NGW, int lane) {
    { int t_ = threadIdx.x; asm volatile("" : "+v"(t_)); lane = t_ & 63; }
    for (int r = gw; r < MLAT; r += NGW) {
        const f32x4* xr = (const f32x4*)(X + (size_t)r * DM); const u32x2* dr = (const u32x2*)(D + (size_t)r * DM); f32x4 v[8]; float ss = 0.f;
#pragma unroll
        for (int j = 0; j < 8; ++j) { v[j] = xr[lane + 64 * j]; const u32x2 d = dr[lane + 64 * j];
            v[j].x += __builtin_bit_cast(float, d.x << 16); v[j].y += __builtin_bit_cast(float, d.x & 0xffff0000u); v[j].z += __builtin_bit_cast(float, d.y << 16); v[j].w += __builtin_bit_cast(float, d.y & 0xffff0000u);
            ss += (v[j].x * v[j].x + v[j].y * v[j].y) + (v[j].z * v[j].z + v[j].w * v[j].w); }
        const float rstd = rsqrtf(wave_sum(ss) * (1.0f / DM) + EPS);
        f32x4* o = (f32x4*)(out + (size_t)r * DM);
#pragma unroll
        for (int j = 0; j < 8; ++j) o[lane + 64 * j] = (v[j] * rstd) * ((const f32x4*)g)[lane + 64 * j];
    }
}
__device__ __forceinline__ void postproj_phase(bf16* P, const float* kvn, const float* qn, const float* rope, int nrows, int gw, int NGW, int lane) {
    { int t_ = threadIdx.x; asm volatile("" : "+v"(t_)); lane = t_ & 63; }
    for (int r = gw; r < nrows; r += NGW) {
        bf16* pr = P + (size_t)r * LDP;
        u32x2* pkv = (u32x2*)(pr + PC_CKV) + lane; v4u* pq = (v4u*)(pr + PC_CQ) + lane;
        const u32x2 wkv = *pkv; const v4u wq = *pq;
        const bool lat = r < MLAT; const int s = r & 2047, prow = s >> 6, pcol = s & 63;
        float x1[9], x2[9];
#pragma unroll
        for (int t = 0; t < 9; ++t) { const int p = lane + 64 * t, v = p >> 5, q = p & 31, half = q >> 4, i = q & 15;
            const int cb = v == 0 ? PC_KR : (v <= 8 ? PC_DK + (v - 1) * 64 : PC_DQ + (v - 9) * 64), ia = cb + half * 32 + i;
            if (lat && p < 544) { x1[t] = bf2f(pr[ia]); x2[t] = bf2f(pr[ia + 16]); } else { x1[t] = 0.f; x2[t] = 0.f; } }
        asm volatile("" ::: "memory");
        { const float x0 = bf2f((unsigned short)(wkv.x & 0xffff)), xa = bf2f((unsigned short)(wkv.x >> 16)), xb = bf2f((unsigned short)(wkv.y & 0xffff)), xc = bf2f((unsigned short)(wkv.y >> 16));
          const float rstd = rsqrtf(wave_sum((x0 * x0 + xa * xa) + (xb * xb + xc * xc)) * (1.0f / 256.0f) + EPS); const f32x4 g = ((const f32x4*)kvn)[lane];
          u32x2 o; o.x = pk2(x0 * rstd * g.x, xa * rstd * g.y); o.y = pk2(xb * rstd * g.z, xc * rstd * g.w); *pkv = o; }
        { float x[8];
          x[0] = bf2f((unsigned short)(wq.x & 0xffff)); x[1] = bf2f((unsigned short)(wq.x >> 16)); x[2] = bf2f((unsigned short)(wq.y & 0xffff)); x[3] = bf2f((unsigned short)(wq.y >> 16));
          x[4] = bf2f((unsigned short)(wq.z & 0xffff)); x[5] = bf2f((unsigned short)(wq.z >> 16)); x[6] = bf2f((unsigned short)(wq.w & 0xffff)); x[7] = bf2f((unsigned short)(wq.w >> 16));
          float ss = 0.f;
#pragma unroll
          for (int j = 0; j < 8; ++j) ss += x[j] * x[j];
          const float rstd = rsqrtf(wave_sum(ss) * (1.0f / 512.0f) + EPS); const f32x4 g0 = ((const f32x4*)qn)[2 * lane], g1 = ((const f32x4*)qn)[2 * lane + 1];
          v4u o; o.x = pk2(x[0] * rstd * g0.x, x[1] * rstd * g0.y); o.y = pk2(x[2] * rstd * g0.z, x[3] * rstd * g0.w); o.z = pk2(x[4] * rstd * g1.x, x[5] * rstd * g1.y); o.w = pk2(x[6] * rstd * g1.z, x[7] * rstd * g1.w); *pq = o; }
        if (lat) {
#pragma unroll
            for (int t = 0; t < 9; ++t) { const int p = lane + 64 * t, v = p >> 5, q = p & 31, half = q >> 4, i = q & 15;
                const int cb = v == 0 ? PC_KR : (v <= 8 ? PC_DK + (v - 1) * 64 : PC_DQ + (v - 9) * 64), ia = cb + half * 32 + i, pos = half ? pcol : prow;
                const float cs = rope[pos * 32 + i], sn = rope[pos * 32 + 16 + i];
                if (p < 544) { pr[ia] = (bf16)f2bf(x1[t] * cs - x2[t] * sn); pr[ia + 16] = (bf16)f2bf(x1[t] * sn + x2[t] * cs); } } }
    }
}
__device__ __forceinline__ void attn_phase(unsigned char* ws, bool with_ctx, char* ldsg, LAS unsigned char* ldsg_las, int vcu, int cv, float lam, float omli, const float* subln) {
    const bf16* P = (const bf16*)(ws + WS_P); const bf16* KV = (const bf16*)(ws + WS_KV); const bf16* Q = (const bf16*)(ws + WS_Q);
    bf16* O = (bf16*)(ws + WS_O);
    for (int rep = 0; rep < 3; ++rep) {
        int b, h, row0, nkeys;
        if (rep < 2) { const int u = vcu + 256 * rep; b = u >> 6; h = (u >> 3) & 7; row0 = b * SEQ + (u & 7) * 256; nkeys = CTXL + SEQ; }
        else { if (!with_ctx || cv < 128 || cv >= 192) break; const int e = cv - 128; b = e >> 3; h = e & 7; row0 = MLAT + b * CTXL; nkeys = CTXL; }
        fa::Src S; S.Q = Q + (size_t)row0 * 1536 + h * 192; S.ldq = 1536; S.Kn = KV + h * 256; S.ldkn = DM; S.Kr = P + PC_KR; S.ldkr = LDP; S.V = KV + h * 256 + 128; S.ldv = DM;
        S.seg0 = MLAT + b * CTXL; S.seg1 = b * SEQ; S.nkeys = nkeys; S.O = O + (size_t)row0 * DM + h * 128; S.ldo = DM;
        S.lam = 0.f; S.omli = 0.f; S.subln = nullptr;
        for (int rp = 0; rp < NREP(17); ++rp) fa::attn_unit_dma<192, 0>(S, ldsg, (LAS unsigned char*)ldsg_las);
    }
    for (int rep = 0; rep < 2; ++rep) {
        int b, hh, row0, nkeys;
        if (rep == 0) { b = vcu >> 5; hh = (vcu >> 3) & 3; row0 = b * SEQ + (vcu & 7) * 256; nkeys = CTXL + SEQ; }
        else { if (!with_ctx || cv < 192 || cv >= 224) break; const int e = cv - 192; b = e >> 2; hh = e & 3; row0 = MLAT + b * CTXL; nkeys = CTXL; }
        fa::Src S; S.Kn = nullptr; S.ldkn = 0; S.ldq = LDP; S.ldkr = LDP; S.V = P + PC_DV + hh * 128; S.ldv = LDP;
        S.seg0 = MLAT + b * CTXL; S.seg1 = b * SEQ; S.nkeys = nkeys; S.O = O + (size_t)row0 * DM + 1024 + hh * 128; S.ldo = DM; S.lam = lam; S.omli = omli; S.subln = subln;
        S.Q = P + (size_t)row0 * LDP + PC_DQ + (2 * hh) * 64; S.Kr = P + PC_DK + (2 * hh) * 64;
        for (int rp = 0; rp < NREP(18); ++rp) {
        fa::attn_unit_dma<64, 1>(S, ldsg, (LAS unsigned char*)ldsg_las);
        S.Q += 64; S.Kr += 64;
        fa::attn_unit_dma<64, 2>(S, ldsg, (LAS unsigned char*)ldsg_las);
        S.Q -= 64; S.Kr -= 64; }
    }
}
#ifndef GSMASK
#define GSMASK 0xffffffffu
#endif
#define GS(n) ((GSMASK >> (n)) & 1u)
__global__ void __launch_bounds__(NWAVES * 64, 2) mega(Args a) {
    extern __shared__ __attribute__((aligned(16))) unsigned char lds_raw[];
    LAS unsigned char* lds = (LAS unsigned char*)lds_raw;
    volatile LAS unsigned* MISC = (volatile LAS unsigned*)(lds + MISC_OFF);
    const int tid = 0, lane = 0;
    const int wave = __builtin_amdgcn_readfirstlane((int)threadIdx.x >> 6);
    const int G = gridDim.x, gw = blockIdx.x * NWAVES + wave, NGW = G * NWAVES;
    unsigned char* ws = a.ws;
    int vcu = (G % 8 == 0) ? (int)(blockIdx.x % 8) * (G / 8) + (int)(blockIdx.x / 8) : (int)blockIdx.x;
    int cv = (int)blockIdx.x;
    for (int u = threadIdx.x; u < (LDS_BYTES - LDSCTL_OFF) / 4; u += NWAVES * 64) ((LAS unsigned*)(lds + LDSCTL_OFF))[u] = 0u;
    __syncthreads();
    const int lo = a.st_lo, hi = a.st_hi;
    XcdBarrier bar; bar.bar = (unsigned*)(ws + WS_CTL) + CW_BAR; bar.x = 0; bar.st = nullptr;
    if (hi - lo > 1) bar = xcd_barrier_post((unsigned*)(ws + WS_CTL) + CW_BAR, MISC + 8);
#define IN(k) (lo <= (k) && (k) < hi)
#define SEAM(k) do { if (hi > (k) + 1) xcd_barrier(bar); else __syncthreads(); } while (0)
#define WSB() ({ unsigned char* p_ = ws; asm volatile("" : "+s"(p_)); p_; })
#define XC ((float*)(WSB() + WS_X))
#define H ((bf16*)(WSB() + WS_H))
#define O ((bf16*)(WSB() + WS_O))
#define ACT ((bf16*)(WSB() + WS_ACT))
#define P ((bf16*)(WSB() + WS_P))
#define KV ((bf16*)(WSB() + WS_KV))
#define Q ((bf16*)(WSB() + WS_Q))
#define OD ((float*)(WSB() + WS_OD))
#define CT ((bf16*)(WSB() + WS_CT))
#define CTC ((bf16*)(WSB() + WS_CTC))
#define PART ((bf16*)(WSB() + WS_PART))
#define DBUF ((bf16*)(WSB() + WS_S))
#define XB ((bf16*)(WSB() + WS_S + 64 * MiB))
#define MOD ((const float*)(WSB() + WS_MOD))
#define ROPE ((const float*)(WSB() + WS_TAB))
#define LAMV ((const float*)(WSB() + WS_TAB + 16384))
    LAS unsigned char* ring = lds;

#ifndef NO_PRO
    if (IN(0)) for (int rp = 0; rp < NREP(10); ++rp) { prologue(a, lds, tid, lane, wave); SEAM(0); }
    if (lo == 0 && hi > 1 && (G % 8) == 0) {
        if (threadIdx.x == 0) { unsigned* bw = (unsigned*)(ws + WS_CTL) + CW_BAR; unsigned start = 0;
            for (unsigned j = 0; j < 16; ++j) { const unsigned cj = xb_ld(&bw[XB_XCNT(j)]); if (j < bar.x) start += cj; }
            MISC[11] = start + MISC[10]; }
        __syncthreads();
        const int u = __builtin_amdgcn_readfirstlane((int)MISC[11]);
        if (u >= 0 && u < G) { vcu = u; cv = (u % (G / 8)) * 8 + u / (G / 8); }
    }
#endif

    for (int fi = 0; fi < 4; ++fi) {
        const int base = 1 + 16 * fi, l = fi >> 1, f = fi & 1;
        const int Mf = (fi == 3) ? MLAT : MTOT;
        const float* modl = MOD + (size_t)l * 9 * MODROW;
        const float* xin_lat = a.in[I_X]; const float* xin_ctx = (fi == 0) ? a.in[I_CTX] : XC;
        if (IN(base + 0)) for (int rp = 0; rp < (fi == 0 ? NREP(0) : 1); ++rp) { norm_mod_phase(xin_lat, xin_ctx, H, a.in[I_NORMG] + (size_t)(l * 3 + 2 * f) * DM, modl, 6 * f + 0, 6 * f + 1, Mf,
                fi > 0 ? DBUF : nullptr, XB, (fi == 1 || fi == 2) ? PART : nullptr, fi == 1 ? modl + 8 * MODROW + 5 * DM : MOD + 8 * MODROW + 8 * DM  , fi == 1 ? 1.0f : 0.5f, XC, gw, NGW, lane);
            if (fi == 1 && NREP(23) > 1) norm_mod_phase(xin_lat, xin_ctx, H, a.in[I_NORMG] + (size_t)(l * 3 + 2 * f) * DM, modl, 6 * f + 0, 6 * f + 1, MLAT, DBUF, XB, nullptr, nullptr, 0.f, XC, gw, NGW, lane);
            SEAM(base + 0); }
        if (IN(base + 1)) for (int rp = 0; rp < NREP(1); ++rp) {
            pg8::Gemm g{H, (const bf16*)(WSB() + WS_WGU) + (size_t)fi * 2 * DFF * DM, Mf, 2 * DFF, DM, 64, 64, 32768, 32768, (size_t)32 * 32768, (size_t)32 * 32768};     pg8::StaticOrder S; S.init(Mf, 2 * DFF, G, cv);
            pg8::EpiSwiglu E{ACT, DFF / 64, 0};
            if (GS(1)) pg8::gemm_phase<pg8::EpiSwiglu, pg8::StaticOrder, true, true>(ring, g, S, E);
            if (fi < 3 && cv >= 96) { __syncthreads(); transpose_set(a, lds, fi + 1, (cv - 96) * NWAVES + wave, (G - 96) * NWAVES); }
            if (NREP(22) > 1) { __syncthreads(); pg8::EpiSwiglu E2{ACT, DFF / 64, 1}; pg8::gemm_phase<pg8::EpiSwiglu, pg8::StaticOrder, true, true>(ring, g, S, E2); }
            SEAM(base + 1);
        }
        if (IN(base + 2)) for (int rp = 0; rp < (fi == 0 ? NREP(2) : 1); ++rp) {
            { pg8::Gemm g{ACT, (const bf16*)(WSB() + WS_WD) + (size_t)fi * DM * DFFP, MTOT, DM, DFF, 64, DFFP, 32768, 128, (size_t)(DFF / 64) * 32768, (size_t)256 * DFFP * 2};
              pg8::LatCtxOrder S; S.init(G, cv, (DFF / 4 / 64) * 32768, (DFF / 4) * 2, DFF / 4 / 64, fi < 3 ? 1 : 0);
              pg8::EpiLatCtx E{{DBUF, modl + (6 * f + 2) * DM, 0.5f, fi == 0 ? 1 : 0}, {PART, MCTX}};
              for (int r2 = 0; r2 < (fi == 0 ? NREP(11) : 1); ++r2) { if (GS(2)) pg8::gemm_phase<pg8::EpiLatCtx, pg8::LatCtxOrder, true, true>(ring, g, S, E); __syncthreads(); } }
            SEAM(base + 2);
        }
        if (f == 0) {
            const int Mq = (l == 0) ? MTOT : MLAT;
            if (IN(base + 3)) { norm_mod_phase(xin_lat, xin_ctx, H, a.in[I_NORMG] + (size_t)(l * 3 + 1) * DM, modl, 3, 4, MTOT, DBUF, XB, PART, modl + 8 * MODROW + 2 * DM, 0.5f, XC, gw, NGW, lane); SEAM(base + 3); }
            if (IN(base + 4)) for (int rp = 0; rp < NREP(4); ++rp) {
                { pg8::Gemm g{H, (const bf16*)(WSB() + WS_WIN) + (size_t)l * LDP * DM, MTOT, LDP, DM, 64, DM, 32768, 128, (size_t)32 * 32768, (size_t)256 * DM * 2}; pg8::StaticOrder S; S.init(MTOT, LDP, G, cv);
                  pg8::EpiStoreBf16 E{P, LDP};
                  if (GS(3)) pg8::gemm_phase<pg8::EpiStoreBf16, pg8::StaticOrder, true, true>(ring, g, S, E); }
                __syncthreads();
                { pg8::Gemm g{(const bf16*)(WSB() + WS_WF1) + (size_t)l * 1024 * DM, H, 1024, Mq, DM, DM, 64, 128, 32768, (size_t)256 * DM * 2, (size_t)32 * 32768}; pg8::StaticOrder S; S.init(1024, Mq, G, (cv + 48) % G);
                  pg8::EpiF1 E{CT, CTC};
                  if (GS(4)) pg8::gemm_phase<pg8::EpiF1, pg8::StaticOrder, true, true>(ring, g, S, E); }
                SEAM(base + 4);
            }
            if (IN(base + 5)) {
                if (cv >= G / 2) postproj_phase(P, a.in[I_KVN] + l * 256, a.in[I_QN] + l * 512, ROPE, MTOT, (cv - G / 2) * NWAVES + wave, (G - G / 2) * NWAVES, lane);
                { pg8::Gemm g = pg8::mk_gemm((const bf16*)(WSB() + WS_DFT), CT, SEQ, NB * 512, 4096, 4096, 4096); pg8::StaticOrder S; S.init(SEQ, NB * 512, G, cv);
                  pg8::EpiF2 E{O, 0, SEQ};
                  for (int r2 = 0; r2 < NREP(19); ++r2) { if (GS(7)) pg8::gemm_phase<pg8::EpiF2, pg8::StaticOrder, true, true>(ring, g, S, E); __syncthreads(); } }
                if (l == 0) {
                  __syncthreads();
                  pg8::Gemm g = pg8::mk_gemm((const bf16*)(WSB() + WS_DFTC), CTC, CTXL, NB * 512, 512, 512, 512); pg8::StaticOrder S; S.init(CTXL, NB * 512, G, (cv + 112) % G);
                  pg8::EpiF2 E{O, MLAT, CTXL};
                  if (GS(8)) pg8::gemm_phase<pg8::EpiF2, pg8::StaticOrder, true, true>(ring, g, S, E); }
                SEAM(base + 5); }
            if (IN(base + 6)) for (int rp = 0; rp < NREP(6); ++rp) {
                { pg8::Gemm g = pg8::mk_gemm(P + PC_CKV, (const bf16*)(WSB() + WS_WUKV) + (size_t)l * 2048 * 256, MTOT, 2048, 256, LDP, 256); pg8::StaticOrder S; S.init(MTOT, 2048, G, cv);
                  pg8::EpiStoreBf16 E{KV, DM};
                  if (GS(5)) pg8::gemm_phase<pg8::EpiStoreBf16, pg8::StaticOrder, true, true>(ring, g, S, E); }
                __syncthreads();
                { pg8::Gemm g = pg8::mk_gemm(P + PC_CQ, (const bf16*)(WSB() + WS_WUQ) + (size_t)l * 1536 * 512, Mq, 1536, 512, LDP, 512); pg8::StaticOrder S; S.init(Mq, 1536, G, (cv + 176) % G);
                  pg8::EpiRopeQ E{Q, 1536, ROPE};
                  if (GS(6)) pg8::gemm_phase<pg8::EpiRopeQ, pg8::StaticOrder, true, true>(ring, g, S, E); }
                SEAM(base + 6);
            }
            if (IN(base + 7)) for (int rp = 0; rp < NREP(7); ++rp) {
                attn_phase(ws, l == 0, (char*)lds_raw, lds, vcu, cv, LAMV[2 * l], LAMV[2 * l + 1], a.in[I_SUBLN] + l * 128);
                SEAM(base + 7);
            }
            if (IN(base + 9)) {
                { pg8::Gemm g = pg8::mk_gemm(O, (const bf16*)(WSB() + WS_WOUT) + (size_t)l * DM * DM, MTOT, DM, DM, DM, DM);
                  pg8::LatCtxOrder S; S.init(G, cv, (DM / 4) * 2, (DM / 4) * 2, DM / 4 / 64, l == 0 ? 1 : 0);
                  pg8::EpiLatCtx E{{DBUF, modl + 5 * DM, 1.0f, 0}, {PART, MCTX}};
                  if (GS(9)) pg8::gemm_phase<pg8::EpiLatCtx, pg8::LatCtxOrder, true, true>(ring, g, S, E); }
                SEAM(base + 9);
            }
        }
    }
    if (IN(65)) final_norm_phase(a.in[I_X], DBUF, a.out, a.in[I_FN], gw, NGW, lane);
#undef IN
#undef SEAM
#undef WSB
#undef XC
#undef H
#undef O
#undef ACT
#undef P
#undef KV
#undef Q
#undef OD
#undef CT
#undef CTC
#undef PART
#undef DBUF
#undef XB
#undef MOD
#undef ROPE
#undef LAMV
}

extern "C" void kernel_launch(void* const* d_in, const int* in_sizes, int n_in, void* d_out, int out_size, void* d_ws, size_t ws_size, hipStream_t stream) {
    static int grid = 0;
    if (grid == 0) {
        if (n_in != 19 || out_size != MLAT * DM || ws_size < WS_END) { fprintf(stderr, "kernel_launch: unexpected shapes (n_in %d, out %d, ws %zu < %zu)\n", n_in, out_size, ws_size, (size_t)WS_END); grid = -1; return; }
        int dev = 0, cus = 0, per_cu = 0;
        if (hipGetDevice(&dev) != hipSuccess || hipDeviceGetAttribute(&cus, hipDeviceAttributeMultiprocessorCount, dev) != hipSuccess) { grid = -1; return; }
        if (hipFuncSetAttribute((const void*)mega, hipFuncAttributeMaxDynamicSharedMemorySize, LDS_BYTES) != hipSuccess) { fprintf(stderr, "kernel_launch: hipFuncSetAttribute failed\n"); grid = -1; return; }
        if (hipOccupancyMaxActiveBlocksPerMultiprocessor(&per_cu, (const void*)mega, NWAVES * 64, LDS_BYTES) != hipSuccess || per_cu < 1) { fprintf(stderr, "kernel_launch: occupancy query says %d\n", per_cu); }
        (void)hipGetLastError();
        grid = cus;
    }
    if (grid < 0) return;
    (void)hipMemsetAsync((char*)d_ws + WS_CTL, 0, CTL_ZERO_BYTES, stream);
    Args a{};
    for (int i = 0; i < 19; ++i) a.in[i] = (const float*)d_in[i];
    a.out = (float*)d_out; a.ws = (unsigned char*)d_ws;
#ifndef MK_ONE_LAUNCH
#define MK_ONE_LAUNCH 1
#endif
    if (MK_ONE_LAUNCH) { a.st_lo = 0; a.st_hi = N_STEPS; hipLaunchKernelGGL(mega, dim3(grid), dim3(NWAVES * 64), LDS_BYTES, stream, a); }
    else {
        int steps[64]; int ns = 0; steps[ns++] = 0;
        for (int fi = 0; fi < 4; ++fi) { const int base = 1 + 16 * fi; for (int k = 0; k < 3; ++k) steps[ns++] = base + k; if ((fi & 1) == 0) for (int k = 3; k < 10; ++k) if (k != 8) steps[ns++] = base + k; }
        steps[ns++] = 65;
        for (int i = 0; i < ns; ++i) { a.st_lo = steps[i]; a.st_hi = steps[i] + 1; hipLaunchKernelGGL(mega, dim3(grid), dim3(NWAVES * 64), LDS_BYTES, stream, a); }
    }
    const hipError_t le = hipPeekAtLastError();
    if (le != hipSuccess) fprintf(stderr, "kernel_launch: launch failed: %s\n", hipGetErrorName(le));
}
```

```cpp
#include <hip/hip_runtime.h>
#include <cstdio>
#include <cstdint>
#ifndef DUPMASK
#define DUPMASK 0u
#endif
#define NREP(k) (1 + (int)((DUPMASK >> (k)) & 1u))
namespace pg8 {
#define PG8_LAS __attribute__((address_space(3)))
typedef unsigned short bf16_t;
typedef short bf16x8 __attribute__((ext_vector_type(8)));
typedef float f32x4 __attribute__((ext_vector_type(4)));
typedef float f32x2 __attribute__((ext_vector_type(2)));
typedef unsigned u32x4 __attribute__((ext_vector_type(4)));
typedef unsigned u32x2 __attribute__((ext_vector_type(2)));
constexpr int BM = 256, BK = 64, HALF = 128, HTB = HALF * BK * 2  , STAGE_BYTES = 8 * HTB, NXCD = 8, WGM = 8;

__host__ __device__ __forceinline__ int lds_byte(int r, int c) { const int st = (r >> 4) * 2 + (c >> 5), rr = r & 15, cc = c & 31, ob = rr * 64 + cc * 2; return st * 1024 + (ob ^ (((ob >> 9) & 1) << 5)); }
__host__ __device__ __forceinline__ void stage_rc(int b, int& R, int& C) { const int st = b / 1024, sb = b % 1024, swz = sb ^ (((sb >> 9) & 1) << 5); R = (st >> 1) * 16 + swz / 64; C = (st & 1) * 32 + (swz % 64) / 2; }
__host__ __device__ __forceinline__ int perm32(int rho) { const int n = rho >> 4, i = rho & 15; return 8 * (i >> 2) + 4 * n + (i & 3); }

struct Unit { int pm, pn, koA, koB, ks, nt; };
struct Gemm { const bf16_t* A; const bf16_t* Bt; int M, N, K, lda, ldb, ksA, ksB; size_t tsA, tsB; };
__host__ __device__ __forceinline__ Gemm mk_gemm(const bf16_t* A, const bf16_t* Bt, int M, int N, int K, int lda, int ldb) { return Gemm{A, Bt, M, N, K, lda, ldb, BK * 2, BK * 2, (size_t)BM * lda * 2, (size_t)BM * ldb * 2}; }

struct StaticOrder {
    int nM, nN, nwg, G, c;
    __host__ __device__ void init(int M, int N, int G_, int c_) { nM = M / BM; nN = N / BM; nwg = nM * nN; G = G_; c = c_; }
    __host__ __device__ bool next(int i, Unit& u) const {
        const long L = (long)i * G + c; if (L >= nwg) return false;
        int wgid = (int)L; { const int q = nwg / NXCD, r = nwg % NXCD, xcd = wgid % NXCD, off = wgid / NXCD; wgid = (xcd < r ? xcd * (q + 1) : r * (q + 1) + (xcd - r) * q) + off; }
        const int nig = WGM * nN, gid = wgid / nig, fm = gid * WGM, gsz = (nM - fm) < WGM ? (nM - fm) : WGM;
        u.pm = fm + ((wgid % nig) % gsz); u.pn = (wgid % nig) / gsz; u.koA = 0; u.koB = 0; u.ks = 0; u.nt = 0; return true;
    }
    __device__ __forceinline__ void a_ready(const Unit&) const {}
    __device__ __forceinline__ void done(const Unit&) const {}
};
struct SplitKOrder {
    int nM, nN, KS, G, c, kpartA, kpartB;
    __host__ __device__ void init(int M, int N, int KS_, int kpartA_, int kpartB_, int G_, int c_) { nM = M / BM; nN = N / BM; KS = KS_; kpartA = kpartA_; kpartB = kpartB_; G = G_; c = c_; }
    __host__ __device__ bool next(int i, Unit& u) const {
        const long L = (long)i * G + c; const int per = nM * nN; if (L >= (long)per * KS) return false;
        const int ks = (int)(L / per), r = (int)(L % per); u.pm = r % nM; u.pn = r / nM; u.ks = ks; u.koA = ks * kpartA; u.koB = ks * kpartB; u.nt = 0; return true;
    }
    __device__ __forceinline__ void a_ready(const Unit&) const {}
    __device__ __forceinline__ void done(const Unit&) const {}
};

struct PanelOrder {
    int nM, nN, G, c;
    __host__ __device__ void init(int M, int N, int G_, int c_) { nM = M / BM; nN = N / BM; G = G_; c = c_; }
    __host__ __device__ bool next(int i, Unit& u) const {
        const int per_x = G / NXCD, xcd = c % NXCD, idx = i * per_x + c / NXCD, pml = idx / nN;
        if (pml >= nM / NXCD) return false;
        u.pm = xcd * (nM / NXCD) + pml; u.pn = idx % nN; u.koA = 0; u.koB = 0; u.ks = 0; u.nt = 0; return true;
    }
    __device__ __forceinline__ void a_ready(const Unit&) const {}
    __device__ __forceinline__ void done(const Unit&) const {}
};
struct LatCtxOrder {
    PanelOrder lat; int G, c, n_lat_rounds, kpartA, kpartB, nt_part, with_ctx;
    __host__ __device__ void init(int G_, int c_, int kpartA_, int kpartB_, int nt_part_, int with_ctx_) { lat.init(16384, 2048, G_, c_); G = G_; c = c_; n_lat_rounds = (64 * 8 + G_ - 1) / G_; kpartA = kpartA_; kpartB = kpartB_; nt_part = nt_part_; with_ctx = with_ctx_; }
    __host__ __device__ bool next(int i, Unit& u) const {
        if (i < n_lat_rounds) { if (lat.next(i, u)) return true; }
        if (!with_ctx) return false;
        const long L = (long)(i - n_lat_rounds) * G + c; if (i < n_lat_rounds || L >= 256) return false;
        const int ks = (int)(L >> 6), r = (int)(L & 63); u.pm = 64 + (r & 7); u.pn = r >> 3; u.ks = ks; u.koA = ks * kpartA; u.koB = ks * kpartB; u.nt = nt_part; return true;
    }
    __device__ __forceinline__ void a_ready(const Unit&) const {}
    __device__ __forceinline__ void done(const Unit&) const {}
};
__device__ __forceinline__ unsigned cvt_pk_bf16(float lo, float hi) { unsigned r; asm volatile("v_cvt_pk_bf16_f32 %0, %1, %2" : "=v"(r) : "v"(lo), "v"(hi)); return r; }
__device__ __forceinline__ float silu_f(float x) { return x * __builtin_amdgcn_rcpf(1.0f + __builtin_amdgcn_exp2f(-1.4426950408889634f * x)); }

constexpr int E_DM = 2048, E_MLAT = 16384, E_MODROW = 9 * 2048;

struct EpiSwiglu {
    static constexpr bool PERM = true, AFTER_DRAIN = false;
    bf16_t* O; int nkt; int skip;
    __device__ __forceinline__ void operator()(const f32x4 (&acc)[2][2][4][2], const Unit& u, int wr, int wc, int fr, int fq) const {
        if (skip && acc[0][0][0][0][0] != 1.2345e30f) return;
        bf16_t* base = O + (((size_t)u.pm * nkt + 2 * u.pn + (wc >> 1)) * BM + wr * 64 + fr) * 64 + (wc & 1) * 32 + 8 * fq;
#pragma unroll
        for (int ai = 0; ai < 2; ++ai)
#pragma unroll
            for (int m = 0; m < 4; ++m) { bf16_t* rowp = base + (size_t)(ai * HALF + m * 16) * 64;
                const f32x4 g0 = acc[ai][0][m][0], g1 = acc[ai][0][m][1], u0 = acc[ai][1][m][0], u1 = acc[ai][1][m][1];
                u32x4 w; w.x = cvt_pk_bf16(silu_f(g0[0]) * u0[0], silu_f(g0[1]) * u0[1]); w.y = cvt_pk_bf16(silu_f(g0[2]) * u0[2], silu_f(g0[3]) * u0[3]);
                w.z = cvt_pk_bf16(silu_f(g1[0]) * u1[0], silu_f(g1[1]) * u1[1]); w.w = cvt_pk_bf16(silu_f(g1[2]) * u1[2], silu_f(g1[3]) * u1[3]);
                *(u32x4*)rowp = w; }
    }
};
struct EpiStoreBf16 {
    static constexpr bool PERM = true, AFTER_DRAIN = false;
    bf16_t* O; int ldc;
    __device__ __forceinline__ void operator()(const f32x4 (&acc)[2][2][4][2], const Unit& u, int wr, int wc, int fr, int fq) const {
        const int row0 = u.pm * BM + wr * 64 + fr, col0 = u.pn * BM + wc * 32 + 8 * fq;
#pragma unroll
        for (int ai = 0; ai < 2; ++ai)
#pragma unroll
            for (int m = 0; m < 4; ++m) { bf16_t* rowp = O + (size_t)(row0 + ai * HALF + m * 16) * ldc + col0;
#pragma unroll
                for (int bj = 0; bj < 2; ++bj) { const f32x4 v0 = acc[ai][bj][m][0], v1 = acc[ai][bj][m][1];
                    u32x4 w; w.x = cvt_pk_bf16(v0[0], v0[1]); w.y = cvt_pk_bf16(v0[2], v0[3]); w.z = cvt_pk_bf16(v1[0], v1[1]); w.w = cvt_pk_bf16(v1[2], v1[3]);
                    *(u32x4*)(rowp + bj * HALF) = w; } }
    }
};
struct EpiDelta {
    static constexpr bool PERM = true, AFTER_DRAIN = false;
    bf16_t* D; const float* gate; float coef; int first;
    __device__ __forceinline__ void operator()(const f32x4 (&acc)[2][2][4][2], const Unit& u, int wr, int wc, int fr, int fq) const {
        const int row0 = u.pm * BM + wr * 64 + fr, col0 = u.pn * BM + wc * 32 + 8 * fq; const float* gp = gate + (size_t)(u.pm >> 3) * E_MODROW + col0;
        f32x4 gv[2][2];
#pragma unroll
        for (int bj = 0; bj < 2; ++bj)
#pragma unroll
            for (int n = 0; n < 2; ++n) gv[bj][n] = *(const f32x4*)(gp + bj * HALF + 4 * n) * coef;
#pragma unroll
        for (int ai = 0; ai < 2; ++ai) { u32x4 old[4][2];
            if (!first) {
#pragma unroll
                for (int m = 0; m < 4; ++m)
#pragma unroll
                    for (int bj = 0; bj < 2; ++bj) old[m][bj] = *(const u32x4*)(D + (size_t)(row0 + ai * HALF + m * 16) * E_DM + col0 + bj * HALF);
                asm volatile("" ::: "memory"); }
#pragma unroll
            for (int m = 0; m < 4; ++m) { bf16_t* rowp = D + (size_t)(row0 + ai * HALF + m * 16) * E_DM + col0;
#pragma unroll
                for (int bj = 0; bj < 2; ++bj) { f32x4 v0 = acc[ai][bj][m][0] * gv[bj][0], v1 = acc[ai][bj][m][1] * gv[bj][1];
                    if (!first) { const u32x4 o = old[m][bj];
                        v0[0] += __builtin_bit_cast(float, o.x << 16); v0[1] += __builtin_bit_cast(float, o.x & 0xffff0000u); v0[2] += __builtin_bit_cast(float, o.y << 16); v0[3] += __builtin_bit_cast(float, o.y & 0xffff0000u);
                        v1[0] += __builtin_bit_cast(float, o.z << 16); v1[1] += __builtin_bit_cast(float, o.z & 0xffff0000u); v1[2] += __builtin_bit_cast(float, o.w << 16); v1[3] += __builtin_bit_cast(float, o.w & 0xffff0000u); }
                    u32x4 w; w.x = cvt_pk_bf16(v0[0], v0[1]); w.y = cvt_pk_bf16(v0[2], v0[3]); w.z = cvt_pk_bf16(v1[0], v1[1]); w.w = cvt_pk_bf16(v1[2], v1[3]);
                    *(u32x4*)(rowp + bj * HALF) = w; } }
            asm volatile("" ::: "memory"); }
    }
};
struct EpiPartial {
    static constexpr bool PERM = true, AFTER_DRAIN = false;
    bf16_t* part; int rows;
    __device__ __forceinline__ void operator()(const f32x4 (&acc)[2][2][4][2], const Unit& u, int wr, int wc, int fr, int fq) const {
        bf16_t* out = part + ((size_t)u.ks * rows + (size_t)u.pm * BM + wr * 64 + fr) * E_DM + u.pn * BM + wc * 32 + 8 * fq;
#pragma unroll
        for (int ai = 0; ai < 2; ++ai)
#pragma unroll
            for (int m = 0; m < 4; ++m) { bf16_t* rowp = out + (size_t)(ai * HALF + m * 16) * E_DM;
#pragma unroll
                for (int bj = 0; bj < 2; ++bj) { const f32x4 v0 = acc[ai][bj][m][0], v1 = acc[ai][bj][m][1];
                    u32x4 w; w.x = cvt_pk_bf16(v0[0], v0[1]); w.y = cvt_pk_bf16(v0[2], v0[3]); w.z = cvt_pk_bf16(v1[0], v1[1]); w.w = cvt_pk_bf16(v1[2], v1[3]);
                    *(u32x4*)(rowp + bj * HALF) = w; } }
    }
};
struct EpiLatCtx {
    static constexpr bool PERM = true, AFTER_DRAIN = false;
    EpiDelta lat; EpiPartial ctx;
    __device__ __forceinline__ void operator()(const f32x4 (&acc)[2][2][4][2], const Unit& u, int wr, int wc, int fr, int fq) const {
        if (u.pm < 64) lat(acc, u, wr, wc, fr, fq);
        else { Unit v = u; v.pm = u.pm - 64; ctx(acc, v, wr, wc, fr, fq); }
    }
};
struct EpiF1 {
    static constexpr bool PERM = true, AFTER_DRAIN = false;
    bf16_t* Ct; bf16_t* Ctc;
    __device__ __forceinline__ void operator()(const f32x4 (&acc)[2][2][4][2], const Unit& u, int wr, int wc, int fr, int fq) const {
        const int row0 = u.pm * BM + wr * 64 + fr, cw = wc * 32 + 8 * fq;
#pragma unroll
        for (int ai = 0; ai < 2; ++ai)
#pragma unroll
            for (int m = 0; m < 4; ++m) { const int mr = row0 + ai * HALF + m * 16, type = mr >> 9, n = mr & 511;
                bf16_t* rowp = u.pn < 64 ? Ct + (((size_t)((u.pn >> 3) * 512 + n)) * 2 + type) * 2048 + (u.pn & 7) * 256 + cw
                                         : Ctc + (((size_t)((u.pn - 64) * 512 + n)) * 2 + type) * 256 + cw;
#pragma unroll
                for (int bj = 0; bj < 2; ++bj) { const f32x4 v0 = acc[ai][bj][m][0], v1 = acc[ai][bj][m][1];
                    u32x4 w; w.x = cvt_pk_bf16(v0[0], v0[1]); w.y = cvt_pk_bf16(v0[2], v0[3]); w.z = cvt_pk_bf16(v1[0], v1[1]); w.w = cvt_pk_bf16(v1[2], v1[3]);
                    *(u32x4*)(rowp + bj * HALF) = w; } }
    }
};
struct EpiF2 {
    static constexpr bool PERM = true, AFTER_DRAIN = false;
    bf16_t* O; int rowbase, rows_per_b;
    __device__ __forceinline__ void operator()(const f32x4 (&acc)[2][2][4][2], const Unit& u, int wr, int wc, int fr, int fq) const {
        const int row0 = rowbase + (u.pn >> 1) * rows_per_b + u.pm * BM + wr * 64 + fr, col0 = 1536 + (u.pn & 1) * 256 + wc * 32 + 8 * fq;
#pragma unroll
        for (int ai = 0; ai < 2; ++ai)
#pragma unroll
            for (int m = 0; m < 4; ++m) { bf16_t* rowp = O + (size_t)(row0 + ai * HALF + m * 16) * E_DM + col0;
#pragma unroll
                for (int bj = 0; bj < 2; ++bj) { const f32x4 v0 = acc[ai][bj][m][0], v1 = acc[ai][bj][m][1];
                    u32x4 w; w.x = cvt_pk_bf16(v0[0], v0[1]); w.y = cvt_pk_bf16(v0[2], v0[3]); w.z = cvt_pk_bf16(v1[0], v1[1]); w.w = cvt_pk_bf16(v1[2], v1[3]);
                    *(u32x4*)(rowp + bj * HALF) = w; } }
    }
};
struct EpiRopeQ {
    static constexpr bool PERM = false, AFTER_DRAIN = false;
    bf16_t* Q; int ldc; const float* rope;
    __device__ __forceinline__ void operator()(const f32x4 (&acc)[2][2][4][2], const Unit& u, int wr, int wc, int fr, int fq) const {
        const int row0 = u.pm * BM + wr * 64 + fr;
#pragma unroll
        for (int bj = 0; bj < 2; ++bj) { const int cg = u.pn * BM + bj * HALF + wc * 32, within = cg % 192; const bool roped = within >= 128 && u.pm < 64; const int half = (within - 128) >> 5;
#pragma unroll
            for (int ai = 0; ai < 2; ++ai)
#pragma unroll
                for (int m = 0; m < 4; ++m) { const int row = row0 + ai * HALF + m * 16, s = row & 2047, pos = half ? (s & 63) : (s >> 6);
                    f32x4 x1 = acc[ai][bj][m][0], x2 = acc[ai][bj][m][1];
                    if (roped) { const f32x4 cs = *(const f32x4*)(rope + pos * 32 + 4 * fq), sn = *(const f32x4*)(rope + pos * 32 + 16 + 4 * fq);
                        const f32x4 o1 = x1 * cs - x2 * sn, o2 = x1 * sn + x2 * cs; x1 = o1; x2 = o2; }
                    bf16_t* p = Q + (size_t)row * ldc + cg + 4 * fq;
                    u32x2 w1, w2; w1.x = cvt_pk_bf16(x1[0], x1[1]); w1.y = cvt_pk_bf16(x1[2], x1[3]); w2.x = cvt_pk_bf16(x2[0], x2[1]); w2.y = cvt_pk_bf16(x2[2], x2[3]);
                    *(u32x2*)p = w1; *(u32x2*)(p + 16) = w2; } }
    }
};

template <class Epi, class Sched, bool ALIGN_EPI = false, bool SP2 = false>
__device__ __forceinline__ void gemm_phase(PG8_LAS unsigned char* lds, const Gemm g, const Sched& S, const Epi& E) {
    int tid_ = threadIdx.x; asm volatile("" : "+v"(tid_));
    const int tid = tid_, wid = __builtin_amdgcn_readfirstlane(tid >> 6), lane = tid & 63, wr = wid >> 2, wc = wid & 3, fr = lane & 15, fq = lane >> 4;
    const int K = g.K, nt0 = K / BK;
    unsigned voffA[2], voffB[2];
#pragma unroll
    for (int i = 0; i < 2; ++i) { int R, C; stage_rc(tid * 16 + i * 8192, R, C); const int Rb = Epi::PERM ? ((R & ~31) + perm32(R & 31)) : R;
        voffA[i] = (unsigned)(R * g.lda + C) * 2u; voffB[i] = (unsigned)(Rb * g.ldb + C) * 2u; }
    const size_t kstepA = (size_t)g.ksA, kstepB = (size_t)g.ksB;
    const size_t hstepA = (size_t)HALF * g.lda * 2, hstepB = (size_t)HALF * g.ldb * 2;
    const size_t tstepA = g.tsA, tstepB = g.tsB;
    const unsigned ldsw = (unsigned)wid * 1024u;
    const int aoff = lds_byte(wr * 64 + fr, fq * 8), boff = lds_byte(wc * 32 + fr, fq * 8);
#define PG8_SA(b, h) (((b) * 2 + (h)) * HTB)
#define PG8_SB(b, h) ((4 + (b) * 2 + (h)) * HTB)
#define PG8_STAGE(bufoff, gbase, voff) do { _Pragma("unroll") for (int _i = 0; _i < 2; ++_i) \
        __builtin_amdgcn_global_load_lds((const unsigned*)((const char*)(gbase) + (voff)[_i]), (PG8_LAS unsigned*)(lds + (bufoff) + ldsw + _i * 8192), 16, 0, 0); } while (0)
#define PG8_LDA(dst, b, h) do { _Pragma("unroll") for (int m = 0; m < 4; ++m) _Pragma("unroll") for (int k = 0; k < 2; ++k) dst[m][k] = *(const PG8_LAS bf16x8*)(lds + PG8_SA(b, h) + aoff + m * 2048 + k * 1024); } while (0)
#define PG8_LDB(dst, b, h) do { _Pragma("unroll") for (int n = 0; n < 2; ++n) _Pragma("unroll") for (int k = 0; k < 2; ++k) dst[n][k] = *(const PG8_LAS bf16x8*)(lds + PG8_SB(b, h) + boff + n * 2048 + k * 1024); } while (0)
#define PG8_MMA(ai, bj, At, Bt) do { __builtin_amdgcn_s_setprio(1); _Pragma("unroll") for (int m = 0; m < 4; ++m) _Pragma("unroll") for (int n = 0; n < 2; ++n) _Pragma("unroll") for (int k = 0; k < 2; ++k) \
        acc[ai][bj][m][n] = __builtin_amdgcn_mfma_f32_16x16x32_bf16(Bt[n][k], At[m][k], acc[ai][bj][m][n], 0, 0, 0); __builtin_amdgcn_s_setprio(0); } while (0)
#define PG8_WAIT_V(n) asm volatile("s_waitcnt vmcnt(" #n ")" ::: "memory")
#define PG8_WAIT_L(n) asm volatile("s_waitcnt lgkmcnt(" #n ")" ::: "memory")
#define PG8_BAR __builtin_amdgcn_s_barrier()
#define PG8_SCHED __builtin_amdgcn_sched_barrier(0)
    Unit cur, nxt; int ui = 0;
    if (!S.next(0, cur)) return;
    f32x4 acc[2][2][4][2];
#pragma unroll
    for (int a = 0; a < 2; ++a)
#pragma unroll
        for (int b = 0; b < 2; ++b)
#pragma unroll
            for (int m = 0; m < 4; ++m)
#pragma unroll
                for (int n = 0; n < 2; ++n) acc[a][b][m][n] = (f32x4){0.f, 0.f, 0.f, 0.f};
    bf16x8 At[4][2], B0[2][2], B1[2][2];
    const char* cA = (const char*)g.A + (size_t)cur.pm * tstepA + cur.koA; const char* cB = (const char*)g.Bt + (size_t)cur.pn * tstepB + cur.koB;
    S.a_ready(cur);
    if constexpr (SP2) {
        PG8_STAGE(PG8_SB(0, 0), cB, voffB); PG8_STAGE(PG8_SB(0, 1), cB + hstepB, voffB); PG8_STAGE(PG8_SA(0, 0), cA, voffA); PG8_STAGE(PG8_SA(0, 1), cA + hstepA, voffA);
        if (wr == 1) PG8_BAR;
        PG8_WAIT_V(2); PG8_BAR;
        PG8_STAGE(PG8_SB(1, 0), cB + kstepB, voffB); PG8_STAGE(PG8_SA(1, 0), cA + kstepA, voffA); PG8_STAGE(PG8_SB(1, 1), cB + hstepB + kstepB, voffB);
        PG8_WAIT_V(6); PG8_BAR;
    } else {
        PG8_STAGE(PG8_SB(0, 0), cB, voffB); PG8_STAGE(PG8_SA(0, 0), cA, voffA); PG8_STAGE(PG8_SB(0, 1), cB + hstepB, voffB); PG8_STAGE(PG8_SA(0, 1), cA + hstepA, voffA);
        if (wr == 1) PG8_BAR;
        PG8_WAIT_V(4); PG8_BAR;
        PG8_STAGE(PG8_SB(1, 0), cB + kstepB, voffB); PG8_STAGE(PG8_SA(1, 0), cA + kstepA, voffA); PG8_STAGE(PG8_SB(1, 1), cB + hstepB + kstepB, voffB);
        PG8_WAIT_V(6); PG8_BAR;
    }
    for (;;) {
        const bool has_next = S.next(ui + 1, nxt);
        const char* nA = has_next ? (const char*)g.A + (size_t)nxt.pm * tstepA + nxt.koA : cA; const char* nB = has_next ? (const char*)g.Bt + (size_t)nxt.pn * tstepB + nxt.koB : cB;
        const int nt = cur.nt ? cur.nt : nt0;
#pragma nounroll
        for (int t = 0; t < nt; t += 2) {
            const bool last = (t == nt - 2);
            const char* a1 = cA + (size_t)(t + 1) * kstepA;
            const char* a2 = last ? nA : cA + (size_t)(t + 2) * kstepA; const char* b2 = last ? nB : cB + (size_t)(t + 2) * kstepB;
            const char* a3 = a2 + kstepA; const char* b3 = b2 + kstepB;
            if (last && has_next) S.a_ready(nxt);
            if constexpr (SP2) {
            PG8_LDB(B0, 0, 0); PG8_LDB(B1, 0, 1); PG8_SCHED; PG8_LDA(At, 0, 0); PG8_STAGE(PG8_SA(1, 1), a1 + hstepA, voffA);
            PG8_WAIT_V(8); PG8_WAIT_L(0); PG8_BAR; PG8_MMA(0, 0, At, B0); PG8_MMA(0, 1, At, B1); PG8_BAR; PG8_SCHED;
            PG8_LDA(At, 0, 1); PG8_STAGE(PG8_SB(0, 0), b2, voffB); PG8_STAGE(PG8_SB(0, 1), b2 + hstepB, voffB); PG8_STAGE(PG8_SA(0, 0), a2, voffA);
            PG8_WAIT_V(8); PG8_WAIT_L(0); PG8_BAR; PG8_MMA(1, 0, At, B0); PG8_MMA(1, 1, At, B1); PG8_BAR; PG8_SCHED;
            PG8_LDB(B0, 1, 0); PG8_LDB(B1, 1, 1); PG8_SCHED; PG8_LDA(At, 1, 0); PG8_STAGE(PG8_SA(0, 1), a2 + hstepA, voffA);
            PG8_WAIT_V(8); PG8_WAIT_L(0); PG8_BAR; PG8_MMA(0, 0, At, B0); PG8_MMA(0, 1, At, B1); PG8_BAR; PG8_SCHED;
            PG8_LDA(At, 1, 1); PG8_STAGE(PG8_SB(1, 0), b3, voffB); PG8_STAGE(PG8_SB(1, 1), b3 + hstepB, voffB); PG8_STAGE(PG8_SA(1, 0), a3, voffA);
            PG8_WAIT_V(8); PG8_WAIT_L(0); PG8_BAR; PG8_MMA(1, 0, At, B0); PG8_MMA(1, 1, At, B1); PG8_BAR; PG8_SCHED;
            } else {
            PG8_LDB(B0, 0, 0); PG8_SCHED; PG8_LDA(At, 0, 0); PG8_STAGE(PG8_SA(1, 1), a1 + hstepA, voffA);
            PG8_WAIT_L(8); PG8_BAR; PG8_WAIT_L(0); PG8_MMA(0, 0, At, B0); PG8_BAR; PG8_SCHED;
            PG8_LDB(B1, 0, 1); PG8_STAGE(PG8_SB(0, 0), b2, voffB);
            PG8_BAR; PG8_WAIT_L(0); PG8_MMA(0, 1, At, B1); PG8_BAR;
            PG8_LDA(At, 0, 1); PG8_STAGE(PG8_SA(0, 0), a2, voffA);
            PG8_BAR; PG8_WAIT_L(0); PG8_MMA(1, 0, At, B0); PG8_BAR; PG8_SCHED;
            PG8_STAGE(PG8_SB(0, 1), b2 + hstepB, voffB);
            PG8_WAIT_V(6); PG8_BAR; PG8_MMA(1, 1, At, B1); PG8_BAR;
            PG8_LDB(B0, 1, 0); PG8_SCHED; PG8_LDA(At, 1, 0); PG8_STAGE(PG8_SA(0, 1), a2 + hstepA, voffA);
            PG8_WAIT_L(8); PG8_BAR; PG8_WAIT_L(0); PG8_MMA(0, 0, At, B0); PG8_BAR; PG8_SCHED;
            PG8_LDB(B1, 1, 1); PG8_STAGE(PG8_SB(1, 0), b3, voffB);
            PG8_BAR; PG8_WAIT_L(0); PG8_MMA(0, 1, At, B1); PG8_BAR;
            PG8_LDA(At, 1, 1); PG8_STAGE(PG8_SA(1, 0), a3, voffA);
            PG8_BAR; PG8_WAIT_L(0); PG8_MMA(1, 0, At, B0); PG8_BAR; PG8_SCHED;
            PG8_STAGE(PG8_SB(1, 1), b3 + hstepB, voffB);
            PG8_WAIT_V(6); PG8_BAR; PG8_MMA(1, 1, At, B1); PG8_BAR;
            }
        }
        if constexpr (ALIGN_EPI) { if (wr == 0) PG8_BAR; }
        if constexpr (!Epi::AFTER_DRAIN) { E(acc, cur, wr, wc, fr, fq); S.done(cur); }
        if (!has_next) break;
#pragma unroll
        for (int a = 0; a < 2; ++a)
#pragma unroll
            for (int b = 0; b < 2; ++b)
#pragma unroll
                for (int m = 0; m < 4; ++m)
#pragma unroll
                    for (int n = 0; n < 2; ++n) acc[a][b][m][n] = (f32x4){0.f, 0.f, 0.f, 0.f};
        cur = nxt; cA = nA; cB = nB; ++ui;
        if constexpr (ALIGN_EPI) { if (wr == 1) PG8_BAR; }
    }
    PG8_WAIT_V(0);
    if constexpr (!ALIGN_EPI) { if (wr == 0) PG8_BAR; }
    PG8_BAR;
    if constexpr (Epi::AFTER_DRAIN) { E.fused(acc, cur, wr, wc, fr, fq, lds, wid, lane); S.done(cur); }
#undef PG8_SA
#undef PG8_SB
#undef PG8_STAGE
#undef PG8_LDA
#undef PG8_LDB
#undef PG8_MMA
#undef PG8_WAIT_V
#undef PG8_WAIT_L
#undef PG8_BAR
#undef PG8_SCHED
}
}

#define GAS __attribute__((address_space(1)))
#define LAS __attribute__((address_space(3)))
typedef unsigned short bf16;
typedef unsigned v4u __attribute__((ext_vector_type(4)));
typedef float f32x4 __attribute__((ext_vector_type(4)));
typedef short bf16x8 __attribute__((ext_vector_type(8)));
typedef GAS unsigned gu32;
typedef GAS unsigned long long gu64;
#define RLX_AGENT __ATOMIC_RELAXED, __HIP_MEMORY_SCOPE_AGENT
#define LDS_WAIT() asm volatile("s_waitcnt lgkmcnt(0)" ::: "memory")
#define VM_WAIT() asm volatile("s_waitcnt vmcnt(0)" ::: "memory")
__device__ __forceinline__ unsigned long long rt() { return __builtin_amdgcn_s_memrealtime(); }
__device__ __forceinline__ unsigned f2bf(float f) { unsigned u = __builtin_bit_cast(unsigned, f); return (u + 0x7fffu + ((u >> 16) & 1u)) >> 16; }
__device__ __forceinline__ unsigned pk2(float lo, float hi) { return f2bf(lo) | (f2bf(hi) << 16); }

#define XB_TMO      128
#define XB_XCNT(j)  (256  + 64 * (j))
#define XB_XSUB(j)  (1280 + 64 * (j))
#define XB_XGEN(j)  (2304 + 64 * (j))
#define XB_TOP      3328
#define XB_TOPGEN   3392
#define XCD_BAR_WORDS 3456
#define XB_SPIN_CAP (1u << 18)

__device__ __forceinline__ unsigned xb_ld(unsigned* p)              { return __hip_atomic_load(p, __ATOMIC_RELAXED, __HIP_MEMORY_SCOPE_AGENT); }
__device__ __forceinline__ unsigned xb_add(unsigned* p, unsigned v) { return __hip_atomic_fetch_add(p, v, __ATOMIC_RELAXED, __HIP_MEMORY_SCOPE_AGENT); }
__device__ __forceinline__ unsigned xb_xcc_id() { return (unsigned)__builtin_amdgcn_s_getreg((3 << 11) | 20) & 0xFu; }
#define XB_SPIN(cond, bar) do { unsigned _sp = 0; while (cond) { __builtin_amdgcn_s_sleep(1); \
    if ((++_sp & 255u) == 0u) { if (xb_ld(&(bar)[XB_TMO])) break; if (_sp > XB_SPIN_CAP) { atomicAdd(&(bar)[XB_TMO], 1u); break; } } } } while (0)

struct XcdBarrier {
    unsigned* bar; unsigned x;
    volatile LAS unsigned* st;
};

__device__ __forceinline__ XcdBarrier xcd_barrier_post(unsigned* bar, volatile LAS unsigned* st) {
    XcdBarrier b; b.bar = bar; b.x = xb_xcc_id(); b.st = st;
    if (threadIdx.x == 0) st[2] = xb_add(&bar[XB_XCNT(b.x)], 1u);
    return b;
}
__device__ __forceinline__ void xcd_barrier_complete(unsigned* bar, unsigned x, unsigned& nloc, unsigned& nx) {
    const unsigned G = gridDim.x * gridDim.y * gridDim.z;
    unsigned sum, cnt, mine, sp = 0u;
    for (;;) {
        sum = 0u; cnt = 0u; mine = 0u;
#pragma unroll
        for (unsigned j = 0; j < 16; ++j) { const unsigned c = xb_ld(&bar[XB_XCNT(j)]); sum += c; cnt += (c > 0u) ? 1u : 0u; mine = (j == x) ? c : mine; }
        if (sum == G) break;
        __builtin_amdgcn_s_sleep(1);
        if ((++sp & 255u) == 0u) { if (xb_ld(&bar[XB_TMO])) break; if (sp > XB_SPIN_CAP) { atomicAdd(&bar[XB_TMO], 1u); break; } }
    }
    nloc = mine > 0u ? mine : 1u; nx = cnt > 0u ? cnt : 1u;
}

__device__ __forceinline__ void xcd_barrier(const XcdBarrier& b) {
    asm volatile("s_waitcnt vmcnt(0)" ::: "memory");
    __syncthreads();
    if (threadIdx.x == 0) {
        unsigned* bar = b.bar; asm volatile("" : "+s"(bar));
        __builtin_amdgcn_s_waitcnt(0);
        unsigned nloc = b.st[0], nx = b.st[1];
        if (nloc == 0u) { xcd_barrier_complete(bar, b.x, nloc, nx); b.st[0] = nloc; b.st[1] = nx; }
        const unsigned old = xb_add(&bar[XB_XSUB(b.x)], 1u);
        const unsigned gen = old / nloc;
        if (old + 1u == (gen + 1u) * nloc) {
            __builtin_amdgcn_fence(__ATOMIC_RELEASE, "agent");
            asm volatile("s_waitcnt vmcnt(0)" ::: "memory");
            const unsigned og = xb_add(&bar[XB_TOP], 1u);
            const unsigned tg = og / nx;
            if (og + 1u == (tg + 1u) * nx) xb_add(&bar[XB_TOPGEN], 1u);
            else XB_SPIN(xb_ld(&bar[XB_TOPGEN]) == tg, bar);
            __builtin_amdgcn_fence(__ATOMIC_ACQUIRE, "agent");
            xb_add(&bar[XB_XGEN(b.x)], 1u);
            asm volatile("s_waitcnt vmcnt(0)" ::: "memory");
        } else {
            XB_SPIN(xb_ld(&bar[XB_XGEN(b.x)]) == gen, bar);
            __builtin_amdgcn_fence(__ATOMIC_ACQUIRE, "agent");
            asm volatile("s_waitcnt vmcnt(0)" ::: "memory");
        }
    }
    __syncthreads();
}

namespace fa {
using bf16 = unsigned short;
using bf16x8 = __attribute__((ext_vector_type(8))) short;
using s16x4  = __attribute__((ext_vector_type(4))) short;
using f32x16 = __attribute__((ext_vector_type(16))) float;
using u32x4  = __attribute__((ext_vector_type(4))) unsigned;
constexpr int NW = 8, QBLK = 32, KVBLK = 64;
constexpr float THR = 8.f;
constexpr int SHM_V = KVBLK * 128 * 2, SHM_KN = KVBLK * 128 * 2, SHM_KR = KVBLK * 64 * 2;
constexpr int OFF_V = 0, OFF_KN = 2 * SHM_V, OFF_KR = OFF_KN + 2 * SHM_KN, OFF_WS = OFF_KR + 2 * SHM_KR, OFF_QR = OFF_WS + NW * 64 * 4, ATTN_LDS = OFF_QR + NW * 4096;
#define FA_KNSWZ(row, colB) ((row) * 256 + ((colB) ^ (((row) & 15) << 4)))
#define FA_KRSWZ(row, c) ((row) * 128 + ((((c) ^ ((row) >> 1)) & 7) << 4))
#define FA_SBAR() __builtin_amdgcn_sched_barrier(0)
__device__ __forceinline__ int crow(int r, int hi) { return (r & 3) + 8 * (r >> 2) + 4 * hi; }
__device__ __forceinline__ unsigned cvtpk(float lo, float hi) { unsigned r; asm volatile("v_cvt_pk_bf16_f32 %0, %1, %2" : "=v"(r) : "v"(lo), "v"(hi)); return r; }

template <int DQK> __device__ __forceinline__ void partialSM(f32x16& p0, f32x16& p1, float& m_reg, float& mn, float& alpha) {
  constexpr float SCALE = (DQK == 192) ? 0.07216878364870322f : 0.125f;
  constexpr float C = SCALE * 1.4426950408889634f;
  float pmax = p0[0];
#pragma unroll
  for (int r = 1; r < 16; ++r) pmax = fmaxf(pmax, p0[r]);
#pragma unroll
  for (int r = 0; r < 16; ++r) pmax = fmaxf(pmax, p1[r]);
  { auto rr = __builtin_amdgcn_permlane32_swap(__float_as_uint(pmax), __float_as_uint(pmax), false, false);
    pmax = fmaxf(__uint_as_float(rr[0]), __uint_as_float(rr[1])); }
  if (__builtin_expect(__all(pmax - m_reg <= THR / SCALE), 1)) { mn = m_reg; alpha = 1.f; }
  else { mn = fmaxf(m_reg, pmax); alpha = __builtin_amdgcn_exp2f((m_reg - mn) * C); m_reg = mn; }
  const float mnC = -mn * C;
#pragma unroll
  for (int r = 0; r < 16; ++r) p0[r] = fmaf(p0[r], C, mnC);
#pragma unroll
  for (int r = 0; r < 16; ++r) p1[r] = fmaf(p1[r], C, mnC);
#pragma unroll
  for (int r = 0; r < 16; ++r) p0[r] = __builtin_amdgcn_exp2f(p0[r]);
}
__device__ __forceinline__ void finishSM(f32x16& p0, f32x16& p1, float alpha, float& l_reg, bf16x8& pa0, bf16x8& pa1, bf16x8& pa2, bf16x8& pa3) {
#pragma unroll
  for (int r = 0; r < 16; ++r) p1[r] = __builtin_amdgcn_exp2f(p1[r]);
  float ps = 0;
#pragma unroll
  for (int r = 0; r < 16; ++r) ps += p0[r];
#pragma unroll
  for (int r = 0; r < 16; ++r) ps += p1[r];
  { auto rr = __builtin_amdgcn_permlane32_swap(__float_as_uint(ps), __float_as_uint(ps), false, false);
    ps = __uint_as_float(rr[0]) + __uint_as_float(rr[1]); }
  l_reg = l_reg * alpha + ps;
#define FA_PK4(P, BASE, OUT) do { unsigned a0 = cvtpk(P[BASE + 0], P[BASE + 1]), a1 = cvtpk(P[BASE + 2], P[BASE + 3]);   \
    unsigned b0 = cvtpk(P[BASE + 4], P[BASE + 5]), b1 = cvtpk(P[BASE + 6], P[BASE + 7]);                              \
    auto r0 = __builtin_amdgcn_permlane32_swap(a0, b0, false, false); auto r1 = __builtin_amdgcn_permlane32_swap(a1, b1, false, false); \
    u32x4 w = {r0[0], r1[0], r0[1], r1[1]}; OUT = *reinterpret_cast<bf16x8*>(&w); } while (0)
  FA_PK4(p0, 0, pa0); FA_PK4(p0, 8, pa1); FA_PK4(p1, 0, pa2); FA_PK4(p1, 8, pa3);
#undef FA_PK4
}
template <int DQK> __device__ __forceinline__ void qkt(f32x16& p0, f32x16& p1, const char* Kn, const char* Kr, const bf16x8* qr, const char* Kn_qbase, int qoff, int r32, int hi) {
  p0 = f32x16{}; p1 = f32x16{};
  constexpr int NKN = (DQK == 192) ? 8 : 0;
#pragma unroll
  for (int d0 = 0; d0 < NKN; ++d0) { const int cb = (d0 * 16 + hi * 8) * 2;
    const bf16x8 b0 = *reinterpret_cast<const bf16x8*>(Kn + FA_KNSWZ(r32, cb));
    const bf16x8 b1 = *reinterpret_cast<const bf16x8*>(Kn + FA_KNSWZ(32 + r32, cb));
    p0 = __builtin_amdgcn_mfma_f32_32x32x16_bf16(b0, qr[d0], p0, 0, 0, 0);
    p1 = __builtin_amdgcn_mfma_f32_32x32x16_bf16(b1, qr[d0], p1, 0, 0, 0); }
  int qo = qoff; asm volatile("" : "+v"(qo));
#pragma unroll
  for (int d0 = 0; d0 < 4; ++d0) { const int c = 2 * d0 + hi;
    const bf16x8 b0 = *reinterpret_cast<const bf16x8*>(Kr + FA_KRSWZ(r32, c));
    const bf16x8 b1 = *reinterpret_cast<const bf16x8*>(Kr + FA_KRSWZ(32 + r32, c));
    bf16x8 q; if constexpr (NKN) q = *reinterpret_cast<const bf16x8*>(Kn_qbase + qo + d0 * 1024); else q = qr[d0];
    p0 = __builtin_amdgcn_mfma_f32_32x32x16_bf16(b0, q, p0, 0, 0, 0);
    p1 = __builtin_amdgcn_mfma_f32_32x32x16_bf16(b1, q, p1, 0, 0, 0); }
}
template <int DQK> __device__ __forceinline__ void qkt_r(f32x16& p0, f32x16& p1, const char* Kn, const char* Kr, const bf16x8* qr, int r32, int hi) {
  p0 = f32x16{}; p1 = f32x16{};
  constexpr int NKN = (DQK == 192) ? 8 : 0;
#pragma unroll
  for (int d0 = 0; d0 < NKN; ++d0) { const int cb = (d0 * 16 + hi * 8) * 2;
    const bf16x8 b0 = *reinterpret_cast<const bf16x8*>(Kn + FA_KNSWZ(r32, cb));
    const bf16x8 b1 = *reinterpret_cast<const bf16x8*>(Kn + FA_KNSWZ(32 + r32, cb));
    p0 = __builtin_amdgcn_mfma_f32_32x32x16_bf16(b0, qr[d0], p0, 0, 0, 0);
    p1 = __builtin_amdgcn_mfma_f32_32x32x16_bf16(b1, qr[d0], p1, 0, 0, 0); }
#pragma unroll
  for (int d0 = 0; d0 < 4; ++d0) { const int c = 2 * d0 + hi;
    const bf16x8 b0 = *reinterpret_cast<const bf16x8*>(Kr + FA_KRSWZ(r32, c));
    const bf16x8 b1 = *reinterpret_cast<const bf16x8*>(Kr + FA_KRSWZ(32 + r32, c));
    p0 = __builtin_amdgcn_mfma_f32_32x32x16_bf16(b0, qr[NKN + d0], p0, 0, 0, 0);
    p1 = __builtin_amdgcn_mfma_f32_32x32x16_bf16(b1, qr[NKN + d0], p1, 0, 0, 0); }
}
__device__ __forceinline__ int v_st(int k, int c) { const int kk = (k & ~0xC) | ((k & 4) << 1) | ((k & 8) >> 1); return ((kk >> 3) * 4 + (c >> 5)) * 512 + ((kk & 7) * 32 + (c & 31)) * 2; }
__device__ __forceinline__ int v_rd_base(int lane) { return ((lane & 3) << 3) | (((lane >> 2) & 3) << 6) | (((lane >> 4) & 1) << 5) | (((lane >> 5) & 1) << 8); }
constexpr int v_rd_off(int d0, int ks, int half) { return d0 * 512 + ks * 4096 + half * 2048; }
template <int OFF> __device__ __forceinline__ s16x4 tr_read(int vb) {
  s16x4 r; asm volatile("ds_read_b64_tr_b16 %0, %1 offset:%2" : "=&v"(r) : "v"(vb), "i"(OFF) : "memory"); return r;
}
template <int D0> __device__ __forceinline__ void pv_one(f32x16& od, int vb, bf16x8 pa0, bf16x8 pa1, bf16x8 pa2, bf16x8 pa3) {
  const s16x4 l0 = tr_read<v_rd_off(D0, 0, 0)>(vb), h0 = tr_read<v_rd_off(D0, 0, 1)>(vb), l1 = tr_read<v_rd_off(D0, 1, 0)>(vb), h1 = tr_read<v_rd_off(D0, 1, 1)>(vb);
  const s16x4 l2 = tr_read<v_rd_off(D0, 2, 0)>(vb), h2 = tr_read<v_rd_off(D0, 2, 1)>(vb), l3 = tr_read<v_rd_off(D0, 3, 0)>(vb), h3 = tr_read<v_rd_off(D0, 3, 1)>(vb);
  asm volatile("s_waitcnt lgkmcnt(0)" ::: "memory"); FA_SBAR();
#define FA_PK(L, H) (bf16x8){L[0], L[1], L[2], L[3], H[0], H[1], H[2], H[3]}
  od = __builtin_amdgcn_mfma_f32_32x32x16_bf16(pa0, FA_PK(l0, h0), od, 0, 0, 0);
  od = __builtin_amdgcn_mfma_f32_32x32x16_bf16(pa1, FA_PK(l1, h1), od, 0, 0, 0);
  od = __builtin_amdgcn_mfma_f32_32x32x16_bf16(pa2, FA_PK(l2, h2), od, 0, 0, 0);
  od = __builtin_amdgcn_mfma_f32_32x32x16_bf16(pa3, FA_PK(l3, h3), od, 0, 0, 0);
#undef FA_PK
}
#define FA_TRLOAD(D0, L0, H0, L1, H1, L2, H2, L3, H3) do { L0 = tr_read<v_rd_off(D0, 0, 0)>(vb); H0 = tr_read<v_rd_off(D0, 0, 1)>(vb); L1 = tr_read<v_rd_off(D0, 1, 0)>(vb); H1 = tr_read<v_rd_off(D0, 1, 1)>(vb); \
    L2 = tr_read<v_rd_off(D0, 2, 0)>(vb); H2 = tr_read<v_rd_off(D0, 2, 1)>(vb); L3 = tr_read<v_rd_off(D0, 3, 0)>(vb); H3 = tr_read<v_rd_off(D0, 3, 1)>(vb); } while (0)
#define FA_PKV(L, H) (bf16x8){L[0], L[1], L[2], L[3], H[0], H[1], H[2], H[3]}
#define FA_PVMMA(OD, L0, H0, L1, H1, L2, H2, L3, H3) do { OD = __builtin_amdgcn_mfma_f32_32x32x16_bf16(pa0, FA_PKV(L0, H0), OD, 0, 0, 0); OD = __builtin_amdgcn_mfma_f32_32x32x16_bf16(pa1, FA_PKV(L1, H1), OD, 0, 0, 0); \
    OD = __builtin_amdgcn_mfma_f32_32x32x16_bf16(pa2, FA_PKV(L2, H2), OD, 0, 0, 0); OD = __builtin_amdgcn_mfma_f32_32x32x16_bf16(pa3, FA_PKV(L3, H3), OD, 0, 0, 0); } while (0)
__device__ __forceinline__ void pv_d0_piped(f32x16* o, int vb, bf16x8 pa0, bf16x8 pa1, bf16x8 pa2, bf16x8 pa3) {
  s16x4 al0, ah0, al1, ah1, al2, ah2, al3, ah3, bl0, bh0, bl1, bh1, bl2, bh2, bl3, bh3;
  FA_TRLOAD(0, al0, ah0, al1, ah1, al2, ah2, al3, ah3);
  FA_TRLOAD(1, bl0, bh0, bl1, bh1, bl2, bh2, bl3, bh3);
  asm volatile("s_waitcnt lgkmcnt(8)" ::: "memory"); FA_SBAR();
  FA_PVMMA(o[0], al0, ah0, al1, ah1, al2, ah2, al3, ah3); FA_SBAR();
  FA_TRLOAD(2, al0, ah0, al1, ah1, al2, ah2, al3, ah3);
  asm volatile("s_waitcnt lgkmcnt(8)" ::: "memory"); FA_SBAR();
  FA_PVMMA(o[1], bl0, bh0, bl1, bh1, bl2, bh2, bl3, bh3); FA_SBAR();
  FA_TRLOAD(3, bl0, bh0, bl1, bh1, bl2, bh2, bl3, bh3);
  asm volatile("s_waitcnt lgkmcnt(8)" ::: "memory"); FA_SBAR();
  FA_PVMMA(o[2], al0, ah0, al1, ah1, al2, ah2, al3, ah3); FA_SBAR();
  asm volatile("s_waitcnt lgkmcnt(0)" ::: "memory"); FA_SBAR();
  FA_PVMMA(o[3], bl0, bh0, bl1, bh1, bl2, bh2, bl3, bh3);
}
#undef FA_TRLOAD
#undef FA_PVMMA
#undef FA_PKV
__device__ __forceinline__ void pv_d0(f32x16* o, int vb, bf16x8 pa0, bf16x8 pa1, bf16x8 pa2, bf16x8 pa3) {
  pv_one<0>(o[0], vb, pa0, pa1, pa2, pa3); pv_one<1>(o[1], vb, pa0, pa1, pa2, pa3); pv_one<2>(o[2], vb, pa0, pa1, pa2, pa3); pv_one<3>(o[3], vb, pa0, pa1, pa2, pa3);
}
template <int DQK> __device__ __forceinline__ void pv_sm(f32x16* o, int vb, bf16x8 pa0, bf16x8 pa1, bf16x8 pa2, bf16x8 pa3, f32x16& p0, f32x16& p1, float& m_reg, float& mn, float& alpha) {
  constexpr float SCALE = (DQK == 192) ? 0.07216878364870322f : 0.125f;
  constexpr float C = SCALE * 1.4426950408889634f;
#define FA_PKV2(L, H) (bf16x8){L[0], L[1], L[2], L[3], H[0], H[1], H[2], H[3]}
#define FA_PVBLK(D0, SLICE) do { \
    const s16x4 l0 = tr_read<v_rd_off(D0, 0, 0)>(vb), h0 = tr_read<v_rd_off(D0, 0, 1)>(vb), l1 = tr_read<v_rd_off(D0, 1, 0)>(vb), h1 = tr_read<v_rd_off(D0, 1, 1)>(vb); \
    const s16x4 l2 = tr_read<v_rd_off(D0, 2, 0)>(vb), h2 = tr_read<v_rd_off(D0, 2, 1)>(vb), l3 = tr_read<v_rd_off(D0, 3, 0)>(vb), h3 = tr_read<v_rd_off(D0, 3, 1)>(vb); \
    SLICE \
    asm volatile("s_waitcnt lgkmcnt(0)" ::: "memory"); FA_SBAR(); \
    o[D0] = __builtin_amdgcn_mfma_f32_32x32x16_bf16(pa0, FA_PKV2(l0, h0), o[D0], 0, 0, 0); o[D0] = __builtin_amdgcn_mfma_f32_32x32x16_bf16(pa1, FA_PKV2(l1, h1), o[D0], 0, 0, 0); \
    o[D0] = __builtin_amdgcn_mfma_f32_32x32x16_bf16(pa2, FA_PKV2(l2, h2), o[D0], 0, 0, 0); o[D0] = __builtin_amdgcn_mfma_f32_32x32x16_bf16(pa3, FA_PKV2(l3, h3), o[D0], 0, 0, 0); } while (0)
  float pmax, mnC;
  FA_PVBLK(0, { pmax = p0[0]; _Pragma("unroll") for (int r = 1; r < 16; ++r) pmax = fmaxf(pmax, p0[r]); _Pragma("unroll") for (int r = 0; r < 16; ++r) pmax = fmaxf(pmax, p1[r]);
      auto rr = __builtin_amdgcn_permlane32_swap(__float_as_uint(pmax), __float_as_uint(pmax), false, false); pmax = fmaxf(__uint_as_float(rr[0]), __uint_as_float(rr[1])); });
  FA_PVBLK(1, { if (__builtin_expect(__all(pmax - m_reg <= THR / SCALE), 1)) { mn = m_reg; alpha = 1.f; } else { mn = fmaxf(m_reg, pmax); alpha = __builtin_amdgcn_exp2f((m_reg - mn) * C); m_reg = mn; }
      mnC = -mn * C; _Pragma("unroll") for (int r = 0; r < 16; ++r) p0[r] = fmaf(p0[r], C, mnC); });
  FA_PVBLK(2, { _Pragma("unroll") for (int r = 0; r < 16; ++r) p1[r] = fmaf(p1[r], C, mnC); _Pragma("unroll") for (int r = 0; r < 8; ++r) p0[r] = __builtin_amdgcn_exp2f(p0[r]); });
  FA_PVBLK(3, { _Pragma("unroll") for (int r = 8; r < 16; ++r) p0[r] = __builtin_amdgcn_exp2f(p0[r]); });
#undef FA_PVBLK
#undef FA_PKV2
}
struct Src {
  const bf16* Q; int ldq;
  const bf16* Kn; int ldkn;
  const bf16* Kr; int ldkr;
  const bf16* V; int ldv;
  int seg0, seg1, nkeys;
  void* O; int ldo;
  float lam, omli; const float* subln;
};
template <int DQK, int SDEPTH, int MODE>
__device__ __forceinline__ void attn_unit(const Src& S, char* lds) {
  int tid_ = threadIdx.x; asm volatile("" : "+v"(tid_));
  const int tid = tid_, wid = tid >> 6, lane = tid & 63, r32 = lane & 31, hi = lane >> 5;
  constexpr int NKN = (DQK == 192) ? 8 : 0, NQ = DQK / 16;
  char* V_lds = lds + OFF_V; char* Kn_lds = lds + OFF_KN; char* Kr_lds = lds + OFF_KR;
  float* wsf = (float*)(lds + OFF_WS) + wid * 64; float* li_l = wsf; float* al_l = wsf + 32;
  constexpr int NQR = NKN ? NKN : 4;
  float m_reg = -1e30f, l_reg = 0; f32x16 o[4] = {}; bf16x8 qr[NQR];
  const bf16* Qw = S.Q + (long)(wid * QBLK + r32) * S.ldq + hi * 8;
  const char* Qr_lds = lds + OFF_QR; const int qoff = wid * 4096 + lane * 16;
#pragma unroll
  for (int d0 = 0; d0 < NQR; ++d0) qr[d0] = *reinterpret_cast<const bf16x8*>(Qw + d0 * 16);
  if constexpr (NKN) {
#pragma unroll
    for (int d0 = 0; d0 < 4; ++d0) *(bf16x8*)(lds + OFF_QR + qoff + d0 * 1024) = *reinterpret_cast<const bf16x8*>(Qw + (NKN + d0) * 16);
  }
  const int sr = tid >> 4, sc = (tid & 15) * 8, vst0 = v_st(sr, sc), vst1 = v_st(32 + sr, sc);
  const int krr = tid >> 3, krc = tid & 7;
  const int vb0 = (int)(uintptr_t)V_lds + v_rd_base(lane);
  struct { bf16x8 vs0, vs1, kn0, kn1, kr; } st_[SDEPTH];
#define FA_ROW(k0) ((k0) < 256 ? S.seg0 + (k0) : S.seg1 + ((k0) - 256))
#define FA_SLOAD(i, k0) do { const long R_ = FA_ROW(k0); \
    st_[i].vs0 = *reinterpret_cast<const bf16x8*>(S.V + (R_ + sr) * S.ldv + sc); st_[i].vs1 = *reinterpret_cast<const bf16x8*>(S.V + (R_ + 32 + sr) * S.ldv + sc); \
    if constexpr (NKN) { st_[i].kn0 = *reinterpret_cast<const bf16x8*>(S.Kn + (R_ + sr) * S.ldkn + sc); st_[i].kn1 = *reinterpret_cast<const bf16x8*>(S.Kn + (R_ + 32 + sr) * S.ldkn + sc); } \
    st_[i].kr = *reinterpret_cast<const bf16x8*>(S.Kr + (R_ + krr) * S.ldkr + krc * 8); } while (0)
#define FA_SWRITE(b, i) do { *(bf16x8*)(V_lds + (b) * SHM_V + vst0) = st_[i].vs0; *(bf16x8*)(V_lds + (b) * SHM_V + vst1) = st_[i].vs1; \
    if constexpr (NKN) { *(bf16x8*)(Kn_lds + (b) * SHM_KN + FA_KNSWZ(sr, sc * 2)) = st_[i].kn0; *(bf16x8*)(Kn_lds + (b) * SHM_KN + FA_KNSWZ(32 + sr, sc * 2)) = st_[i].kn1; } \
    *(bf16x8*)(Kr_lds + (b) * SHM_KR + FA_KRSWZ(krr, krc)) = st_[i].kr; } while (0)
#define FA_SWAIT() do { if constexpr (SDEPTH == 2) { if constexpr (NKN) asm volatile("s_waitcnt vmcnt(5)" ::: "memory"); else asm volatile("s_waitcnt vmcnt(3)" ::: "memory"); } \
    else asm volatile("s_waitcnt vmcnt(0)" ::: "memory"); } while (0)
#define FA_RESC(a) do { if (__any((a) < 1.f)) { if (hi == 0) al_l[r32] = (a); asm volatile("s_waitcnt lgkmcnt(0)" ::: "memory"); \
    _Pragma("unroll") for (int d = 0; d < 4; ++d) _Pragma("unroll") for (int r = 0; r < 16; ++r) o[d][r] *= al_l[crow(r, hi)]; } } while (0)
  f32x16 pA0, pA1, pB0, pB1; float mnA, mnB, alA, alB; bf16x8 pa0, pa1, pa2, pa3; const int NT = S.nkeys / KVBLK;
  constexpr int SE = 0, SO = SDEPTH - 1;
  FA_SLOAD(SE, 0); asm volatile("s_waitcnt vmcnt(0)" ::: "memory"); FA_SWRITE(0, SE); __syncthreads();
  qkt<DQK>(pA0, pA1, Kn_lds, Kr_lds, qr, Qr_lds, qoff, r32, hi); partialSM<DQK>(pA0, pA1, m_reg, mnA, alA);
  FA_SLOAD(SO, KVBLK); if constexpr (SDEPTH == 2) { if (2 < NT) FA_SLOAD(SE, 2 * KVBLK); }
  FA_SWAIT(); FA_SWRITE(1, SO); __syncthreads();
  for (int j = 1; j + 1 < NT; j += 2) {
    FA_SBAR(); qkt<DQK>(pB0, pB1, Kn_lds + SHM_KN, Kr_lds + SHM_KR, qr, Qr_lds, qoff, r32, hi);
    finishSM(pA0, pA1, alA, l_reg, pa0, pa1, pa2, pa3); FA_SBAR();
    FA_SLOAD(SO, (j + SDEPTH) * KVBLK); FA_SBAR();
    if constexpr (DQK == 64) pv_d0_piped(o, vb0, pa0, pa1, pa2, pa3); else pv_d0(o, vb0, pa0, pa1, pa2, pa3); partialSM<DQK>(pB0, pB1, m_reg, mnB, alB);
    __syncthreads(); FA_SWAIT(); FA_SWRITE(0, SE);
    FA_RESC(alB); __syncthreads();
    FA_SBAR(); qkt<DQK>(pA0, pA1, Kn_lds, Kr_lds, qr, Qr_lds, qoff, r32, hi);
    finishSM(pB0, pB1, alB, l_reg, pa0, pa1, pa2, pa3); FA_SBAR();
    if (SDEPTH == 1 || j + 3 < NT) FA_SLOAD(SE, (j + 1 + SDEPTH) * KVBLK); FA_SBAR();
    if constexpr (DQK == 64) pv_d0_piped(o, vb0 + SHM_V, pa0, pa1, pa2, pa3); else pv_d0(o, vb0 + SHM_V, pa0, pa1, pa2, pa3); partialSM<DQK>(pA0, pA1, m_reg, mnA, alA);
    __syncthreads(); FA_SWAIT(); FA_SWRITE(1, SO);
    FA_RESC(alA); __syncthreads();
  }
  FA_SBAR(); qkt<DQK>(pB0, pB1, Kn_lds + SHM_KN, Kr_lds + SHM_KR, qr, Qr_lds, qoff, r32, hi);
  finishSM(pA0, pA1, alA, l_reg, pa0, pa1, pa2, pa3); FA_SBAR();
  if constexpr (DQK == 64) pv_d0_piped(o, vb0, pa0, pa1, pa2, pa3); else pv_d0(o, vb0, pa0, pa1, pa2, pa3); partialSM<DQK>(pB0, pB1, m_reg, mnB, alB);
  __syncthreads(); FA_RESC(alB);
  finishSM(pB0, pB1, alB, l_reg, pa0, pa1, pa2, pa3); FA_SBAR();
  if constexpr (DQK == 64) pv_d0_piped(o, vb0 + SHM_V, pa0, pa1, pa2, pa3); else pv_d0(o, vb0 + SHM_V, pa0, pa1, pa2, pa3);
  if (hi == 0) li_l[r32] = l_reg; asm volatile("s_waitcnt lgkmcnt(0)" ::: "memory");
  float rli[16];
#pragma unroll
  for (int r = 0; r < 16; ++r) rli[r] = __builtin_amdgcn_rcpf(li_l[crow(r, hi)]);
  if constexpr (MODE == 0) {
    bf16* Ow = (bf16*)S.O + (long)(wid * QBLK) * S.ldo;
#pragma unroll
    for (int r = 0; r < 16; ++r) { const int orow = crow(r, hi);
#pragma unroll
      for (int d0 = 0; d0 < 4; ++d0) { const float v = o[d0][r] * rli[r]; const float nb = __int_as_float(__builtin_amdgcn_update_dpp(0, __float_as_int(v), 0xB1, 0xF, 0xF, true));
        if ((lane & 1) == 0) *(unsigned*)(Ow + (long)orow * S.ldo + d0 * 32 + r32) = cvtpk(v, nb); } }
  } else if constexpr (MODE == 1) {
    static_assert(DQK == 64, "the parking area overlays the DQK = 192 buffers");
    char* pk = lds + OFF_KN + tid * 64; char* pq = lds + OFF_QR + tid * 64;
#pragma unroll
    for (int d0 = 0; d0 < 4; ++d0) { u32x4 w0, w1;
      w0[0] = cvtpk(o[d0][0] * rli[0], o[d0][1] * rli[1]); w0[1] = cvtpk(o[d0][2] * rli[2], o[d0][3] * rli[3]); w0[2] = cvtpk(o[d0][4] * rli[4], o[d0][5] * rli[5]); w0[3] = cvtpk(o[d0][6] * rli[6], o[d0][7] * rli[7]);
      w1[0] = cvtpk(o[d0][8] * rli[8], o[d0][9] * rli[9]); w1[1] = cvtpk(o[d0][10] * rli[10], o[d0][11] * rli[11]); w1[2] = cvtpk(o[d0][12] * rli[12], o[d0][13] * rli[13]); w1[3] = cvtpk(o[d0][14] * rli[14], o[d0][15] * rli[15]);
      char* p = (d0 < 2 ? pk : pq) + (d0 & 1) * 32; *(u32x4*)p = w0; *(u32x4*)(p + 16) = w1; }
  } else {
    const char* pk = lds + OFF_KN + tid * 64; const char* pq = lds + OFF_QR + tid * 64;
    float ss[16];
#pragma unroll
    for (int r = 0; r < 16; ++r) ss[r] = 0.f;
#pragma unroll
    for (int d0 = 0; d0 < 4; ++d0) { const char* p = (d0 < 2 ? pk : pq) + (d0 & 1) * 32; const u32x4 w0 = *(const u32x4*)p, w1 = *(const u32x4*)(p + 16);
#pragma unroll
      for (int r = 0; r < 16; ++r) { const unsigned w = (r < 8 ? w0[r >> 1] : w1[(r - 8) >> 1]); const float o1 = __uint_as_float((r & 1) ? (w & 0xffff0000u) : (w << 16));
        const float v = o1 - S.lam * (o[d0][r] * rli[r]); o[d0][r] = v; ss[r] += v * v; } }
#pragma unroll
    for (int r = 0; r < 16; ++r) {
#pragma unroll
      for (int sft = 1; sft < 32; sft <<= 1) ss[r] += __shfl_xor(ss[r], sft);
      ss[r] = rsqrtf(ss[r] * (1.0f / 128.0f) + 1e-6f) * S.omli; }
    bf16* Ow = (bf16*)S.O + (long)(wid * QBLK) * S.ldo;
#pragma unroll
    for (int d0 = 0; d0 < 4; ++d0) { const float gsub = S.subln[d0 * 32 + r32];
#pragma unroll
      for (int r = 0; r < 16; ++r) { const int orow = crow(r, hi); const float v = o[d0][r] * ss[r] * gsub; const float nb = __int_as_float(__builtin_amdgcn_update_dpp(0, __float_as_int(v), 0xB1, 0xF, 0xF, true));
        if ((lane & 1) == 0) *(unsigned*)(Ow + (long)orow * S.ldo + d0 * 32 + r32) = cvtpk(v, nb); } }
  }
  __syncthreads();
#undef FA_ROW
#undef FA_SLOAD
#undef FA_SWRITE
#undef FA_SWAIT
#undef FA_RESC
}
template <int DQK, int MODE>
__device__ __forceinline__ void attn_unit_dma(const Src& S, char* lds, __attribute__((address_space(3))) unsigned char* ldsl) {
  int tid_ = threadIdx.x; asm volatile("" : "+v"(tid_));
  const int tid = tid_, wid = __builtin_amdgcn_readfirstlane(tid >> 6), lane = tid & 63, r32 = lane & 31, hi = lane >> 5;
  constexpr int NKN = (DQK == 192) ? 8 : 0, NQ = DQK / 16;
  char* V_lds = lds + OFF_V; char* Kn_lds = lds + OFF_KN; char* Kr_lds = lds + OFF_KR;
  float* wsf = (float*)(lds + OFF_WS) + wid * 64; float* li_l = wsf; float* al_l = wsf + 32;
  constexpr int NQR = NQ;
  float m_reg = -1e30f, l_reg = 0; f32x16 o[4] = {}; bf16x8 qr[NQR];
  const bf16* Qw = S.Q + (long)(wid * QBLK + r32) * S.ldq + hi * 8;
  const char* Qr_lds = lds + OFF_QR; const int qoff = wid * 4096 + lane * 16;
#pragma unroll
  for (int d0 = 0; d0 < NQR; ++d0) qr[d0] = *reinterpret_cast<const bf16x8*>(Qw + d0 * 16);
  const int vb0 = (int)(uintptr_t)V_lds + v_rd_base(lane);
  long offV[2], offKn[2], offKr;
#pragma unroll
  for (int i = 0; i < 2; ++i) { const int sub = 2 * (2 * wid + i) + (lane >> 5), kk = (sub >> 2) * 8 + ((lane & 31) >> 2), key = (kk & ~0xC) | ((kk & 4) << 1) | ((kk & 8) >> 1), c = (sub & 3) * 32 + (lane & 3) * 8;
    offV[i] = (long)key * S.ldv + c;
    const int r = 4 * (2 * wid + i) + (lane >> 4), c16 = (lane & 15) ^ (r & 15); offKn[i] = (long)r * S.ldkn + c16 * 8; }
  { const int r = 8 * wid + (lane >> 3), c = (lane & 7) ^ ((r >> 1) & 7); offKr = (long)r * S.ldkr + c * 8; }
#define FA_ROW(k0) ((k0) < 256 ? S.seg0 + (k0) : S.seg1 + ((k0) - 256))
#define FA_GLDS(gp, off) __builtin_amdgcn_global_load_lds((const unsigned*)(gp), (__attribute__((address_space(3))) unsigned*)(ldsl + (off)), 16, 0, 0)
#define FA_DMA_K(t, b) do { const int t_ = (t) < NT ? (t) : NT - 1; const long R_ = FA_ROW(t_ * KVBLK); \
    if constexpr (NKN) { FA_GLDS(S.Kn + R_ * S.ldkn + offKn[0], OFF_KN + (b) * SHM_KN + (2 * wid) * 1024); FA_GLDS(S.Kn + R_ * S.ldkn + offKn[1], OFF_KN + (b) * SHM_KN + (2 * wid + 1) * 1024); } \
    FA_GLDS(S.Kr + R_ * S.ldkr + offKr, OFF_KR + (b) * SHM_KR + wid * 1024); } while (0)
#define FA_DMA_V(t, b) do { const int t_ = (t) < NT ? (t) : NT - 1; const long R_ = FA_ROW(t_ * KVBLK); \
    FA_GLDS(S.V + R_ * S.ldv + offV[0], OFF_V + (b) * SHM_V + (2 * wid) * 1024); FA_GLDS(S.V + R_ * S.ldv + offV[1], OFF_V + (b) * SHM_V + (2 * wid + 1) * 1024); } while (0)
#define FA_WBAR() do { asm volatile("s_waitcnt vmcnt(0)" ::: "memory"); __builtin_amdgcn_s_barrier(); asm volatile("" ::: "memory"); } while (0)
#define FA_RESC(a) do { if (__any((a) < 1.f)) { if (hi == 0) al_l[r32] = (a); asm volatile("s_waitcnt lgkmcnt(0)" ::: "memory"); \
    _Pragma("unroll") for (int d = 0; d < 4; ++d) _Pragma("unroll") for (int r = 0; r < 16; ++r) o[d][r] *= al_l[crow(r, hi)]; } } while (0)
#define FA_PV(vb) do { if constexpr (DQK == 64) pv_d0_piped(o, vb, pa0, pa1, pa2, pa3); else pv_d0(o, vb, pa0, pa1, pa2, pa3); } while (0)
  f32x16 pA0, pA1, pB0, pB1; float mnA, mnB, alA, alB; bf16x8 pa0, pa1, pa2, pa3; const int NT = S.nkeys / KVBLK;
  FA_DMA_K(0, 0); FA_DMA_V(0, 0); FA_DMA_K(1, 1);
  FA_WBAR();
  qkt_r<DQK>(pA0, pA1, Kn_lds, Kr_lds, qr, r32, hi); partialSM<DQK>(pA0, pA1, m_reg, mnA, alA);
  FA_WBAR(); FA_DMA_V(1, 1); FA_DMA_K(2, 0);
  for (int j = 1; j + 1 < NT; j += 2) {
    FA_SBAR(); qkt_r<DQK>(pB0, pB1, Kn_lds + SHM_KN, Kr_lds + SHM_KR, qr, r32, hi);
    finishSM(pA0, pA1, alA, l_reg, pa0, pa1, pa2, pa3);
    pv_sm<DQK>(o, vb0, pa0, pa1, pa2, pa3, pB0, pB1, m_reg, mnB, alB);
    FA_WBAR(); FA_DMA_V(j + 1, 0); FA_DMA_K(j + 2, 1); FA_RESC(alB);
    FA_SBAR(); qkt_r<DQK>(pA0, pA1, Kn_lds, Kr_lds, qr, r32, hi);
    finishSM(pB0, pB1, alB, l_reg, pa0, pa1, pa2, pa3);
    pv_sm<DQK>(o, vb0 + SHM_V, pa0, pa1, pa2, pa3, pA0, pA1, m_reg, mnA, alA);
    FA_WBAR(); FA_DMA_V(j + 2, 1); FA_DMA_K(j + 3, 0); FA_RESC(alA);
  }
  FA_SBAR(); qkt_r<DQK>(pB0, pB1, Kn_lds + SHM_KN, Kr_lds + SHM_KR, qr, r32, hi);
  finishSM(pA0, pA1, alA, l_reg, pa0, pa1, pa2, pa3); FA_SBAR();
  pv_sm<DQK>(o, vb0, pa0, pa1, pa2, pa3, pB0, pB1, m_reg, mnB, alB);
  FA_WBAR(); FA_RESC(alB);
  finishSM(pB0, pB1, alB, l_reg, pa0, pa1, pa2, pa3); FA_SBAR();
  FA_PV(vb0 + SHM_V);
  if (hi == 0) li_l[r32] = l_reg; asm volatile("s_waitcnt lgkmcnt(0)" ::: "memory");
  float rli[16];
#pragma unroll
  for (int r = 0; r < 16; ++r) rli[r] = __builtin_amdgcn_rcpf(li_l[crow(r, hi)]);
  if constexpr (MODE == 0) {
    bf16* Ow = (bf16*)S.O + (long)(wid * QBLK) * S.ldo;
#pragma unroll
    for (int r = 0; r < 16; ++r) { const int orow = crow(r, hi);
#pragma unroll
      for (int d0 = 0; d0 < 4; ++d0) { const float v = o[d0][r] * rli[r]; const float nb = __int_as_float(__builtin_amdgcn_update_dpp(0, __float_as_int(v), 0xB1, 0xF, 0xF, true));
        if ((lane & 1) == 0) *(unsigned*)(Ow + (long)orow * S.ldo + d0 * 32 + r32) = cvtpk(v, nb); } }
  } else if constexpr (MODE == 1) {
    static_assert(DQK == 64, "the parking area overlays the DQK = 192 buffers");
    char* pk = lds + OFF_KN + tid * 64; char* pq = lds + OFF_QR + tid * 64;
#pragma unroll
    for (int d0 = 0; d0 < 4; ++d0) { u32x4 w0, w1;
      w0[0] = cvtpk(o[d0][0] * rli[0], o[d0][1] * rli[1]); w0[1] = cvtpk(o[d0][2] * rli[2], o[d0][3] * rli[3]); w0[2] = cvtpk(o[d0][4] * rli[4], o[d0][5] * rli[5]); w0[3] = cvtpk(o[d0][6] * rli[6], o[d0][7] * rli[7]);
      w1[0] = cvtpk(o[d0][8] * rli[8], o[d0][9] * rli[9]); w1[1] = cvtpk(o[d0][10] * rli[10], o[d0][11] * rli[11]); w1[2] = cvtpk(o[d0][12] * rli[12], o[d0][13] * rli[13]); w1[3] = cvtpk(o[d0][14] * rli[14], o[d0][15] * rli[15]);
      char* p = (d0 < 2 ? pk : pq) + (d0 & 1) * 32; *(u32x4*)p = w0; *(u32x4*)(p + 16) = w1; }
  } else {
    const char* pk = lds + OFF_KN + tid * 64; const char* pq = lds + OFF_QR + tid * 64;
    float ss[16];
#pragma unroll
    for (int r = 0; r < 16; ++r) ss[r] = 0.f;
#pragma unroll
    for (int d0 = 0; d0 < 4; ++d0) { const char* p = (d0 < 2 ? pk : pq) + (d0 & 1) * 32; const u32x4 w0 = *(const u32x4*)p, w1 = *(const u32x4*)(p + 16);
#pragma unroll
      for (int r = 0; r < 16; ++r) { const unsigned w = (r < 8 ? w0[r >> 1] : w1[(r - 8) >> 1]); const float o1 = __uint_as_float((r & 1) ? (w & 0xffff0000u) : (w << 16));
        const float v = o1 - S.lam * (o[d0][r] * rli[r]); o[d0][r] = v; ss[r] += v * v; } }
#pragma unroll
    for (int r = 0; r < 16; ++r) {
#pragma unroll
      for (int sft = 1; sft < 32; sft <<= 1) ss[r] += __shfl_xor(ss[r], sft);
      ss[r] = rsqrtf(ss[r] * (1.0f / 128.0f) + 1e-6f) * S.omli; }
    bf16* Ow = (bf16*)S.O + (long)(wid * QBLK) * S.ldo;
#pragma unroll
    for (int d0 = 0; d0 < 4; ++d0) { const float gsub = S.subln[d0 * 32 + r32];
#pragma unroll
      for (int r = 0; r < 16; ++r) { const int orow = crow(r, hi); const float v = o[d0][r] * ss[r] * gsub; const float nb = __int_as_float(__builtin_amdgcn_update_dpp(0, __float_as_int(v), 0xB1, 0xF, 0xF, true));
        if ((lane & 1) == 0) *(unsigned*)(Ow + (long)orow * S.ldo + d0 * 32 + r32) = cvtpk(v, nb); } }
  }
  __syncthreads();
#undef FA_ROW
#undef FA_GLDS
#undef FA_DMA_K
#undef FA_DMA_V
#undef FA_WBAR
#undef FA_RESC
#undef FA_PV
}
}

constexpr int NWAVES = 8;
constexpr int DM = 2048, NB = 8, SEQ = 2048, CTXL = 256, DFF = 5632, NMOD = 9;
constexpr int DFFP = DFF + 64;
constexpr int MLAT = NB * SEQ, MCTX = NB * CTXL, MTOT = MLAT + MCTX;
constexpr int WIN_N = 2880;
constexpr int PC_CKV = 0, PC_KR = 256, PC_DK = 320, PC_DV = 832, PC_CQ = 1344, PC_DQ = 1856, PC_END = 2368, LDP = 2560;
constexpr int MODROW = NMOD * DM;
constexpr float EPS = 1e-6f;
constexpr float MLA_C = 0.07216878364870322f * 1.4426950408889634f;
constexpr float DIFF_C = 0.125f * 1.4426950408889634f;

constexpr size_t MiB = 1u << 20;
constexpr size_t WS_CTL = 0, CTL_ZERO_BYTES = 32768;
constexpr size_t WS_MOD = 1 * MiB;
constexpr size_t WS_TAB = 3 * MiB;
constexpr size_t WS_WGU = 4 * MiB;
constexpr size_t WS_WD = WS_WGU + 176 * MiB;
constexpr size_t WS_WIN = WS_WD + 90 * MiB;
constexpr size_t WS_WF1 = WS_WIN + 20 * MiB;
constexpr size_t WS_WUKV = WS_WF1 + 8 * MiB;
constexpr size_t WS_WUQ = WS_WUKV + 2 * MiB;
constexpr size_t WS_WOUT = WS_WUQ + 3 * MiB;
constexpr size_t WS_DFT = WS_WOUT + 16 * MiB;
constexpr size_t WS_DFTC = WS_DFT + 16 * MiB;
constexpr size_t WS_X = WS_DFTC + 1 * MiB;
constexpr size_t WS_S = WS_X + 16 * MiB;
constexpr size_t WS_H = WS_X + 144 * MiB;
constexpr size_t WS_O = WS_H + 72 * MiB;
constexpr size_t WS_ACT = WS_O + 72 * MiB;
constexpr size_t WS_OD = WS_ACT;
constexpr size_t WS_CT = WS_ACT + 72 * MiB;
constexpr size_t WS_CTC = WS_CT + 32 * MiB;
constexpr size_t WS_P = WS_ACT + 202 * MiB;
constexpr size_t WS_KV = WS_P + 90 * MiB;
constexpr size_t WS_Q = WS_KV + 72 * MiB;
constexpr size_t WS_PART = WS_Q + 54 * MiB;
constexpr size_t WS_END = WS_PART + 64 * MiB;
static_assert(WS_CTC + 4 * MiB <= WS_P && (size_t)MTOT * DFFP * 2 <= 202 * MiB && (size_t)MTOT * LDP * 2 <= 90 * MiB, "ws map");
constexpr int CW_BAR = 4096;
constexpr int N_STEPS = 66;

constexpr int RING_BYTES = 131072;
constexpr int LDSCTL_OFF = RING_BYTES, MISC_OFF = LDSCTL_OFF + 320;
constexpr int LDS_BYTES = 147456;

typedef unsigned u32x2 __attribute__((ext_vector_type(2)));
typedef float f32x2 __attribute__((ext_vector_type(2)));
__device__ __forceinline__ float bf2f(unsigned short b) { return __builtin_bit_cast(float, ((unsigned)b) << 16); }
__device__ __forceinline__ float wave_sum(float v) {
#pragma unroll
    for (int o = 1; o < 64; o <<= 1) v += __shfl_xor(v, o);
    return v;
}
__device__ __forceinline__ float wave_max(float v) {
#pragma unroll
    for (int o = 1; o < 64; o <<= 1) v = fmaxf(v, __shfl_xor(v, o));
    return v;
}

__device__ __forceinline__ void transpose_item(const float* W, int N, bf16* WT, int ldt, int dest_row0, LAS float* scr, int k0, int n0, int lane) {
    float tv[32];
#pragma unroll
    for (int i = 0; i < 32; ++i) tv[i] = W[(size_t)(k0 + 2 * i + (lane >> 5)) * N + n0 + (lane & 31)];
    asm volatile("" ::: "memory");
#pragma unroll
    for (int i = 0; i < 32; ++i) scr[(2 * i + (lane >> 5)) * 33 + (lane & 31)] = tv[i];
    LDS_WAIT(); asm volatile("" ::: "memory");
    const int c = lane & 7;
#pragma unroll
    for (int j = 0; j < 4; ++j) { const int n = (lane >> 3) + 8 * j; const LAS float* s = scr + (8 * c) * 33 + n;
        v4u o; o.x = pk2(s[0 * 33], s[1 * 33]); o.y = pk2(s[2 * 33], s[3 * 33]); o.z = pk2(s[4 * 33], s[5 * 33]); o.w = pk2(s[6 * 33], s[7 * 33]);
        *(GAS v4u*)(WT + (size_t)(dest_row0 + n) * ldt + k0 + 8 * c) = o; }
    LDS_WAIT(); asm volatile("" ::: "memory");
}

struct Args { const float* in[19]; float* out; unsigned char* ws; int st_lo, st_hi; };
enum { I_X = 0, I_C, I_CTX, I_CCTX, I_ADAW, I_ADAB, I_NORMG, I_WG, I_WU, I_WD, I_WIN, I_QN, I_KVN, I_WUQ, I_WUKV, I_LAM, I_SUBLN, I_WOUT, I_FN };

__device__ __forceinline__ void transpose_set(const Args& a, LAS unsigned char* lds, int set, int widx, int nw) {
    unsigned char* ws = a.ws; int lane, wave; { int t_ = threadIdx.x; asm volatile("" : "+v"(t_)); lane = t_ & 63; wave = __builtin_amdgcn_readfirstlane(t_ >> 6); }
    {
        LAS float* scr = (LAS float*)(lds + wave * 8704);
        constexpr int PER_LF = 3 * 5632, N_FFN = 4 * PER_LF, PER_L = 2368 + 256 + 384 + 2048; const int nv = (set == 0) ? PER_LF + 2 * PER_L : PER_LF;
        struct TI { const float* src; bf16* dst; int N, ldt; };
        auto decode = [&](int v) -> TI { TI t; const int it = (set == 0) ? (v < PER_LF ? v : v - PER_LF + N_FFN) : set * PER_LF + v;
            if (it < N_FFN) { const int lf = it / PER_LF, r = it % PER_LF, which = r / 5632, q = r % 5632;
                if (which < 2) { const int kb = q / 176, nb = q % 176, n0 = nb * 32;
                    t.src = (which == 0 ? a.in[I_WG] : a.in[I_WU]) + (size_t)lf * DM * DFF + (size_t)(kb * 64) * DFF + n0; t.N = DFF;
                    t.dst = (bf16*)(ws + WS_WGU) + (size_t)lf * 2 * DFF * DM + ((size_t)((n0 >> 7) * 32 + kb) * 256 + which * 128 + (n0 & 127)) * 64; t.ldt = 64;
                } else { const int kb = q / 64, nb = q % 64;
                    t.src = a.in[I_WD] + (size_t)lf * DFF * DM + (size_t)(kb * 64) * DM + nb * 32; t.N = DM;
                    t.dst = (bf16*)(ws + WS_WD) + (size_t)lf * DM * DFFP + (size_t)(nb * 32) * DFFP + kb * 64; t.ldt = DFFP; }
            } else { int r = it - N_FFN; const int l = r / PER_L; r %= PER_L;
                if (r < 2368) { const int kb = r / 74, nb = r % 74; t.src = a.in[I_WIN] + (size_t)l * DM * WIN_N + (size_t)(kb * 64) * WIN_N + nb * 32; t.N = WIN_N; t.dst = (bf16*)(ws + WS_WIN) + (size_t)l * LDP * DM + (size_t)(nb * 32) * DM + kb * 64; t.ldt = DM; }
                else if ((r -= 2368) < 256) { const int kb = r / 64, nb = r % 64; t.src = a.in[I_WUKV] + (size_t)l * 256 * 2048 + (size_t)(kb * 64) * 2048 + nb * 32; t.N = 2048; t.dst = (bf16*)(ws + WS_WUKV) + (size_t)l * 2048 * 256 + (size_t)(nb * 32) * 256 + kb * 64; t.ldt = 256; }
                else if ((r -= 256) < 384) { const int kb = r / 48, nb = r % 48; t.src = a.in[I_WUQ] + (size_t)l * 512 * 1536 + (size_t)(kb * 64) * 1536 + nb * 32; t.N = 1536; t.dst = (bf16*)(ws + WS_WUQ) + (size_t)l * 1536 * 512 + (size_t)(nb * 32) * 512 + kb * 64; t.ldt = 512; }
                else { r -= 384; const int kb = r / 64, nb = r % 64; t.src = a.in[I_WOUT] + (size_t)l * DM * DM + (size_t)(kb * 64) * DM + nb * 32; t.N = DM; t.dst = (bf16*)(ws + WS_WOUT) + (size_t)l * DM * DM + (size_t)(nb * 32) * DM + kb * 64; t.ldt = DM; } }
            return t; };
#define TR_LOAD(t, tv) do { _Pragma("unroll") for (int i_ = 0; i_ < 32; ++i_) tv[i_] = (t).src[(size_t)(2 * i_ + (lane >> 5)) * (t).N + (lane & 31)]; } while (0)
#define TR_PROC(t, tv) do { _Pragma("unroll") for (int i_ = 0; i_ < 32; ++i_) scr[(2 * i_ + (lane >> 5)) * 33 + (lane & 31)] = tv[i_]; \
            LDS_WAIT(); asm volatile("" ::: "memory"); const int c_ = lane & 7; \
            _Pragma("unroll") for (int j_ = 0; j_ < 4; ++j_) { const int n_ = (lane >> 3) + 8 * j_; const LAS float* s_ = scr + (8 * c_) * 33 + n_; \
                v4u o_; o_.x = pk2(s_[0 * 33], s_[1 * 33]); o_.y = pk2(s_[2 * 33], s_[3 * 33]); o_.z = pk2(s_[4 * 33], s_[5 * 33]); o_.w = pk2(s_[6 * 33], s_[7 * 33]); \
                *(GAS v4u*)((t).dst + (size_t)n_ * (t).ldt + 8 * c_) = o_; } \
            LDS_WAIT(); asm volatile("" ::: "memory"); } while (0)
        float tvA[32], tvB[32]; TI d0, d1; int it = widx;
        if (it < nv) { d0 = decode(it); TR_LOAD(d0, tvA); }
        while (it < nv) {
            const int it1 = it + nw, it2 = it1 + nw;
            if (it1 < nv) { d1 = decode(it1); TR_LOAD(d1, tvB); }
            TR_PROC(d0, tvA);
            if (it1 < nv) { if (it2 < nv) { d0 = decode(it2); TR_LOAD(d0, tvA); } TR_PROC(d1, tvB); }
            it = it2;
        }
#undef TR_LOAD
#undef TR_PROC
    }
}
__device__ __forceinline__ void prologue(const Args& a, LAS unsigned char* lds, int tid, int lane, int wave) {
    tid = threadIdx.x; asm volatile("" : "+v"(tid)); lane = tid & 63;
    unsigned char* ws = a.ws;
    const int G = gridDim.x, gw = blockIdx.x * NWAVES + wave, NGW = G * NWAVES;
    const int gt = blockIdx.x * (NWAVES * 64) + tid, NGT = G * NWAVES * 64;
    {
        for (int rp = 0; rp < NREP(13); ++rp) transpose_set(a, lds, 0, gw, NGW);
        for (int i = gt; i < 2 * 192 * DM / 8; i += NGT) { const int l = i / (192 * DM / 8), r = i % (192 * DM / 8);
            *(GAS v4u*)((bf16*)(ws + WS_WIN) + (size_t)l * LDP * DM + (size_t)PC_END * DM + (size_t)r * 8) = (v4u){0u, 0u, 0u, 0u}; }
    }
    for (int rpb = 0; rpb < NREP(20); ++rpb) {
        float* rope = (float*)(ws + WS_TAB);
        if (gt < 1024) { const int pos = gt >> 4, i = gt & 15; const float inv = powf(10000.0f, -(float)i / 16.0f), ang = (float)pos * inv; rope[pos * 32 + i] = cosf(ang); rope[pos * 32 + 16 + i] = sinf(ang); }
        if (blockIdx.x == 2 && wave == 0) { float* lamv = (float*)(ws + WS_TAB + 16384);
            for (int l = 0; l < 2; ++l) { const float* lf = a.in[I_LAM] + l * 256;
                const float s1 = wave_sum(lf[lane] * lf[64 + lane]), s2 = wave_sum(lf[128 + lane] * lf[192 + lane]);
                const float li = 0.8f - 0.6f * expf(-0.3f * (float)l); if (lane == 0) { lamv[2 * l] = expf(s1) - expf(s2) + li; lamv[2 * l + 1] = 1.0f - li; } } }
        bf16* dft = (bf16*)(ws + WS_DFT);
        for (int rp = 0; rp < NREP(16); ++rp)
        for (int i = gt; i < 2048 * 512; i += NGT) { const int sp = i >> 9, k = (i & 511) * 8, type = k >> 11, s = k & 2047; unsigned w[4];
#pragma unroll
            for (int j = 0; j < 4; ++j) { float v[2];
#pragma unroll
                for (int e = 0; e < 2; ++e) { const int t = ((s + 2 * j + e) * sp) & 2047; float sn, cs; sincospif((float)t * (1.0f / 1024.0f), &sn, &cs); v[e] = (type ? -sn : cs) * (1.0f / 512.0f); }
                w[j] = pk2(v[0], v[1]); }
            *(GAS v4u*)(dft + (size_t)sp * 4096 + k) = (v4u){w[0], w[1], w[2], w[3]}; }
        bf16* dftc = (bf16*)(ws + WS_DFTC);
        for (int i = gt; i < 256 * 64; i += NGT) { const int sp = i >> 6, k = (i & 63) * 8, type = k >> 8, s = k & 255; unsigned w[4];
#pragma unroll
            for (int j = 0; j < 4; ++j) { float v[2];
#pragma unroll
                for (int e = 0; e < 2; ++e) { const int t = ((s + 2 * j + e) * sp) & 255; float sn, cs; sincospif((float)t * (1.0f / 128.0f), &sn, &cs); v[e] = (type ? -sn : cs) * 0.005524271728019903f; }
                w[j] = pk2(v[0], v[1]); }
            *(GAS v4u*)(dftc + (size_t)sp * 512 + k) = (v4u){w[0], w[1], w[2], w[3]}; }
    }
    __syncthreads();
    {
        LAS float* U = (LAS float*)lds;
        LAS float* T = (LAS float*)(lds + 64 * 129 * 4);
        if (tid < 128) { float sn, cs; sincospif((float)tid * (1.0f / 64.0f), &sn, &cs); T[tid] = cs; T[128 + tid] = sn; }
        for (int rp = 0; rp < NREP(14); ++rp)
        for (int it = blockIdx.x; it < 2 * 4 * 32; it += G) { const int l = it >> 7, g = (it >> 5) & 3, k0 = (it & 31) * 64;
            __syncthreads();
            const float* src = a.in[I_WIN] + (size_t)l * DM * WIN_N + PC_END + g * 128;
            for (int i = tid; i < 64 * 128; i += NWAVES * 64) { const int r = i >> 7, c = i & 127; U[r * 129 + c] = src[(size_t)(k0 + r) * WIN_N + c]; }
            __syncthreads();
            typedef short bx8 __attribute__((ext_vector_type(8))); typedef float fx16 __attribute__((ext_vector_type(16)));
            const int r32 = lane & 31, hi = lane >> 5, cpr = (wave & 3) * 32 + r32; const LAS float* Tt = T + (wave >> 2) * 128;
            fx16 acc0 = {}, acc1 = {};
#pragma unroll 2
            for (int st = 0; st < 8; ++st) { const int c0 = 16 * st + 8 * hi; unsigned aw0[4], aw1[4], bw[4];
#pragma unroll
                for (int e = 0; e < 4; ++e) { aw0[e] = pk2(U[r32 * 129 + c0 + 2 * e], U[r32 * 129 + c0 + 2 * e + 1]); aw1[e] = pk2(U[(32 + r32) * 129 + c0 + 2 * e], U[(32 + r32) * 129 + c0 + 2 * e + 1]);
                    bw[e] = pk2(Tt[((c0 + 2 * e) * cpr) & 127], Tt[((c0 + 2 * e + 1) * cpr) & 127]); }
                const bx8 A0 = __builtin_bit_cast(bx8, (v4u){aw0[0], aw0[1], aw0[2], aw0[3]}), A1 = __builtin_bit_cast(bx8, (v4u){aw1[0], aw1[1], aw1[2], aw1[3]}), B = __builtin_bit_cast(bx8, (v4u){bw[0], bw[1], bw[2], bw[3]});
                acc0 = __builtin_amdgcn_mfma_f32_32x32x16_bf16(A0, B, acc0, 0, 0, 0); acc1 = __builtin_amdgcn_mfma_f32_32x32x16_bf16(A1, B, acc1, 0, 0, 0); }
            bf16* wrow = (bf16*)(ws + WS_WF1) + (size_t)l * 1024 * DM + (size_t)((wave >> 2) * 512 + g * 128 + cpr) * DM + k0 + 4 * hi;
#pragma unroll
            for (int q = 0; q < 4; ++q) { u32x2 w0, w1; w0.x = pk2(acc0[4 * q], acc0[4 * q + 1]); w0.y = pk2(acc0[4 * q + 2], acc0[4 * q + 3]); w1.x = pk2(acc1[4 * q], acc1[4 * q + 1]); w1.y = pk2(acc1[4 * q + 2], acc1[4 * q + 3]);
                *(u32x2*)(wrow + 8 * q) = w0; *(u32x2*)(wrow + 32 + 8 * q) = w1; }
        }
    }
    __syncthreads();
    {
        LAS float* S = (LAS float*)lds;
        LAS float* red = (LAS float*)(lds + 9 * 2048 * 4);
        for (int rps = 0; rps < NREP(21); ++rps)
        for (int i = tid; i < 9 * 2048; i += NWAVES * 64) { const int r = i >> 11, k = i & 2047; const float c = r < 8 ? a.in[I_C][r * DM + k] : a.in[I_CCTX][k]; S[i] = c / (1.0f + expf(-c)); }
        __syncthreads();
        float* mod = (float*)(ws + WS_MOD);
        const int cg = tid % 36, ks = tid / 36;
        for (int rp = 0; rp < NREP(15); ++rp)
        for (int ch = blockIdx.x; ch < 256; ch += G) { const int l = ch >> 7, col0 = (ch & 127) * 144;
            f32x4 acc[9];
#pragma unroll
            for (int r = 0; r < 9; ++r) acc[r] = (f32x4){0.f, 0.f, 0.f, 0.f};
            if (tid < 504) { const float* W = a.in[I_ADAW] + (size_t)l * DM * MODROW + col0 + 4 * cg; const int kbeg = ks * 147, kend = kbeg + 147 < 2048 ? kbeg + 147 : 2048;
#pragma unroll 8
                for (int k = kbeg; k < kend; ++k) { const f32x4 w = *(const f32x4*)(W + (size_t)k * MODROW);
#pragma unroll
                    for (int r = 0; r < 9; ++r) acc[r] += w * S[r * 2048 + k]; } }
#pragma unroll
            for (int p = 0; p < 3; ++p) {
                __syncthreads();
                if (tid < 504) {
#pragma unroll
                    for (int j = 0; j < 3; ++j) *(LAS f32x4*)(red + (size_t)tid * 12 + 4 * j) = acc[3 * p + j]; }
                __syncthreads();
                if (tid < 432) { const int cgo = tid / 12, j = tid % 12; float s = 0.f;
#pragma unroll
                    for (int q = 0; q < 14; ++q) s += red[(q * 36 + cgo) * 12 + j];
                    const int r = 3 * p + (j >> 2), col = col0 + 4 * cgo + (j & 3);
                    float val = s + a.in[I_ADAB][l * MODROW + col]; const int chunk = col >> 11;
                    if (chunk == 1 || chunk == 4 || chunk == 7) val = (1.0f + val) * a.in[I_NORMG][(size_t)(l * 3 + (chunk - 1) / 3) * DM + (col & 2047)];
                    mod[((size_t)l * 9 + r) * MODROW + col] = val; }
            }
        }
    }
    __syncthreads();
}

__device__ __forceinline__ void norm_mod_phase(const float* src_lat, const float* src_ctx, bf16* H, const float* g, const float* modl, int ish, int isc, int nrows,
                                               const bf16* dlat, bf16* xb, const bf16* pend, const float* pgate, float pcoef, float* xout_ctx, int gw, int NGW, int lane) {
    { int t_ = threadIdx.x; asm volatile("" : "+v"(t_)); lane = t_ & 63; }
#define NM_LOAD(r, raw) do { \
        if ((r) < MLAT) { \
            if (dlat != nullptr) { const u32x2* dr_ = (const u32x2*)(dlat + (size_t)(r) * DM); const u32x2* xbr_ = (const u32x2*)(xb + (size_t)(r) * DM); \
                _Pragma("unroll") for (int j = 0; j < 8; ++j) { const u32x2 x_ = xbr_[lane + 64 * j], d_ = dr_[lane + 64 * j]; raw[j] = (v4u){x_.x, x_.y, d_.x, d_.y}; } }     \
            else { const v4u* xr_ = (const v4u*)(src_lat + (size_t)(r) * DM); _Pragma("unroll") for (int j = 0; j < 8; ++j) raw[j] = xr_[lane + 64 * j]; } \
        } else { const v4u* xr_ = (const v4u*)(src_ctx + (size_t)((r) - MLAT) * DM); _Pragma("unroll") for (int j = 0; j < 8; ++j) raw[j] = xr_[lane + 64 * j]; } } while (0)
      \
#define NM_GAIN(r) do { const float* mr_ = modl + (size_t)((r) < MLAT ? ((r) >> 11) : 8) * MODROW; \
        _Pragma("unroll") for (int j = 0; j < 8; ++j) { const int c4 = lane + 64 * j; scv[j] = ((const f32x4*)(mr_ + isc * DM))[c4]; shv[j] = ((const f32x4*)(mr_ + ish * DM))[c4]; } } while (0)
#define NM_FINISH(r, raw) do { f32x4 v[8]; \
        u32x2* o_ = (u32x2*)(H + (((size_t)((r) >> 8) * 32 + (lane >> 4)) * 256 + ((r) & 255)) * 64 + 4 * (lane & 15));     \
        if ((r) < MLAT) { \
            if (dlat != nullptr) { _Pragma("unroll") for (int j = 0; j < 8; ++j) { const v4u w_ = raw[j]; \
                v[j].x = __builtin_bit_cast(float, w_.x << 16) + __builtin_bit_cast(float, w_.z << 16); v[j].y = __builtin_bit_cast(float, w_.x & 0xffff0000u) + __builtin_bit_cast(float, w_.z & 0xffff0000u); \
                v[j].z = __builtin_bit_cast(float, w_.y << 16) + __builtin_bit_cast(float, w_.w << 16); v[j].w = __builtin_bit_cast(float, w_.y & 0xffff0000u) + __builtin_bit_cast(float, w_.w & 0xffff0000u); } } \
            else { _Pragma("unroll") for (int j = 0; j < 8; ++j) v[j] = __builtin_bit_cast(f32x4, raw[j]); } \
            if (dlat == nullptr && xb != nullptr) { u32x2* xbw_ = (u32x2*)(xb + (size_t)(r) * DM); _Pragma("unroll") for (int j = 0; j < 8; ++j) { u32x2 w_; w_.x = pk2(v[j].x, v[j].y); w_.y = pk2(v[j].z, v[j].w); xbw_[lane + 64 * j] = w_; } } \
        } else { _Pragma("unroll") for (int j = 0; j < 8; ++j) v[j] = __builtin_bit_cast(f32x4, raw[j]); if (pend != nullptr) { const size_t ro_ = (size_t)((r) - MLAT) * DM; \
            _Pragma("unroll") for (int j = 0; j < 8; ++j) { const int c4 = lane + 64 * j; f32x4 p_ = (f32x4){0.f, 0.f, 0.f, 0.f}; \
                _Pragma("unroll") for (int q = 0; q < 4; ++q) { const u32x2 e_ = ((const u32x2*)(pend + (size_t)q * MCTX * DM + ro_))[c4]; \
                    p_.x += __builtin_bit_cast(float, e_.x << 16); p_.y += __builtin_bit_cast(float, e_.x & 0xffff0000u); p_.z += __builtin_bit_cast(float, e_.y << 16); p_.w += __builtin_bit_cast(float, e_.y & 0xffff0000u); } \
                v[j] = v[j] + (((const f32x4*)pgate)[c4] * pcoef) * p_; ((f32x4*)(xout_ctx + ro_))[c4] = v[j]; } } } \
        float ss_ = 0.f; \
        _Pragma("unroll") for (int j = 0; j < 8; ++j) ss_ += (v[j].x * v[j].x + v[j].y * v[j].y) + (v[j].z * v[j].z + v[j].w * v[j].w); \
        const float rstd_ = rsqrtf(wave_sum(ss_) * (1.0f / DM) + EPS); \
        _Pragma("unroll") for (int j = 0; j < 8; ++j) { const f32x4 sc_ = scv[j], sh_ = shv[j];     \
            const f32x4 y_ = (v[j] * rstd_) * sc_ + sh_; u32x2 w_; w_.x = pk2(y_.x, y_.y); w_.y = pk2(y_.z, y_.w); o_[(size_t)j * (4 * 256 * 64 / 4)] = w_; } } while (0)
    v4u rawA[8], rawB[8]; f32x4 scv[8], shv[8];
    int r = gw;
    if (r < nrows) NM_LOAD(r, rawA);
    while (r < nrows) {
        const int r1 = r + NGW, r2 = r1 + NGW;
        asm volatile("" ::: "memory");
        NM_GAIN(r);
        asm volatile("" ::: "memory");
        if (r1 < nrows) NM_LOAD(r1, rawB);
        asm volatile("" ::: "memory");
        NM_FINISH(r, rawA);
        if (r1 < nrows) { asm volatile("" ::: "memory"); NM_GAIN(r1); asm volatile("" ::: "memory"); if (r2 < nrows) NM_LOAD(r2, rawA); asm volatile("" ::: "memory"); NM_FINISH(r1, rawB); }
        r = r2;
    }
#undef NM_LOAD
#undef NM_GAIN
#undef NM_FINISH
}
__device__ __forceinline__ void final_norm_phase(const float* X, const bf16* D, float* out, const float* g, int gw, int NGW, int lane) {
    { int t_ = threadIdx.x; asm volatile("" : "+v"(t_)); lane = t_ & 63; }
#define FN_LOAD(r, v, d) do { const f32x4* xr_ = (const f32x4*)(X + (size_t)(r) * DM); const u32x2* dr_ = (const u32x2*)(D + (size_t)(r) * DM); \
        _Pragma("unroll") for (int j = 0; j < 8; ++j) { v[j] = xr_[lane + 64 * j]; d[j] = dr_[lane + 64 * j]; } } while (0)
#define FN_FINISH(r, v, d) do { float ss_ = 0.f; \
        _Pragma("unroll") for (int j = 0; j < 8; ++j) { \
            v[j].x += __builtin_bit_cast(float, d[j].x << 16); v[j].y += __builtin_bit_cast(float, d[j].x & 0xffff0000u); v[j].z += __builtin_bit_cast(float, d[j].y << 16); v[j].w += __builtin_bit_cast(float, d[j].y & 0xffff0000u); \
            ss_ += (v[j].x * v[j].x + v[j].y * v[j].y) + (v[j].z * v[j].z + v[j].w * v[j].w); } \
        const float rstd_ = rsqrtf(wave_sum(ss_) * (1.0f / DM) + EPS); f32x4* o_ = (f32x4*)(out + (size_t)(r) * DM); \
        _Pragma("unroll") for (int j = 0; j < 8; ++j) o_[lane + 64 * j] = (v[j] * rstd_) * gv[j]; } while (0)
    f32x4 va[8], vb[8], gv[8]; u32x2 da[8], db[8];
#pragma unroll
    for (int j = 0; j < 8; ++j) gv[j] = ((const f32x4*)g)[lane + 64 * j];
    int r = gw;
    if (r < MLAT) FN_LOAD(r, va, da);
    while (r < MLAT) {
        const int r1 = r + NGW, r2 = r1 + NGW;
        if (r1 < MLAT) FN_LOAD(r1, vb, db);
        asm volatile("" ::: "memory");
        FN_FINISH(r, va, da);
        if (r1 < MLAT) { if (r2 < MLAT) FN_LOAD(r2, va, da); asm volatile("" ::: "memory"); FN_FINISH(r1, vb, db); }
        r = r2;
    }
#undef FN_LOAD
#undef FN_FINISH
}
__device__ __forceinline__ void postproj_phase(bf16* P, const float* kvn, const float* qn, const float* rope, int nrows, int gw, int NGW, int lane) {
    { int t_ = threadIdx.x; asm volatile("" : "+v"(t_)); lane = t_ & 63; }
    for (int r = gw; r < nrows; r += NGW) {
        bf16* pr = P + (size_t)r * LDP;
        u32x2* pkv = (u32x2*)(pr + PC_CKV) + lane; v4u* pq = (v4u*)(pr + PC_CQ) + lane;
        const u32x2 wkv = *pkv; const v4u wq = *pq;
        const bool lat = r < MLAT; const int s = r & 2047, prow = s >> 6, pcol = s & 63;
        float x1[9], x2[9];
#pragma unroll
        for (int t = 0; t < 9; ++t) { const int p = lane + 64 * t, v = p >> 5, q = p & 31, half = q >> 4, i = q & 15;
            const int cb = v == 0 ? PC_KR : (v <= 8 ? PC_DK + (v - 1) * 64 : PC_DQ + (v - 9) * 64), ia = cb + half * 32 + i;
            if (lat && p < 544) { x1[t] = bf2f(pr[ia]); x2[t] = bf2f(pr[ia + 16]); } else { x1[t] = 0.f; x2[t] = 0.f; } }
        asm volatile("" ::: "memory");
        { const float x0 = bf2f((unsigned short)(wkv.x & 0xffff)), xa = bf2f((unsigned short)(wkv.x >> 16)), xb = bf2f((unsigned short)(wkv.y & 0xffff)), xc = bf2f((unsigned short)(wkv.y >> 16));
          const float rstd = rsqrtf(wave_sum((x0 * x0 + xa * xa) + (xb * xb + xc * xc)) * (1.0f / 256.0f) + EPS); const f32x4 g = ((const f32x4*)kvn)[lane];
          u32x2 o; o.x = pk2(x0 * rstd * g.x, xa * rstd * g.y); o.y = pk2(xb * rstd * g.z, xc * rstd * g.w); *pkv = o; }
        { float x[8];
          x[0] = bf2f((unsigned short)(wq.x & 0xffff)); x[1] = bf2f((unsigned short)(wq.x >> 16)); x[2] = bf2f((unsigned short)(wq.y & 0xffff)); x[3] = bf2f((unsigned short)(wq.y >> 16));
          x[4] = bf2f((unsigned short)(wq.z & 0xffff)); x[5] = bf2f((unsigned short)(wq.z >> 16)); x[6] = bf2f((unsigned short)(wq.w & 0xffff)); x[7] = bf2f((unsigned short)(wq.w >> 16));
          float ss = 0.f;
#pragma unroll
          for (int j = 0; j < 8; ++j) ss += x[j] * x[j];
          const float rstd = rsqrtf(wave_sum(ss) * (1.0f / 512.0f) + EPS); const f32x4 g0 = ((const f32x4*)qn)[2 * lane], g1 = ((const f32x4*)qn)[2 * lane + 1];
          v4u o; o.x = pk2(x[0] * rstd * g0.x, x[1] * rstd * g0.y); o.y = pk2(x[2] * rstd * g0.z, x[3] * rstd * g0.w); o.z = pk2(x[4] * rstd * g1.x, x[5] * rstd * g1.y); o.w = pk2(x[6] * rstd * g1.z, x[7] * rstd * g1.w); *pq = o; }
        if (lat) {
#pragma unroll
            for (int t = 0; t < 9; ++t) { const int p = lane + 64 * t, v = p >> 5, q = p & 31, half = q >> 4, i = q & 15;
                const int cb = v == 0 ? PC_KR : (v <= 8 ? PC_DK + (v - 1) * 64 : PC_DQ + (v - 9) * 64), ia = cb + half * 32 + i, pos = half ? pcol : prow;
                const float cs = rope[pos * 32 + i], sn = rope[pos * 32 + 16 + i];
                if (p < 544) { pr[ia] = (bf16)f2bf(x1[t] * cs - x2[t] * sn); pr[ia + 16] = (bf16)f2bf(x1[t] * sn + x2[t] * cs); } } }
    }
}
__device__ __forceinline__ void attn_phase(unsigned char* ws, bool with_ctx, char* ldsg, LAS unsigned char* ldsg_las, int vcu, int cv, float lam, float omli, const float* subln) {
    const bf16* P = (const bf16*)(ws + WS_P); const bf16* KV = (const bf16*)(ws + WS_KV); const bf16* Q = (const bf16*)(ws + WS_Q);
    bf16* O = (bf16*)(ws + WS_O);
    for (int rep = 0; rep < 3; ++rep) {
        int b, h, row0, nkeys;
        if (rep < 2) { const int u = vcu + 256 * rep; b = u >> 6; h = (u >> 3) & 7; row0 = b * SEQ + (u & 7) * 256; nkeys = CTXL + SEQ; }
        else { if (!with_ctx || cv < 128 || cv >= 192) break; const int e = cv - 128; b = e >> 3; h = e & 7; row0 = MLAT + b * CTXL; nkeys = CTXL; }
        fa::Src S; S.Q = Q + (size_t)row0 * 1536 + h * 192; S.ldq = 1536; S.Kn = KV + h * 256; S.ldkn = DM; S.Kr = P + PC_KR; S.ldkr = LDP; S.V = KV + h * 256 + 128; S.ldv = DM;
        S.seg0 = MLAT + b * CTXL; S.seg1 = b * SEQ; S.nkeys = nkeys; S.O = O + (size_t)row0 * DM + h * 128; S.ldo = DM;
        S.lam = 0.f; S.omli = 0.f; S.subln = nullptr;
        for (int rp = 0; rp < NREP(17); ++rp) fa::attn_unit_dma<192, 0>(S, ldsg, (LAS unsigned char*)ldsg_las);
    }
    for (int rep = 0; rep < 2; ++rep) {
        int b, hh, row0, nkeys;
        if (rep == 0) { b = vcu >> 5; hh = (vcu >> 3) & 3; row0 = b * SEQ + (vcu & 7) * 256; nkeys = CTXL + SEQ; }
        else { if (!with_ctx || cv < 192 || cv >= 224) break; const int e = cv - 192; b = e >> 2; hh = e & 3; row0 = MLAT + b * CTXL; nkeys = CTXL; }
        fa::Src S; S.Kn = nullptr; S.ldkn = 0; S.ldq = LDP; S.ldkr = LDP; S.V = P + PC_DV + hh * 128; S.ldv = LDP;
        S.seg0 = MLAT + b * CTXL; S.seg1 = b * SEQ; S.nkeys = nkeys; S.O = O + (size_t)row0 * DM + 1024 + hh * 128; S.ldo = DM; S.lam = lam; S.omli = omli; S.subln = subln;
        S.Q = P + (size_t)row0 * LDP + PC_DQ + (2 * hh) * 64; S.Kr = P + PC_DK + (2 * hh) * 64;
        for (int rp = 0; rp < NREP(18); ++rp) {
        fa::attn_unit_dma<64, 1>(S, ldsg, (LAS unsigned char*)ldsg_las);
        S.Q += 64; S.Kr += 64;
        fa::attn_unit_dma<64, 2>(S, ldsg, (LAS unsigned char*)ldsg_las);
        S.Q -= 64; S.Kr -= 64; }
    }
}
#ifndef GSMASK
#define GSMASK 0xffffffffu
#endif
#define GS(n) ((GSMASK >> (n)) & 1u)
__global__ void __launch_bounds__(NWAVES * 64, 2) mega(Args a) {
    extern __shared__ __attribute__((aligned(16))) unsigned char lds_raw[];
    LAS unsigned char* lds = (LAS unsigned char*)lds_raw;
    volatile LAS unsigned* MISC = (volatile LAS unsigned*)(lds + MISC_OFF);
    const int tid = 0, lane = 0;
    const int wave = __builtin_amdgcn_readfirstlane((int)threadIdx.x >> 6);
    const int G = gridDim.x, gw = blockIdx.x * NWAVES + wave, NGW = G * NWAVES;
    unsigned char* ws = a.ws;
    int vcu = (G % 8 == 0) ? (int)(blockIdx.x % 8) * (G / 8) + (int)(blockIdx.x / 8) : (int)blockIdx.x;
    int cv = (int)blockIdx.x;
    for (int u = threadIdx.x; u < (LDS_BYTES - LDSCTL_OFF) / 4; u += NWAVES * 64) ((LAS unsigned*)(lds + LDSCTL_OFF))[u] = 0u;
    __syncthreads();
    const int lo = a.st_lo, hi = a.st_hi;
    XcdBarrier bar; bar.bar = (unsigned*)(ws + WS_CTL) + CW_BAR; bar.x = 0; bar.st = nullptr;
    if (hi - lo > 1) bar = xcd_barrier_post((unsigned*)(ws + WS_CTL) + CW_BAR, MISC + 8);
#define IN(k) (lo <= (k) && (k) < hi)
#define SEAM(k) do { if (hi > (k) + 1) xcd_barrier(bar); else __syncthreads(); } while (0)
#define WSB() ({ unsigned char* p_ = ws; asm volatile("" : "+s"(p_)); p_; })
#define XC ((float*)(WSB() + WS_X))
#define H ((bf16*)(WSB() + WS_H))
#define O ((bf16*)(WSB() + WS_O))
#define ACT ((bf16*)(WSB() + WS_ACT))
#define P ((bf16*)(WSB() + WS_P))
#define KV ((bf16*)(WSB() + WS_KV))
#define Q ((bf16*)(WSB() + WS_Q))
#define OD ((float*)(WSB() + WS_OD))
#define CT ((bf16*)(WSB() + WS_CT))
#define CTC ((bf16*)(WSB() + WS_CTC))
#define PART ((bf16*)(WSB() + WS_PART))
#define DBUF ((bf16*)(WSB() + WS_S))
#define XB ((bf16*)(WSB() + WS_S + 64 * MiB))
#define MOD ((const float*)(WSB() + WS_MOD))
#define ROPE ((const float*)(WSB() + WS_TAB))
#define LAMV ((const float*)(WSB() + WS_TAB + 16384))
    LAS unsigned char* ring = lds;

#ifndef NO_PRO
    if (IN(0)) for (int rp = 0; rp < NREP(10); ++rp) { prologue(a, lds, tid, lane, wave); SEAM(0); }
    if (lo == 0 && hi > 1 && (G % 8) == 0) {
        if (threadIdx.x == 0) { unsigned* bw = (unsigned*)(ws + WS_CTL) + CW_BAR; unsigned start = 0;
            for (unsigned j = 0; j < 16; ++j) { const unsigned cj = xb_ld(&bw[XB_XCNT(j)]); if (j < bar.x) start += cj; }
            MISC[11] = start + MISC[10]; }
        __syncthreads();
        const int u = __builtin_amdgcn_readfirstlane((int)MISC[11]);
        if (u >= 0 && u < G) { vcu = u; cv = (u % (G / 8)) * 8 + u / (G / 8); }
    }
#endif

    for (int fi = 0; fi < 4; ++fi) {
        const int base = 1 + 16 * fi, l = fi >> 1, f = fi & 1;
        const int Mf = (fi == 3) ? MLAT : MTOT;
        const float* modl = MOD + (size_t)l * 9 * MODROW;
        const float* xin_lat = a.in[I_X]; const float* xin_ctx = (fi == 0) ? a.in[I_CTX] : XC;
        if (IN(base + 0)) for (int rp = 0; rp < (fi == 0 ? NREP(0) : 1); ++rp) { norm_mod_phase(xin_lat, xin_ctx, H, a.in[I_NORMG] + (size_t)(l * 3 + 2 * f) * DM, modl, 6 * f + 0, 6 * f + 1, Mf,
                fi > 0 ? DBUF : nullptr, XB, (fi == 1 || fi == 2) ? PART : nullptr, fi == 1 ? modl + 8 * MODROW + 5 * DM : MOD + 8 * MODROW + 8 * DM  , fi == 1 ? 1.0f : 0.5f, XC, gw, NGW, lane);
            if (fi == 1 && NREP(23) > 1) norm_mod_phase(xin_lat, xin_ctx, H, a.in[I_NORMG] + (size_t)(l * 3 + 2 * f) * DM, modl, 6 * f + 0, 6 * f + 1, MLAT, DBUF, XB, nullptr, nullptr, 0.f, XC, gw, NGW, lane);
            SEAM(base + 0); }
        if (IN(base + 1)) for (int rp = 0; rp < NREP(1); ++rp) {
            pg8::Gemm g{H, (const bf16*)(WSB() + WS_WGU) + (size_t)fi * 2 * DFF * DM, Mf, 2 * DFF, DM, 64, 64, 32768, 32768, (size_t)32 * 32768, (size_t)32 * 32768};     pg8::StaticOrder S; S.init(Mf, 2 * DFF, G, cv);
            pg8::EpiSwiglu E{ACT, DFF / 64, 0};
            if (GS(1)) pg8::gemm_phase<pg8::EpiSwiglu, pg8::StaticOrder, true, true>(ring, g, S, E);
            if (fi < 3 && cv >= 96) { __syncthreads(); transpose_set(a, lds, fi + 1, (cv - 96) * NWAVES + wave, (G - 96) * NWAVES); }
            if (NREP(22) > 1) { __syncthreads(); pg8::EpiSwiglu E2{ACT, DFF / 64, 1}; pg8::gemm_phase<pg8::EpiSwiglu, pg8::StaticOrder, true, true>(ring, g, S, E2); }
            SEAM(base + 1);
        }
        if (IN(base + 2)) for (int rp = 0; rp < (fi == 0 ? NREP(2) : 1); ++rp) {
            { pg8::Gemm g{ACT, (const bf16*)(WSB() + WS_WD) + (size_t)fi * DM * DFFP, MTOT, DM, DFF, 64, DFFP, 32768, 128, (size_t)(DFF / 64) * 32768, (size_t)256 * DFFP * 2};
              pg8::LatCtxOrder S; S.init(G, cv, (DFF / 4 / 64) * 32768, (DFF / 4) * 2, DFF / 4 / 64, fi < 3 ? 1 : 0);
              pg8::EpiLatCtx E{{DBUF, modl + (6 * f + 2) * DM, 0.5f, fi == 0 ? 1 : 0}, {PART, MCTX}};
              for (int r2 = 0; r2 < (fi == 0 ? NREP(11) : 1); ++r2) { if (GS(2)) pg8::gemm_phase<pg8::EpiLatCtx, pg8::LatCtxOrder, true, true>(ring, g, S, E); __syncthreads(); } }
            SEAM(base + 2);
        }
        if (f == 0) {
            const int Mq = (l == 0) ? MTOT : MLAT;
            if (IN(base + 3)) { norm_mod_phase(xin_lat, xin_ctx, H, a.in[I_NORMG] + (size_t)(l * 3 + 1) * DM, modl, 3, 4, MTOT, DBUF, XB, PART, modl + 8 * MODROW + 2 * DM, 0.5f, XC, gw, NGW, lane); SEAM(base + 3); }
            if (IN(base + 4)) for (int rp = 0; rp < NREP(4); ++rp) {
                { pg8::Gemm g{H, (const bf16*)(WSB() + WS_WIN) + (size_t)l * LDP * DM, MTOT, LDP, DM, 64, DM, 32768, 128, (size_t)32 * 32768, (size_t)256 * DM * 2}; pg8::StaticOrder S; S.init(MTOT, LDP, G, cv);
                  pg8::EpiStoreBf16 E{P, LDP};
                  if (GS(3)) pg8::gemm_phase<pg8::EpiStoreBf16, pg8::StaticOrder, true, true>(ring, g, S, E); }
                __syncthreads();
                { pg8::Gemm g{(const bf16*)(WSB() + WS_WF1) + (size_t)l * 1024 * DM, H, 1024, Mq, DM, DM, 64, 128, 32768, (size_t)256 * DM * 2, (size_t)32 * 32768}; pg8::StaticOrder S; S.init(1024, Mq, G, (cv + 48) % G);
                  pg8::EpiF1 E{CT, CTC};
                  if (GS(4)) pg8::gemm_phase<pg8::EpiF1, pg8::StaticOrder, true, true>(ring, g, S, E); }
                SEAM(base + 4);
            }
            if (IN(base + 5)) {
                if (cv >= G / 2) postproj_phase(P, a.in[I_KVN] + l * 256, a.in[I_QN] + l * 512, ROPE, MTOT, (cv - G / 2) * NWAVES + wave, (G - G / 2) * NWAVES, lane);
                { pg8::Gemm g = pg8::mk_gemm((const bf16*)(WSB() + WS_DFT), CT, SEQ, NB * 512, 4096, 4096, 4096); pg8::StaticOrder S; S.init(SEQ, NB * 512, G, cv);
                  pg8::EpiF2 E{O, 0, SEQ};
                  for (int r2 = 0; r2 < NREP(19); ++r2) { if (GS(7)) pg8::gemm_phase<pg8::EpiF2, pg8::StaticOrder, true, true>(ring, g, S, E); __syncthreads(); } }
                if (l == 0) {
                  __syncthreads();
                  pg8::Gemm g = pg8::mk_gemm((const bf16*)(WSB() + WS_DFTC), CTC, CTXL, NB * 512, 512, 512, 512); pg8::StaticOrder S; S.init(CTXL, NB * 512, G, (cv + 112) % G);
                  pg8::EpiF2 E{O, MLAT, CTXL};
                  if (GS(8)) pg8::gemm_phase<pg8::EpiF2, pg8::StaticOrder, true, true>(ring, g, S, E); }
                SEAM(base + 5); }
            if (IN(base + 6)) for (int rp = 0; rp < NREP(6); ++rp) {
                { pg8::Gemm g = pg8::mk_gemm(P + PC_CKV, (const bf16*)(WSB() + WS_WUKV) + (size_t)l * 2048 * 256, MTOT, 2048, 256, LDP, 256); pg8::StaticOrder S; S.init(MTOT, 2048, G, cv);
                  pg8::EpiStoreBf16 E{KV, DM};
                  if (GS(5)) pg8::gemm_phase<pg8::EpiStoreBf16, pg8::StaticOrder, true, true>(ring, g, S, E); }
                __syncthreads();
                { pg8::Gemm g = pg8::mk_gemm(P + PC_CQ, (const bf16*)(WSB() + WS_WUQ) + (size_t)l * 1536 * 512, Mq, 1536, 512, LDP, 512); pg8::StaticOrder S; S.init(Mq, 1536, G, (cv + 176) % G);
                  pg8::EpiRopeQ E{Q, 1536, ROPE};
                  if (GS(6)) pg8::gemm_phase<pg8::EpiRopeQ, pg8::StaticOrder, true, true>(ring, g, S, E); }
                SEAM(base + 6);
            }
            if (IN(base + 7)) for (int rp = 0; rp < NREP(7); ++rp) {
                attn_phase(ws, l == 0, (char*)lds_raw, lds, vcu, cv, LAMV[2 * l], LAMV[2 * l + 1], a.in[I_SUBLN] + l * 128);
                SEAM(base + 7);
            }
            if (IN(base + 9)) {
                { pg8::Gemm g = pg8::mk_gemm(O, (const bf16*)(WSB() + WS_WOUT) + (size_t)l * DM * DM, MTOT, DM, DM, DM, DM);
                  pg8::LatCtxOrder S; S.init(G, cv, (DM / 4) * 2, (DM / 4) * 2, DM / 4 / 64, l == 0 ? 1 : 0);
                  pg8::EpiLatCtx E{{DBUF, modl + 5 * DM, 1.0f, 0}, {PART, MCTX}};
                  if (GS(9)) pg8::gemm_phase<pg8::EpiLatCtx, pg8::LatCtxOrder, true, true>(ring, g, S, E); }
                SEAM(base + 9);
            }
        }
    }
    if (IN(65)) final_norm_phase(a.in[I_X], DBUF, a.out, a.in[I_FN], gw, NGW, lane);
#undef IN
#undef SEAM
#undef WSB
#undef XC
#undef H
#undef O
#undef ACT
#undef P
#undef KV
#undef Q
#undef OD
#undef CT
#undef CTC
#undef PART
#undef DBUF
#undef XB
#undef MOD
#undef ROPE
#undef LAMV
}

extern "C" void kernel_launch(void* const* d_in, const int* in_sizes, int n_in, void* d_out, int out_size, void* d_ws, size_t ws_size, hipStream_t stream) {
    static int grid = 0;
    if (grid == 0) {
        if (n_in != 19 || out_size != MLAT * DM || ws_size < WS_END) { fprintf(stderr, "kernel_launch: unexpected shapes (n_in %d, out %d, ws %zu < %zu)\n", n_in, out_size, ws_size, (size_t)WS_END); grid = -1; return; }
        int dev = 0, cus = 0, per_cu = 0;
        if (hipGetDevice(&dev) != hipSuccess || hipDeviceGetAttribute(&cus, hipDeviceAttributeMultiprocessorCount, dev) != hipSuccess) { grid = -1; return; }
        if (hipFuncSetAttribute((const void*)mega, hipFuncAttributeMaxDynamicSharedMemorySize, LDS_BYTES) != hipSuccess) { fprintf(stderr, "kernel_launch: hipFuncSetAttribute failed\n"); grid = -1; return; }
        if (hipOccupancyMaxActiveBlocksPerMultiprocessor(&per_cu, (const void*)mega, NWAVES * 64, LDS_BYTES) != hipSuccess || per_cu < 1) { fprintf(stderr, "kernel_launch: occupancy query says %d\n", per_cu); }
        (void)hipGetLastError();
        grid = cus;
    }
    if (grid < 0) return;
    (void)hipMemsetAsync((char*)d_ws + WS_CTL, 0, CTL_ZERO_BYTES, stream);
    Args a{};
    for (int i = 0; i < 19; ++i) a.in[i] = (const float*)d_in[i];
    a.out = (float*)d_out; a.ws = (unsigned char*)d_ws;
#ifndef MK_ONE_LAUNCH
#define MK_ONE_LAUNCH 1
#endif
    if (MK_ONE_LAUNCH) { a.st_lo = 0; a.st_hi = N_STEPS; hipLaunchKernelGGL(mega, dim3(grid), dim3(NWAVES * 64), LDS_BYTES, stream, a); }
    else {
        int steps[64]; int ns = 0; steps[ns++] = 0;
        for (int fi = 0; fi < 4; ++fi) { const int base = 1 + 16 * fi; for (int k = 0; k < 3; ++k) steps[ns++] = base + k; if ((fi & 1) == 0) for (int k = 3; k < 10; ++k) if (k != 8) steps[ns++] = base + k; }
        steps[ns++] = 65;
        for (int i = 0; i < ns; ++i) { a.st_lo = steps[i]; a.st_hi = steps[i] + 1; hipLaunchKernelGGL(mega, dim3(grid), dim3(NWAVES * 64), LDS_BYTES, stream, a); }
    }
    const hipError_t le = hipPeekAtLastError();
    if (le != hipSuccess) fprintf(stderr, "kernel_launch: launch failed: %s\n", hipGetErrorName(le));
}
```

```cpp
#include <hip/hip_runtime.h>
#include <cstdio>
#include <cstdint>
#ifndef DUPMASK
#define DUPMASK 0u
#endif
#define NREP(k) (1 + (int)((DUPMASK >> (k)) & 1u))
namespace pg8 {
#define PG8_LAS __attribute__((address_space(3)))
typedef unsigned short bf16_t;
typedef short bf16x8 __attribute__((ext_vector_type(8)));
typedef float f32x4 __attribute__((ext_vector_type(4)));
typedef float f32x2 __attribute__((ext_vector_type(2)));
typedef unsigned u32x4 __attribute__((ext_vector_type(4)));
typedef unsigned u32x2 __attribute__((ext_vector_type(2)));
constexpr int BM = 256, BK = 64, HALF = 128, HTB = HALF * BK * 2  , STAGE_BYTES = 8 * HTB, NXCD = 8, WGM = 8;

__host__ __device__ __forceinline__ int lds_byte(int r, int c) { const int st = (r >> 4) * 2 + (c >> 5), rr = r & 15, cc = c & 31, ob = rr * 64 + cc * 2; return st * 1024 + (ob ^ (((ob >> 9) & 1) << 5)); }
__host__ __device__ __forceinline__ void stage_rc(int b, int& R, int& C) { const int st = b / 1024, sb = b % 1024, swz = sb ^ (((sb >> 9) & 1) << 5); R = (st >> 1) * 16 + swz / 64; C = (st & 1) * 32 + (swz % 64) / 2; }
__host__ __device__ __forceinline__ int perm32(int rho) { const int n = rho >> 4, i = rho & 15; return 8 * (i >> 2) + 4 * n + (i & 3); }

struct Unit { int pm, pn, koA, koB, ks, nt; };
struct Gemm { const bf16_t* A; const bf16_t* Bt; int M, N, K, lda, ldb, ksA, ksB; size_t tsA, tsB; };
__host__ __device__ __forceinline__ Gemm mk_gemm(const bf16_t* A, const bf16_t* Bt, int M, int N, int K, int lda, int ldb) { return Gemm{A, Bt, M, N, K, lda, ldb, BK * 2, BK * 2, (size_t)BM * lda * 2, (size_t)BM * ldb * 2}; }

struct StaticOrder {
    int nM, nN, nwg, G, c;
    __host__ __device__ void init(int M, int N, int G_, int c_) { nM = M / BM; nN = N / BM; nwg = nM * nN; G = G_; c = c_; }
    __host__ __device__ bool next(int i, Unit& u) const {
        const long L = (long)i * G + c; if (L >= nwg) return false;
        int wgid = (int)L; { const int q = nwg / NXCD, r = nwg % NXCD, xcd = wgid % NXCD, off = wgid / NXCD; wgid = (xcd < r ? xcd * (q + 1) : r * (q + 1) + (xcd - r) * q) + off; }
        const int nig = WGM * nN, gid = wgid / nig, fm = gid * WGM, gsz = (nM - fm) < WGM ? (nM - fm) : WGM;
        u.pm = fm + ((wgid % nig) % gsz); u.pn = (wgid % nig) / gsz; u.koA = 0; u.koB = 0; u.ks = 0; u.nt = 0; return true;
    }
    __device__ __forceinline__ void a_ready(const Unit&) const {}
    __device__ __forceinline__ void done(const Unit&) const {}
};
struct SplitKOrder {
    int nM, nN, KS, G, c, kpartA, kpartB;
    __host__ __device__ void init(int M, int N, int KS_, int kpartA_, int kpartB_, int G_, int c_) { nM = M / BM; nN = N / BM; KS = KS_; kpartA = kpartA_; kpartB = kpartB_; G = G_; c = c_; }
    __host__ __device__ bool next(int i, Unit& u) const {
        const long L = (long)i * G + c; const int per = nM * nN; if (L >= (long)per * KS) return false;
        const int ks = (int)(L / per), r = (int)(L % per); u.pm = r % nM; u.pn = r / nM; u.ks = ks; u.koA = ks * kpartA; u.koB = ks * kpartB; u.nt = 0; return true;
    }
    __device__ __forceinline__ void a_ready(const Unit&) const {}
    __device__ __forceinline__ void done(const Unit&) const {}
};

struct PanelOrder {
    int nM, nN, G, c;
    __host__ __device__ void init(int M, int N, int G_, int c_) { nM = M / BM; nN = N / BM; G = G_; c = c_; }
    __host__ __device__ bool next(int i, Unit& u) const {
        const int per_x = G / NXCD, xcd = c % NXCD, idx = i * per_x + c / NXCD, pml = idx / nN;
        if (pml >= nM / NXCD) return false;
        u.pm = xcd * (nM / NXCD) + pml; u.pn = idx % nN; u.koA = 0; u.koB = 0; u.ks = 0; u.nt = 0; return true;
    }
    __device__ __forceinline__ void a_ready(const Unit&) const {}
    __device__ __forceinline__ void done(const Unit&) const {}
};
struct LatCtxOrder {
    PanelOrder lat; int G, c, n_lat_rounds, kpartA, kpartB, nt_part, with_ctx;
    __host__ __device__ void init(int G_, int c_, int kpartA_, int kpartB_, int nt_part_, int with_ctx_) { lat.init(16384, 2048, G_, c_); G = G_; c = c_; n_lat_rounds = (64 * 8 + G_ - 1) / G_; kpartA = kpartA_; kpartB = kpartB_; nt_part = nt_part_; with_ctx = with_ctx_; }
    __host__ __device__ bool next(int i, Unit& u) const {
        if (i < n_lat_rounds) { if (lat.next(i, u)) return true; }
        if (!with_ctx) return false;
        const long L = (long)(i - n_lat_rounds) * G + c; if (i < n_lat_rounds || L >= 256) return false;
        const int ks = (int)(L >> 6), r = (int)(L & 63); u.pm = 64 + (r & 7); u.pn = r >> 3; u.ks = ks; u.koA = ks * kpartA; u.koB = ks * kpartB; u.nt = nt_part; return true;
    }
    __device__ __forceinline__ void a_ready(const Unit&) const {}
    __device__ __forceinline__ void done(const Unit&) const {}
};
__device__ __forceinline__ unsigned cvt_pk_bf16(float lo, float hi) { unsigned r; asm volatile("v_cvt_pk_bf16_f32 %0, %1, %2" : "=v"(r) : "v"(lo), "v"(hi)); return r; }
__device__ __forceinline__ float silu_f(float x) { return x * __builtin_amdgcn_rcpf(1.0f + __builtin_amdgcn_exp2f(-1.4426950408889634f * x)); }

constexpr int E_DM = 2048, E_MLAT = 16384, E_MODROW = 9 * 2048;

struct EpiSwiglu {
    static constexpr bool PERM = true, AFTER_DRAIN = false;
    bf16_t* O; int nkt; int skip;
    __device__ __forceinline__ void operator()(const f32x4 (&acc)[2][2][4][2], const Unit& u, int wr, int wc, int fr, int fq) const {
        if (skip && acc[0][0][0][0][0] != 1.2345e30f) return;
        bf16_t* base = O + (((size_t)u.pm * nkt + 2 * u.pn + (wc >> 1)) * BM + wr * 64 + fr) * 64 + (wc & 1) * 32 + 8 * fq;
#pragma unroll
        for (int ai = 0; ai < 2; ++ai)
#pragma unroll
            for (int m = 0; m < 4; ++m) { bf16_t* rowp = base + (size_t)(ai * HALF + m * 16) * 64;
                const f32x4 g0 = acc[ai][0][m][0], g1 = acc[ai][0][m][1], u0 = acc[ai][1][m][0], u1 = acc[ai][1][m][1];
                u32x4 w; w.x = cvt_pk_bf16(silu_f(g0[0]) * u0[0], silu_f(g0[1]) * u0[1]); w.y = cvt_pk_bf16(silu_f(g0[2]) * u0[2], silu_f(g0[3]) * u0[3]);
                w.z = cvt_pk_bf16(silu_f(g1[0]) * u1[0], silu_f(g1[1]) * u1[1]); w.w = cvt_pk_bf16(silu_f(g1[2]) * u1[2], silu_f(g1[3]) * u1[3]);
                *(u32x4*)rowp = w; }
    }
};
struct EpiStoreBf16 {
    static constexpr bool PERM = true, AFTER_DRAIN = false;
    bf16_t* O; int ldc;
    __device__ __forceinline__ void operator()(const f32x4 (&acc)[2][2][4][2], const Unit& u, int wr, int wc, int fr, int fq) const {
        const int row0 = u.pm * BM + wr * 64 + fr, col0 = u.pn * BM + wc * 32 + 8 * fq;
#pragma unroll
        for (int ai = 0; ai < 2; ++ai)
#pragma unroll
            for (int m = 0; m < 4; ++m) { bf16_t* rowp = O + (size_t)(row0 + ai * HALF + m * 16) * ldc + col0;
#pragma unroll
                for (int bj = 0; bj < 2; ++bj) { const f32x4 v0 = acc[ai][bj][m][0], v1 = acc[ai][bj][m][1];
                    u32x4 w; w.x = cvt_pk_bf16(v0[0], v0[1]); w.y = cvt_pk_bf16(v0[2], v0[3]); w.z = cvt_pk_bf16(v1[0], v1[1]); w.w = cvt_pk_bf16(v1[2], v1[3]);
                    *(u32x4*)(rowp + bj * HALF) = w; } }
    }
};
struct EpiDelta {
    static constexpr bool PERM = true, AFTER_DRAIN = false;
    bf16_t* D; const float* gate; float coef; int first;
    __device__ __forceinline__ void operator()(const f32x4 (&acc)[2][2][4][2], const Unit& u, int wr, int wc, int fr, int fq) const {
        const int row0 = u.pm * BM + wr * 64 + fr, col0 = u.pn * BM + wc * 32 + 8 * fq; const float* gp = gate + (size_t)(u.pm >> 3) * E_MODROW + col0;
        f32x4 gv[2][2];
#pragma unroll
        for (int bj = 0; bj < 2; ++bj)
#pragma unroll
            for (int n = 0; n < 2; ++n) gv[bj][n] = *(const f32x4*)(gp + bj * HALF + 4 * n) * coef;
#pragma unroll
        for (int ai = 0; ai < 2; ++ai) { u32x4 old[4][2];
            if (!first) {
#pragma unroll
                for (int m = 0; m < 4; ++m)
#pragma unroll
                    for (int bj = 0; bj < 2; ++bj) old[m][bj] = *(const u32x4*)(D + (size_t)(row0 + ai * HALF + m * 16) * E_DM + col0 + bj * HALF);
                asm volatile("" ::: "memory"); }
#pragma unroll
            for (int m = 0; m < 4; ++m) { bf16_t* rowp = D + (size_t)(row0 + ai * HALF + m * 16) * E_DM + col0;
#pragma unroll
                for (int bj = 0; bj < 2; ++bj) { f32x4 v0 = acc[ai][bj][m][0] * gv[bj][0], v1 = acc[ai][bj][m][1] * gv[bj][1];
                    if (!first) { const u32x4 o = old[m][bj];
                        v0[0] += __builtin_bit_cast(float, o.x << 16); v0[1] += __builtin_bit_cast(float, o.x & 0xffff0000u); v0[2] += __builtin_bit_cast(float, o.y << 16); v0[3] += __builtin_bit_cast(float, o.y & 0xffff0000u);
                        v1[0] += __builtin_bit_cast(float, o.z << 16); v1[1] += __builtin_bit_cast(float, o.z & 0xffff0000u); v1[2] += __builtin_bit_cast(float, o.w << 16); v1[3] += __builtin_bit_cast(float, o.w & 0xffff0000u); }
                    u32x4 w; w.x = cvt_pk_bf16(v0[0], v0[1]); w.y = cvt_pk_bf16(v0[2], v0[3]); w.z = cvt_pk_bf16(v1[0], v1[1]); w.w = cvt_pk_bf16(v1[2], v1[3]);
                    *(u32x4*)(rowp + bj * HALF) = w; } }
            asm volatile("" ::: "memory"); }
    }
};
struct EpiPartial {
    static constexpr bool PERM = true, AFTER_DRAIN = false;
    bf16_t* part; int rows;
    __device__ __forceinline__ void operator()(const f32x4 (&acc)[2][2][4][2], const Unit& u, int wr, int wc, int fr, int fq) const {
        bf16_t* out = part + ((size_t)u.ks * rows + (size_t)u.pm * BM + wr * 64 + fr) * E_DM + u.pn * BM + wc * 32 + 8 * fq;
#pragma unroll
        for (int ai = 0; ai < 2; ++ai)
#pragma unroll
            for (int m = 0; m < 4; ++m) { bf16_t* rowp = out + (size_t)(ai * HALF + m * 16) * E_DM;
#pragma unroll
                for (int bj = 0; bj < 2; ++bj) { const f32x4 v0 = acc[ai][bj][m][0], v1 = acc[ai][bj][m][1];
                    u32x4 w; w.x = cvt_pk_bf16(v0[0], v0[1]); w.y = cvt_pk_bf16(v0[2], v0[3]); w.z = cvt_pk_bf16(v1[0], v1[1]); w.w = cvt_pk_bf16(v1[2], v1[3]);
                    *(u32x4*)(rowp + bj * HALF) = w; } }
    }
};
struct EpiLatCtx {
    static constexpr bool PERM = true, AFTER_DRAIN = false;
    EpiDelta lat; EpiPartial ctx;
    __device__ __forceinline__ void operator()(const f32x4 (&acc)[2][2][4][2], const Unit& u, int wr, int wc, int fr, int fq) const {
        if (u.pm < 64) lat(acc, u, wr, wc, fr, fq);
        else { Unit v = u; v.pm = u.pm - 64; ctx(acc, v, wr, wc, fr, fq); }
    }
};
struct EpiF1 {
    static constexpr bool PERM = true, AFTER_DRAIN = false;
    bf16_t* Ct; bf16_t* Ctc;
    __device__ __forceinline__ void operator()(const f32x4 (&acc)[2][2][4][2], const Unit& u, int wr, int wc, int fr, int fq) const {
        const int row0 = u.pm * BM + wr * 64 + fr, cw = wc * 32 + 8 * fq;
#pragma unroll
        for (int ai = 0; ai < 2; ++ai)
#pragma unroll
            for (int m = 0; m < 4; ++m) { const int mr = row0 + ai * HALF + m * 16, type = mr >> 9, n = mr & 511;
                bf16_t* rowp = u.pn < 64 ? Ct + (((size_t)((u.pn >> 3) * 512 + n)) * 2 + type) * 2048 + (u.pn & 7) * 256 + cw
                                         : Ctc + (((size_t)((u.pn - 64) * 512 + n)) * 2 + type) * 256 + cw;
#pragma unroll
                for (int bj = 0; bj < 2; ++bj) { const f32x4 v0 = acc[ai][bj][m][0], v1 = acc[ai][bj][m][1];
                    u32x4 w; w.x = cvt_pk_bf16(v0[0], v0[1]); w.y = cvt_pk_bf16(v0[2], v0[3]); w.z = cvt_pk_bf16(v1[0], v1[1]); w.w = cvt_pk_bf16(v1[2], v1[3]);
                    *(u32x4*)(rowp + bj * HALF) = w; } }
    }
};
struct EpiF2 {
    static constexpr bool PERM = true, AFTER_DRAIN = false;
    bf16_t* O; int rowbase, rows_per_b;
    __device__ __forceinline__ void operator()(const f32x4 (&acc)[2][2][4][2], const Unit& u, int wr, int wc, int fr, int fq) const {
        const int row0 = rowbase + (u.pn >> 1) * rows_per_b + u.pm * BM + wr * 64 + fr, col0 = 1536 + (u.pn & 1) * 256 + wc * 32 + 8 * fq;
#pragma unroll
        for (int ai = 0; ai < 2; ++ai)
#pragma unroll
            for (int m = 0; m < 4; ++m) { bf16_t* rowp = O + (size_t)(row0 + ai * HALF + m * 16) * E_DM + col0;
#pragma unroll
                for (int bj = 0; bj < 2; ++bj) { const f32x4 v0 = acc[ai][bj][m][0], v1 = acc[ai][bj][m][1];
                    u32x4 w; w.x = cvt_pk_bf16(v0[0], v0[1]); w.y = cvt_pk_bf16(v0[2], v0[3]); w.z = cvt_pk_bf16(v1[0], v1[1]); w.w = cvt_pk_bf16(v1[2], v1[3]);
                    *(u32x4*)(rowp + bj * HALF) = w; } }
    }
};
struct EpiPartF32 {
    static constexpr bool PERM = true, AFTER_DRAIN = false, DRAINED = false;
    float* part; int rows, ld;
    __device__ __forceinline__ void operator()(const f32x4 (&acc)[2][2][4][2], const Unit& u, int wr, int wc, int fr, int fq) const {
        float* out = part + ((size_t)u.ks * rows + (size_t)u.pm * BM + wr * 64 + fr) * ld + u.pn * BM + wc * 32 + 8 * fq;
#pragma unroll
        for (int ai = 0; ai < 2; ++ai)
#pragma unroll
            for (int m = 0; m < 4; ++m) { float* rowp = out + (size_t)(ai * HALF + m * 16) * ld;
#pragma unroll
                for (int bj = 0; bj < 2; ++bj) { *(f32x4*)(rowp + bj * HALF) = acc[ai][bj][m][0]; *(f32x4*)(rowp + bj * HALF + 4) = acc[ai][bj][m][1]; } }
    }
};
struct EpiRopeQ {
    static constexpr bool PERM = false, AFTER_DRAIN = false;
    bf16_t* Q; int ldc; const float* rope;
    __device__ __forceinline__ void operator()(const f32x4 (&acc)[2][2][4][2], const Unit& u, int wr, int wc, int fr, int fq) const {
        const int row0 = u.pm * BM + wr * 64 + fr;
#pragma unroll
        for (int bj = 0; bj < 2; ++bj) { const int cg = u.pn * BM + bj * HALF + wc * 32, within = cg % 192; const bool roped = within >= 128 && u.pm < 64; const int half = (within - 128) >> 5;
#pragma unroll
            for (int ai = 0; ai < 2; ++ai)
#pragma unroll
                for (int m = 0; m < 4; ++m) { const int row = row0 + ai * HALF + m * 16, s = row & 2047, pos = half ? (s & 63) : (s >> 6);
                    f32x4 x1 = acc[ai][bj][m][0], x2 = acc[ai][bj][m][1];
                    if (roped) { const f32x4 cs = *(const f32x4*)(rope + pos * 32 + 4 * fq), sn = *(const f32x4*)(rope + pos * 32 + 16 + 4 * fq);
                        const f32x4 o1 = x1 * cs - x2 * sn, o2 = x1 * sn + x2 * cs; x1 = o1; x2 = o2; }
                    bf16_t* p = Q + (size_t)row * ldc + cg + 4 * fq;
                    u32x2 w1, w2; w1.x = cvt_pk_bf16(x1[0], x1[1]); w1.y = cvt_pk_bf16(x1[2], x1[3]); w2.x = cvt_pk_bf16(x2[0], x2[1]); w2.y = cvt_pk_bf16(x2[2], x2[3]);
                    *(u32x2*)p = w1; *(u32x2*)(p + 16) = w2; } }
    }
};

template <class Epi, class Sched, bool ALIGN_EPI = false, bool SP2 = false>
__device__ __forceinline__ void gemm_phase(PG8_LAS unsigned char* lds, const Gemm g, const Sched& S, const Epi& E) {
    int tid_ = threadIdx.x; asm volatile("" : "+v"(tid_));
    const int tid = tid_, wid = __builtin_amdgcn_readfirstlane(tid >> 6), lane = tid & 63, wr = wid >> 2, wc = wid & 3, fr = lane & 15, fq = lane >> 4;
    const int K = g.K, nt0 = K / BK;
    unsigned voffA[2], voffB[2];
#pragma unroll
    for (int i = 0; i < 2; ++i) { int R, C; stage_rc(tid * 16 + i * 8192, R, C); const int Rb = Epi::PERM ? ((R & ~31) + perm32(R & 31)) : R;
        voffA[i] = (unsigned)(R * g.lda + C) * 2u; voffB[i] = (unsigned)(Rb * g.ldb + C) * 2u; }
    const size_t kstepA = (size_t)g.ksA, kstepB = (size_t)g.ksB;
    const size_t hstepA = (size_t)HALF * g.lda * 2, hstepB = (size_t)HALF * g.ldb * 2;
    const size_t tstepA = g.tsA, tstepB = g.tsB;
    const unsigned ldsw = (unsigned)wid * 1024u;
    const int aoff = lds_byte(wr * 64 + fr, fq * 8), boff = lds_byte(wc * 32 + fr, fq * 8);
#define PG8_SA(b, h) (((b) * 2 + (h)) * HTB)
#define PG8_SB(b, h) ((4 + (b) * 2 + (h)) * HTB)
#define PG8_STAGE(bufoff, gbase, voff) do { _Pragma("unroll") for (int _i = 0; _i < 2; ++_i) \
        __builtin_amdgcn_global_load_lds((const unsigned*)((const char*)(gbase) + (voff)[_i]), (PG8_LAS unsigned*)(lds + (bufoff) + ldsw + _i * 8192), 16, 0, 0); } while (0)
#define PG8_LDA(dst, b, h) do { _Pragma("unroll") for (int m = 0; m < 4; ++m) _Pragma("unroll") for (int k = 0; k < 2; ++k) dst[m][k] = *(const PG8_LAS bf16x8*)(lds + PG8_SA(b, h) + aoff + m * 2048 + k * 1024); } while (0)
#define PG8_LDB(dst, b, h) do { _Pragma("unroll") for (int n = 0; n < 2; ++n) _Pragma("unroll") for (int k = 0; k < 2; ++k) dst[n][k] = *(const PG8_LAS bf16x8*)(lds + PG8_SB(b, h) + boff + n * 2048 + k * 1024); } while (0)
#define PG8_MMA(ai, bj, At, Bt) do { __builtin_amdgcn_s_setprio(1); _Pragma("unroll") for (int m = 0; m < 4; ++m) _Pragma("unroll") for (int n = 0; n < 2; ++n) _Pragma("unroll") for (int k = 0; k < 2; ++k) \
        acc[ai][bj][m][n] = __builtin_amdgcn_mfma_f32_16x16x32_bf16(Bt[n][k], At[m][k], acc[ai][bj][m][n], 0, 0, 0); __builtin_amdgcn_s_setprio(0); } while (0)
#define PG8_WAIT_V(n) asm volatile("s_waitcnt vmcnt(" #n ")" ::: "memory")
#define PG8_WAIT_L(n) asm volatile("s_waitcnt lgkmcnt(" #n ")" ::: "memory")
#define PG8_BAR __builtin_amdgcn_s_barrier()
#define PG8_SCHED __builtin_amdgcn_sched_barrier(0)
    Unit cur, nxt; int ui = 0;
    if (!S.next(0, cur)) return;
    f32x4 acc[2][2][4][2];
#pragma unroll
    for (int a = 0; a < 2; ++a)
#pragma unroll
        for (int b = 0; b < 2; ++b)
#pragma unroll
            for (int m = 0; m < 4; ++m)
#pragma unroll
                for (int n = 0; n < 2; ++n) acc[a][b][m][n] = (f32x4){0.f, 0.f, 0.f, 0.f};
    bf16x8 At[4][2], B0[2][2], B1[2][2];
    const char* cA = (const char*)g.A + (size_t)cur.pm * tstepA + cur.koA; const char* cB = (const char*)g.Bt + (size_t)cur.pn * tstepB + cur.koB;
    S.a_ready(cur);
    if constexpr (SP2) {
        PG8_STAGE(PG8_SB(0, 0), cB, voffB); PG8_STAGE(PG8_SB(0, 1), cB + hstepB, voffB); PG8_STAGE(PG8_SA(0, 0), cA, voffA); PG8_STAGE(PG8_SA(0, 1), cA + hstepA, voffA);
        if (wr == 1) PG8_BAR;
        PG8_WAIT_V(2); PG8_BAR;
        PG8_STAGE(PG8_SB(1, 0), cB + kstepB, voffB); PG8_STAGE(PG8_SA(1, 0), cA + kstepA, voffA); PG8_STAGE(PG8_SB(1, 1), cB + hstepB + kstepB, voffB);
        PG8_WAIT_V(6); PG8_BAR;
    } else {
        PG8_STAGE(PG8_SB(0, 0), cB, voffB); PG8_STAGE(PG8_SA(0, 0), cA, voffA); PG8_STAGE(PG8_SB(0, 1), cB + hstepB, voffB); PG8_STAGE(PG8_SA(0, 1), cA + hstepA, voffA);
        if (wr == 1) PG8_BAR;
        PG8_WAIT_V(4); PG8_BAR;
        PG8_STAGE(PG8_SB(1, 0), cB + kstepB, voffB); PG8_STAGE(PG8_SA(1, 0), cA + kstepA, voffA); PG8_STAGE(PG8_SB(1, 1), cB + hstepB + kstepB, voffB);
        PG8_WAIT_V(6); PG8_BAR;
    }
    for (;;) {
        const bool has_next = S.next(ui + 1, nxt);
        const char* nA = has_next ? (const char*)g.A + (size_t)nxt.pm * tstepA + nxt.koA : cA; const char* nB = has_next ? (const char*)g.Bt + (size_t)nxt.pn * tstepB + nxt.koB : cB;
        const int nt = cur.nt ? cur.nt : nt0;
#pragma nounroll
        for (int t = 0; t < nt; t += 2) {
            const bool last = (t == nt - 2);
            const char* a1 = cA + (size_t)(t + 1) * kstepA;
            const char* a2 = last ? nA : cA + (size_t)(t + 2) * kstepA; const char* b2 = last ? nB : cB + (size_t)(t + 2) * kstepB;
            const char* a3 = a2 + kstepA; const char* b3 = b2 + kstepB;
            if (last && has_next) S.a_ready(nxt);
            if constexpr (SP2) {
            PG8_LDB(B0, 0, 0); PG8_LDB(B1, 0, 1); PG8_SCHED; PG8_LDA(At, 0, 0); PG8_STAGE(PG8_SA(1, 1), a1 + hstepA, voffA);
            PG8_WAIT_V(8); PG8_WAIT_L(0); PG8_BAR; PG8_MMA(0, 0, At, B0); PG8_MMA(0, 1, At, B1); PG8_BAR; PG8_SCHED;
            PG8_LDA(At, 0, 1); PG8_STAGE(PG8_SB(0, 0), b2, voffB); PG8_STAGE(PG8_SB(0, 1), b2 + hstepB, voffB); PG8_STAGE(PG8_SA(0, 0), a2, voffA);
            PG8_WAIT_V(8); PG8_WAIT_L(0); PG8_BAR; PG8_MMA(1, 0, At, B0); PG8_MMA(1, 1, At, B1); PG8_BAR; PG8_SCHED;
            PG8_LDB(B0, 1, 0); PG8_LDB(B1, 1, 1); PG8_SCHED; PG8_LDA(At, 1, 0); PG8_STAGE(PG8_SA(0, 1), a2 + hstepA, voffA);
            PG8_WAIT_V(8); PG8_WAIT_L(0); PG8_BAR; PG8_MMA(0, 0, At, B0); PG8_MMA(0, 1, At, B1); PG8_BAR; PG8_SCHED;
            PG8_LDA(At, 1, 1); PG8_STAGE(PG8_SB(1, 0), b3, voffB); PG8_STAGE(PG8_SB(1, 1), b3 + hstepB, voffB); PG8_STAGE(PG8_SA(1, 0), a3, voffA);
            PG8_WAIT_V(8); PG8_WAIT_L(0); PG8_BAR; PG8_MMA(1, 0, At, B0); PG8_MMA(1, 1, At, B1); PG8_BAR; PG8_SCHED;
            } else {
            PG8_LDB(B0, 0, 0); PG8_SCHED; PG8_LDA(At, 0, 0); PG8_STAGE(PG8_SA(1, 1), a1 + hstepA, voffA);
            PG8_WAIT_L(8); PG8_BAR; PG8_WAIT_L(0); PG8_MMA(0, 0, At, B0); PG8_BAR; PG8_SCHED;
            PG8_LDB(B1, 0, 1); PG8_STAGE(PG8_SB(0, 0), b2, voffB);
            PG8_BAR; PG8_WAIT_L(0); PG8_MMA(0, 1, At, B1); PG8_BAR;
            PG8_LDA(At, 0, 1); PG8_STAGE(PG8_SA(0, 0), a2, voffA);
            PG8_BAR; PG8_WAIT_L(0); PG8_MMA(1, 0, At, B0); PG8_BAR; PG8_SCHED;
            PG8_STAGE(PG8_SB(0, 1), b2 + hstepB, voffB);
            PG8_WAIT_V(6); PG8_BAR; PG8_MMA(1, 1, At, B1); PG8_BAR;
            PG8_LDB(B0, 1, 0); PG8_SCHED; PG8_LDA(At, 1, 0); PG8_STAGE(PG8_SA(0, 1), a2 + hstepA, voffA);
            PG8_WAIT_L(8); PG8_BAR; PG8_WAIT_L(0); PG8_MMA(0, 0, At, B0); PG8_BAR; PG8_SCHED;
            PG8_LDB(B1, 1, 1); PG8_STAGE(PG8_SB(1, 0), b3, voffB);
            PG8_BAR; PG8_WAIT_L(0); PG8_MMA(0, 1, At, B1); PG8_BAR;
            PG8_LDA(At, 1, 1); PG8_STAGE(PG8_SA(1, 0), a3, voffA);
            PG8_BAR; PG8_WAIT_L(0); PG8_MMA(1, 0, At, B0); PG8_BAR; PG8_SCHED;
            PG8_STAGE(PG8_SB(1, 1), b3 + hstepB, voffB);
            PG8_WAIT_V(6); PG8_BAR; PG8_MMA(1, 1, At, B1); PG8_BAR;
            }
        }
        if constexpr (ALIGN_EPI) { if (wr == 0) PG8_BAR; }
        if constexpr (!Epi::AFTER_DRAIN) { E(acc, cur, wr, wc, fr, fq); S.done(cur); }
        if (!has_next) break;
#pragma unroll
        for (int a = 0; a < 2; ++a)
#pragma unroll
            for (int b = 0; b < 2; ++b)
#pragma unroll
                for (int m = 0; m < 4; ++m)
#pragma unroll
                    for (int n = 0; n < 2; ++n) acc[a][b][m][n] = (f32x4){0.f, 0.f, 0.f, 0.f};
        cur = nxt; cA = nA; cB = nB; ++ui;
        if constexpr (ALIGN_EPI) { if (wr == 1) PG8_BAR; }
    }
    PG8_WAIT_V(0);
    if constexpr (!ALIGN_EPI) { if (wr == 0) PG8_BAR; }
    PG8_BAR;
    if constexpr (Epi::AFTER_DRAIN) { E.fused(acc, cur, wr, wc, fr, fq, lds, wid, lane); S.done(cur); }
#undef PG8_SA
#undef PG8_SB
#undef PG8_STAGE
#undef PG8_LDA
#undef PG8_LDB
#undef PG8_MMA
#undef PG8_WAIT_V
#undef PG8_WAIT_L
#undef PG8_BAR
#undef PG8_SCHED
}
}

#define GAS __attribute__((address_space(1)))
#define LAS __attribute__((address_space(3)))
typedef unsigned short bf16;
typedef unsigned v4u __attribute__((ext_vector_type(4)));
typedef float f32x4 __attribute__((ext_vector_type(4)));
typedef short bf16x8 __attribute__((ext_vector_type(8)));
typedef GAS unsigned gu32;
typedef GAS unsigned long long gu64;
#define RLX_AGENT __ATOMIC_RELAXED, __HIP_MEMORY_SCOPE_AGENT
#define LDS_WAIT() asm volatile("s_waitcnt lgkmcnt(0)" ::: "memory")
#define VM_WAIT() asm volatile("s_waitcnt vmcnt(0)" ::: "memory")
__device__ __forceinline__ unsigned long long rt() { return __builtin_amdgcn_s_memrealtime(); }
__device__ __forceinline__ unsigned f2bf(float f) { unsigned u = __builtin_bit_cast(unsigned, f); return (u + 0x7fffu + ((u >> 16) & 1u)) >> 16; }
__device__ __forceinline__ unsigned pk2(float lo, float hi) { return f2bf(lo) | (f2bf(hi) << 16); }

#define XB_TMO      128
#define XB_XCNT(j)  (256  + 64 * (j))
#define XB_XSUB(j)  (1280 + 64 * (j))
#define XB_XGEN(j)  (2304 + 64 * (j))
#define XB_TOP      3328
#define XB_TOPGEN   3392
#define XCD_BAR_WORDS 3456
#define XB_SPIN_CAP (1u << 18)

__device__ __forceinline__ unsigned xb_ld(unsigned* p)              { return __hip_atomic_load(p, __ATOMIC_RELAXED, __HIP_MEMORY_SCOPE_AGENT); }
__device__ __forceinline__ unsigned xb_add(unsigned* p, unsigned v) { return __hip_atomic_fetch_add(p, v, __ATOMIC_RELAXED, __HIP_MEMORY_SCOPE_AGENT); }
__device__ __forceinline__ unsigned xb_xcc_id() { return (unsigned)__builtin_amdgcn_s_getreg((3 << 11) | 20) & 0xFu; }
#define XB_SPIN(cond, bar) do { unsigned _sp = 0; while (cond) { __builtin_amdgcn_s_sleep(1); \
    if ((++_sp & 255u) == 0u) { if (xb_ld(&(bar)[XB_TMO])) break; if (_sp > XB_SPIN_CAP) { atomicAdd(&(bar)[XB_TMO], 1u); break; } } } } while (0)

struct XcdBarrier {
    unsigned* bar; unsigned x;
    volatile LAS unsigned* st;
};

__device__ __forceinline__ XcdBarrier xcd_barrier_post(unsigned* bar, volatile LAS unsigned* st) {
    XcdBarrier b; b.bar = bar; b.x = xb_xcc_id(); b.st = st;
    if (threadIdx.x == 0) st[2] = xb_add(&bar[XB_XCNT(b.x)], 1u);
    return b;
}
__device__ __forceinline__ void xcd_barrier_complete(unsigned* bar, unsigned x, unsigned& nloc, unsigned& nx) {
    const unsigned G = gridDim.x * gridDim.y * gridDim.z;
    unsigned sum, cnt, mine, sp = 0u;
    for (;;) {
        sum = 0u; cnt = 0u; mine = 0u;
#pragma unroll
        for (unsigned j = 0; j < 16; ++j) { const unsigned c = xb_ld(&bar[XB_XCNT(j)]); sum += c; cnt += (c > 0u) ? 1u : 0u; mine = (j == x) ? c : mine; }
        if (sum == G) break;
        __builtin_amdgcn_s_sleep(1);
        if ((++sp & 255u) == 0u) { if (xb_ld(&bar[XB_TMO])) break; if (sp > XB_SPIN_CAP) { atomicAdd(&bar[XB_TMO], 1u); break; } }
    }
    nloc = mine > 0u ? mine : 1u; nx = cnt > 0u ? cnt : 1u;
}

__device__ __forceinline__ void xcd_barrier(const XcdBarrier& b) {
    asm volatile("s_waitcnt vmcnt(0)" ::: "memory");
    __syncthreads();
    if (threadIdx.x == 0) {
        unsigned* bar = b.bar; asm volatile("" : "+s"(bar));
        __builtin_amdgcn_s_waitcnt(0);
        unsigned nloc = b.st[0], nx = b.st[1];
        if (nloc == 0u) { xcd_barrier_complete(bar, b.x, nloc, nx); b.st[0] = nloc; b.st[1] = nx; }
        const unsigned old = xb_add(&bar[XB_XSUB(b.x)], 1u);
        const unsigned gen = old / nloc;
        if (old + 1u == (gen + 1u) * nloc) {
            __builtin_amdgcn_fence(__ATOMIC_RELEASE, "agent");
            asm volatile("s_waitcnt vmcnt(0)" ::: "memory");
            const unsigned og = xb_add(&bar[XB_TOP], 1u);
            const unsigned tg = og / nx;
            if (og + 1u == (tg + 1u) * nx) xb_add(&bar[XB_TOPGEN], 1u);
            else XB_SPIN(xb_ld(&bar[XB_TOPGEN]) == tg, bar);
            __builtin_amdgcn_fence(__ATOMIC_ACQUIRE, "agent");
            xb_add(&bar[XB_XGEN(b.x)], 1u);
            asm volatile("s_waitcnt vmcnt(0)" ::: "memory");
        } else {
            XB_SPIN(xb_ld(&bar[XB_XGEN(b.x)]) == gen, bar);
            __builtin_amdgcn_fence(__ATOMIC_ACQUIRE, "agent");
            asm volatile("s_waitcnt vmcnt(0)" ::: "memory");
        }
    }
    __syncthreads();
}

namespace fa {
using bf16 = unsigned short;
using bf16x8 = __attribute__((ext_vector_type(8))) short;
using s16x4  = __attribute__((ext_vector_type(4))) short;
using f32x16 = __attribute__((ext_vector_type(16))) float;
using u32x4  = __attribute__((ext_vector_type(4))) unsigned;
constexpr int NW = 8, QBLK = 32, KVBLK = 64;
constexpr float THR = 8.f;
constexpr int SHM_V = KVBLK * 128 * 2, SHM_KN = KVBLK * 128 * 2, SHM_KR = KVBLK * 64 * 2;
constexpr int OFF_V = 0, OFF_KN = 2 * SHM_V, OFF_KR = OFF_KN + 2 * SHM_KN, OFF_WS = OFF_KR + 2 * SHM_KR, OFF_QR = OFF_WS + NW * 64 * 4, ATTN_LDS = OFF_QR + NW * 4096;
#define FA_KNSWZ(row, colB) ((row) * 256 + ((colB) ^ (((row) & 15) << 4)))
#define FA_KRSWZ(row, c) ((row) * 128 + ((((c) ^ ((row) >> 1)) & 7) << 4))
#define FA_SBAR() __builtin_amdgcn_sched_barrier(0)
__device__ __forceinline__ int crow(int r, int hi) { return (r & 3) + 8 * (r >> 2) + 4 * hi; }
__device__ __forceinline__ unsigned cvtpk(float lo, float hi) { unsigned r; asm volatile("v_cvt_pk_bf16_f32 %0, %1, %2" : "=v"(r) : "v"(lo), "v"(hi)); return r; }

template <int DQK> __device__ __forceinline__ void partialSM(f32x16& p0, f32x16& p1, float& m_reg, float& mn, float& alpha) {
  constexpr float SCALE = (DQK == 192) ? 0.07216878364870322f : 0.125f;
  constexpr float C = SCALE * 1.4426950408889634f;
  float pmax = p0[0];
#pragma unroll
  for (int r = 1; r < 16; ++r) pmax = fmaxf(pmax, p0[r]);
#pragma unroll
  for (int r = 0; r < 16; ++r) pmax = fmaxf(pmax, p1[r]);
  { auto rr = __builtin_amdgcn_permlane32_swap(__float_as_uint(pmax), __float_as_uint(pmax), false, false);
    pmax = fmaxf(__uint_as_float(rr[0]), __uint_as_float(rr[1])); }
  if (__builtin_expect(__all(pmax - m_reg <= THR / SCALE), 1)) { mn = m_reg; alpha = 1.f; }
  else { mn = fmaxf(m_reg, pmax); alpha = __builtin_amdgcn_exp2f((m_reg - mn) * C); m_reg = mn; }
  const float mnC = -mn * C;
#pragma unroll
  for (int r = 0; r < 16; ++r) p0[r] = fmaf(p0[r], C, mnC);
#pragma unroll
  for (int r = 0; r < 16; ++r) p1[r] = fmaf(p1[r], C, mnC);
#pragma unroll
  for (int r = 0; r < 16; ++r) p0[r] = __builtin_amdgcn_exp2f(p0[r]);
}
__device__ __forceinline__ void finishSM(f32x16& p0, f32x16& p1, float alpha, float& l_reg, bf16x8& pa0, bf16x8& pa1, bf16x8& pa2, bf16x8& pa3) {
#pragma unroll
  for (int r = 0; r < 16; ++r) p1[r] = __builtin_amdgcn_exp2f(p1[r]);
  float ps = 0;
#pragma unroll
  for (int r = 0; r < 16; ++r) ps += p0[r];
#pragma unroll
  for (int r = 0; r < 16; ++r) ps += p1[r];
  { auto rr = __builtin_amdgcn_permlane32_swap(__float_as_uint(ps), __float_as_uint(ps), false, false);
    ps = __uint_as_float(rr[0]) + __uint_as_float(rr[1]); }
  l_reg = l_reg * alpha + ps;
#define FA_PK4(P, BASE, OUT) do { unsigned a0 = cvtpk(P[BASE + 0], P[BASE + 1]), a1 = cvtpk(P[BASE + 2], P[BASE + 3]);   \
    unsigned b0 = cvtpk(P[BASE + 4], P[BASE + 5]), b1 = cvtpk(P[BASE + 6], P[BASE + 7]);                              \
    auto r0 = __builtin_amdgcn_permlane32_swap(a0, b0, false, false); auto r1 = __builtin_amdgcn_permlane32_swap(a1, b1, false, false); \
    u32x4 w = {r0[0], r1[0], r0[1], r1[1]}; OUT = *reinterpret_cast<bf16x8*>(&w); } while (0)
  FA_PK4(p0, 0, pa0); FA_PK4(p0, 8, pa1); FA_PK4(p1, 0, pa2); FA_PK4(p1, 8, pa3);
#undef FA_PK4
}
template <int DQK> __device__ __forceinline__ void qkt(f32x16& p0, f32x16& p1, const char* Kn, const char* Kr, const bf16x8* qr, const char* Kn_qbase, int qoff, int r32, int hi) {
  p0 = f32x16{}; p1 = f32x16{};
  constexpr int NKN = (DQK == 192) ? 8 : 0;
#pragma unroll
  for (int d0 = 0; d0 < NKN; ++d0) { const int cb = (d0 * 16 + hi * 8) * 2;
    const bf16x8 b0 = *reinterpret_cast<const bf16x8*>(Kn + FA_KNSWZ(r32, cb));
    const bf16x8 b1 = *reinterpret_cast<const bf16x8*>(Kn + FA_KNSWZ(32 + r32, cb));
    p0 = __builtin_amdgcn_mfma_f32_32x32x16_bf16(b0, qr[d0], p0, 0, 0, 0);
    p1 = __builtin_amdgcn_mfma_f32_32x32x16_bf16(b1, qr[d0], p1, 0, 0, 0); }
  int qo = qoff; asm volatile("" : "+v"(qo));
#pragma unroll
  for (int d0 = 0; d0 < 4; ++d0) { const int c = 2 * d0 + hi;
    const bf16x8 b0 = *reinterpret_cast<const bf16x8*>(Kr + FA_KRSWZ(r32, c));
    const bf16x8 b1 = *reinterpret_cast<const bf16x8*>(Kr + FA_KRSWZ(32 + r32, c));
    bf16x8 q; if constexpr (NKN) q = *reinterpret_cast<const bf16x8*>(Kn_qbase + qo + d0 * 1024); else q = qr[d0];
    p0 = __builtin_amdgcn_mfma_f32_32x32x16_bf16(b0, q, p0, 0, 0, 0);
    p1 = __builtin_amdgcn_mfma_f32_32x32x16_bf16(b1, q, p1, 0, 0, 0); }
}
template <int DQK> __device__ __forceinline__ void qkt_r(f32x16& p0, f32x16& p1, const char* Kn, const char* Kr, const bf16x8* qr, int r32, int hi) {
  p0 = f32x16{}; p1 = f32x16{};
  constexpr int NKN = (DQK == 192) ? 8 : 0;
#pragma unroll
  for (int d0 = 0; d0 < NKN; ++d0) { const int cb = (d0 * 16 + hi * 8) * 2;
    const bf16x8 b0 = *reinterpret_cast<const bf16x8*>(Kn + FA_KNSWZ(r32, cb));
    const bf16x8 b1 = *reinterpret_cast<const bf16x8*>(Kn + FA_KNSWZ(32 + r32, cb));
    p0 = __builtin_amdgcn_mfma_f32_32x32x16_bf16(b0, qr[d0], p0, 0, 0, 0);
    p1 = __builtin_amdgcn_mfma_f32_32x32x16_bf16(b1, qr[d0], p1, 0, 0, 0); }
#pragma unroll
  for (int d0 = 0; d0 < 4; ++d0) { const int c = 2 * d0 + hi;
    const bf16x8 b0 = *reinterpret_cast<const bf16x8*>(Kr + FA_KRSWZ(r32, c));
    const bf16x8 b1 = *reinterpret_cast<const bf16x8*>(Kr + FA_KRSWZ(32 + r32, c));
    p0 = __builtin_amdgcn_mfma_f32_32x32x16_bf16(b0, qr[NKN + d0], p0, 0, 0, 0);
    p1 = __builtin_amdgcn_mfma_f32_32x32x16_bf16(b1, qr[NKN + d0], p1, 0, 0, 0); }
}
__device__ __forceinline__ int v_st(int k, int c) { const int kk = (k & ~0xC) | ((k & 4) << 1) | ((k & 8) >> 1); return ((kk >> 3) * 4 + (c >> 5)) * 512 + ((kk & 7) * 32 + (c & 31)) * 2; }
__device__ __forceinline__ int v_rd_base(int lane) { return ((lane & 3) << 3) | (((lane >> 2) & 3) << 6) | (((lane >> 4) & 1) << 5) | (((lane >> 5) & 1) << 8); }
constexpr int v_rd_off(int d0, int ks, int half) { return d0 * 512 + ks * 4096 + half * 2048; }
template <int OFF> __device__ __forceinline__ s16x4 tr_read(int vb) {
  s16x4 r; asm volatile("ds_read_b64_tr_b16 %0, %1 offset:%2" : "=&v"(r) : "v"(vb), "i"(OFF) : "memory"); return r;
}
template <int D0> __device__ __forceinline__ void pv_one(f32x16& od, int vb, bf16x8 pa0, bf16x8 pa1, bf16x8 pa2, bf16x8 pa3) {
  const s16x4 l0 = tr_read<v_rd_off(D0, 0, 0)>(vb), h0 = tr_read<v_rd_off(D0, 0, 1)>(vb), l1 = tr_read<v_rd_off(D0, 1, 0)>(vb), h1 = tr_read<v_rd_off(D0, 1, 1)>(vb);
  const s16x4 l2 = tr_read<v_rd_off(D0, 2, 0)>(vb), h2 = tr_read<v_rd_off(D0, 2, 1)>(vb), l3 = tr_read<v_rd_off(D0, 3, 0)>(vb), h3 = tr_read<v_rd_off(D0, 3, 1)>(vb);
  asm volatile("s_waitcnt lgkmcnt(0)" ::: "memory"); FA_SBAR();
#define FA_PK(L, H) (bf16x8){L[0], L[1], L[2], L[3], H[0], H[1], H[2], H[3]}
  od = __builtin_amdgcn_mfma_f32_32x32x16_bf16(pa0, FA_PK(l0, h0), od, 0, 0, 0);
  od = __builtin_amdgcn_mfma_f32_32x32x16_bf16(pa1, FA_PK(l1, h1), od, 0, 0, 0);
  od = __builtin_amdgcn_mfma_f32_32x32x16_bf16(pa2, FA_PK(l2, h2), od, 0, 0, 0);
  od = __builtin_amdgcn_mfma_f32_32x32x16_bf16(pa3, FA_PK(l3, h3), od, 0, 0, 0);
#undef FA_PK
}
#define FA_TRLOAD(D0, L0, H0, L1, H1, L2, H2, L3, H3) do { L0 = tr_read<v_rd_off(D0, 0, 0)>(vb); H0 = tr_read<v_rd_off(D0, 0, 1)>(vb); L1 = tr_read<v_rd_off(D0, 1, 0)>(vb); H1 = tr_read<v_rd_off(D0, 1, 1)>(vb); \
    L2 = tr_read<v_rd_off(D0, 2, 0)>(vb); H2 = tr_read<v_rd_off(D0, 2, 1)>(vb); L3 = tr_read<v_rd_off(D0, 3, 0)>(vb); H3 = tr_read<v_rd_off(D0, 3, 1)>(vb); } while (0)
#define FA_PKV(L, H) (bf16x8){L[0], L[1], L[2], L[3], H[0], H[1], H[2], H[3]}
#define FA_PVMMA(OD, L0, H0, L1, H1, L2, H2, L3, H3) do { OD = __builtin_amdgcn_mfma_f32_32x32x16_bf16(pa0, FA_PKV(L0, H0), OD, 0, 0, 0); OD = __builtin_amdgcn_mfma_f32_32x32x16_bf16(pa1, FA_PKV(L1, H1), OD, 0, 0, 0); \
    OD = __builtin_amdgcn_mfma_f32_32x32x16_bf16(pa2, FA_PKV(L2, H2), OD, 0, 0, 0); OD = __builtin_amdgcn_mfma_f32_32x32x16_bf16(pa3, FA_PKV(L3, H3), OD, 0, 0, 0); } while (0)
__device__ __forceinline__ void pv_d0_piped(f32x16* o, int vb, bf16x8 pa0, bf16x8 pa1, bf16x8 pa2, bf16x8 pa3) {
  s16x4 al0, ah0, al1, ah1, al2, ah2, al3, ah3, bl0, bh0, bl1, bh1, bl2, bh2, bl3, bh3;
  FA_TRLOAD(0, al0, ah0, al1, ah1, al2, ah2, al3, ah3);
  FA_TRLOAD(1, bl0, bh0, bl1, bh1, bl2, bh2, bl3, bh3);
  asm volatile("s_waitcnt lgkmcnt(8)" ::: "memory"); FA_SBAR();
  FA_PVMMA(o[0], al0, ah0, al1, ah1, al2, ah2, al3, ah3); FA_SBAR();
  FA_TRLOAD(2, al0, ah0, al1, ah1, al2, ah2, al3, ah3);
  asm volatile("s_waitcnt lgkmcnt(8)" ::: "memory"); FA_SBAR();
  FA_PVMMA(o[1], bl0, bh0, bl1, bh1, bl2, bh2, bl3, bh3); FA_SBAR();
  FA_TRLOAD(3, bl0, bh0, bl1, bh1, bl2, bh2, bl3, bh3);
  asm volatile("s_waitcnt lgkmcnt(8)" ::: "memory"); FA_SBAR();
  FA_PVMMA(o[2], al0, ah0, al1, ah1, al2, ah2, al3, ah3); FA_SBAR();
  asm volatile("s_waitcnt lgkmcnt(0)" ::: "memory"); FA_SBAR();
  FA_PVMMA(o[3], bl0, bh0, bl1, bh1, bl2, bh2, bl3, bh3);
}
#undef FA_TRLOAD
#undef FA_PVMMA
#undef FA_PKV
__device__ __forceinline__ void pv_d0(f32x16* o, int vb, bf16x8 pa0, bf16x8 pa1, bf16x8 pa2, bf16x8 pa3) {
  pv_one<0>(o[0], vb, pa0, pa1, pa2, pa3); pv_one<1>(o[1], vb, pa0, pa1, pa2, pa3); pv_one<2>(o[2], vb, pa0, pa1, pa2, pa3); pv_one<3>(o[3], vb, pa0, pa1, pa2, pa3);
}
template <int DQK> __device__ __forceinline__ void pv_sm(f32x16* o, int vb, bf16x8 pa0, bf16x8 pa1, bf16x8 pa2, bf16x8 pa3, f32x16& p0, f32x16& p1, float& m_reg, float& mn, float& alpha) {
  constexpr float SCALE = (DQK == 192) ? 0.07216878364870322f : 0.125f;
  constexpr float C = SCALE * 1.4426950408889634f;
#define FA_PKV2(L, H) (bf16x8){L[0], L[1], L[2], L[3], H[0], H[1], H[2], H[3]}
#define FA_PVBLK(D0, SLICE) do { \
    const s16x4 l0 = tr_read<v_rd_off(D0, 0, 0)>(vb), h0 = tr_read<v_rd_off(D0, 0, 1)>(vb), l1 = tr_read<v_rd_off(D0, 1, 0)>(vb), h1 = tr_read<v_rd_off(D0, 1, 1)>(vb); \
    const s16x4 l2 = tr_read<v_rd_off(D0, 2, 0)>(vb), h2 = tr_read<v_rd_off(D0, 2, 1)>(vb), l3 = tr_read<v_rd_off(D0, 3, 0)>(vb), h3 = tr_read<v_rd_off(D0, 3, 1)>(vb); \
    SLICE \
    asm volatile("s_waitcnt lgkmcnt(0)" ::: "memory"); FA_SBAR(); \
    o[D0] = __builtin_amdgcn_mfma_f32_32x32x16_bf16(pa0, FA_PKV2(l0, h0), o[D0], 0, 0, 0); o[D0] = __builtin_amdgcn_mfma_f32_32x32x16_bf16(pa1, FA_PKV2(l1, h1), o[D0], 0, 0, 0); \
    o[D0] = __builtin_amdgcn_mfma_f32_32x32x16_bf16(pa2, FA_PKV2(l2, h2), o[D0], 0, 0, 0); o[D0] = __builtin_amdgcn_mfma_f32_32x32x16_bf16(pa3, FA_PKV2(l3, h3), o[D0], 0, 0, 0); } while (0)
  float pmax, mnC;
  FA_PVBLK(0, { pmax = p0[0]; _Pragma("unroll") for (int r = 1; r < 16; ++r) pmax = fmaxf(pmax, p0[r]); _Pragma("unroll") for (int r = 0; r < 16; ++r) pmax = fmaxf(pmax, p1[r]);
      auto rr = __builtin_amdgcn_permlane32_swap(__float_as_uint(pmax), __float_as_uint(pmax), false, false); pmax = fmaxf(__uint_as_float(rr[0]), __uint_as_float(rr[1])); });
  FA_PVBLK(1, { if (__builtin_expect(__all(pmax - m_reg <= THR / SCALE), 1)) { mn = m_reg; alpha = 1.f; } else { mn = fmaxf(m_reg, pmax); alpha = __builtin_amdgcn_exp2f((m_reg - mn) * C); m_reg = mn; }
      mnC = -mn * C; _Pragma("unroll") for (int r = 0; r < 16; ++r) p0[r] = fmaf(p0[r], C, mnC); });
  FA_PVBLK(2, { _Pragma("unroll") for (int r = 0; r < 16; ++r) p1[r] = fmaf(p1[r], C, mnC); _Pragma("unroll") for (int r = 0; r < 8; ++r) p0[r] = __builtin_amdgcn_exp2f(p0[r]); });
  FA_PVBLK(3, { _Pragma("unroll") for (int r = 8; r < 16; ++r) p0[r] = __builtin_amdgcn_exp2f(p0[r]); });
#undef FA_PVBLK
#undef FA_PKV2
}
struct Src {
  const bf16* Q; int ldq;
  const bf16* Kn; int ldkn;
  const bf16* Kr; int ldkr;
  const bf16* V; int ldv;
  int seg0, seg1, nkeys;
  void* O; int ldo;
  float lam, omli; const float* subln;
};
template <int DQK, int SDEPTH, int MODE>
__device__ __forceinline__ void attn_unit(const Src& S, char* lds) {
  int tid_ = threadIdx.x; asm volatile("" : "+v"(tid_));
  const int tid = tid_, wid = tid >> 6, lane = tid & 63, r32 = lane & 31, hi = lane >> 5;
  constexpr int NKN = (DQK == 192) ? 8 : 0, NQ = DQK / 16;
  char* V_lds = lds + OFF_V; char* Kn_lds = lds + OFF_KN; char* Kr_lds = lds + OFF_KR;
  float* wsf = (float*)(lds + OFF_WS) + wid * 64; float* li_l = wsf; float* al_l = wsf + 32;
  constexpr int NQR = NKN ? NKN : 4;
  float m_reg = -1e30f, l_reg = 0; f32x16 o[4] = {}; bf16x8 qr[NQR];
  const bf16* Qw = S.Q + (long)(wid * QBLK + r32) * S.ldq + hi * 8;
  const char* Qr_lds = lds + OFF_QR; const int qoff = wid * 4096 + lane * 16;
#pragma unroll
  for (int d0 = 0; d0 < NQR; ++d0) qr[d0] = *reinterpret_cast<const bf16x8*>(Qw + d0 * 16);
  if constexpr (NKN) {
#pragma unroll
    for (int d0 = 0; d0 < 4; ++d0) *(bf16x8*)(lds + OFF_QR + qoff + d0 * 1024) = *reinterpret_cast<const bf16x8*>(Qw + (NKN + d0) * 16);
  }
  const int sr = tid >> 4, sc = (tid & 15) * 8, vst0 = v_st(sr, sc), vst1 = v_st(32 + sr, sc);
  const int krr = tid >> 3, krc = tid & 7;
  const int vb0 = (int)(uintptr_t)V_lds + v_rd_base(lane);
  struct { bf16x8 vs0, vs1, kn0, kn1, kr; } st_[SDEPTH];
#define FA_ROW(k0) ((k0) < 256 ? S.seg0 + (k0) : S.seg1 + ((k0) - 256))
#define FA_SLOAD(i, k0) do { const long R_ = FA_ROW(k0); \
    st_[i].vs0 = *reinterpret_cast<const bf16x8*>(S.V + (R_ + sr) * S.ldv + sc); st_[i].vs1 = *reinterpret_cast<const bf16x8*>(S.V + (R_ + 32 + sr) * S.ldv + sc); \
    if constexpr (NKN) { st_[i].kn0 = *reinterpret_cast<const bf16x8*>(S.Kn + (R_ + sr) * S.ldkn + sc); st_[i].kn1 = *reinterpret_cast<const bf16x8*>(S.Kn + (R_ + 32 + sr) * S.ldkn + sc); } \
    st_[i].kr = *reinterpret_cast<const bf16x8*>(S.Kr + (R_ + krr) * S.ldkr + krc * 8); } while (0)
#define FA_SWRITE(b, i) do { *(bf16x8*)(V_lds + (b) * SHM_V + vst0) = st_[i].vs0; *(bf16x8*)(V_lds + (b) * SHM_V + vst1) = st_[i].vs1; \
    if constexpr (NKN) { *(bf16x8*)(Kn_lds + (b) * SHM_KN + FA_KNSWZ(sr, sc * 2)) = st_[i].kn0; *(bf16x8*)(Kn_lds + (b) * SHM_KN + FA_KNSWZ(32 + sr, sc * 2)) = st_[i].kn1; } \
    *(bf16x8*)(Kr_lds + (b) * SHM_KR + FA_KRSWZ(krr, krc)) = st_[i].kr; } while (0)
#define FA_SWAIT() do { if constexpr (SDEPTH == 2) { if constexpr (NKN) asm volatile("s_waitcnt vmcnt(5)" ::: "memory"); else asm volatile("s_waitcnt vmcnt(3)" ::: "memory"); } \
    else asm volatile("s_waitcnt vmcnt(0)" ::: "memory"); } while (0)
#define FA_RESC(a) do { if (__any((a) < 1.f)) { if (hi == 0) al_l[r32] = (a); asm volatile("s_waitcnt lgkmcnt(0)" ::: "memory"); \
    _Pragma("unroll") for (int d = 0; d < 4; ++d) _Pragma("unroll") for (int r = 0; r < 16; ++r) o[d][r] *= al_l[crow(r, hi)]; } } while (0)
  f32x16 pA0, pA1, pB0, pB1; float mnA, mnB, alA, alB; bf16x8 pa0, pa1, pa2, pa3; const int NT = S.nkeys / KVBLK;
  constexpr int SE = 0, SO = SDEPTH - 1;
  FA_SLOAD(SE, 0); asm volatile("s_waitcnt vmcnt(0)" ::: "memory"); FA_SWRITE(0, SE); __syncthreads();
  qkt<DQK>(pA0, pA1, Kn_lds, Kr_lds, qr, Qr_lds, qoff, r32, hi); partialSM<DQK>(pA0, pA1, m_reg, mnA, alA);
  FA_SLOAD(SO, KVBLK); if constexpr (SDEPTH == 2) { if (2 < NT) FA_SLOAD(SE, 2 * KVBLK); }
  FA_SWAIT(); FA_SWRITE(1, SO); __syncthreads();
  for (int j = 1; j + 1 < NT; j += 2) {
    FA_SBAR(); qkt<DQK>(pB0, pB1, Kn_lds + SHM_KN, Kr_lds + SHM_KR, qr, Qr_lds, qoff, r32, hi);
    finishSM(pA0, pA1, alA, l_reg, pa0, pa1, pa2, pa3); FA_SBAR();
    FA_SLOAD(SO, (j + SDEPTH) * KVBLK); FA_SBAR();
    if constexpr (DQK == 64) pv_d0_piped(o, vb0, pa0, pa1, pa2, pa3); else pv_d0(o, vb0, pa0, pa1, pa2, pa3); partialSM<DQK>(pB0, pB1, m_reg, mnB, alB);
    __syncthreads(); FA_SWAIT(); FA_SWRITE(0, SE);
    FA_RESC(alB); __syncthreads();
    FA_SBAR(); qkt<DQK>(pA0, pA1, Kn_lds, Kr_lds, qr, Qr_lds, qoff, r32, hi);
    finishSM(pB0, pB1, alB, l_reg, pa0, pa1, pa2, pa3); FA_SBAR();
    if (SDEPTH == 1 || j + 3 < NT) FA_SLOAD(SE, (j + 1 + SDEPTH) * KVBLK); FA_SBAR();
    if constexpr (DQK == 64) pv_d0_piped(o, vb0 + SHM_V, pa0, pa1, pa2, pa3); else pv_d0(o, vb0 + SHM_V, pa0, pa1, pa2, pa3); partialSM<DQK>(pA0, pA1, m_reg, mnA, alA);
    __syncthreads(); FA_SWAIT(); FA_SWRITE(1, SO);
    FA_RESC(alA); __syncthreads();
  }
  FA_SBAR(); qkt<DQK>(pB0, pB1, Kn_lds + SHM_KN, Kr_lds + SHM_KR, qr, Qr_lds, qoff, r32, hi);
  finishSM(pA0, pA1, alA, l_reg, pa0, pa1, pa2, pa3); FA_SBAR();
  if constexpr (DQK == 64) pv_d0_piped(o, vb0, pa0, pa1, pa2, pa3); else pv_d0(o, vb0, pa0, pa1, pa2, pa3); partialSM<DQK>(pB0, pB1, m_reg, mnB, alB);
  __syncthreads(); FA_RESC(alB);
  finishSM(pB0, pB1, alB, l_reg, pa0, pa1, pa2, pa3); FA_SBAR();
  if constexpr (DQK == 64) pv_d0_piped(o, vb0 + SHM_V, pa0, pa1, pa2, pa3); else pv_d0(o, vb0 + SHM_V, pa0, pa1, pa2, pa3);
  if (hi == 0) li_l[r32] = l_reg; asm volatile("s_waitcnt lgkmcnt(0)" ::: "memory");
  float rli[16];
#pragma unroll
  for (int r = 0; r < 16; ++r) rli[r] = __builtin_amdgcn_rcpf(li_l[crow(r, hi)]);
  if constexpr (MODE == 0) {
    bf16* Ow = (bf16*)S.O + (long)(wid * QBLK) * S.ldo;
#pragma unroll
    for (int r = 0; r < 16; ++r) { const int orow = crow(r, hi);
#pragma unroll
      for (int d0 = 0; d0 < 4; ++d0) { const float v = o[d0][r] * rli[r]; const float nb = __int_as_float(__builtin_amdgcn_update_dpp(0, __float_as_int(v), 0xB1, 0xF, 0xF, true));
        if ((lane & 1) == 0) *(unsigned*)(Ow + (long)orow * S.ldo + d0 * 32 + r32) = cvtpk(v, nb); } }
  } else if constexpr (MODE == 1) {
    static_assert(DQK == 64, "the parking area overlays the DQK = 192 buffers");
    char* pk = lds + OFF_KN + tid * 64; char* pq = lds + OFF_QR + tid * 64;
#pragma unroll
    for (int d0 = 0; d0 < 4; ++d0) { u32x4 w0, w1;
      w0[0] = cvtpk(o[d0][0] * rli[0], o[d0][1] * rli[1]); w0[1] = cvtpk(o[d0][2] * rli[2], o[d0][3] * rli[3]); w0[2] = cvtpk(o[d0][4] * rli[4], o[d0][5] * rli[5]); w0[3] = cvtpk(o[d0][6] * rli[6], o[d0][7] * rli[7]);
      w1[0] = cvtpk(o[d0][8] * rli[8], o[d0][9] * rli[9]); w1[1] = cvtpk(o[d0][10] * rli[10], o[d0][11] * rli[11]); w1[2] = cvtpk(o[d0][12] * rli[12], o[d0][13] * rli[13]); w1[3] = cvtpk(o[d0][14] * rli[14], o[d0][15] * rli[15]);
      char* p = (d0 < 2 ? pk : pq) + (d0 & 1) * 32; *(u32x4*)p = w0; *(u32x4*)(p + 16) = w1; }
  } else {
    const char* pk = lds + OFF_KN + tid * 64; const char* pq = lds + OFF_QR + tid * 64;
    float ss[16];
#pragma unroll
    for (int r = 0; r < 16; ++r) ss[r] = 0.f;
#pragma unroll
    for (int d0 = 0; d0 < 4; ++d0) { const char* p = (d0 < 2 ? pk : pq) + (d0 & 1) * 32; const u32x4 w0 = *(const u32x4*)p, w1 = *(const u32x4*)(p + 16);
#pragma unroll
      for (int r = 0; r < 16; ++r) { const unsigned w = (r < 8 ? w0[r >> 1] : w1[(r - 8) >> 1]); const float o1 = __uint_as_float((r & 1) ? (w & 0xffff0000u) : (w << 16));
        const float v = o1 - S.lam * (o[d0][r] * rli[r]); o[d0][r] = v; ss[r] += v * v; } }
#pragma unroll
    for (int r = 0; r < 16; ++r) {
#pragma unroll
      for (int sft = 1; sft < 32; sft <<= 1) ss[r] += __shfl_xor(ss[r], sft);
      ss[r] = rsqrtf(ss[r] * (1.0f / 128.0f) + 1e-6f) * S.omli; }
    bf16* Ow = (bf16*)S.O + (long)(wid * QBLK) * S.ldo;
#pragma unroll
    for (int d0 = 0; d0 < 4; ++d0) { const float gsub = S.subln[d0 * 32 + r32];
#pragma unroll
      for (int r = 0; r < 16; ++r) { const int orow = crow(r, hi); const float v = o[d0][r] * ss[r] * gsub; const float nb = __int_as_float(__builtin_amdgcn_update_dpp(0, __float_as_int(v), 0xB1, 0xF, 0xF, true));
        if ((lane & 1) == 0) *(unsigned*)(Ow + (long)orow * S.ldo + d0 * 32 + r32) = cvtpk(v, nb); } }
  }
  __syncthreads();
#undef FA_ROW
#undef FA_SLOAD
#undef FA_SWRITE
#undef FA_SWAIT
#undef FA_RESC
}
template <int DQK, int MODE>
__device__ __forceinline__ void attn_unit_dma(const Src& S, char* lds, __attribute__((address_space(3))) unsigned char* ldsl) {
  int tid_ = threadIdx.x; asm volatile("" : "+v"(tid_));
  const int tid = tid_, wid = __builtin_amdgcn_readfirstlane(tid >> 6), lane = tid & 63, r32 = lane & 31, hi = lane >> 5;
  constexpr int NKN = (DQK == 192) ? 8 : 0, NQ = DQK / 16;
  char* V_lds = lds + OFF_V; char* Kn_lds = lds + OFF_KN; char* Kr_lds = lds + OFF_KR;
  float* wsf = (float*)(lds + OFF_WS) + wid * 64; float* li_l = wsf; float* al_l = wsf + 32;
  constexpr int NQR = NQ;
  float m_reg = -1e30f, l_reg = 0; f32x16 o[4] = {}; bf16x8 qr[NQR];
  const bf16* Qw = S.Q + (long)(wid * QBLK + r32) * S.ldq + hi * 8;
  const char* Qr_lds = lds + OFF_QR; const int qoff = wid * 4096 + lane * 16;
#pragma unroll
  for (int d0 = 0; d0 < NQR; ++d0) qr[d0] = *reinterpret_cast<const bf16x8*>(Qw + d0 * 16);
  const int vb0 = (int)(uintptr_t)V_lds + v_rd_base(lane);
  long offV[2], offKn[2], offKr;
#pragma unroll
  for (int i = 0; i < 2; ++i) { const int sub = 2 * (2 * wid + i) + (lane >> 5), kk = (sub >> 2) * 8 + ((lane & 31) >> 2), key = (kk & ~0xC) | ((kk & 4) << 1) | ((kk & 8) >> 1), c = (sub & 3) * 32 + (lane & 3) * 8;
    offV[i] = (long)key * S.ldv + c;
    const int r = 4 * (2 * wid + i) + (lane >> 4), c16 = (lane & 15) ^ (r & 15); offKn[i] = (long)r * S.ldkn + c16 * 8; }
  { const int r = 8 * wid + (lane >> 3), c = (lane & 7) ^ ((r >> 1) & 7); offKr = (long)r * S.ldkr + c * 8; }
#define FA_ROW(k0) ((k0) < 256 ? S.seg0 + (k0) : S.seg1 + ((k0) - 256))
#define FA_GLDS(gp, off) __builtin_amdgcn_global_load_lds((const unsigned*)(gp), (__attribute__((address_space(3))) unsigned*)(ldsl + (off)), 16, 0, 0)
#define FA_DMA_K(t, b) do { const int t_ = (t) < NT ? (t) : NT - 1; const long R_ = FA_ROW(t_ * KVBLK); \
    if constexpr (NKN) { FA_GLDS(S.Kn + R_ * S.ldkn + offKn[0], OFF_KN + (b) * SHM_KN + (2 * wid) * 1024); FA_GLDS(S.Kn + R_ * S.ldkn + offKn[1], OFF_KN + (b) * SHM_KN + (2 * wid + 1) * 1024); } \
    FA_GLDS(S.Kr + R_ * S.ldkr + offKr, OFF_KR + (b) * SHM_KR + wid * 1024); } while (0)
#define FA_DMA_V(t, b) do { const int t_ = (t) < NT ? (t) : NT - 1; const long R_ = FA_ROW(t_ * KVBLK); \
    FA_GLDS(S.V + R_ * S.ldv + offV[0], OFF_V + (b) * SHM_V + (2 * wid) * 1024); FA_GLDS(S.V + R_ * S.ldv + offV[1], OFF_V + (b) * SHM_V + (2 * wid + 1) * 1024); } while (0)
#define FA_WBAR() do { asm volatile("s_waitcnt vmcnt(0)" ::: "memory"); __builtin_amdgcn_s_barrier(); asm volatile("" ::: "memory"); } while (0)
#define FA_RESC(a) do { if (__any((a) < 1.f)) { if (hi == 0) al_l[r32] = (a); asm volatile("s_waitcnt lgkmcnt(0)" ::: "memory"); \
    _Pragma("unroll") for (int d = 0; d < 4; ++d) _Pragma("unroll") for (int r = 0; r < 16; ++r) o[d][r] *= al_l[crow(r, hi)]; } } while (0)
#define FA_PV(vb) do { if constexpr (DQK == 64) pv_d0_piped(o, vb, pa0, pa1, pa2, pa3); else pv_d0(o, vb, pa0, pa1, pa2, pa3); } while (0)
  f32x16 pA0, pA1, pB0, pB1; float mnA, mnB, alA, alB; bf16x8 pa0, pa1, pa2, pa3; const int NT = S.nkeys / KVBLK;
  FA_DMA_K(0, 0); FA_DMA_V(0, 0); FA_DMA_K(1, 1);
  FA_WBAR();
  qkt_r<DQK>(pA0, pA1, Kn_lds, Kr_lds, qr, r32, hi); partialSM<DQK>(pA0, pA1, m_reg, mnA, alA);
  FA_WBAR(); FA_DMA_V(1, 1); FA_DMA_K(2, 0);
  for (int j = 1; j + 1 < NT; j += 2) {
    FA_SBAR(); qkt_r<DQK>(pB0, pB1, Kn_lds + SHM_KN, Kr_lds + SHM_KR, qr, r32, hi);
    finishSM(pA0, pA1, alA, l_reg, pa0, pa1, pa2, pa3);
    pv_sm<DQK>(o, vb0, pa0, pa1, pa2, pa3, pB0, pB1, m_reg, mnB, alB);
    FA_WBAR(); FA_DMA_V(j + 1, 0); FA_DMA_K(j + 2, 1); FA_RESC(alB);
    FA_SBAR(); qkt_r<DQK>(pA0, pA1, Kn_lds, Kr_lds, qr, r32, hi);
    finishSM(pB0, pB1, alB, l_reg, pa0, pa1, pa2, pa3);
    pv_sm<DQK>(o, vb0 + SHM_V, pa0, pa1, pa2, pa3, pA0, pA1, m_reg, mnA, alA);
    FA_WBAR(); FA_DMA_V(j + 2, 1); FA_DMA_K(j + 3, 0); FA_RESC(alA);
  }
  FA_SBAR(); qkt_r<DQK>(pB0, pB1, Kn_lds + SHM_KN, Kr_lds + SHM_KR, qr, r32, hi);
  finishSM(pA0, pA1, alA, l_reg, pa0, pa1, pa2, pa3); FA_SBAR();
  pv_sm<DQK>(o, vb0, pa0, pa1, pa2, pa3, pB0, pB1, m_reg, mnB, alB);
  FA_WBAR(); FA_RESC(alB);
  finishSM(pB0, pB1, alB, l_reg, pa0, pa1, pa2, pa3); FA_SBAR();
  FA_PV(vb0 + SHM_V);
  if (hi == 0) li_l[r32] = l_reg; asm volatile("s_waitcnt lgkmcnt(0)" ::: "memory");
  float rli[16];
#pragma unroll
  for (int r = 0; r < 16; ++r) rli[r] = __builtin_amdgcn_rcpf(li_l[crow(r, hi)]);
  if constexpr (MODE == 0) {
    bf16* Ow = (bf16*)S.O + (long)(wid * QBLK) * S.ldo;
#pragma unroll
    for (int r = 0; r < 16; ++r) { const int orow = crow(r, hi);
#pragma unroll
      for (int d0 = 0; d0 < 4; ++d0) { const float v = o[d0][r] * rli[r]; const float nb = __int_as_float(__builtin_amdgcn_update_dpp(0, __float_as_int(v), 0xB1, 0xF, 0xF, true));
        if ((lane & 1) == 0) *(unsigned*)(Ow + (long)orow * S.ldo + d0 * 32 + r32) = cvtpk(v, nb); } }
  } else if constexpr (MODE == 1) {
    static_assert(DQK == 64, "the parking area overlays the DQK = 192 buffers");
    char* pk = lds + OFF_KN + tid * 64; char* pq = lds + OFF_QR + tid * 64;
#pragma unroll
    for (int d0 = 0; d0 < 4; ++d0) { u32x4 w0, w1;
      w0[0] = cvtpk(o[d0][0] * rli[0], o[d0][1] * rli[1]); w0[1] = cvtpk(o[d0][2] * rli[2], o[d0][3] * rli[3]); w0[2] = cvtpk(o[d0][4] * rli[4], o[d0][5] * rli[5]); w0[3] = cvtpk(o[d0][6] * rli[6], o[d0][7] * rli[7]);
      w1[0] = cvtpk(o[d0][8] * rli[8], o[d0][9] * rli[9]); w1[1] = cvtpk(o[d0][10] * rli[10], o[d0][11] * rli[11]); w1[2] = cvtpk(o[d0][12] * rli[12], o[d0][13] * rli[13]); w1[3] = cvtpk(o[d0][14] * rli[14], o[d0][15] * rli[15]);
      char* p = (d0 < 2 ? pk : pq) + (d0 & 1) * 32; *(u32x4*)p = w0; *(u32x4*)(p + 16) = w1; }
  } else {
    const char* pk = lds + OFF_KN + tid * 64; const char* pq = lds + OFF_QR + tid * 64;
    float ss[16];
#pragma unroll
    for (int r = 0; r < 16; ++r) ss[r] = 0.f;
#pragma unroll
    for (int d0 = 0; d0 < 4; ++d0) { const char* p = (d0 < 2 ? pk : pq) + (d0 & 1) * 32; const u32x4 w0 = *(const u32x4*)p, w1 = *(const u32x4*)(p + 16);
#pragma unroll
      for (int r = 0; r < 16; ++r) { const unsigned w = (r < 8 ? w0[r >> 1] : w1[(r - 8) >> 1]); const float o1 = __uint_as_float((r & 1) ? (w & 0xffff0000u) : (w << 16));
        const float v = o1 - S.lam * (o[d0][r] * rli[r]); o[d0][r] = v; ss[r] += v * v; } }
#pragma unroll
    for (int r = 0; r < 16; ++r) {
#pragma unroll
      for (int sft = 1; sft < 32; sft <<= 1) ss[r] += __shfl_xor(ss[r], sft);
      ss[r] = rsqrtf(ss[r] * (1.0f / 128.0f) + 1e-6f) * S.omli; }
    bf16* Ow = (bf16*)S.O + (long)(wid * QBLK) * S.ldo;
#pragma unroll
    for (int d0 = 0; d0 < 4; ++d0) { const float gsub = S.subln[d0 * 32 + r32];
#pragma unroll
      for (int r = 0; r < 16; ++r) { const int orow = crow(r, hi); const float v = o[d0][r] * ss[r] * gsub; const float nb = __int_as_float(__builtin_amdgcn_update_dpp(0, __float_as_int(v), 0xB1, 0xF, 0xF, true));
        if ((lane & 1) == 0) *(unsigned*)(Ow + (long)orow * S.ldo + d0 * 32 + r32) = cvtpk(v, nb); } }
  }
  __syncthreads();
#undef FA_ROW
#undef FA_GLDS
#undef FA_DMA_K
#undef FA_DMA_V
#undef FA_WBAR
#undef FA_RESC
#undef FA_PV
}
}

constexpr int NWAVES = 8;
constexpr int DM = 2048, NB = 8, SEQ = 2048, CTXL = 256, DFF = 5632, NMOD = 9;
constexpr int DFFP = DFF + 64;
constexpr int MLAT = NB * SEQ, MCTX = NB * CTXL, MTOT = MLAT + MCTX;
constexpr int WIN_N = 2880;
constexpr int PC_CKV = 0, PC_KR = 256, PC_DK = 320, PC_DV = 832, PC_CQ = 1344, PC_DQ = 1856, PC_END = 2368, LDP = 2560;
constexpr int MODROW = NMOD * DM;
constexpr float EPS = 1e-6f;
constexpr float MLA_C = 0.07216878364870322f * 1.4426950408889634f;
constexpr float DIFF_C = 0.125f * 1.4426950408889634f;

constexpr size_t MiB = 1u << 20;
constexpr size_t WS_CTL = 0, CTL_ZERO_BYTES = 32768;
constexpr size_t WS_MOD = 1 * MiB;
constexpr size_t WS_TAB = 3 * MiB;
constexpr size_t WS_WGU = 4 * MiB;
constexpr size_t WS_WD = WS_WGU + 176 * MiB;
constexpr size_t WS_WIN = WS_WD + 90 * MiB;
constexpr size_t WS_WF1 = WS_WIN + 20 * MiB;
constexpr size_t WS_WUKV = WS_WF1 + 8 * MiB;
constexpr size_t WS_WUQ = WS_WUKV + 2 * MiB;
constexpr size_t WS_WOUT = WS_WUQ + 3 * MiB;
constexpr size_t WS_DFT = WS_WOUT + 16 * MiB;
constexpr size_t WS_DFTC = WS_DFT + 16 * MiB;
constexpr size_t WS_X = WS_DFTC + 1 * MiB;
constexpr size_t WS_S = WS_X + 16 * MiB;
constexpr size_t WS_H = WS_X + 144 * MiB;
constexpr size_t WS_O = WS_H + 72 * MiB;
constexpr size_t WS_ACT = WS_O + 72 * MiB;
constexpr size_t WS_OD = WS_ACT;
constexpr size_t WS_CT = WS_ACT + 72 * MiB;
constexpr size_t WS_CTC = WS_CT + 32 * MiB;
constexpr size_t WS_P = WS_ACT + 202 * MiB;
constexpr size_t WS_KV = WS_P + 90 * MiB;
constexpr size_t WS_Q = WS_KV + 72 * MiB;
constexpr size_t WS_PART = WS_Q + 54 * MiB;
constexpr size_t WS_END = WS_PART + 64 * MiB;
static_assert(WS_CTC + 4 * MiB <= WS_P && (size_t)MTOT * DFFP * 2 <= 202 * MiB && (size_t)MTOT * LDP * 2 <= 90 * MiB, "ws map");
constexpr int CW_BAR = 4096;
constexpr int N_STEPS = 66;

constexpr int RING_BYTES = 131072;
constexpr int LDSCTL_OFF = RING_BYTES, MISC_OFF = LDSCTL_OFF + 320;
constexpr int LDS_BYTES = 147456;

typedef unsigned u32x2 __attribute__((ext_vector_type(2)));
typedef float f32x2 __attribute__((ext_vector_type(2)));
__device__ __forceinline__ float bf2f(unsigned short b) { return __builtin_bit_cast(float, ((unsigned)b) << 16); }
__device__ __forceinline__ float wave_sum(float v) {
#pragma unroll
    for (int o = 1; o < 64; o <<= 1) v += __shfl_xor(v, o);
    return v;
}
__device__ __forceinline__ float wave_max(float v) {
#pragma unroll
    for (int o = 1; o < 64; o <<= 1) v = fmaxf(v, __shfl_xor(v, o));
    return v;
}

__device__ __forceinline__ void transpose_item(const float* W, int N, bf16* WT, int ldt, int dest_row0, LAS float* scr, int k0, int n0, int lane) {
    float tv[32];
#pragma unroll
    for (int i = 0; i < 32; ++i) tv[i] = W[(size_t)(k0 + 2 * i + (lane >> 5)) * N + n0 + (lane & 31)];
    asm volatile("" ::: "memory");
#pragma unroll
    for (int i = 0; i < 32; ++i) scr[(2 * i + (lane >> 5)) * 33 + (lane & 31)] = tv[i];
    LDS_WAIT(); asm volatile("" ::: "memory");
    const int c = lane & 7;
#pragma unroll
    for (int j = 0; j < 4; ++j) { const int n = (lane >> 3) + 8 * j; const LAS float* s = scr + (8 * c) * 33 + n;
        v4u o; o.x = pk2(s[0 * 33], s[1 * 33]); o.y = pk2(s[2 * 33], s[3 * 33]); o.z = pk2(s[4 * 33], s[5 * 33]); o.w = pk2(s[6 * 33], s[7 * 33]);
        *(GAS v4u*)(WT + (size_t)(dest_row0 + n) * ldt + k0 + 8 * c) = o; }
    LDS_WAIT(); asm volatile("" ::: "memory");
}

struct Args { const float* in[19]; float* out; unsigned char* ws; int st_lo, st_hi; };
enum { I_X = 0, I_C, I_CTX, I_CCTX, I_ADAW, I_ADAB, I_NORMG, I_WG, I_WU, I_WD, I_WIN, I_QN, I_KVN, I_WUQ, I_WUKV, I_LAM, I_SUBLN, I_WOUT, I_FN };

__device__ __forceinline__ void transpose_set(const Args& a, LAS unsigned char* lds, int set, int widx, int nw) {
    unsigned char* ws = a.ws; int lane, wave; { int t_ = threadIdx.x; asm volatile("" : "+v"(t_)); lane = t_ & 63; wave = __builtin_amdgcn_readfirstlane(t_ >> 6); }
    {
        LAS float* scr = (LAS float*)(lds + wave * 8704);
        constexpr int PER_LF = 3 * 5632, N_FFN = 4 * PER_LF, PER_L = 2368 + 256 + 384 + 2048; const int nv = (set == 0) ? PER_LF + 2 * PER_L : PER_LF;
        struct TI { const float* src; bf16* dst; int N, ldt; };
        auto decode = [&](int v) -> TI { TI t; const int it = (set == 0) ? (v < PER_LF ? v : v - PER_LF + N_FFN) : set * PER_LF + v;
            if (it < N_FFN) { const int lf = it / PER_LF, r = it % PER_LF, which = r / 5632, q = r % 5632;
                if (which < 2) { const int kb = q / 176, nb = q % 176, n0 = nb * 32;
                    t.src = (which == 0 ? a.in[I_WG] : a.in[I_WU]) + (size_t)lf * DM * DFF + (size_t)(kb * 64) * DFF + n0; t.N = DFF;
                    t.dst = (bf16*)(ws + WS_WGU) + (size_t)lf * 2 * DFF * DM + ((size_t)((n0 >> 7) * 32 + kb) * 256 + which * 128 + (n0 & 127)) * 64; t.ldt = 64;
                } else { const int kb = q / 64, nb = q % 64;
                    t.src = a.in[I_WD] + (size_t)lf * DFF * DM + (size_t)(kb * 64) * DM + nb * 32; t.N = DM;
                    t.dst = (bf16*)(ws + WS_WD) + (size_t)lf * DM * DFFP + (size_t)(nb * 32) * DFFP + kb * 64; t.ldt = DFFP; }
            } else { int r = it - N_FFN; const int l = r / PER_L; r %= PER_L;
                if (r < 2368) { const int kb = r / 74, nb = r % 74; t.src = a.in[I_WIN] + (size_t)l * DM * WIN_N + (size_t)(kb * 64) * WIN_N + nb * 32; t.N = WIN_N; t.dst = (bf16*)(ws + WS_WIN) + (size_t)l * LDP * DM + (size_t)(nb * 32) * DM + kb * 64; t.ldt = DM; }
                else if ((r -= 2368) < 256) { const int kb = r / 64, nb = r % 64; t.src = a.in[I_WUKV] + (size_t)l * 256 * 2048 + (size_t)(kb * 64) * 2048 + nb * 32; t.N = 2048; t.dst = (bf16*)(ws + WS_WUKV) + (size_t)l * 2048 * 256 + (size_t)(nb * 32) * 256 + kb * 64; t.ldt = 256; }
                else if ((r -= 256) < 384) { const int kb = r / 48, nb = r % 48; t.src = a.in[I_WUQ] + (size_t)l * 512 * 1536 + (size_t)(kb * 64) * 1536 + nb * 32; t.N = 1536; t.dst = (bf16*)(ws + WS_WUQ) + (size_t)l * 1536 * 512 + (size_t)(nb * 32) * 512 + kb * 64; t.ldt = 512; }
                else { r -= 384; const int kb = r / 64, nb = r % 64; t.src = a.in[I_WOUT] + (size_t)l * DM * DM + (size_t)(kb * 64) * DM + nb * 32; t.N = DM; t.dst = (bf16*)(ws + WS_WOUT) + (size_t)l * DM * DM + (size_t)(nb * 32) * DM + kb * 64; t.ldt = DM; } }
            return t; };
#define TR_LOAD(t, tv) do { _Pragma("unroll") for (int i_ = 0; i_ < 32; ++i_) tv[i_] = (t).src[(size_t)(2 * i_ + (lane >> 5)) * (t).N + (lane & 31)]; } while (0)
#define TR_PROC(t, tv) do { _Pragma("unroll") for (int i_ = 0; i_ < 32; ++i_) scr[(2 * i_ + (lane >> 5)) * 33 + (lane & 31)] = tv[i_]; \
            LDS_WAIT(); asm volatile("" ::: "memory"); const int c_ = lane & 7; \
            _Pragma("unroll") for (int j_ = 0; j_ < 4; ++j_) { const int n_ = (lane >> 3) + 8 * j_; const LAS float* s_ = scr + (8 * c_) * 33 + n_; \
                v4u o_; o_.x = pk2(s_[0 * 33], s_[1 * 33]); o_.y = pk2(s_[2 * 33], s_[3 * 33]); o_.z = pk2(s_[4 * 33], s_[5 * 33]); o_.w = pk2(s_[6 * 33], s_[7 * 33]); \
                *(GAS v4u*)((t).dst + (size_t)n_ * (t).ldt + 8 * c_) = o_; } \
            LDS_WAIT(); asm volatile("" ::: "memory"); } while (0)
        float tvA[32], tvB[32]; TI d0, d1; int it = widx;
        if (it < nv) { d0 = decode(it); TR_LOAD(d0, tvA); }
        while (it < nv) {
            const int it1 = it + nw, it2 = it1 + nw;
            if (it1 < nv) { d1 = decode(it1); TR_LOAD(d1, tvB); }
            TR_PROC(d0, tvA);
            if (it1 < nv) { if (it2 < nv) { d0 = decode(it2); TR_LOAD(d0, tvA); } TR_PROC(d1, tvB); }
            it = it2;
        }
#undef TR_LOAD
#undef TR_PROC
    }
}
__device__ __forceinline__ void prologue(const Args& a, LAS unsigned char* lds, int tid, int lane, int wave) {
    tid = threadIdx.x; asm volatile("" : "+v"(tid)); lane = tid & 63;
    unsigned char* ws = a.ws;
    const int G = gridDim.x, gw = blockIdx.x * NWAVES + wave, NGW = G * NWAVES;
    const int gt = blockIdx.x * (NWAVES * 64) + tid, NGT = G * NWAVES * 64;
    {
        for (int rp = 0; rp < NREP(13); ++rp) transpose_set(a, lds, 0, gw, NGW);
        for (int i = gt; i < 2 * 192 * DM / 8; i += NGT) { const int l = i / (192 * DM / 8), r = i % (192 * DM / 8);
            *(GAS v4u*)((bf16*)(ws + WS_WIN) + (size_t)l * LDP * DM + (size_t)PC_END * DM + (size_t)r * 8) = (v4u){0u, 0u, 0u, 0u}; }
    }
    for (int rpb = 0; rpb < NREP(20); ++rpb) {
        float* rope = (float*)(ws + WS_TAB);
        if (gt < 1024) { const int pos = gt >> 4, i = gt & 15; const float inv = powf(10000.0f, -(float)i / 16.0f), ang = (float)pos * inv; rope[pos * 32 + i] = cosf(ang); rope[pos * 32 + 16 + i] = sinf(ang); }
        if (blockIdx.x == 2 && wave == 0) { float* lamv = (float*)(ws + WS_TAB + 16384);
            for (int l = 0; l < 2; ++l) { const float* lf = a.in[I_LAM] + l * 256;
                const float s1 = wave_sum(lf[lane] * lf[64 + lane]), s2 = wave_sum(lf[128 + lane] * lf[192 + lane]);
                const float li = 0.8f - 0.6f * expf(-0.3f * (float)l); if (lane == 0) { lamv[2 * l] = expf(s1) - expf(s2) + li; lamv[2 * l + 1] = 1.0f - li; } } }
        bf16* dft = (bf16*)(ws + WS_DFT);
        for (int rp = 0; rp < NREP(16); ++rp)
        for (int i = gt; i < 2048 * 512; i += NGT) { const int sp = i >> 9, k = (i & 511) * 8, type = k >> 11, s = k & 2047; unsigned w[4];
#pragma unroll
            for (int j = 0; j < 4; ++j) { float v[2];
#pragma unroll
                for (int e = 0; e < 2; ++e) { const int t = ((s + 2 * j + e) * sp) & 2047; float sn, cs; sincospif((float)t * (1.0f / 1024.0f), &sn, &cs); v[e] = (type ? -sn : cs) * (1.0f / 512.0f); }
                w[j] = pk2(v[0], v[1]); }
            *(GAS v4u*)(dft + (size_t)sp * 4096 + k) = (v4u){w[0], w[1], w[2], w[3]}; }
        bf16* dftc = (bf16*)(ws + WS_DFTC);
        for (int i = gt; i < 256 * 64; i += NGT) { const int sp = i >> 6, k = (i & 63) * 8, type = k >> 8, s = k & 255; unsigned w[4];
#pragma unroll
            for (int j = 0; j < 4; ++j) { float v[2];
#pragma unroll
                for (int e = 0; e < 2; ++e) { const int t = ((s + 2 * j + e) * sp) & 255; float sn, cs; sincospif((float)t * (1.0f / 128.0f), &sn, &cs); v[e] = (type ? -sn : cs) * 0.005524271728019903f; }
                w[j] = pk2(v[0], v[1]); }
            *(GAS v4u*)(dftc + (size_t)sp * 512 + k) = (v4u){w[0], w[1], w[2], w[3]}; }
    }
    __syncthreads();
    {
        LAS float* U = (LAS float*)lds;
        LAS float* T = (LAS float*)(lds + 64 * 129 * 4);
        if (tid < 128) { float sn, cs; sincospif((float)tid * (1.0f / 64.0f), &sn, &cs); T[tid] = cs; T[128 + tid] = sn; }
        for (int rp = 0; rp < NREP(14); ++rp)
        for (int it = blockIdx.x; it < 2 * 4 * 32; it += G) { const int l = it >> 7, g = (it >> 5) & 3, k0 = (it & 31) * 64;
            __syncthreads();
            const float* src = a.in[I_WIN] + (size_t)l * DM * WIN_N + PC_END + g * 128;
            for (int i = tid; i < 64 * 128; i += NWAVES * 64) { const int r = i >> 7, c = i & 127; U[r * 129 + c] = src[(size_t)(k0 + r) * WIN_N + c]; }
            __syncthreads();
            typedef short bx8 __attribute__((ext_vector_type(8))); typedef float fx16 __attribute__((ext_vector_type(16)));
            const int r32 = lane & 31, hi = lane >> 5, cpr = (wave & 3) * 32 + r32; const LAS float* Tt = T + (wave >> 2) * 128;
            fx16 acc0 = {}, acc1 = {};
#pragma unroll 2
            for (int st = 0; st < 8; ++st) { const int c0 = 16 * st + 8 * hi; unsigned aw0[4], aw1[4], bw[4];
#pragma unroll
                for (int e = 0; e < 4; ++e) { aw0[e] = pk2(U[r32 * 129 + c0 + 2 * e], U[r32 * 129 + c0 + 2 * e + 1]); aw1[e] = pk2(U[(32 + r32) * 129 + c0 + 2 * e], U[(32 + r32) * 129 + c0 + 2 * e + 1]);
                    bw[e] = pk2(Tt[((c0 + 2 * e) * cpr) & 127], Tt[((c0 + 2 * e + 1) * cpr) & 127]); }
                const bx8 A0 = __builtin_bit_cast(bx8, (v4u){aw0[0], aw0[1], aw0[2], aw0[3]}), A1 = __builtin_bit_cast(bx8, (v4u){aw1[0], aw1[1], aw1[2], aw1[3]}), B = __builtin_bit_cast(bx8, (v4u){bw[0], bw[1], bw[2], bw[3]});
                acc0 = __builtin_amdgcn_mfma_f32_32x32x16_bf16(A0, B, acc0, 0, 0, 0); acc1 = __builtin_amdgcn_mfma_f32_32x32x16_bf16(A1, B, acc1, 0, 0, 0); }
            bf16* wrow = (bf16*)(ws + WS_WF1) + (size_t)l * 1024 * DM + (size_t)((wave >> 2) * 512 + g * 128 + cpr) * DM + k0 + 4 * hi;
#pragma unroll
            for (int q = 0; q < 4; ++q) { u32x2 w0, w1; w0.x = pk2(acc0[4 * q], acc0[4 * q + 1]); w0.y = pk2(acc0[4 * q + 2], acc0[4 * q + 3]); w1.x = pk2(acc1[4 * q], acc1[4 * q + 1]); w1.y = pk2(acc1[4 * q + 2], acc1[4 * q + 3]);
                *(u32x2*)(wrow + 8 * q) = w0; *(u32x2*)(wrow + 32 + 8 * q) = w1; }
        }
    }
    __syncthreads();
    {
        LAS float* S = (LAS float*)lds;
        LAS float* red = (LAS float*)(lds + 9 * 2048 * 4);
        for (int rps = 0; rps < NREP(21); ++rps)
        for (int i = tid; i < 9 * 2048; i += NWAVES * 64) { const int r = i >> 11, k = i & 2047; const float c = r < 8 ? a.in[I_C][r * DM + k] : a.in[I_CCTX][k]; S[i] = c / (1.0f + expf(-c)); }
        __syncthreads();
        float* mod = (float*)(ws + WS_MOD);
        const int cg = tid % 36, ks = tid / 36;
        for (int rp = 0; rp < NREP(15); ++rp)
        for (int ch = blockIdx.x; ch < 256; ch += G) { const int l = ch >> 7, col0 = (ch & 127) * 144;
            f32x4 acc[9];
#pragma unroll
            for (int r = 0; r < 9; ++r) acc[r] = (f32x4){0.f, 0.f, 0.f, 0.f};
            if (tid < 504) { const float* W = a.in[I_ADAW] + (size_t)l * DM * MODROW + col0 + 4 * cg; const int kbeg = ks * 147, kend = kbeg + 147 < 2048 ? kbeg + 147 : 2048;
#pragma unroll 8
                for (int k = kbeg; k < kend; ++k) { const f32x4 w = *(const f32x4*)(W + (size_t)k * MODROW);
#pragma unroll
                    for (int r = 0; r < 9; ++r) acc[r] += w * S[r * 2048 + k]; } }
#pragma unroll
            for (int p = 0; p < 3; ++p) {
                __syncthreads();
                if (tid < 504) {
#pragma unroll
                    for (int j = 0; j < 3; ++j) *(LAS f32x4*)(red + (size_t)tid * 12 + 4 * j) = acc[3 * p + j]; }
                __syncthreads();
                if (tid < 432) { const int cgo = tid / 12, j = tid % 12; float s = 0.f;
#pragma unroll
                    for (int q = 0; q < 14; ++q) s += red[(q * 36 + cgo) * 12 + j];
                    const int r = 3 * p + (j >> 2), col = col0 + 4 * cgo + (j & 3);
                    float val = s + a.in[I_ADAB][l * MODROW + col]; const int chunk = col >> 11;
                    if (chunk == 1 || chunk == 4 || chunk == 7) val = (1.0f + val) * a.in[I_NORMG][(size_t)(l * 3 + (chunk - 1) / 3) * DM + (col & 2047)];
                    mod[((size_t)l * 9 + r) * MODROW + col] = val; }
            }
        }
    }
    __syncthreads();
}

__device__ __forceinline__ void norm_mod_phase(const float* src_lat, const float* src_ctx, bf16* H, const float* g, const float* modl, int ish, int isc, int nrows,
                                               const bf16* dlat, bf16* xb, const bf16* pend, const float* pgate, float pcoef, float* xout_ctx, int gw, int NGW, int lane) {
    { int t_ = threadIdx.x; asm volatile("" : "+v"(t_)); lane = t_ & 63; }
#define NM_LOAD(r, raw) do { \
        if ((r) < MLAT) { \
            if (dlat != nullptr) { const u32x2* dr_ = (const u32x2*)(dlat + (size_t)(r) * DM); const u32x2* xbr_ = (const u32x2*)(xb + (size_t)(r) * DM); \
                _Pragma("unroll") for (int j = 0; j < 8; ++j) { const u32x2 x_ = xbr_[lane + 64 * j], d_ = dr_[lane + 64 * j]; raw[j] = (v4u){x_.x, x_.y, d_.x, d_.y}; } }     \
            else { const v4u* xr_ = (const v4u*)(src_lat + (size_t)(r) * DM); _Pragma("unroll") for (int j = 0; j < 8; ++j) raw[j] = xr_[lane + 64 * j]; } \
        } else { const v4u* xr_ = (const v4u*)(src_ctx + (size_t)((r) - MLAT) * DM); _Pragma("unroll") for (int j = 0; j < 8; ++j) raw[j] = xr_[lane + 64 * j]; } } while (0)
      \
#define NM_GAIN(r) do { const float* mr_ = modl + (size_t)((r) < MLAT ? ((r) >> 11) : 8) * MODROW; \
        _Pragma("unroll") for (int j = 0; j < 8; ++j) { const int c4 = lane + 64 * j; scv[j] = ((const f32x4*)(mr_ + isc * DM))[c4]; shv[j] = ((const f32x4*)(mr_ + ish * DM))[c4]; } } while (0)
#define NM_FINISH(r, raw) do { f32x4 v[8]; \
        u32x2* o_ = (u32x2*)(H + (((size_t)((r) >> 8) * 32 + (lane >> 4)) * 256 + ((r) & 255)) * 64 + 4 * (lane & 15));     \
        if ((r) < MLAT) { \
            if (dlat != nullptr) { _Pragma("unroll") for (int j = 0; j < 8; ++j) { const v4u w_ = raw[j]; \
                v[j].x = __builtin_bit_cast(float, w_.x << 16) + __builtin_bit_cast(float, w_.z << 16); v[j].y = __builtin_bit_cast(float, w_.x & 0xffff0000u) + __builtin_bit_cast(float, w_.z & 0xffff0000u); \
                v[j].z = __builtin_bit_cast(float, w_.y << 16) + __builtin_bit_cast(float, w_.w << 16); v[j].w = __builtin_bit_cast(float, w_.y & 0xffff0000u) + __builtin_bit_cast(float, w_.w & 0xffff0000u); } } \
            else { _Pragma("unroll") for (int j = 0; j < 8; ++j) v[j] = __builtin_bit_cast(f32x4, raw[j]); } \
            if (dlat == nullptr && xb != nullptr) { u32x2* xbw_ = (u32x2*)(xb + (size_t)(r) * DM); _Pragma("unroll") for (int j = 0; j < 8; ++j) { u32x2 w_; w_.x = pk2(v[j].x, v[j].y); w_.y = pk2(v[j].z, v[j].w); xbw_[lane + 64 * j] = w_; } } \
        } else { _Pragma("unroll") for (int j = 0; j < 8; ++j) v[j] = __builtin_bit_cast(f32x4, raw[j]); if (pend != nullptr) { const size_t ro_ = (size_t)((r) - MLAT) * DM; \
            _Pragma("unroll") for (int j = 0; j < 8; ++j) { const int c4 = lane + 64 * j; f32x4 p_ = (f32x4){0.f, 0.f, 0.f, 0.f}; \
                _Pragma("unroll") for (int q = 0; q < 4; ++q) { const u32x2 e_ = ((const u32x2*)(pend + (size_t)q * MCTX * DM + ro_))[c4]; \
                    p_.x += __builtin_bit_cast(float, e_.x << 16); p_.y += __builtin_bit_cast(float, e_.x & 0xffff0000u); p_.z += __builtin_bit_cast(float, e_.y << 16); p_.w += __builtin_bit_cast(float, e_.y & 0xffff0000u); } \
                v[j] = v[j] + (((const f32x4*)pgate)[c4] * pcoef) * p_; ((f32x4*)(xout_ctx + ro_))[c4] = v[j]; } } } \
        float ss_ = 0.f; \
        _Pragma("unroll") for (int j = 0; j < 8; ++j) ss_ += (v[j].x * v[j].x + v[j].y * v[j].y) + (v[j].z * v[j].z + v[j].w * v[j].w); \
        const float rstd_ = rsqrtf(wave_sum(ss_) * (1.0f / DM) + EPS); \
        _Pragma("unroll") for (int j = 0; j < 8; ++j) { const f32x4 sc_ = scv[j], sh_ = shv[j];     \
            const f32x4 y_ = (v[j] * rstd_) * sc_ + sh_; u32x2 w_; w_.x = pk2(y_.x, y_.y); w_.y = pk2(y_.z, y_.w); o_[(size_t)j * (4 * 256 * 64 / 4)] = w_; } } while (0)
    v4u rawA[8], rawB[8]; f32x4 scv[8], shv[8];
    int r = gw;
    if (r < nrows) NM_LOAD(r, rawA);
    while (r < nrows) {
        const int r1 = r + NGW, r2 = r1 + NGW;
        asm volatile("" ::: "memory");
        NM_GAIN(r);
        asm volatile("" ::: "memory");
        if (r1 < nrows) NM_LOAD(r1, rawB);
        asm volatile("" ::: "memory");
        NM_FINISH(r, rawA);
        if (r1 < nrows) { asm volatile("" ::: "memory"); NM_GAIN(r1); asm volatile("" ::: "memory"); if (r2 < nrows) NM_LOAD(r2, rawA); asm volatile("" ::: "memory"); NM_FINISH(r1, rawB); }
        r = r2;
    }
#undef NM_LOAD
#undef NM_GAIN
#undef NM_FINISH
}
__device__ __forceinline__ void final_norm_phase(const float* X, const bf16* D, float* out, const float* g, int gw, int NGW, int lane) {
    { int t_ = threadIdx.x; asm volatile("" : "+v"(t_)); lane = t_ & 63; }
#define FN_LOAD(r, v, d) do { const f32x4* xr_ = (const f32x4*)(X + (size_t)(r) * DM); const u32x2* dr_ = (const u32x2*)(D + (size_t)(r) * DM); \
        _Pragma("unroll") for (int j = 0; j < 8; ++j) { v[j] = xr_[lane + 64 * j]; d[j] = dr_[lane + 64 * j]; } } while (0)
#define FN_FINISH(r, v, d) do { float ss_ = 0.f; \
        _Pragma("unroll") for (int j = 0; j < 8; ++j) { \
            v[j].x += __builtin_bit_cast(float, d[j].x << 16); v[j].y += __builtin_bit_cast(float, d[j].x & 0xffff0000u); v[j].z += __builtin_bit_cast(float, d[j].y << 16); v[j].w += __builtin_bit_cast(float, d[j].y & 0xffff0000u); \
            ss_ += (v[j].x * v[j].x + v[j].y * v[j].y) + (v[j].z * v[j].z + v[j].w * v[j].w); } \
        const float rstd_ = rsqrtf(wave_sum(ss_) * (1.0f / DM) + EPS); f32x4* o_ = (f32x4*)(out + (size_t)(r) * DM); \
        _Pragma("unroll") for (int j = 0; j < 8; ++j) o_[lane + 64 * j] = (v[j] * rstd_) * gv[j]; } while (0)
    f32x4 va[8], vb[8], gv[8]; u32x2 da[8], db[8];
#pragma unroll
    for (int j = 0; j < 8; ++j) gv[j] = ((const f32x4*)g)[lane + 64 * j];
    int r = gw;
    if (r < MLAT) FN_LOAD(r, va, da);
    while (r < MLAT) {
        const int r1 = r + NGW, r2 = r1 + NGW;
        if (r1 < MLAT) FN_LOAD(r1, vb, db);
        asm volatile("" ::: "memory");
        FN_FINISH(r, va, da);
        if (r1 < MLAT) { if (r2 < MLAT) FN_LOAD(r2, va, da); asm volatile("" ::: "memory"); FN_FINISH(r1, vb, db); }
        r = r2;
    }
#undef FN_LOAD
#undef FN_FINISH
}
__device__ __forceinline__ void postproj_phase(bf16* P, const float* kvn, const float* qn, const float* rope, int nrows, int gw, int NGW, int lane) {
    { int t_ = threadIdx.x; asm volatile("" : "+v"(t_)); lane = t_ & 63; }
    for (int r = gw; r < nrows; r += NGW) {
        bf16* pr = P + (size_t)r * LDP;
        u32x2* pkv = (u32x2*)(pr + PC_CKV) + lane; v4u* pq = (v4u*)(pr + PC_CQ) + lane;
        const u32x2 wkv = *pkv; const v4u wq = *pq;
        const bool lat = r < MLAT; const int s = r & 2047, prow = s >> 6, pcol = s & 63;
        float x1[9], x2[9];
#pragma unroll
        for (int t = 0; t < 9; ++t) { const int p = lane + 64 * t, v = p >> 5, q = p & 31, half = q >> 4, i = q & 15;
            const int cb = v == 0 ? PC_KR : (v <= 8 ? PC_DK + (v - 1) * 64 : PC_DQ + (v - 9) * 64), ia = cb + half * 32 + i;
            if (lat && p < 544) { x1[t] = bf2f(pr[ia]); x2[t] = bf2f(pr[ia + 16]); } else { x1[t] = 0.f; x2[t] = 0.f; } }
        asm volatile("" ::: "memory");
        { const float x0 = bf2f((unsigned short)(wkv.x & 0xffff)), xa = bf2f((unsigned short)(wkv.x >> 16)), xb = bf2f((unsigned short)(wkv.y & 0xffff)), xc = bf2f((unsigned short)(wkv.y >> 16));
          const float rstd = rsqrtf(wave_sum((x0 * x0 + xa * xa) + (xb * xb + xc * xc)) * (1.0f / 256.0f) + EPS); const f32x4 g = ((const f32x4*)kvn)[lane];
          u32x2 o; o.x = pk2(x0 * rstd * g.x, xa * rstd * g.y); o.y = pk2(xb * rstd * g.z, xc * rstd * g.w); *pkv = o; }
        { float x[8];
          x[0] = bf2f((unsigned short)(wq.x & 0xffff)); x[1] = bf2f((unsigned short)(wq.x >> 16)); x[2] = bf2f((unsigned short)(wq.y & 0xffff)); x[3] = bf2f((unsigned short)(wq.y >> 16));
          x[4] = bf2f((unsigned short)(wq.z & 0xffff)); x[5] = bf2f((unsigned short)(wq.z >> 16)); x[6] = bf2f((unsigned short)(wq.w & 0xffff)); x[7] = bf2f((unsigned short)(wq.w >> 16));
          float ss = 0.f;
#pragma unroll
          for (int j = 0; j < 8; ++j) ss += x[j] * x[j];
          const float rstd = rsqrtf(wave_sum(ss) * (1.0f / 512.0f) + EPS); const f32x4 g0 = ((const f32x4*)qn)[2 * lane], g1 = ((const f32x4*)qn)[2 * lane + 1];
          v4u o; o.x = pk2(x[0] * rstd * g0.x, x[1] * rstd * g0.y); o.y = pk2(x[2] * rstd * g0.z, x[3] * rstd * g0.w); o.z = pk2(x[4] * rstd * g1.x, x[5] * rstd * g1.y); o.w = pk2(x[6] * rstd * g1.z, x[7] * rstd * g1.w); *pq = o; }
        if (lat) {
#pragma unroll
            for (int t = 0; t < 9; ++t) { const int p = lane + 64 * t, v = p >> 5, q = p & 31, half = q >> 4, i = q & 15;
                const int cb = v == 0 ? PC_KR : (v <= 8 ? PC_DK + (v - 1) * 64 : PC_DQ + (v - 9) * 64), ia = cb + half * 32 + i, pos = half ? pcol : prow;
                const float cs = rope[pos * 32 + i], sn = rope[pos * 32 + 16 + i];
                if (p < 544) { pr[ia] = (bf16)f2bf(x1[t] * cs - x2[t] * sn); pr[ia + 16] = (bf16)f2bf(x1[t] * sn + x2[t] * cs); } } }
    }
}
__device__ __forceinline__ void fourier_combine(const float* F2p, const bf16* Ct, bf16* Oo, int gw, int NGW) {
    int lane; { int t_ = threadIdx.x; asm volatile("" : "+v"(t_)); lane = t_ & 63; }
    constexpr int NIT = NB * 1024, PER = 4;
    f32x4 p1[PER][2], p2[PER][2];
#pragma unroll
    for (int q = 0; q < PER; ++q) { const int it = gw + q * NGW; if (it < NIT) { const int b = it >> 10, sp = it & 1023;
        const f32x4* r1 = (const f32x4*)(F2p + (size_t)sp * (NB * 512) + b * 512) + 2 * lane; const f32x4* r2 = (const f32x4*)(F2p + ((size_t)1024 + sp) * (NB * 512) + b * 512) + 2 * lane;
        p1[q][0] = r1[0]; p1[q][1] = r1[1]; p2[q][0] = r2[0]; p2[q][1] = r2[1]; } }
    v4u cv[2][4];
#pragma unroll
    for (int q = 0; q < 2; ++q) { const int it = gw + q * NGW; if (it < NB * 512) { const v4u* src = (const v4u*)(Ct + (size_t)it * 4096) + 4 * lane;
#pragma unroll
        for (int j = 0; j < 4; ++j) cv[q][j] = src[j]; } }
    asm volatile("" ::: "memory");
#pragma unroll
    for (int q = 0; q < PER; ++q) { const int it = gw + q * NGW; if (it < NIT) { const int b = it >> 10, sp = it & 1023;
        const f32x4 a0 = p1[q][0] + p2[q][0], a1 = p1[q][1] + p2[q][1], d0 = p1[q][0] - p2[q][0], d1 = p1[q][1] - p2[q][1];
        v4u w; w.x = pk2(a0.x, a0.y); w.y = pk2(a0.z, a0.w); w.z = pk2(a1.x, a1.y); w.w = pk2(a1.z, a1.w);
        *((v4u*)(Oo + ((size_t)b * SEQ + sp) * DM + 1536) + lane) = w;
        if (sp != 0) { v4u x; x.x = pk2(d0.x, d0.y); x.y = pk2(d0.z, d0.w); x.z = pk2(d1.x, d1.y); x.w = pk2(d1.z, d1.w);
            *((v4u*)(Oo + ((size_t)b * SEQ + (SEQ - sp)) * DM + 1536) + lane) = x; } } }
#pragma unroll
    for (int q = 0; q < 2; ++q) { const int it = gw + q * NGW; if (it < NB * 512) { float sacc = 0.f;
#pragma unroll
        for (int j = 0; j < 4; ++j) { const v4u c = cv[q][j]; const unsigned wds[4] = {c.x, c.y, c.z, c.w};
#pragma unroll
            for (int e = 0; e < 4; ++e) sacc += __builtin_bit_cast(float, wds[e] << 16) - __builtin_bit_cast(float, wds[e] & 0xffff0000u); }
        const float tot = wave_sum(sacc) * (1.0f / 512.0f);
        if (lane == 0) { const int b = it >> 9, n = it & 511; Oo[((size_t)b * SEQ + 1024) * DM + 1536 + n] = (bf16)f2bf(tot); } } }
}
__device__ __forceinline__ void attn_phase(unsigned char* ws, bool with_ctx, char* ldsg, LAS unsigned char* ldsg_las, int vcu, int cv, float lam, float omli, const float* subln) {
    const bf16* P = (const bf16*)(ws + WS_P); const bf16* KV = (const bf16*)(ws + WS_KV); const bf16* Q = (const bf16*)(ws + WS_Q);
    bf16* O = (bf16*)(ws + WS_O);
    for (int rep = 0; rep < 3; ++rep) {
        int b, h, row0, nkeys;
        if (rep < 2) { const int u = vcu + 256 * rep; b = u >> 6; h = (u >> 3) & 7; row0 = b * SEQ + (u & 7) * 256; nkeys = CTXL + SEQ; }
        else { if (!with_ctx || cv < 128 || cv >= 192) break; const int e = cv - 128; b = e >> 3; h = e & 7; row0 = MLAT + b * CTXL; nkeys = CTXL; }
        fa::Src S; S.Q = Q + (size_t)row0 * 1536 + h * 192; S.ldq = 1536; S.Kn = KV + h * 256; S.ldkn = DM; S.Kr = P + PC_KR; S.ldkr = LDP; S.V = KV + h * 256 + 128; S.ldv = DM;
        S.seg0 = MLAT + b * CTXL; S.seg1 = b * SEQ; S.nkeys = nkeys; S.O = O + (size_t)row0 * DM + h * 128; S.ldo = DM;
        S.lam = 0.f; S.omli = 0.f; S.subln = nullptr;
        for (int rp = 0; rp < NREP(17); ++rp) fa::attn_unit_dma<192, 0>(S, ldsg, (LAS unsigned char*)ldsg_las);
    }
    for (int rep = 0; rep < 2; ++rep) {
        int b, hh, row0, nkeys;
        if (rep == 0) { b = vcu >> 5; hh = (vcu >> 3) & 3; row0 = b * SEQ + (vcu & 7) * 256; nkeys = CTXL + SEQ; }
        else { if (!with_ctx || cv < 192 || cv >= 224) break; const int e = cv - 192; b = e >> 2; hh = e & 3; row0 = MLAT + b * CTXL; nkeys = CTXL; }
        fa::Src S; S.Kn = nullptr; S.ldkn = 0; S.ldq = LDP; S.ldkr = LDP; S.V = P + PC_DV + hh * 128; S.ldv = LDP;
        S.seg0 = MLAT + b * CTXL; S.seg1 = b * SEQ; S.nkeys = nkeys; S.O = O + (size_t)row0 * DM + 1024 + hh * 128; S.ldo = DM; S.lam = lam; S.omli = omli; S.subln = subln;
        S.Q = P + (size_t)row0 * LDP + PC_DQ + (2 * hh) * 64; S.Kr = P + PC_DK + (2 * hh) * 64;
        for (int rp = 0; rp < NREP(18); ++rp) {
        fa::attn_unit_dma<64, 1>(S, ldsg, (LAS unsigned char*)ldsg_las);
        S.Q += 64; S.Kr += 64;
        fa::attn_unit_dma<64, 2>(S, ldsg, (LAS unsigned char*)ldsg_las);
        S.Q -= 64; S.Kr -= 64; }
    }
}
#ifndef GSMASK
#define GSMASK 0xffffffffu
#endif
#define GS(n) ((GSMASK >> (n)) & 1u)
__global__ void __launch_bounds__(NWAVES * 64, 2) mega(Args a) {
    extern __shared__ __attribute__((aligned(16))) unsigned char lds_raw[];
    LAS unsigned char* lds = (LAS unsigned char*)lds_raw;
    volatile LAS unsigned* MISC = (volatile LAS unsigned*)(lds + MISC_OFF);
    const int tid = 0, lane = 0;
    const int wave = __builtin_amdgcn_readfirstlane((int)threadIdx.x >> 6);
    const int G = gridDim.x, gw = blockIdx.x * NWAVES + wave, NGW = G * NWAVES;
    unsigned char* ws = a.ws;
    int vcu = (G % 8 == 0) ? (int)(blockIdx.x % 8) * (G / 8) + (int)(blockIdx.x / 8) : (int)blockIdx.x;
    int cv = (int)blockIdx.x;
    for (int u = threadIdx.x; u < (LDS_BYTES - LDSCTL_OFF) / 4; u += NWAVES * 64) ((LAS unsigned*)(lds + LDSCTL_OFF))[u] = 0u;
    __syncthreads();
    const int lo = a.st_lo, hi = a.st_hi;
    XcdBarrier bar; bar.bar = (unsigned*)(ws + WS_CTL) + CW_BAR; bar.x = 0; bar.st = nullptr;
    if (hi - lo > 1) bar = xcd_barrier_post((unsigned*)(ws + WS_CTL) + CW_BAR, MISC + 8);
#define IN(k) (lo <= (k) && (k) < hi)
#define SEAM(k) do { if (hi > (k) + 1) xcd_barrier(bar); else __syncthreads(); } while (0)
#define WSB() ({ unsigned char* p_ = ws; asm volatile("" : "+s"(p_)); p_; })
#define XC ((float*)(WSB() + WS_X))
#define H ((bf16*)(WSB() + WS_H))
#define O ((bf16*)(WSB() + WS_O))
#define ACT ((bf16*)(WSB() + WS_ACT))
#define P ((bf16*)(WSB() + WS_P))
#define KV ((bf16*)(WSB() + WS_KV))
#define Q ((bf16*)(WSB() + WS_Q))
#define OD ((float*)(WSB() + WS_OD))
#define CT ((bf16*)(WSB() + WS_CT))
#define CTC ((bf16*)(WSB() + WS_CTC))
#define PART ((bf16*)(WSB() + WS_PART))
#define F2P ((float*)(WSB() + WS_PART + 32 * MiB))
#define DBUF ((bf16*)(WSB() + WS_S))
#define XB ((bf16*)(WSB() + WS_S + 64 * MiB))
#define MOD ((const float*)(WSB() + WS_MOD))
#define ROPE ((const float*)(WSB() + WS_TAB))
#define LAMV ((const float*)(WSB() + WS_TAB + 16384))
    LAS unsigned char* ring = lds;

#ifndef NO_PRO
    if (IN(0)) for (int rp = 0; rp < NREP(10); ++rp) { prologue(a, lds, tid, lane, wave); SEAM(0); }
    if (lo == 0 && hi > 1 && (G % 8) == 0) {
        if (threadIdx.x == 0) { unsigned* bw = (unsigned*)(ws + WS_CTL) + CW_BAR; unsigned start = 0;
            for (unsigned j = 0; j < 16; ++j) { const unsigned cj = xb_ld(&bw[XB_XCNT(j)]); if (j < bar.x) start += cj; }
            MISC[11] = start + MISC[10]; }
        __syncthreads();
        const int u = __builtin_amdgcn_readfirstlane((int)MISC[11]);
        if (u >= 0 && u < G) { vcu = u; cv = (u % (G / 8)) * 8 + u / (G / 8); }
    }
#endif

    for (int fi = 0; fi < 4; ++fi) {
        const int base = 1 + 16 * fi, l = fi >> 1, f = fi & 1;
        const int Mf = (fi == 3) ? MLAT : MTOT;
        const float* modl = MOD + (size_t)l * 9 * MODROW;
        const float* xin_lat = a.in[I_X]; const float* xin_ctx = (fi == 0) ? a.in[I_CTX] : XC;
        if (IN(base + 0)) for (int rp = 0; rp < (fi == 0 ? NREP(0) : 1); ++rp) { norm_mod_phase(xin_lat, xin_ctx, H, a.in[I_NORMG] + (size_t)(l * 3 + 2 * f) * DM, modl, 6 * f + 0, 6 * f + 1, Mf,
                fi > 0 ? DBUF : nullptr, XB, (fi == 1 || fi == 2) ? PART : nullptr, fi == 1 ? modl + 8 * MODROW + 5 * DM : MOD + 8 * MODROW + 8 * DM  , fi == 1 ? 1.0f : 0.5f, XC, gw, NGW, lane);
            if (fi == 1 && NREP(23) > 1) norm_mod_phase(xin_lat, xin_ctx, H, a.in[I_NORMG] + (size_t)(l * 3 + 2 * f) * DM, modl, 6 * f + 0, 6 * f + 1, MLAT, DBUF, XB, nullptr, nullptr, 0.f, XC, gw, NGW, lane);
            SEAM(base + 0); }
        if (IN(base + 1)) for (int rp = 0; rp < NREP(1); ++rp) {
            pg8::Gemm g{H, (const bf16*)(WSB() + WS_WGU) + (size_t)fi * 2 * DFF * DM, Mf, 2 * DFF, DM, 64, 64, 32768, 32768, (size_t)32 * 32768, (size_t)32 * 32768};     pg8::StaticOrder S; S.init(Mf, 2 * DFF, G, cv);
            pg8::EpiSwiglu E{ACT, DFF / 64, 0};
            if (GS(1)) pg8::gemm_phase<pg8::EpiSwiglu, pg8::StaticOrder, true, true>(ring, g, S, E);
            if (fi < 3 && cv >= 96) { __syncthreads(); transpose_set(a, lds, fi + 1, (cv - 96) * NWAVES + wave, (G - 96) * NWAVES); }
            if (NREP(22) > 1) { __syncthreads(); pg8::EpiSwiglu E2{ACT, DFF / 64, 1}; pg8::gemm_phase<pg8::EpiSwiglu, pg8::StaticOrder, true, true>(ring, g, S, E2); }
            SEAM(base + 1);
        }
        if (IN(base + 2)) for (int rp = 0; rp < (fi == 0 ? NREP(2) : 1); ++rp) {
            { pg8::Gemm g{ACT, (const bf16*)(WSB() + WS_WD) + (size_t)fi * DM * DFFP, MTOT, DM, DFF, 64, DFFP, 32768, 128, (size_t)(DFF / 64) * 32768, (size_t)256 * DFFP * 2};
              pg8::LatCtxOrder S; S.init(G, cv, (DFF / 4 / 64) * 32768, (DFF / 4) * 2, DFF / 4 / 64, fi < 3 ? 1 : 0);
              pg8::EpiLatCtx E{{DBUF, modl + (6 * f + 2) * DM, 0.5f, fi == 0 ? 1 : 0}, {PART, MCTX}};
              for (int r2 = 0; r2 < (fi == 0 ? NREP(11) : 1); ++r2) { if (GS(2)) pg8::gemm_phase<pg8::EpiLatCtx, pg8::LatCtxOrder, true, true>(ring, g, S, E); __syncthreads(); } }
            SEAM(base + 2);
        }
        if (f == 0) {
            const int Mq = (l == 0) ? MTOT : MLAT;
            if (IN(base + 3)) { norm_mod_phase(xin_lat, xin_ctx, H, a.in[I_NORMG] + (size_t)(l * 3 + 1) * DM, modl, 3, 4, MTOT, DBUF, XB, PART, modl + 8 * MODROW + 2 * DM, 0.5f, XC, gw, NGW, lane); SEAM(base + 3); }
            if (IN(base + 4)) for (int rp = 0; rp < NREP(4); ++rp) {
                { pg8::Gemm g{H, (const bf16*)(WSB() + WS_WIN) + (size_t)l * LDP * DM, MTOT, LDP, DM, 64, DM, 32768, 128, (size_t)32 * 32768, (size_t)256 * DM * 2}; pg8::StaticOrder S; S.init(MTOT, LDP, G, cv);
                  pg8::EpiStoreBf16 E{P, LDP};
                  if (GS(3)) pg8::gemm_phase<pg8::EpiStoreBf16, pg8::StaticOrder, true, true>(ring, g, S, E); }
                __syncthreads();
                { pg8::Gemm g{(const bf16*)(WSB() + WS_WF1) + (size_t)l * 1024 * DM, H, 1024, Mq, DM, DM, 64, 128, 32768, (size_t)256 * DM * 2, (size_t)32 * 32768}; pg8::StaticOrder S; S.init(1024, Mq, G, (cv + 48) % G);
                  pg8::EpiF1 E{CT, CTC};
                  if (GS(4)) pg8::gemm_phase<pg8::EpiF1, pg8::StaticOrder, true, true>(ring, g, S, E); }
                SEAM(base + 4);
            }
            if (IN(base + 5)) {
                if (cv >= G / 2) postproj_phase(P, a.in[I_KVN] + l * 256, a.in[I_QN] + l * 512, ROPE, MTOT, (cv - G / 2) * NWAVES + wave, (G - G / 2) * NWAVES, lane);
                { pg8::Gemm g = pg8::mk_gemm((const bf16*)(WSB() + WS_DFT), CT, SEQ / 2, NB * 512, 2048, 4096, 4096); pg8::SplitKOrder S; S.init(SEQ / 2, NB * 512, 2, 2048 * 2, 2048 * 2, G, cv);
                  pg8::EpiPartF32 E{F2P, SEQ / 2, NB * 512};
                  for (int r2 = 0; r2 < NREP(19); ++r2) { if (GS(7)) pg8::gemm_phase<pg8::EpiPartF32, pg8::SplitKOrder, true, true>(ring, g, S, E); __syncthreads(); } }
                if (l == 0) {
                  __syncthreads();
                  pg8::Gemm g = pg8::mk_gemm((const bf16*)(WSB() + WS_DFTC), CTC, CTXL, NB * 512, 512, 512, 512); pg8::StaticOrder S; S.init(CTXL, NB * 512, G, (cv + 112) % G);
                  pg8::EpiF2 E{O, MLAT, CTXL};
                  if (GS(8)) pg8::gemm_phase<pg8::EpiF2, pg8::StaticOrder, true, true>(ring, g, S, E); }
                SEAM(base + 5); }
            if (IN(base + 6)) for (int rp = 0; rp < NREP(6); ++rp) {
                fourier_combine(F2P, CT, O, gw, NGW); __syncthreads();
                { pg8::Gemm g = pg8::mk_gemm(P + PC_CKV, (const bf16*)(WSB() + WS_WUKV) + (size_t)l * 2048 * 256, MTOT, 2048, 256, LDP, 256); pg8::StaticOrder S; S.init(MTOT, 2048, G, cv);
                  pg8::EpiStoreBf16 E{KV, DM};
                  if (GS(5)) pg8::gemm_phase<pg8::EpiStoreBf16, pg8::StaticOrder, true, true>(ring, g, S, E); }
                __syncthreads();
                { pg8::Gemm g = pg8::mk_gemm(P + PC_CQ, (const bf16*)(WSB() + WS_WUQ) + (size_t)l * 1536 * 512, Mq, 1536, 512, LDP, 512); pg8::StaticOrder S; S.init(Mq, 1536, G, (cv + 176) % G);
                  pg8::EpiRopeQ E{Q, 1536, ROPE};
                  if (GS(6)) pg8::gemm_phase<pg8::EpiRopeQ, pg8::StaticOrder, true, true>(ring, g, S, E); }
                SEAM(base + 6);
            }
            if (IN(base + 7)) for (int rp = 0; rp < NREP(7); ++rp) {
                attn_phase(ws, l == 0, (char*)lds_raw, lds, vcu, cv, LAMV[2 * l], LAMV[2 * l + 1], a.in[I_SUBLN] + l * 128);
                SEAM(base + 7);
            }
            if (IN(base + 9)) {
                { pg8::Gemm g = pg8::mk_gemm(O, (const bf16*)(WSB() + WS_WOUT) + (size_t)l * DM * DM, MTOT, DM, DM, DM, DM);
                  pg8::LatCtxOrder S; S.init(G, cv, (DM / 4) * 2, (DM / 4) * 2, DM / 4 / 64, l == 0 ? 1 : 0);
                  pg8::EpiLatCtx E{{DBUF, modl + 5 * DM, 1.0f, 0}, {PART, MCTX}};
                  if (GS(9)) pg8::gemm_phase<pg8::EpiLatCtx, pg8::LatCtxOrder, true, true>(ring, g, S, E); }
                SEAM(base + 9);
            }
        }
    }
    if (IN(65)) final_norm_phase(a.in[I_X], DBUF, a.out, a.in[I_FN], gw, NGW, lane);
#undef IN
#undef SEAM
#undef WSB
#undef XC
#undef H
#undef O
#undef ACT
#undef P
#undef KV
#undef Q
#undef OD
#undef CT
#undef CTC
#undef PART
#undef DBUF
#undef XB
#undef MOD
#undef ROPE
#undef LAMV
}

extern "C" void kernel_launch(void* const* d_in, const int* in_sizes, int n_in, void* d_out, int out_size, void* d_ws, size_t ws_size, hipStream_t stream) {
    static int grid = 0;
    if (grid == 0) {
        if (n_in != 19 || out_size != MLAT * DM || ws_size < WS_END) { fprintf(stderr, "kernel_launch: unexpected shapes (n_in %d, out %d, ws %zu < %zu)\n", n_in, out_size, ws_size, (size_t)WS_END); grid = -1; return; }
        int dev = 0, cus = 0, per_cu = 0;
        if (hipGetDevice(&dev) != hipSuccess || hipDeviceGetAttribute(&cus, hipDeviceAttributeMultiprocessorCount, dev) != hipSuccess) { grid = -1; return; }
        if (hipFuncSetAttribute((const void*)mega, hipFuncAttributeMaxDynamicSharedMemorySize, LDS_BYTES) != hipSuccess) { fprintf(stderr, "kernel_launch: hipFuncSetAttribute failed\n"); grid = -1; return; }
        if (hipOccupancyMaxActiveBlocksPerMultiprocessor(&per_cu, (const void*)mega, NWAVES * 64, LDS_BYTES) != hipSuccess || per_cu < 1) { fprintf(stderr, "kernel_launch: occupancy query says %d\n", per_cu); }
        (void)hipGetLastError();
        grid = cus;
    }
    if (grid < 0) return;
    (void)hipMemsetAsync((char*)d_ws + WS_CTL, 0, CTL_ZERO_BYTES, stream);
    Args a{};
    for (int i = 0; i < 19; ++i) a.in[i] = (const float*)d_in[i];
    a.out = (float*)d_out; a.ws = (unsigned char*)d_ws;
#ifndef MK_ONE_LAUNCH
#define MK_ONE_LAUNCH 1
#endif
    if (MK_ONE_LAUNCH) { a.st_lo = 0; a.st_hi = N_STEPS; hipLaunchKernelGGL(mega, dim3(grid), dim3(NWAVES * 64), LDS_BYTES, stream, a); }
    else {
        int steps[64]; int ns = 0; steps[ns++] = 0;
        for (int fi = 0; fi < 4; ++fi) { const int base = 1 + 16 * fi; for (int k = 0; k < 3; ++k) steps[ns++] = base + k; if ((fi & 1) == 0) for (int k = 3; k < 10; ++k) if (k != 8) steps[ns++] = base + k; }
        steps[ns++] = 65;
        for (int i = 0; i < ns; ++i) { a.st_lo = steps[i]; a.st_hi = steps[i] + 1; hipLaunchKernelGGL(mega, dim3(grid), dim3(NWAVES * 64), LDS_BYTES, stream, a); }
    }
    const hipError_t le = hipPeekAtLastError();
    if (le != hipSuccess) fprintf(stderr, "kernel_launch: launch failed: %s\n", hipGetErrorName(le));
}
```

```cpp
#include <hip/hip_runtime.h>
#include <cstdio>
#include <cstdint>
#ifndef DUPMASK
#define DUPMASK 0u
#endif
#define NREP(k) (1 + (int)((DUPMASK >> (k)) & 1u))
namespace pg8 {
#define PG8_LAS __attribute__((address_space(3)))
typedef unsigned short bf16_t;
typedef short bf16x8 __attribute__((ext_vector_type(8)));
typedef float f32x4 __attribute__((ext_vector_type(4)));
typedef float f32x2 __attribute__((ext_vector_type(2)));
typedef unsigned u32x4 __attribute__((ext_vector_type(4)));
typedef unsigned u32x2 __attribute__((ext_vector_type(2)));
constexpr int BM = 256, BK = 64, HALF = 128, HTB = HALF * BK * 2  , STAGE_BYTES = 8 * HTB, NXCD = 8, WGM = 8;

__host__ __device__ __forceinline__ int lds_byte(int r, int c) { const int st = (r >> 4) * 2 + (c >> 5), rr = r & 15, cc = c & 31, ob = rr * 64 + cc * 2; return st * 1024 + (ob ^ (((ob >> 9) & 1) << 5)); }
__host__ __device__ __forceinline__ void stage_rc(int b, int& R, int& C) { const int st = b / 1024, sb = b % 1024, swz = sb ^ (((sb >> 9) & 1) << 5); R = (st >> 1) * 16 + swz / 64; C = (st & 1) * 32 + (swz % 64) / 2; }
__host__ __device__ __forceinline__ int perm32(int rho) { const int n = rho >> 4, i = rho & 15; return 8 * (i >> 2) + 4 * n + (i & 3); }

struct Unit { int pm, pn, koA, koB, ks, nt; };
struct Gemm { const bf16_t* A; const bf16_t* Bt; int M, N, K, lda, ldb, ksA, ksB; size_t tsA, tsB; };
__host__ __device__ __forceinline__ Gemm mk_gemm(const bf16_t* A, const bf16_t* Bt, int M, int N, int K, int lda, int ldb) { return Gemm{A, Bt, M, N, K, lda, ldb, BK * 2, BK * 2, (size_t)BM * lda * 2, (size_t)BM * ldb * 2}; }

struct StaticOrder {
    int nM, nN, nwg, G, c;
    __host__ __device__ void init(int M, int N, int G_, int c_) { nM = M / BM; nN = N / BM; nwg = nM * nN; G = G_; c = c_; }
    __host__ __device__ bool next(int i, Unit& u) const {
        const long L = (long)i * G + c; if (L >= nwg) return false;
        int wgid = (int)L; { const int q = nwg / NXCD, r = nwg % NXCD, xcd = wgid % NXCD, off = wgid / NXCD; wgid = (xcd < r ? xcd * (q + 1) : r * (q + 1) + (xcd - r) * q) + off; }
        const int nig = WGM * nN, gid = wgid / nig, fm = gid * WGM, gsz = (nM - fm) < WGM ? (nM - fm) : WGM;
        u.pm = fm + ((wgid % nig) % gsz); u.pn = (wgid % nig) / gsz; u.koA = 0; u.koB = 0; u.ks = 0; u.nt = 0; return true;
    }
    __device__ __forceinline__ void a_ready(const Unit&) const {}
    __device__ __forceinline__ void done(const Unit&) const {}
};
struct SplitKOrder {
    int nM, nN, KS, G, c, kpartA, kpartB;
    __host__ __device__ void init(int M, int N, int KS_, int kpartA_, int kpartB_, int G_, int c_) { nM = M / BM; nN = N / BM; KS = KS_; kpartA = kpartA_; kpartB = kpartB_; G = G_; c = c_; }
    __host__ __device__ bool next(int i, Unit& u) const {
        const long L = (long)i * G + c; const int per = nM * nN; if (L >= (long)per * KS) return false;
        const int ks = (int)(L / per), r = (int)(L % per); u.pm = r % nM; u.pn = r / nM; u.ks = ks; u.koA = ks * kpartA; u.koB = ks * kpartB; u.nt = 0; return true;
    }
    __device__ __forceinline__ void a_ready(const Unit&) const {}
    __device__ __forceinline__ void done(const Unit&) const {}
};

struct PanelOrder {
    int nM, nN, G, c;
    __host__ __device__ void init(int M, int N, int G_, int c_) { nM = M / BM; nN = N / BM; G = G_; c = c_; }
    __host__ __device__ bool next(int i, Unit& u) const {
        const int per_x = G / NXCD, xcd = c % NXCD, idx = i * per_x + c / NXCD, pml = idx / nN;
        if (pml >= nM / NXCD) return false;
        u.pm = xcd * (nM / NXCD) + pml; u.pn = idx % nN; u.koA = 0; u.koB = 0; u.ks = 0; u.nt = 0; return true;
    }
    __device__ __forceinline__ void a_ready(const Unit&) const {}
    __device__ __forceinline__ void done(const Unit&) const {}
};
struct LatCtxOrder {
    PanelOrder lat; int G, c, n_lat_rounds, kpartA, kpartB, nt_part, with_ctx;
    __host__ __device__ void init(int G_, int c_, int kpartA_, int kpartB_, int nt_part_, int with_ctx_) { lat.init(16384, 2048, G_, c_); G = G_; c = c_; n_lat_rounds = (64 * 8 + G_ - 1) / G_; kpartA = kpartA_; kpartB = kpartB_; nt_part = nt_part_; with_ctx = with_ctx_; }
    __host__ __device__ bool next(int i, Unit& u) const {
        if (i < n_lat_rounds) { if (lat.next(i, u)) return true; }
        if (!with_ctx) return false;
        const long L = (long)(i - n_lat_rounds) * G + c; if (i < n_lat_rounds || L >= 256) return false;
        const int ks = (int)(L >> 6), r = (int)(L & 63); u.pm = 64 + (r & 7); u.pn = r >> 3; u.ks = ks; u.koA = ks * kpartA; u.koB = ks * kpartB; u.nt = nt_part; return true;
    }
    __device__ __forceinline__ void a_ready(const Unit&) const {}
    __device__ __forceinline__ void done(const Unit&) const {}
};
__device__ __forceinline__ unsigned cvt_pk_bf16(float lo, float hi) { unsigned r; asm volatile("v_cvt_pk_bf16_f32 %0, %1, %2" : "=v"(r) : "v"(lo), "v"(hi)); return r; }
__device__ __forceinline__ float silu_f(float x) { return x * __builtin_amdgcn_rcpf(1.0f + __builtin_amdgcn_exp2f(-1.4426950408889634f * x)); }

constexpr int E_DM = 2048, E_MLAT = 16384, E_MODROW = 9 * 2048;

struct EpiSwiglu {
    static constexpr bool PERM = true, AFTER_DRAIN = false;
    bf16_t* O; int nkt; int skip;
    __device__ __forceinline__ void operator()(const f32x4 (&acc)[2][2][4][2], const Unit& u, int wr, int wc, int fr, int fq) const {
        if (skip && acc[0][0][0][0][0] != 1.2345e30f) return;
        bf16_t* base = O + (((size_t)u.pm * nkt + 2 * u.pn + (wc >> 1)) * BM + wr * 64 + fr) * 64 + (wc & 1) * 32 + 8 * fq;
#pragma unroll
        for (int ai = 0; ai < 2; ++ai)
#pragma unroll
            for (int m = 0; m < 4; ++m) { bf16_t* rowp = base + (size_t)(ai * HALF + m * 16) * 64;
                const f32x4 g0 = acc[ai][0][m][0], g1 = acc[ai][0][m][1], u0 = acc[ai][1][m][0], u1 = acc[ai][1][m][1];
                u32x4 w; w.x = cvt_pk_bf16(silu_f(g0[0]) * u0[0], silu_f(g0[1]) * u0[1]); w.y = cvt_pk_bf16(silu_f(g0[2]) * u0[2], silu_f(g0[3]) * u0[3]);
                w.z = cvt_pk_bf16(silu_f(g1[0]) * u1[0], silu_f(g1[1]) * u1[1]); w.w = cvt_pk_bf16(silu_f(g1[2]) * u1[2], silu_f(g1[3]) * u1[3]);
                *(u32x4*)rowp = w; }
    }
};
struct EpiStoreBf16 {
    static constexpr bool PERM = true, AFTER_DRAIN = false;
    bf16_t* O; int ldc;
    __device__ __forceinline__ void operator()(const f32x4 (&acc)[2][2][4][2], const Unit& u, int wr, int wc, int fr, int fq) const {
        const int row0 = u.pm * BM + wr * 64 + fr, col0 = u.pn * BM + wc * 32 + 8 * fq;
#pragma unroll
        for (int ai = 0; ai < 2; ++ai)
#pragma unroll
            for (int m = 0; m < 4; ++m) { bf16_t* rowp = O + (size_t)(row0 + ai * HALF + m * 16) * ldc + col0;
#pragma unroll
                for (int bj = 0; bj < 2; ++bj) { const f32x4 v0 = acc[ai][bj][m][0], v1 = acc[ai][bj][m][1];
                    u32x4 w; w.x = cvt_pk_bf16(v0[0], v0[1]); w.y = cvt_pk_bf16(v0[2], v0[3]); w.z = cvt_pk_bf16(v1[0], v1[1]); w.w = cvt_pk_bf16(v1[2], v1[3]);
                    *(u32x4*)(rowp + bj * HALF) = w; } }
    }
};
struct EpiDelta {
    static constexpr bool PERM = true, AFTER_DRAIN = false;
    bf16_t* D; const float* gate; float coef; int first;
    __device__ __forceinline__ void operator()(const f32x4 (&acc)[2][2][4][2], const Unit& u, int wr, int wc, int fr, int fq) const {
        const int row0 = u.pm * BM + wr * 64 + fr, col0 = u.pn * BM + wc * 32 + 8 * fq; const float* gp = gate + (size_t)(u.pm >> 3) * E_MODROW + col0;
        f32x4 gv[2][2];
#pragma unroll
        for (int bj = 0; bj < 2; ++bj)
#pragma unroll
            for (int n = 0; n < 2; ++n) gv[bj][n] = *(const f32x4*)(gp + bj * HALF + 4 * n) * coef;
#pragma unroll
        for (int ai = 0; ai < 2; ++ai) { u32x4 old[4][2];
            if (!first) {
#pragma unroll
                for (int m = 0; m < 4; ++m)
#pragma unroll
                    for (int bj = 0; bj < 2; ++bj) old[m][bj] = *(const u32x4*)(D + (size_t)(row0 + ai * HALF + m * 16) * E_DM + col0 + bj * HALF);
                asm volatile("" ::: "memory"); }
#pragma unroll
            for (int m = 0; m < 4; ++m) { bf16_t* rowp = D + (size_t)(row0 + ai * HALF + m * 16) * E_DM + col0;
#pragma unroll
                for (int bj = 0; bj < 2; ++bj) { f32x4 v0 = acc[ai][bj][m][0] * gv[bj][0], v1 = acc[ai][bj][m][1] * gv[bj][1];
                    if (!first) { const u32x4 o = old[m][bj];
                        v0[0] += __builtin_bit_cast(float, o.x << 16); v0[1] += __builtin_bit_cast(float, o.x & 0xffff0000u); v0[2] += __builtin_bit_cast(float, o.y << 16); v0[3] += __builtin_bit_cast(float, o.y & 0xffff0000u);
                        v1[0] += __builtin_bit_cast(float, o.z << 16); v1[1] += __builtin_bit_cast(float, o.z & 0xffff0000u); v1[2] += __builtin_bit_cast(float, o.w << 16); v1[3] += __builtin_bit_cast(float, o.w & 0xffff0000u); }
                    u32x4 w; w.x = cvt_pk_bf16(v0[0], v0[1]); w.y = cvt_pk_bf16(v0[2], v0[3]); w.z = cvt_pk_bf16(v1[0], v1[1]); w.w = cvt_pk_bf16(v1[2], v1[3]);
                    *(u32x4*)(rowp + bj * HALF) = w; } }
            asm volatile("" ::: "memory"); }
    }
};
struct EpiPartial {
    static constexpr bool PERM = true, AFTER_DRAIN = false;
    bf16_t* part; int rows;
    __device__ __forceinline__ void operator()(const f32x4 (&acc)[2][2][4][2], const Unit& u, int wr, int wc, int fr, int fq) const {
        bf16_t* out = part + ((size_t)u.ks * rows + (size_t)u.pm * BM + wr * 64 + fr) * E_DM + u.pn * BM + wc * 32 + 8 * fq;
#pragma unroll
        for (int ai = 0; ai < 2; ++ai)
#pragma unroll
            for (int m = 0; m < 4; ++m) { bf16_t* rowp = out + (size_t)(ai * HALF + m * 16) * E_DM;
#pragma unroll
                for (int bj = 0; bj < 2; ++bj) { const f32x4 v0 = acc[ai][bj][m][0], v1 = acc[ai][bj][m][1];
                    u32x4 w; w.x = cvt_pk_bf16(v0[0], v0[1]); w.y = cvt_pk_bf16(v0[2], v0[3]); w.z = cvt_pk_bf16(v1[0], v1[1]); w.w = cvt_pk_bf16(v1[2], v1[3]);
                    *(u32x4*)(rowp + bj * HALF) = w; } }
    }
};
struct EpiLatCtx {
    static constexpr bool PERM = true, AFTER_DRAIN = false;
    EpiDelta lat; EpiPartial ctx;
    __device__ __forceinline__ void operator()(const f32x4 (&acc)[2][2][4][2], const Unit& u, int wr, int wc, int fr, int fq) const {
        if (u.pm < 64) lat(acc, u, wr, wc, fr, fq);
        else { Unit v = u; v.pm = u.pm - 64; ctx(acc, v, wr, wc, fr, fq); }
    }
};
struct EpiF1 {
    static constexpr bool PERM = true, AFTER_DRAIN = false;
    bf16_t* Ct; bf16_t* Ctc;
    __device__ __forceinline__ void operator()(const f32x4 (&acc)[2][2][4][2], const Unit& u, int wr, int wc, int fr, int fq) const {
        const int row0 = u.pm * BM + wr * 64 + fr, cw = wc * 32 + 8 * fq;
#pragma unroll
        for (int ai = 0; ai < 2; ++ai)
#pragma unroll
            for (int m = 0; m < 4; ++m) { const int mr = row0 + ai * HALF + m * 16, type = mr >> 9, n = mr & 511;
                bf16_t* rowp = u.pn < 64 ? Ct + (((size_t)((u.pn >> 3) * 512 + n)) * 2 + type) * 2048 + (u.pn & 7) * 256 + cw
                                         : Ctc + (((size_t)((u.pn - 64) * 512 + n)) * 2 + type) * 256 + cw;
#pragma unroll
                for (int bj = 0; bj < 2; ++bj) { const f32x4 v0 = acc[ai][bj][m][0], v1 = acc[ai][bj][m][1];
                    u32x4 w; w.x = cvt_pk_bf16(v0[0], v0[1]); w.y = cvt_pk_bf16(v0[2], v0[3]); w.z = cvt_pk_bf16(v1[0], v1[1]); w.w = cvt_pk_bf16(v1[2], v1[3]);
                    *(u32x4*)(rowp + bj * HALF) = w; } }
    }
};
struct EpiF2 {
    static constexpr bool PERM = true, AFTER_DRAIN = false;
    bf16_t* O; int rowbase, rows_per_b;
    __device__ __forceinline__ void operator()(const f32x4 (&acc)[2][2][4][2], const Unit& u, int wr, int wc, int fr, int fq) const {
        const int row0 = rowbase + (u.pn >> 1) * rows_per_b + u.pm * BM + wr * 64 + fr, col0 = 1536 + (u.pn & 1) * 256 + wc * 32 + 8 * fq;
#pragma unroll
        for (int ai = 0; ai < 2; ++ai)
#pragma unroll
            for (int m = 0; m < 4; ++m) { bf16_t* rowp = O + (size_t)(row0 + ai * HALF + m * 16) * E_DM + col0;
#pragma unroll
                for (int bj = 0; bj < 2; ++bj) { const f32x4 v0 = acc[ai][bj][m][0], v1 = acc[ai][bj][m][1];
                    u32x4 w; w.x = cvt_pk_bf16(v0[0], v0[1]); w.y = cvt_pk_bf16(v0[2], v0[3]); w.z = cvt_pk_bf16(v1[0], v1[1]); w.w = cvt_pk_bf16(v1[2], v1[3]);
                    *(u32x4*)(rowp + bj * HALF) = w; } }
    }
};
struct EpiPartF32 {
    static constexpr bool PERM = true, AFTER_DRAIN = false, DRAINED = false;
    float* part; int rows, ld;
    __device__ __forceinline__ void operator()(const f32x4 (&acc)[2][2][4][2], const Unit& u, int wr, int wc, int fr, int fq) const {
        float* out = part + ((size_t)u.ks * rows + (size_t)u.pm * BM + wr * 64 + fr) * ld + u.pn * BM + wc * 32 + 8 * fq;
#pragma unroll
        for (int ai = 0; ai < 2; ++ai)
#pragma unroll
            for (int m = 0; m < 4; ++m) { float* rowp = out + (size_t)(ai * HALF + m * 16) * ld;
#pragma unroll
                for (int bj = 0; bj < 2; ++bj) { *(f32x4*)(rowp + bj * HALF) = acc[ai][bj][m][0]; *(f32x4*)(rowp + bj * HALF + 4) = acc[ai][bj][m][1]; } }
    }
};
struct EpiRopeQ {
    static constexpr bool PERM = false, AFTER_DRAIN = false;
    bf16_t* Q; int ldc; const float* rope;
    __device__ __forceinline__ void operator()(const f32x4 (&acc)[2][2][4][2], const Unit& u, int wr, int wc, int fr, int fq) const {
        const int row0 = u.pm * BM + wr * 64 + fr;
#pragma unroll
        for (int bj = 0; bj < 2; ++bj) { const int cg = u.pn * BM + bj * HALF + wc * 32, within = cg % 192; const bool roped = within >= 128 && u.pm < 64; const int half = (within - 128) >> 5;
#pragma unroll
            for (int ai = 0; ai < 2; ++ai)
#pragma unroll
                for (int m = 0; m < 4; ++m) { const int row = row0 + ai * HALF + m * 16, s = row & 2047, pos = half ? (s & 63) : (s >> 6);
                    f32x4 x1 = acc[ai][bj][m][0], x2 = acc[ai][bj][m][1];
                    if (roped) { const f32x4 cs = *(const f32x4*)(rope + pos * 32 + 4 * fq), sn = *(const f32x4*)(rope + pos * 32 + 16 + 4 * fq);
                        const f32x4 o1 = x1 * cs - x2 * sn, o2 = x1 * sn + x2 * cs; x1 = o1; x2 = o2; }
                    bf16_t* p = Q + (size_t)row * ldc + cg + 4 * fq;
                    u32x2 w1, w2; w1.x = cvt_pk_bf16(x1[0], x1[1]); w1.y = cvt_pk_bf16(x1[2], x1[3]); w2.x = cvt_pk_bf16(x2[0], x2[1]); w2.y = cvt_pk_bf16(x2[2], x2[3]);
                    *(u32x2*)p = w1; *(u32x2*)(p + 16) = w2; } }
    }
};

template <class Epi, class Sched, bool ALIGN_EPI = false, bool SP2 = false>
__device__ __forceinline__ void gemm_phase(PG8_LAS unsigned char* lds, const Gemm g, const Sched& S, const Epi& E) {
    int tid_ = threadIdx.x; asm volatile("" : "+v"(tid_));
    const int tid = tid_, wid = __builtin_amdgcn_readfirstlane(tid >> 6), lane = tid & 63, wr = wid >> 2, wc = wid & 3, fr = lane & 15, fq = lane >> 4;
    const int K = g.K, nt0 = K / BK;
    unsigned voffA[2], voffB[2];
#pragma unroll
    for (int i = 0; i < 2; ++i) { int R, C; stage_rc(tid * 16 + i * 8192, R, C); const int Rb = Epi::PERM ? ((R & ~31) + perm32(R & 31)) : R;
        voffA[i] = (unsigned)(R * g.lda + C) * 2u; voffB[i] = (unsigned)(Rb * g.ldb + C) * 2u; }
    const size_t kstepA = (size_t)g.ksA, kstepB = (size_t)g.ksB;
    const size_t hstepA = (size_t)HALF * g.lda * 2, hstepB = (size_t)HALF * g.ldb * 2;
    const size_t tstepA = g.tsA, tstepB = g.tsB;
    const unsigned ldsw = (unsigned)wid * 1024u;
    const int aoff = lds_byte(wr * 64 + fr, fq * 8), boff = lds_byte(wc * 32 + fr, fq * 8);
#define PG8_SA(b, h) (((b) * 2 + (h)) * HTB)
#define PG8_SB(b, h) ((4 + (b) * 2 + (h)) * HTB)
#define PG8_STAGE(bufoff, gbase, voff) do { _Pragma("unroll") for (int _i = 0; _i < 2; ++_i) \
        __builtin_amdgcn_global_load_lds((const unsigned*)((const char*)(gbase) + (voff)[_i]), (PG8_LAS unsigned*)(lds + (bufoff) + ldsw + _i * 8192), 16, 0, 0); } while (0)
#define PG8_LDA(dst, b, h) do { _Pragma("unroll") for (int m = 0; m < 4; ++m) _Pragma("unroll") for (int k = 0; k < 2; ++k) dst[m][k] = *(const PG8_LAS bf16x8*)(lds + PG8_SA(b, h) + aoff + m * 2048 + k * 1024); } while (0)
#define PG8_LDB(dst, b, h) do { _Pragma("unroll") for (int n = 0; n < 2; ++n) _Pragma("unroll") for (int k = 0; k < 2; ++k) dst[n][k] = *(const PG8_LAS bf16x8*)(lds + PG8_SB(b, h) + boff + n * 2048 + k * 1024); } while (0)
#define PG8_MMA(ai, bj, At, Bt) do { __builtin_amdgcn_s_setprio(1); _Pragma("unroll") for (int m = 0; m < 4; ++m) _Pragma("unroll") for (int n = 0; n < 2; ++n) _Pragma("unroll") for (int k = 0; k < 2; ++k) \
        acc[ai][bj][m][n] = __builtin_amdgcn_mfma_f32_16x16x32_bf16(Bt[n][k], At[m][k], acc[ai][bj][m][n], 0, 0, 0); __builtin_amdgcn_s_setprio(0); } while (0)
#define PG8_WAIT_V(n) asm volatile("s_waitcnt vmcnt(" #n ")" ::: "memory")
#define PG8_WAIT_L(n) asm volatile("s_waitcnt lgkmcnt(" #n ")" ::: "memory")
#define PG8_BAR __builtin_amdgcn_s_barrier()
#define PG8_SCHED __builtin_amdgcn_sched_barrier(0)
    Unit cur, nxt; int ui = 0;
    if (!S.next(0, cur)) return;
    f32x4 acc[2][2][4][2];
#pragma unroll
    for (int a = 0; a < 2; ++a)
#pragma unroll
        for (int b = 0; b < 2; ++b)
#pragma unroll
            for (int m = 0; m < 4; ++m)
#pragma unroll
                for (int n = 0; n < 2; ++n) acc[a][b][m][n] = (f32x4){0.f, 0.f, 0.f, 0.f};
    bf16x8 At[4][2], B0[2][2], B1[2][2];
    const char* cA = (const char*)g.A + (size_t)cur.pm * tstepA + cur.koA; const char* cB = (const char*)g.Bt + (size_t)cur.pn * tstepB + cur.koB;
    S.a_ready(cur);
    if constexpr (SP2) {
        PG8_STAGE(PG8_SB(0, 0), cB, voffB); PG8_STAGE(PG8_SB(0, 1), cB + hstepB, voffB); PG8_STAGE(PG8_SA(0, 0), cA, voffA); PG8_STAGE(PG8_SA(0, 1), cA + hstepA, voffA);
        if (wr == 1) PG8_BAR;
        PG8_WAIT_V(2); PG8_BAR;
        PG8_STAGE(PG8_SB(1, 0), cB + kstepB, voffB); PG8_STAGE(PG8_SA(1, 0), cA + kstepA, voffA); PG8_STAGE(PG8_SB(1, 1), cB + hstepB + kstepB, voffB);
        PG8_WAIT_V(6); PG8_BAR;
    } else {
        PG8_STAGE(PG8_SB(0, 0), cB, voffB); PG8_STAGE(PG8_SA(0, 0), cA, voffA); PG8_STAGE(PG8_SB(0, 1), cB + hstepB, voffB); PG8_STAGE(PG8_SA(0, 1), cA + hstepA, voffA);
        if (wr == 1) PG8_BAR;
        PG8_WAIT_V(4); PG8_BAR;
        PG8_STAGE(PG8_SB(1, 0), cB + kstepB, voffB); PG8_STAGE(PG8_SA(1, 0), cA + kstepA, voffA); PG8_STAGE(PG8_SB(1, 1), cB + hstepB + kstepB, voffB);
        PG8_WAIT_V(6); PG8_BAR;
    }
    for (;;) {
        const bool has_next = S.next(ui + 1, nxt);
        const char* nA = has_next ? (const char*)g.A + (size_t)nxt.pm * tstepA + nxt.koA : cA; const char* nB = has_next ? (const char*)g.Bt + (size_t)nxt.pn * tstepB + nxt.koB : cB;
        const int nt = cur.nt ? cur.nt : nt0;
#pragma nounroll
        for (int t = 0; t < nt; t += 2) {
            const bool last = (t == nt - 2);
            const char* a1 = cA + (size_t)(t + 1) * kstepA;
            const char* a2 = last ? nA : cA + (size_t)(t + 2) * kstepA; const char* b2 = last ? nB : cB + (size_t)(t + 2) * kstepB;
            const char* a3 = a2 + kstepA; const char* b3 = b2 + kstepB;
            if (last && has_next) S.a_ready(nxt);
            if constexpr (SP2) {
            PG8_LDB(B0, 0, 0); PG8_LDB(B1, 0, 1); PG8_SCHED; PG8_LDA(At, 0, 0); PG8_STAGE(PG8_SA(1, 1), a1 + hstepA, voffA);
            PG8_WAIT_V(8); PG8_WAIT_L(0); PG8_BAR; PG8_MMA(0, 0, At, B0); PG8_MMA(0, 1, At, B1); PG8_BAR; PG8_SCHED;
            PG8_LDA(At, 0, 1); PG8_STAGE(PG8_SB(0, 0), b2, voffB); PG8_STAGE(PG8_SB(0, 1), b2 + hstepB, voffB); PG8_STAGE(PG8_SA(0, 0), a2, voffA);
            PG8_WAIT_V(8); PG8_WAIT_L(0); PG8_BAR; PG8_MMA(1, 0, At, B0); PG8_MMA(1, 1, At, B1); PG8_BAR; PG8_SCHED;
            PG8_LDB(B0, 1, 0); PG8_LDB(B1, 1, 1); PG8_SCHED; PG8_LDA(At, 1, 0); PG8_STAGE(PG8_SA(0, 1), a2 + hstepA, voffA);
            PG8_WAIT_V(8); PG8_WAIT_L(0); PG8_BAR; PG8_MMA(0, 0, At, B0); PG8_MMA(0, 1, At, B1); PG8_BAR; PG8_SCHED;
            PG8_LDA(At, 1, 1); PG8_STAGE(PG8_SB(1, 0), b3, voffB); PG8_STAGE(PG8_SB(1, 1), b3 + hstepB, voffB); PG8_STAGE(PG8_SA(1, 0), a3, voffA);
            PG8_WAIT_V(8); PG8_WAIT_L(0); PG8_BAR; PG8_MMA(1, 0, At, B0); PG8_MMA(1, 1, At, B1); PG8_BAR; PG8_SCHED;
            } else {
            PG8_LDB(B0, 0, 0); PG8_SCHED; PG8_LDA(At, 0, 0); PG8_STAGE(PG8_SA(1, 1), a1 + hstepA, voffA);
            PG8_WAIT_L(8); PG8_BAR; PG8_WAIT_L(0); PG8_MMA(0, 0, At, B0); PG8_BAR; PG8_SCHED;
            PG8_LDB(B1, 0, 1); PG8_STAGE(PG8_SB(0, 0), b2, voffB);
            PG8_BAR; PG8_WAIT_L(0); PG8_MMA(0, 1, At, B1); PG8_BAR;
            PG8_LDA(At, 0, 1); PG8_STAGE(PG8_SA(0, 0), a2, voffA);
            PG8_BAR; PG8_WAIT_L(0); PG8_MMA(1, 0, At, B0); PG8_BAR; PG8_SCHED;
            PG8_STAGE(PG8_SB(0, 1), b2 + hstepB, voffB);
            PG8_WAIT_V(6); PG8_BAR; PG8_MMA(1, 1, At, B1); PG8_BAR;
            PG8_LDB(B0, 1, 0); PG8_SCHED; PG8_LDA(At, 1, 0); PG8_STAGE(PG8_SA(0, 1), a2 + hstepA, voffA);
            PG8_WAIT_L(8); PG8_BAR; PG8_WAIT_L(0); PG8_MMA(0, 0, At, B0); PG8_BAR; PG8_SCHED;
            PG8_LDB(B1, 1, 1); PG8_STAGE(PG8_SB(1, 0), b3, voffB);
            PG8_BAR; PG8_WAIT_L(0); PG8_MMA(0, 1, At, B1); PG8_BAR;
            PG8_LDA(At, 1, 1); PG8_STAGE(PG8_SA(1, 0), a3, voffA);
            PG8_BAR; PG8_WAIT_L(0); PG8_MMA(1, 0, At, B0); PG8_BAR; PG8_SCHED;
            PG8_STAGE(PG8_SB(1, 1), b3 + hstepB, voffB);
            PG8_WAIT_V(6); PG8_BAR; PG8_MMA(1, 1, At, B1); PG8_BAR;
            }
        }
        if constexpr (ALIGN_EPI) { if (wr == 0) PG8_BAR; }
        if constexpr (!Epi::AFTER_DRAIN) { E(acc, cur, wr, wc, fr, fq); S.done(cur); }
        if (!has_next) break;
#pragma unroll
        for (int a = 0; a < 2; ++a)
#pragma unroll
            for (int b = 0; b < 2; ++b)
#pragma unroll
                for (int m = 0; m < 4; ++m)
#pragma unroll
                    for (int n = 0; n < 2; ++n) acc[a][b][m][n] = (f32x4){0.f, 0.f, 0.f, 0.f};
        cur = nxt; cA = nA; cB = nB; ++ui;
        if constexpr (ALIGN_EPI) { if (wr == 1) PG8_BAR; }
    }
    PG8_WAIT_V(0);
    if constexpr (!ALIGN_EPI) { if (wr == 0) PG8_BAR; }
    PG8_BAR;
    if constexpr (Epi::AFTER_DRAIN) { E.fused(acc, cur, wr, wc, fr, fq, lds, wid, lane); S.done(cur); }
#undef PG8_SA
#undef PG8_SB
#undef PG8_STAGE
#undef PG8_LDA
#undef PG8_LDB
#undef PG8_MMA
#undef PG8_WAIT_V
#undef PG8_WAIT_L
#undef PG8_BAR
#undef PG8_SCHED
}
}

#define GAS __attribute__((address_space(1)))
#define LAS __attribute__((address_space(3)))
typedef unsigned short bf16;
typedef unsigned v4u __attribute__((ext_vector_type(4)));
typedef float f32x4 __attribute__((ext_vector_type(4)));
typedef short bf16x8 __attribute__((ext_vector_type(8)));
typedef GAS unsigned gu32;
typedef GAS unsigned long long gu64;
#define RLX_AGENT __ATOMIC_RELAXED, __HIP_MEMORY_SCOPE_AGENT
#define LDS_WAIT() asm volatile("s_waitcnt lgkmcnt(0)" ::: "memory")
#define VM_WAIT() asm volatile("s_waitcnt vmcnt(0)" ::: "memory")
__device__ __forceinline__ unsigned long long rt() { return __builtin_amdgcn_s_memrealtime(); }
__device__ __forceinline__ unsigned f2bf(float f) { unsigned u = __builtin_bit_cast(unsigned, f); return (u + 0x7fffu + ((u >> 16) & 1u)) >> 16; }
__device__ __forceinline__ unsigned pk2(float lo, float hi) { return f2bf(lo) | (f2bf(hi) << 16); }

#define XB_TMO      128
#define XB_XCNT(j)  (256  + 64 * (j))
#define XB_XSUB(j)  (1280 + 64 * (j))
#define XB_XGEN(j)  (2304 + 64 * (j))
#define XB_TOP      3328
#define XB_TOPGEN   3392
#define XCD_BAR_WORDS 3456
#define XB_SPIN_CAP (1u << 18)

__device__ __forceinline__ unsigned xb_ld(unsigned* p)              { return __hip_atomic_load(p, __ATOMIC_RELAXED, __HIP_MEMORY_SCOPE_AGENT); }
__device__ __forceinline__ unsigned xb_add(unsigned* p, unsigned v) { return __hip_atomic_fetch_add(p, v, __ATOMIC_RELAXED, __HIP_MEMORY_SCOPE_AGENT); }
__device__ __forceinline__ unsigned xb_xcc_id() { return (unsigned)__builtin_amdgcn_s_getreg((3 << 11) | 20) & 0xFu; }
#define XB_SPIN(cond, bar) do { unsigned _sp = 0; while (cond) { __builtin_amdgcn_s_sleep(1); \
    if ((++_sp & 255u) == 0u) { if (xb_ld(&(bar)[XB_TMO])) break; if (_sp > XB_SPIN_CAP) { atomicAdd(&(bar)[XB_TMO], 1u); break; } } } } while (0)

struct XcdBarrier {
    unsigned* bar; unsigned x;
    volatile LAS unsigned* st;
};

__device__ __forceinline__ XcdBarrier xcd_barrier_post(unsigned* bar, volatile LAS unsigned* st) {
    XcdBarrier b; b.bar = bar; b.x = xb_xcc_id(); b.st = st;
    if (threadIdx.x == 0) st[2] = xb_add(&bar[XB_XCNT(b.x)], 1u);
    return b;
}
__device__ __forceinline__ void xcd_barrier_complete(unsigned* bar, unsigned x, unsigned& nloc, unsigned& nx) {
    const unsigned G = gridDim.x * gridDim.y * gridDim.z;
    unsigned sum, cnt, mine, sp = 0u;
    for (;;) {
        sum = 0u; cnt = 0u; mine = 0u;
#pragma unroll
        for (unsigned j = 0; j < 16; ++j) { const unsigned c = xb_ld(&bar[XB_XCNT(j)]); sum += c; cnt += (c > 0u) ? 1u : 0u; mine = (j == x) ? c : mine; }
        if (sum == G) break;
        __builtin_amdgcn_s_sleep(1);
        if ((++sp & 255u) == 0u) { if (xb_ld(&bar[XB_TMO])) break; if (sp > XB_SPIN_CAP) { atomicAdd(&bar[XB_TMO], 1u); break; } }
    }
    nloc = mine > 0u ? mine : 1u; nx = cnt > 0u ? cnt : 1u;
}

__device__ __forceinline__ void xcd_barrier(const XcdBarrier& b) {
    asm volatile("s_waitcnt vmcnt(0)" ::: "memory");
    __syncthreads();
    if (threadIdx.x == 0) {
        unsigned* bar = b.bar; asm volatile("" : "+s"(bar));
        __builtin_amdgcn_s_waitcnt(0);
        unsigned nloc = b.st[0], nx = b.st[1];
        if (nloc == 0u) { xcd_barrier_complete(bar, b.x, nloc, nx); b.st[0] = nloc; b.st[1] = nx; }
        const unsigned old = xb_add(&bar[XB_XSUB(b.x)], 1u);
        const unsigned gen = old / nloc;
        if (old + 1u == (gen + 1u) * nloc) {
            __builtin_amdgcn_fence(__ATOMIC_RELEASE, "agent");
            asm volatile("s_waitcnt vmcnt(0)" ::: "memory");
            const unsigned og = xb_add(&bar[XB_TOP], 1u);
            const unsigned tg = og / nx;
            if (og + 1u == (tg + 1u) * nx) xb_add(&bar[XB_TOPGEN], 1u);
            else XB_SPIN(xb_ld(&bar[XB_TOPGEN]) == tg, bar);
            __builtin_amdgcn_fence(__ATOMIC_ACQUIRE, "agent");
            xb_add(&bar[XB_XGEN(b.x)], 1u);
            asm volatile("s_waitcnt vmcnt(0)" ::: "memory");
        } else {
            XB_SPIN(xb_ld(&bar[XB_XGEN(b.x)]) == gen, bar);
            __builtin_amdgcn_fence(__ATOMIC_ACQUIRE, "agent");
            asm volatile("s_waitcnt vmcnt(0)" ::: "memory");
        }
    }
    __syncthreads();
}

namespace fa {
using bf16 = unsigned short;
using bf16x8 = __attribute__((ext_vector_type(8))) short;
using s16x4  = __attribute__((ext_vector_type(4))) short;
using f32x16 = __attribute__((ext_vector_type(16))) float;
using u32x4  = __attribute__((ext_vector_type(4))) unsigned;
constexpr int NW = 8, QBLK = 32, KVBLK = 64;
constexpr float THR = 8.f;
constexpr int SHM_V = KVBLK * 128 * 2, SHM_KN = KVBLK * 128 * 2, SHM_KR = KVBLK * 64 * 2;
constexpr int OFF_V = 0, OFF_KN = 2 * SHM_V, OFF_KR = OFF_KN + 2 * SHM_KN, OFF_WS = OFF_KR + 2 * SHM_KR, OFF_QR = OFF_WS + NW * 64 * 4, ATTN_LDS = OFF_QR + NW * 4096;
#define FA_KNSWZ(row, colB) ((row) * 256 + ((colB) ^ (((row) & 15) << 4)))
#define FA_KRSWZ(row, c) ((row) * 128 + ((((c) ^ ((row) >> 1)) & 7) << 4))
#define FA_SBAR() __builtin_amdgcn_sched_barrier(0)
__device__ __forceinline__ int crow(int r, int hi) { return (r & 3) + 8 * (r >> 2) + 4 * hi; }
__device__ __forceinline__ unsigned cvtpk(float lo, float hi) { unsigned r; asm volatile("v_cvt_pk_bf16_f32 %0, %1, %2" : "=v"(r) : "v"(lo), "v"(hi)); return r; }

template <int DQK> __device__ __forceinline__ void partialSM(f32x16& p0, f32x16& p1, float& m_reg, float& mn, float& alpha) {
  constexpr float SCALE = (DQK == 192) ? 0.07216878364870322f : 0.125f;
  constexpr float C = SCALE * 1.4426950408889634f;
  float pmax = p0[0];
#pragma unroll
  for (int r = 1; r < 16; ++r) pmax = fmaxf(pmax, p0[r]);
#pragma unroll
  for (int r = 0; r < 16; ++r) pmax = fmaxf(pmax, p1[r]);
  { auto rr = __builtin_amdgcn_permlane32_swap(__float_as_uint(pmax), __float_as_uint(pmax), false, false);
    pmax = fmaxf(__uint_as_float(rr[0]), __uint_as_float(rr[1])); }
  if (__builtin_expect(__all(pmax - m_reg <= THR / SCALE), 1)) { mn = m_reg; alpha = 1.f; }
  else { mn = fmaxf(m_reg, pmax); alpha = __builtin_amdgcn_exp2f((m_reg - mn) * C); m_reg = mn; }
  const float mnC = -mn * C;
#pragma unroll
  for (int r = 0; r < 16; ++r) p0[r] = fmaf(p0[r], C, mnC);
#pragma unroll
  for (int r = 0; r < 16; ++r) p1[r] = fmaf(p1[r], C, mnC);
#pragma unroll
  for (int r = 0; r < 16; ++r) p0[r] = __builtin_amdgcn_exp2f(p0[r]);
}
__device__ __forceinline__ void finishSM(f32x16& p0, f32x16& p1, float alpha, float& l_reg, bf16x8& pa0, bf16x8& pa1, bf16x8& pa2, bf16x8& pa3) {
#pragma unroll
  for (int r = 0; r < 16; ++r) p1[r] = __builtin_amdgcn_exp2f(p1[r]);
  float ps = 0;
#pragma unroll
  for (int r = 0; r < 16; ++r) ps += p0[r];
#pragma unroll
  for (int r = 0; r < 16; ++r) ps += p1[r];
  { auto rr = __builtin_amdgcn_permlane32_swap(__float_as_uint(ps), __float_as_uint(ps), false, false);
    ps = __uint_as_float(rr[0]) + __uint_as_float(rr[1]); }
  l_reg = l_reg * alpha + ps;
#define FA_PK4(P, BASE, OUT) do { unsigned a0 = cvtpk(P[BASE + 0], P[BASE + 1]), a1 = cvtpk(P[BASE + 2], P[BASE + 3]);   \
    unsigned b0 = cvtpk(P[BASE + 4], P[BASE + 5]), b1 = cvtpk(P[BASE + 6], P[BASE + 7]);                              \
    auto r0 = __builtin_amdgcn_permlane32_swap(a0, b0, false, false); auto r1 = __builtin_amdgcn_permlane32_swap(a1, b1, false, false); \
    u32x4 w = {r0[0], r1[0], r0[1], r1[1]}; OUT = *reinterpret_cast<bf16x8*>(&w); } while (0)
  FA_PK4(p0, 0, pa0); FA_PK4(p0, 8, pa1); FA_PK4(p1, 0, pa2); FA_PK4(p1, 8, pa3);
#undef FA_PK4
}
template <int DQK> __device__ __forceinline__ void qkt(f32x16& p0, f32x16& p1, const char* Kn, const char* Kr, const bf16x8* qr, const char* Kn_qbase, int qoff, int r32, int hi) {
  p0 = f32x16{}; p1 = f32x16{};
  constexpr int NKN = (DQK == 192) ? 8 : 0;
#pragma unroll
  for (int d0 = 0; d0 < NKN; ++d0) { const int cb = (d0 * 16 + hi * 8) * 2;
    const bf16x8 b0 = *reinterpret_cast<const bf16x8*>(Kn + FA_KNSWZ(r32, cb));
    const bf16x8 b1 = *reinterpret_cast<const bf16x8*>(Kn + FA_KNSWZ(32 + r32, cb));
    p0 = __builtin_amdgcn_mfma_f32_32x32x16_bf16(b0, qr[d0], p0, 0, 0, 0);
    p1 = __builtin_amdgcn_mfma_f32_32x32x16_bf16(b1, qr[d0], p1, 0, 0, 0); }
  int qo = qoff; asm volatile("" : "+v"(qo));
#pragma unroll
  for (int d0 = 0; d0 < 4; ++d0) { const int c = 2 * d0 + hi;
    const bf16x8 b0 = *reinterpret_cast<const bf16x8*>(Kr + FA_KRSWZ(r32, c));
    const bf16x8 b1 = *reinterpret_cast<const bf16x8*>(Kr + FA_KRSWZ(32 + r32, c));
    bf16x8 q; if constexpr (NKN) q = *reinterpret_cast<const bf16x8*>(Kn_qbase + qo + d0 * 1024); else q = qr[d0];
    p0 = __builtin_amdgcn_mfma_f32_32x32x16_bf16(b0, q, p0, 0, 0, 0);
    p1 = __builtin_amdgcn_mfma_f32_32x32x16_bf16(b1, q, p1, 0, 0, 0); }
}
template <int DQK> __device__ __forceinline__ void qkt_r(f32x16& p0, f32x16& p1, const char* Kn, const char* Kr, const bf16x8* qr, int r32, int hi) {
  p0 = f32x16{}; p1 = f32x16{};
  constexpr int NKN = (DQK == 192) ? 8 : 0;
#pragma unroll
  for (int d0 = 0; d0 < NKN; ++d0) { const int cb = (d0 * 16 + hi * 8) * 2;
    const bf16x8 b0 = *reinterpret_cast<const bf16x8*>(Kn + FA_KNSWZ(r32, cb));
    const bf16x8 b1 = *reinterpret_cast<const bf16x8*>(Kn + FA_KNSWZ(32 + r32, cb));
    p0 = __builtin_amdgcn_mfma_f32_32x32x16_bf16(b0, qr[d0], p0, 0, 0, 0);
    p1 = __builtin_amdgcn_mfma_f32_32x32x16_bf16(b1, qr[d0], p1, 0, 0, 0); }
#pragma unroll
  for (int d0 = 0; d0 < 4; ++d0) { const int c = 2 * d0 + hi;
    const bf16x8 b0 = *reinterpret_cast<const bf16x8*>(Kr + FA_KRSWZ(r32, c));
    const bf16x8 b1 = *reinterpret_cast<const bf16x8*>(Kr + FA_KRSWZ(32 + r32, c));
    p0 = __builtin_amdgcn_mfma_f32_32x32x16_bf16(b0, qr[NKN + d0], p0, 0, 0, 0);
    p1 = __builtin_amdgcn_mfma_f32_32x32x16_bf16(b1, qr[NKN + d0], p1, 0, 0, 0); }
}
__device__ __forceinline__ int v_st(int k, int c) { const int kk = (k & ~0xC) | ((k & 4) << 1) | ((k & 8) >> 1); return ((kk >> 3) * 4 + (c >> 5)) * 512 + ((kk & 7) * 32 + (c & 31)) * 2; }
__device__ __forceinline__ int v_rd_base(int lane) { return ((lane & 3) << 3) | (((lane >> 2) & 3) << 6) | (((lane >> 4) & 1) << 5) | (((lane >> 5) & 1) << 8); }
constexpr int v_rd_off(int d0, int ks, int half) { return d0 * 512 + ks * 4096 + half * 2048; }
template <int OFF> __device__ __forceinline__ s16x4 tr_read(int vb) {
  s16x4 r; asm volatile("ds_read_b64_tr_b16 %0, %1 offset:%2" : "=&v"(r) : "v"(vb), "i"(OFF) : "memory"); return r;
}
template <int D0> __device__ __forceinline__ void pv_one(f32x16& od, int vb, bf16x8 pa0, bf16x8 pa1, bf16x8 pa2, bf16x8 pa3) {
  const s16x4 l0 = tr_read<v_rd_off(D0, 0, 0)>(vb), h0 = tr_read<v_rd_off(D0, 0, 1)>(vb), l1 = tr_read<v_rd_off(D0, 1, 0)>(vb), h1 = tr_read<v_rd_off(D0, 1, 1)>(vb);
  const s16x4 l2 = tr_read<v_rd_off(D0, 2, 0)>(vb), h2 = tr_read<v_rd_off(D0, 2, 1)>(vb), l3 = tr_read<v_rd_off(D0, 3, 0)>(vb), h3 = tr_read<v_rd_off(D0, 3, 1)>(vb);
  asm volatile("s_waitcnt lgkmcnt(0)" ::: "memory"); FA_SBAR();
#define FA_PK(L, H) (bf16x8){L[0], L[1], L[2], L[3], H[0], H[1], H[2], H[3]}
  od = __builtin_amdgcn_mfma_f32_32x32x16_bf16(pa0, FA_PK(l0, h0), od, 0, 0, 0);
  od = __builtin_amdgcn_mfma_f32_32x32x16_bf16(pa1, FA_PK(l1, h1), od, 0, 0, 0);
  od = __builtin_amdgcn_mfma_f32_32x32x16_bf16(pa2, FA_PK(l2, h2), od, 0, 0, 0);
  od = __builtin_amdgcn_mfma_f32_32x32x16_bf16(pa3, FA_PK(l3, h3), od, 0, 0, 0);
#undef FA_PK
}
#define FA_TRLOAD(D0, L0, H0, L1, H1, L2, H2, L3, H3) do { L0 = tr_read<v_rd_off(D0, 0, 0)>(vb); H0 = tr_read<v_rd_off(D0, 0, 1)>(vb); L1 = tr_read<v_rd_off(D0, 1, 0)>(vb); H1 = tr_read<v_rd_off(D0, 1, 1)>(vb); \
    L2 = tr_read<v_rd_off(D0, 2, 0)>(vb); H2 = tr_read<v_rd_off(D0, 2, 1)>(vb); L3 = tr_read<v_rd_off(D0, 3, 0)>(vb); H3 = tr_read<v_rd_off(D0, 3, 1)>(vb); } while (0)
#define FA_PKV(L, H) (bf16x8){L[0], L[1], L[2], L[3], H[0], H[1], H[2], H[3]}
#define FA_PVMMA(OD, L0, H0, L1, H1, L2, H2, L3, H3) do { OD = __builtin_amdgcn_mfma_f32_32x32x16_bf16(pa0, FA_PKV(L0, H0), OD, 0, 0, 0); OD = __builtin_amdgcn_mfma_f32_32x32x16_bf16(pa1, FA_PKV(L1, H1), OD, 0, 0, 0); \
    OD = __builtin_amdgcn_mfma_f32_32x32x16_bf16(pa2, FA_PKV(L2, H2), OD, 0, 0, 0); OD = __builtin_amdgcn_mfma_f32_32x32x16_bf16(pa3, FA_PKV(L3, H3), OD, 0, 0, 0); } while (0)
__device__ __forceinline__ void pv_d0_piped(f32x16* o, int vb, bf16x8 pa0, bf16x8 pa1, bf16x8 pa2, bf16x8 pa3) {
  s16x4 al0, ah0, al1, ah1, al2, ah2, al3, ah3, bl0, bh0, bl1, bh1, bl2, bh2, bl3, bh3;
  FA_TRLOAD(0, al0, ah0, al1, ah1, al2, ah2, al3, ah3);
  FA_TRLOAD(1, bl0, bh0, bl1, bh1, bl2, bh2, bl3, bh3);
  asm volatile("s_waitcnt lgkmcnt(8)" ::: "memory"); FA_SBAR();
  FA_PVMMA(o[0], al0, ah0, al1, ah1, al2, ah2, al3, ah3); FA_SBAR();
  FA_TRLOAD(2, al0, ah0, al1, ah1, al2, ah2, al3, ah3);
  asm volatile("s_waitcnt lgkmcnt(8)" ::: "memory"); FA_SBAR();
  FA_PVMMA(o[1], bl0, bh0, bl1, bh1, bl2, bh2, bl3, bh3); FA_SBAR();
  FA_TRLOAD(3, bl0, bh0, bl1, bh1, bl2, bh2, bl3, bh3);
  asm volatile("s_waitcnt lgkmcnt(8)" ::: "memory"); FA_SBAR();
  FA_PVMMA(o[2], al0, ah0, al1, ah1, al2, ah2, al3, ah3); FA_SBAR();
  asm volatile("s_waitcnt lgkmcnt(0)" ::: "memory"); FA_SBAR();
  FA_PVMMA(o[3], bl0, bh0, bl1, bh1, bl2, bh2, bl3, bh3);
}
#undef FA_TRLOAD
#undef FA_PVMMA
#undef FA_PKV
__device__ __forceinline__ void pv_d0(f32x16* o, int vb, bf16x8 pa0, bf16x8 pa1, bf16x8 pa2, bf16x8 pa3) {
  pv_one<0>(o[0], vb, pa0, pa1, pa2, pa3); pv_one<1>(o[1], vb, pa0, pa1, pa2, pa3); pv_one<2>(o[2], vb, pa0, pa1, pa2, pa3); pv_one<3>(o[3], vb, pa0, pa1, pa2, pa3);
}
template <int DQK> __device__ __forceinline__ void pv_sm(f32x16* o, int vb, bf16x8 pa0, bf16x8 pa1, bf16x8 pa2, bf16x8 pa3, f32x16& p0, f32x16& p1, float& m_reg, float& mn, float& alpha) {
  constexpr float SCALE = (DQK == 192) ? 0.07216878364870322f : 0.125f;
  constexpr float C = SCALE * 1.4426950408889634f;
#define FA_PKV2(L, H) (bf16x8){L[0], L[1], L[2], L[3], H[0], H[1], H[2], H[3]}
#define FA_PVBLK(D0, SLICE) do { \
    const s16x4 l0 = tr_read<v_rd_off(D0, 0, 0)>(vb), h0 = tr_read<v_rd_off(D0, 0, 1)>(vb), l1 = tr_read<v_rd_off(D0, 1, 0)>(vb), h1 = tr_read<v_rd_off(D0, 1, 1)>(vb); \
    const s16x4 l2 = tr_read<v_rd_off(D0, 2, 0)>(vb), h2 = tr_read<v_rd_off(D0, 2, 1)>(vb), l3 = tr_read<v_rd_off(D0, 3, 0)>(vb), h3 = tr_read<v_rd_off(D0, 3, 1)>(vb); \
    SLICE \
    asm volatile("s_waitcnt lgkmcnt(0)" ::: "memory"); FA_SBAR(); \
    o[D0] = __builtin_amdgcn_mfma_f32_32x32x16_bf16(pa0, FA_PKV2(l0, h0), o[D0], 0, 0, 0); o[D0] = __builtin_amdgcn_mfma_f32_32x32x16_bf16(pa1, FA_PKV2(l1, h1), o[D0], 0, 0, 0); \
    o[D0] = __builtin_amdgcn_mfma_f32_32x32x16_bf16(pa2, FA_PKV2(l2, h2), o[D0], 0, 0, 0); o[D0] = __builtin_amdgcn_mfma_f32_32x32x16_bf16(pa3, FA_PKV2(l3, h3), o[D0], 0, 0, 0); } while (0)
  float pmax, mnC;
  FA_PVBLK(0, { pmax = p0[0]; _Pragma("unroll") for (int r = 1; r < 16; ++r) pmax = fmaxf(pmax, p0[r]); _Pragma("unroll") for (int r = 0; r < 16; ++r) pmax = fmaxf(pmax, p1[r]);
      auto rr = __builtin_amdgcn_permlane32_swap(__float_as_uint(pmax), __float_as_uint(pmax), false, false); pmax = fmaxf(__uint_as_float(rr[0]), __uint_as_float(rr[1])); });
  FA_PVBLK(1, { if (__builtin_expect(__all(pmax - m_reg <= THR / SCALE), 1)) { mn = m_reg; alpha = 1.f; } else { mn = fmaxf(m_reg, pmax); alpha = __builtin_amdgcn_exp2f((m_reg - mn) * C); m_reg = mn; }
      mnC = -mn * C; _Pragma("unroll") for (int r = 0; r < 16; ++r) p0[r] = fmaf(p0[r], C, mnC); });
  FA_PVBLK(2, { _Pragma("unroll") for (int r = 0; r < 16; ++r) p1[r] = fmaf(p1[r], C, mnC); _Pragma("unroll") for (int r = 0; r < 8; ++r) p0[r] = __builtin_amdgcn_exp2f(p0[r]); });
  FA_PVBLK(3, { _Pragma("unroll") for (int r = 8; r < 16; ++r) p0[r] = __builtin_amdgcn_exp2f(p0[r]); });
#undef FA_PVBLK
#undef FA_PKV2
}
struct Src {
  const bf16* Q; int ldq;
  const bf16* Kn; int ldkn;
  const bf16* Kr; int ldkr;
  const bf16* V; int ldv;
  int seg0, seg1, nkeys;
  void* O; int ldo;
  float lam, omli; const float* subln;
};
template <int DQK, int SDEPTH, int MODE>
__device__ __forceinline__ void attn_unit(const Src& S, char* lds) {
  int tid_ = threadIdx.x; asm volatile("" : "+v"(tid_));
  const int tid = tid_, wid = tid >> 6, lane = tid & 63, r32 = lane & 31, hi = lane >> 5;
  constexpr int NKN = (DQK == 192) ? 8 : 0, NQ = DQK / 16;
  char* V_lds = lds + OFF_V; char* Kn_lds = lds + OFF_KN; char* Kr_lds = lds + OFF_KR;
  float* wsf = (float*)(lds + OFF_WS) + wid * 64; float* li_l = wsf; float* al_l = wsf + 32;
  constexpr int NQR = NKN ? NKN : 4;
  float m_reg = -1e30f, l_reg = 0; f32x16 o[4] = {}; bf16x8 qr[NQR];
  const bf16* Qw = S.Q + (long)(wid * QBLK + r32) * S.ldq + hi * 8;
  const char* Qr_lds = lds + OFF_QR; const int qoff = wid * 4096 + lane * 16;
#pragma unroll
  for (int d0 = 0; d0 < NQR; ++d0) qr[d0] = *reinterpret_cast<const bf16x8*>(Qw + d0 * 16);
  if constexpr (NKN) {
#pragma unroll
    for (int d0 = 0; d0 < 4; ++d0) *(bf16x8*)(lds + OFF_QR + qoff + d0 * 1024) = *reinterpret_cast<const bf16x8*>(Qw + (NKN + d0) * 16);
  }
  const int sr = tid >> 4, sc = (tid & 15) * 8, vst0 = v_st(sr, sc), vst1 = v_st(32 + sr, sc);
  const int krr = tid >> 3, krc = tid & 7;
  const int vb0 = (int)(uintptr_t)V_lds + v_rd_base(lane);
  struct { bf16x8 vs0, vs1, kn0, kn1, kr; } st_[SDEPTH];
#define FA_ROW(k0) ((k0) < 256 ? S.seg0 + (k0) : S.seg1 + ((k0) - 256))
#define FA_SLOAD(i, k0) do { const long R_ = FA_ROW(k0); \
    st_[i].vs0 = *reinterpret_cast<const bf16x8*>(S.V + (R_ + sr) * S.ldv + sc); st_[i].vs1 = *reinterpret_cast<const bf16x8*>(S.V + (R_ + 32 + sr) * S.ldv + sc); \
    if constexpr (NKN) { st_[i].kn0 = *reinterpret_cast<const bf16x8*>(S.Kn + (R_ + sr) * S.ldkn + sc); st_[i].kn1 = *reinterpret_cast<const bf16x8*>(S.Kn + (R_ + 32 + sr) * S.ldkn + sc); } \
    st_[i].kr = *reinterpret_cast<const bf16x8*>(S.Kr + (R_ + krr) * S.ldkr + krc * 8); } while (0)
#define FA_SWRITE(b, i) do { *(bf16x8*)(V_lds + (b) * SHM_V + vst0) = st_[i].vs0; *(bf16x8*)(V_lds + (b) * SHM_V + vst1) = st_[i].vs1; \
    if constexpr (NKN) { *(bf16x8*)(Kn_lds + (b) * SHM_KN + FA_KNSWZ(sr, sc * 2)) = st_[i].kn0; *(bf16x8*)(Kn_lds + (b) * SHM_KN + FA_KNSWZ(32 + sr, sc * 2)) = st_[i].kn1; } \
    *(bf16x8*)(Kr_lds + (b) * SHM_KR + FA_KRSWZ(krr, krc)) = st_[i].kr; } while (0)
#define FA_SWAIT() do { if constexpr (SDEPTH == 2) { if constexpr (NKN) asm volatile("s_waitcnt vmcnt(5)" ::: "memory"); else asm volatile("s_waitcnt vmcnt(3)" ::: "memory"); } \
    else asm volatile("s_waitcnt vmcnt(0)" ::: "memory"); } while (0)
#define FA_RESC(a) do { if (__any((a) < 1.f)) { if (hi == 0) al_l[r32] = (a); asm volatile("s_waitcnt lgkmcnt(0)" ::: "memory"); \
    _Pragma("unroll") for (int d = 0; d < 4; ++d) _Pragma("unroll") for (int r = 0; r < 16; ++r) o[d][r] *= al_l[crow(r, hi)]; } } while (0)
  f32x16 pA0, pA1, pB0, pB1; float mnA, mnB, alA, alB; bf16x8 pa0, pa1, pa2, pa3; const int NT = S.nkeys / KVBLK;
  constexpr int SE = 0, SO = SDEPTH - 1;
  FA_SLOAD(SE, 0); asm volatile("s_waitcnt vmcnt(0)" ::: "memory"); FA_SWRITE(0, SE); __syncthreads();
  qkt<DQK>(pA0, pA1, Kn_lds, Kr_lds, qr, Qr_lds, qoff, r32, hi); partialSM<DQK>(pA0, pA1, m_reg, mnA, alA);
  FA_SLOAD(SO, KVBLK); if constexpr (SDEPTH == 2) { if (2 < NT) FA_SLOAD(SE, 2 * KVBLK); }
  FA_SWAIT(); FA_SWRITE(1, SO); __syncthreads();
  for (int j = 1; j + 1 < NT; j += 2) {
    FA_SBAR(); qkt<DQK>(pB0, pB1, Kn_lds + SHM_KN, Kr_lds + SHM_KR, qr, Qr_lds, qoff, r32, hi);
    finishSM(pA0, pA1, alA, l_reg, pa0, pa1, pa2, pa3); FA_SBAR();
    FA_SLOAD(SO, (j + SDEPTH) * KVBLK); FA_SBAR();
    if constexpr (DQK == 64) pv_d0_piped(o, vb0, pa0, pa1, pa2, pa3); else pv_d0(o, vb0, pa0, pa1, pa2, pa3); partialSM<DQK>(pB0, pB1, m_reg, mnB, alB);
    __syncthreads(); FA_SWAIT(); FA_SWRITE(0, SE);
    FA_RESC(alB); __syncthreads();
    FA_SBAR(); qkt<DQK>(pA0, pA1, Kn_lds, Kr_lds, qr, Qr_lds, qoff, r32, hi);
    finishSM(pB0, pB1, alB, l_reg, pa0, pa1, pa2, pa3); FA_SBAR();
    if (SDEPTH == 1 || j + 3 < NT) FA_SLOAD(SE, (j + 1 + SDEPTH) * KVBLK); FA_SBAR();
    if constexpr (DQK == 64) pv_d0_piped(o, vb0 + SHM_V, pa0, pa1, pa2, pa3); else pv_d0(o, vb0 + SHM_V, pa0, pa1, pa2, pa3); partialSM<DQK>(pA0, pA1, m_reg, mnA, alA);
    __syncthreads(); FA_SWAIT(); FA_SWRITE(1, SO);
    FA_RESC(alA); __syncthreads();
  }
  FA_SBAR(); qkt<DQK>(pB0, pB1, Kn_lds + SHM_KN, Kr_lds + SHM_KR, qr, Qr_lds, qoff, r32, hi);
  finishSM(pA0, pA1, alA, l_reg, pa0, pa1, pa2, pa3); FA_SBAR();
  if constexpr (DQK == 64) pv_d0_piped(o, vb0, pa0, pa1, pa2, pa3); else pv_d0(o, vb0, pa0, pa1, pa2, pa3); partialSM<DQK>(pB0, pB1, m_reg, mnB, alB);
  __syncthreads(); FA_RESC(alB);
  finishSM(pB0, pB1, alB, l_reg, pa0, pa1, pa2, pa3); FA_SBAR();
  if constexpr (DQK == 64) pv_d0_piped(o, vb0 + SHM_V, pa0, pa1, pa2, pa3); else pv_d0(o, vb0 + SHM_V, pa0, pa1, pa2, pa3);
  if (hi == 0) li_l[r32] = l_reg; asm volatile("s_waitcnt lgkmcnt(0)" ::: "memory");
  float rli[16];
#pragma unroll
  for (int r = 0; r < 16; ++r) rli[r] = __builtin_amdgcn_rcpf(li_l[crow(r, hi)]);
  if constexpr (MODE == 0) {
    bf16* Ow = (bf16*)S.O + (long)(wid * QBLK) * S.ldo;
#pragma unroll
    for (int r = 0; r < 16; ++r) { const int orow = crow(r, hi);
#pragma unroll
      for (int d0 = 0; d0 < 4; ++d0) { const float v = o[d0][r] * rli[r]; const float nb = __int_as_float(__builtin_amdgcn_update_dpp(0, __float_as_int(v), 0xB1, 0xF, 0xF, true));
        if ((lane & 1) == 0) *(unsigned*)(Ow + (long)orow * S.ldo + d0 * 32 + r32) = cvtpk(v, nb); } }
  } else if constexpr (MODE == 1) {
    static_assert(DQK == 64, "the parking area overlays the DQK = 192 buffers");
    char* pk = lds + OFF_KN + tid * 64; char* pq = lds + OFF_QR + tid * 64;
#pragma unroll
    for (int d0 = 0; d0 < 4; ++d0) { u32x4 w0, w1;
      w0[0] = cvtpk(o[d0][0] * rli[0], o[d0][1] * rli[1]); w0[1] = cvtpk(o[d0][2] * rli[2], o[d0][3] * rli[3]); w0[2] = cvtpk(o[d0][4] * rli[4], o[d0][5] * rli[5]); w0[3] = cvtpk(o[d0][6] * rli[6], o[d0][7] * rli[7]);
      w1[0] = cvtpk(o[d0][8] * rli[8], o[d0][9] * rli[9]); w1[1] = cvtpk(o[d0][10] * rli[10], o[d0][11] * rli[11]); w1[2] = cvtpk(o[d0][12] * rli[12], o[d0][13] * rli[13]); w1[3] = cvtpk(o[d0][14] * rli[14], o[d0][15] * rli[15]);
      char* p = (d0 < 2 ? pk : pq) + (d0 & 1) * 32; *(u32x4*)p = w0; *(u32x4*)(p + 16) = w1; }
  } else {
    const char* pk = lds + OFF_KN + tid * 64; const char* pq = lds + OFF_QR + tid * 64;
    float ss[16];
#pragma unroll
    for (int r = 0; r < 16; ++r) ss[r] = 0.f;
#pragma unroll
    for (int d0 = 0; d0 < 4; ++d0) { const char* p = (d0 < 2 ? pk : pq) + (d0 & 1) * 32; const u32x4 w0 = *(const u32x4*)p, w1 = *(const u32x4*)(p + 16);
#pragma unroll
      for (int r = 0; r < 16; ++r) { const unsigned w = (r < 8 ? w0[r >> 1] : w1[(r - 8) >> 1]); const float o1 = __uint_as_float((r & 1) ? (w & 0xffff0000u) : (w << 16));
        const float v = o1 - S.lam * (o[d0][r] * rli[r]); o[d0][r] = v; ss[r] += v * v; } }
#pragma unroll
    for (int r = 0; r < 16; ++r) {
#pragma unroll
      for (int sft = 1; sft < 32; sft <<= 1) ss[r] += __shfl_xor(ss[r], sft);
      ss[r] = rsqrtf(ss[r] * (1.0f / 128.0f) + 1e-6f) * S.omli; }
    bf16* Ow = (bf16*)S.O + (long)(wid * QBLK) * S.ldo;
#pragma unroll
    for (int d0 = 0; d0 < 4; ++d0) { const float gsub = S.subln[d0 * 32 + r32];
#pragma unroll
      for (int r = 0; r < 16; ++r) { const int orow = crow(r, hi); const float v = o[d0][r] * ss[r] * gsub; const float nb = __int_as_float(__builtin_amdgcn_update_dpp(0, __float_as_int(v), 0xB1, 0xF, 0xF, true));
        if ((lane & 1) == 0) *(unsigned*)(Ow + (long)orow * S.ldo + d0 * 32 + r32) = cvtpk(v, nb); } }
  }
  __syncthreads();
#undef FA_ROW
#undef FA_SLOAD
#undef FA_SWRITE
#undef FA_SWAIT
#undef FA_RESC
}
template <int DQK, int MODE>
__device__ __forceinline__ void attn_unit_dma(const Src& S, char* lds, __attribute__((address_space(3))) unsigned char* ldsl) {
  int tid_ = threadIdx.x; asm volatile("" : "+v"(tid_));
  const int tid = tid_, wid = __builtin_amdgcn_readfirstlane(tid >> 6), lane = tid & 63, r32 = lane & 31, hi = lane >> 5;
  constexpr int NKN = (DQK == 192) ? 8 : 0, NQ = DQK / 16;
  char* V_lds = lds + OFF_V; char* Kn_lds = lds + OFF_KN; char* Kr_lds = lds + OFF_KR;
  float* wsf = (float*)(lds + OFF_WS) + wid * 64; float* li_l = wsf; float* al_l = wsf + 32;
  constexpr int NQR = NQ;
  float m_reg = -1e30f, l_reg = 0; f32x16 o[4] = {}; bf16x8 qr[NQR];
  const bf16* Qw = S.Q + (long)(wid * QBLK + r32) * S.ldq + hi * 8;
  const char* Qr_lds = lds + OFF_QR; const int qoff = wid * 4096 + lane * 16;
#pragma unroll
  for (int d0 = 0; d0 < NQR; ++d0) qr[d0] = *reinterpret_cast<const bf16x8*>(Qw + d0 * 16);
  const int vb0 = (int)(uintptr_t)V_lds + v_rd_base(lane);
  long offV[2], offKn[2], offKr;
#pragma unroll
  for (int i = 0; i < 2; ++i) { const int sub = 2 * (2 * wid + i) + (lane >> 5), kk = (sub >> 2) * 8 + ((lane & 31) >> 2), key = (kk & ~0xC) | ((kk & 4) << 1) | ((kk & 8) >> 1), c = (sub & 3) * 32 + (lane & 3) * 8;
    offV[i] = (long)key * S.ldv + c;
    const int r = 4 * (2 * wid + i) + (lane >> 4), c16 = (lane & 15) ^ (r & 15); offKn[i] = (long)r * S.ldkn + c16 * 8; }
  { const int r = 8 * wid + (lane >> 3), c = (lane & 7) ^ ((r >> 1) & 7); offKr = (long)r * S.ldkr + c * 8; }
#define FA_ROW(k0) ((k0) < 256 ? S.seg0 + (k0) : S.seg1 + ((k0) - 256))
#define FA_GLDS(gp, off) __builtin_amdgcn_global_load_lds((const unsigned*)(gp), (__attribute__((address_space(3))) unsigned*)(ldsl + (off)), 16, 0, 0)
#define FA_DMA_K(t, b) do { const int t_ = (t) < NT ? (t) : NT - 1; const long R_ = FA_ROW(t_ * KVBLK); \
    if constexpr (NKN) { FA_GLDS(S.Kn + R_ * S.ldkn + offKn[0], OFF_KN + (b) * SHM_KN + (2 * wid) * 1024); FA_GLDS(S.Kn + R_ * S.ldkn + offKn[1], OFF_KN + (b) * SHM_KN + (2 * wid + 1) * 1024); } \
    FA_GLDS(S.Kr + R_ * S.ldkr + offKr, OFF_KR + (b) * SHM_KR + wid * 1024); } while (0)
#define FA_DMA_V(t, b) do { const int t_ = (t) < NT ? (t) : NT - 1; const long R_ = FA_ROW(t_ * KVBLK); \
    FA_GLDS(S.V + R_ * S.ldv + offV[0], OFF_V + (b) * SHM_V + (2 * wid) * 1024); FA_GLDS(S.V + R_ * S.ldv + offV[1], OFF_V + (b) * SHM_V + (2 * wid + 1) * 1024); } while (0)
#define FA_WBAR() do { asm volatile("s_waitcnt vmcnt(0)" ::: "memory"); __builtin_amdgcn_s_barrier(); asm volatile("" ::: "memory"); } while (0)
#define FA_RESC(a) do { if (__any((a) < 1.f)) { if (hi == 0) al_l[r32] = (a); asm volatile("s_waitcnt lgkmcnt(0)" ::: "memory"); \
    _Pragma("unroll") for (int d = 0; d < 4; ++d) _Pragma("unroll") for (int r = 0; r < 16; ++r) o[d][r] *= al_l[crow(r, hi)]; } } while (0)
#define FA_PV(vb) do { if constexpr (DQK == 64) pv_d0_piped(o, vb, pa0, pa1, pa2, pa3); else pv_d0(o, vb, pa0, pa1, pa2, pa3); } while (0)
  f32x16 pA0, pA1, pB0, pB1; float mnA, mnB, alA, alB; bf16x8 pa0, pa1, pa2, pa3; const int NT = S.nkeys / KVBLK;
  FA_DMA_K(0, 0); FA_DMA_V(0, 0); FA_DMA_K(1, 1);
  FA_WBAR();
  qkt_r<DQK>(pA0, pA1, Kn_lds, Kr_lds, qr, r32, hi); partialSM<DQK>(pA0, pA1, m_reg, mnA, alA);
  FA_WBAR(); FA_DMA_V(1, 1); FA_DMA_K(2, 0);
  for (int j = 1; j + 1 < NT; j += 2) {
    FA_SBAR(); qkt_r<DQK>(pB0, pB1, Kn_lds + SHM_KN, Kr_lds + SHM_KR, qr, r32, hi);
    finishSM(pA0, pA1, alA, l_reg, pa0, pa1, pa2, pa3);
    pv_sm<DQK>(o, vb0, pa0, pa1, pa2, pa3, pB0, pB1, m_reg, mnB, alB);
    FA_WBAR(); FA_DMA_V(j + 1, 0); FA_DMA_K(j + 2, 1); FA_RESC(alB);
    FA_SBAR(); qkt_r<DQK>(pA0, pA1, Kn_lds, Kr_lds, qr, r32, hi);
    finishSM(pB0, pB1, alB, l_reg, pa0, pa1, pa2, pa3);
    pv_sm<DQK>(o, vb0 + SHM_V, pa0, pa1, pa2, pa3, pA0, pA1, m_reg, mnA, alA);
    FA_WBAR(); FA_DMA_V(j + 2, 1); FA_DMA_K(j + 3, 0); FA_RESC(alA);
  }
  FA_SBAR(); qkt_r<DQK>(pB0, pB1, Kn_lds + SHM_KN, Kr_lds + SHM_KR, qr, r32, hi);
  finishSM(pA0, pA1, alA, l_reg, pa0, pa1, pa2, pa3); FA_SBAR();
  pv_sm<DQK>(o, vb0, pa0, pa1, pa2, pa3, pB0, pB1, m_reg, mnB, alB);
  FA_WBAR(); FA_RESC(alB);
  finishSM(pB0, pB1, alB, l_reg, pa0, pa1, pa2, pa3); FA_SBAR();
  FA_PV(vb0 + SHM_V);
  if (hi == 0) li_l[r32] = l_reg; asm volatile("s_waitcnt lgkmcnt(0)" ::: "memory");
  float rli[16];
#pragma unroll
  for (int r = 0; r < 16; ++r) rli[r] = __builtin_amdgcn_rcpf(li_l[crow(r, hi)]);
  if constexpr (MODE == 0) {
    bf16* Ow = (bf16*)S.O + (long)(wid * QBLK) * S.ldo;
#pragma unroll
    for (int r = 0; r < 16; ++r) { const int orow = crow(r, hi);
#pragma unroll
      for (int d0 = 0; d0 < 4; ++d0) { const float v = o[d0][r] * rli[r]; const float nb = __int_as_float(__builtin_amdgcn_update_dpp(0, __float_as_int(v), 0xB1, 0xF, 0xF, true));
        if ((lane & 1) == 0) *(unsigned*)(Ow + (long)orow * S.ldo + d0 * 32 + r32) = cvtpk(v, nb); } }
  } else if constexpr (MODE == 1) {
    static_assert(DQK == 64, "the parking area overlays the DQK = 192 buffers");
    char* pk = lds + OFF_KN + tid * 64; char* pq = lds + OFF_QR + tid * 64;
#pragma unroll
    for (int d0 = 0; d0 < 4; ++d0) { u32x4 w0, w1;
      w0[0] = cvtpk(o[d0][0] * rli[0], o[d0][1] * rli[1]); w0[1] = cvtpk(o[d0][2] * rli[2], o[d0][3] * rli[3]); w0[2] = cvtpk(o[d0][4] * rli[4], o[d0][5] * rli[5]); w0[3] = cvtpk(o[d0][6] * rli[6], o[d0][7] * rli[7]);
      w1[0] = cvtpk(o[d0][8] * rli[8], o[d0][9] * rli[9]); w1[1] = cvtpk(o[d0][10] * rli[10], o[d0][11] * rli[11]); w1[2] = cvtpk(o[d0][12] * rli[12], o[d0][13] * rli[13]); w1[3] = cvtpk(o[d0][14] * rli[14], o[d0][15] * rli[15]);
      char* p = (d0 < 2 ? pk : pq) + (d0 & 1) * 32; *(u32x4*)p = w0; *(u32x4*)(p + 16) = w1; }
  } else {
    const char* pk = lds + OFF_KN + tid * 64; const char* pq = lds + OFF_QR + tid * 64;
    float ss[16];
#pragma unroll
    for (int r = 0; r < 16; ++r) ss[r] = 0.f;
#pragma unroll
    for (int d0 = 0; d0 < 4; ++d0) { const char* p = (d0 < 2 ? pk : pq) + (d0 & 1) * 32; const u32x4 w0 = *(const u32x4*)p, w1 = *(const u32x4*)(p + 16);
#pragma unroll
      for (int r = 0; r < 16; ++r) { const unsigned w = (r < 8 ? w0[r >> 1] : w1[(r - 8) >> 1]); const float o1 = __uint_as_float((r & 1) ? (w & 0xffff0000u) : (w << 16));
        const float v = o1 - S.lam * (o[d0][r] * rli[r]); o[d0][r] = v; ss[r] += v * v; } }
#pragma unroll
    for (int r = 0; r < 16; ++r) {
#pragma unroll
      for (int sft = 1; sft < 32; sft <<= 1) ss[r] += __shfl_xor(ss[r], sft);
      ss[r] = rsqrtf(ss[r] * (1.0f / 128.0f) + 1e-6f) * S.omli; }
    bf16* Ow = (bf16*)S.O + (long)(wid * QBLK) * S.ldo;
#pragma unroll
    for (int d0 = 0; d0 < 4; ++d0) { const float gsub = S.subln[d0 * 32 + r32];
#pragma unroll
      for (int r = 0; r < 16; ++r) { const int orow = crow(r, hi); const float v = o[d0][r] * ss[r] * gsub; const float nb = __int_as_float(__builtin_amdgcn_update_dpp(0, __float_as_int(v), 0xB1, 0xF, 0xF, true));
        if ((lane & 1) == 0) *(unsigned*)(Ow + (long)orow * S.ldo + d0 * 32 + r32) = cvtpk(v, nb); } }
  }
  __syncthreads();
#undef FA_ROW
#undef FA_GLDS
#undef FA_DMA_K
#undef FA_DMA_V
#undef FA_WBAR
#undef FA_RESC
#undef FA_PV
}
}

constexpr int NWAVES = 8;
constexpr int DM = 2048, NB = 8, SEQ = 2048, CTXL = 256, DFF = 5632, NMOD = 9;
constexpr int DFFP = DFF + 64;
constexpr int MLAT = NB * SEQ, MCTX = NB * CTXL, MTOT = MLAT + MCTX;
constexpr int WIN_N = 2880;
constexpr int PC_CKV = 0, PC_KR = 256, PC_DK = 320, PC_DV = 832, PC_CQ = 1344, PC_DQ = 1856, PC_END = 2368, LDP = 2560;
constexpr int MODROW = NMOD * DM;
constexpr float EPS = 1e-6f;
constexpr float MLA_C = 0.07216878364870322f * 1.4426950408889634f;
constexpr float DIFF_C = 0.125f * 1.4426950408889634f;

constexpr size_t MiB = 1u << 20;
constexpr size_t WS_CTL = 0, CTL_ZERO_BYTES = 32768;
constexpr size_t WS_MOD = 1 * MiB;
constexpr size_t WS_TAB = 3 * MiB;
constexpr size_t WS_WGU = 4 * MiB;
constexpr size_t WS_WD = WS_WGU + 176 * MiB;
constexpr size_t WS_WIN = WS_WD + 90 * MiB;
constexpr size_t WS_WF1 = WS_WIN + 20 * MiB;
constexpr size_t WS_WUKV = WS_WF1 + 8 * MiB;
constexpr size_t WS_WUQ = WS_WUKV + 2 * MiB;
constexpr size_t WS_WOUT = WS_WUQ + 3 * MiB;
constexpr size_t WS_DFT = WS_WOUT + 16 * MiB;
constexpr size_t WS_DFTC = WS_DFT + 16 * MiB;
constexpr size_t WS_X = WS_DFTC + 1 * MiB;
constexpr size_t WS_S = WS_X + 16 * MiB;
constexpr size_t WS_H = WS_X + 144 * MiB;
constexpr size_t WS_O = WS_H + 72 * MiB;
constexpr size_t WS_ACT = WS_O + 72 * MiB;
constexpr size_t WS_OD = WS_ACT;
constexpr size_t WS_CT = WS_ACT + 72 * MiB;
constexpr size_t WS_CTC = WS_CT + 32 * MiB;
constexpr size_t WS_P = WS_ACT + 202 * MiB;
constexpr size_t WS_KV = WS_P + 90 * MiB;
constexpr size_t WS_Q = WS_KV + 72 * MiB;
constexpr size_t WS_PART = WS_Q + 54 * MiB;
constexpr size_t WS_END = WS_PART + 64 * MiB;
static_assert(WS_CTC + 4 * MiB <= WS_P && (size_t)MTOT * DFFP * 2 <= 202 * MiB && (size_t)MTOT * LDP * 2 <= 90 * MiB, "ws map");
constexpr int CW_BAR = 4096;
constexpr int N_STEPS = 66;

constexpr int RING_BYTES = 131072;
constexpr int LDSCTL_OFF = RING_BYTES, MISC_OFF = LDSCTL_OFF + 320;
constexpr int LDS_BYTES = 147456;

typedef unsigned u32x2 __attribute__((ext_vector_type(2)));
typedef float f32x2 __attribute__((ext_vector_type(2)));
__device__ __forceinline__ float bf2f(unsigned short b) { return __builtin_bit_cast(float, ((unsigned)b) << 16); }
__device__ __forceinline__ float wave_sum(float v) {
#pragma unroll
    for (int o = 1; o < 64; o <<= 1) v += __shfl_xor(v, o);
    return v;
}
__device__ __forceinline__ float wave_max(float v) {
#pragma unroll
    for (int o = 1; o < 64; o <<= 1) v = fmaxf(v, __shfl_xor(v, o));
    return v;
}

__device__ __forceinline__ void transpose_item(const float* W, int N, bf16* WT, int ldt, int dest_row0, LAS float* scr, int k0, int n0, int lane) {
    float tv[32];
#pragma unroll
    for (int i = 0; i < 32; ++i) tv[i] = W[(size_t)(k0 + 2 * i + (lane >> 5)) * N + n0 + (lane & 31)];
    asm volatile("" ::: "memory");
#pragma unroll
    for (int i = 0; i < 32; ++i) scr[(2 * i + (lane >> 5)) * 33 + (lane & 31)] = tv[i];
    LDS_WAIT(); asm volatile("" ::: "memory");
    const int c = lane & 7;
#pragma unroll
    for (int j = 0; j < 4; ++j) { const int n = (lane >> 3) + 8 * j; const LAS float* s = scr + (8 * c) * 33 + n;
        v4u o; o.x = pk2(s[0 * 33], s[1 * 33]); o.y = pk2(s[2 * 33], s[3 * 33]); o.z = pk2(s[4 * 33], s[5 * 33]); o.w = pk2(s[6 * 33], s[7 * 33]);
        *(GAS v4u*)(WT + (size_t)(dest_row0 + n) * ldt + k0 + 8 * c) = o; }
    LDS_WAIT(); asm volatile("" ::: "memory");
}

struct Args { const float* in[19]; float* out; unsigned char* ws; int st_lo, st_hi; };
enum { I_X = 0, I_C, I_CTX, I_CCTX, I_ADAW, I_ADAB, I_NORMG, I_WG, I_WU, I_WD, I_WIN, I_QN, I_KVN, I_WUQ, I_WUKV, I_LAM, I_SUBLN, I_WOUT, I_FN };

__device__ __forceinline__ void transpose_set(const Args& a, LAS unsigned char* lds, int set, int widx, int nw) {
    unsigned char* ws = a.ws; int lane, wave; { int t_ = threadIdx.x; asm volatile("" : "+v"(t_)); lane = t_ & 63; wave = __builtin_amdgcn_readfirstlane(t_ >> 6); }
    {
        LAS float* scr = (LAS float*)(lds + wave * 8704);
        constexpr int PER_LF = 3 * 5632, N_FFN = 4 * PER_LF, PER_L = 2368 + 256 + 384 + 2048; const int nv = (set == 0) ? PER_LF + 2 * PER_L : PER_LF;
        struct TI { const float* src; bf16* dst; int N, ldt; };
        auto decode = [&](int v) -> TI { TI t; const int it = (set == 0) ? (v < PER_LF ? v : v - PER_LF + N_FFN) : set * PER_LF + v;
            if (it < N_FFN) { const int lf = it / PER_LF, r = it % PER_LF, which = r / 5632, q = r % 5632;
                if (which < 2) { const int kb = q / 176, nb = q % 176, n0 = nb * 32;
                    t.src = (which == 0 ? a.in[I_WG] : a.in[I_WU]) + (size_t)lf * DM * DFF + (size_t)(kb * 64) * DFF + n0; t.N = DFF;
                    t.dst = (bf16*)(ws + WS_WGU) + (size_t)lf * 2 * DFF * DM + ((size_t)((n0 >> 7) * 32 + kb) * 256 + which * 128 + (n0 & 127)) * 64; t.ldt = 64;
                } else { const int kb = q / 64, nb = q % 64;
                    t.src = a.in[I_WD] + (size_t)lf * DFF * DM + (size_t)(kb * 64) * DM + nb * 32; t.N = DM;
                    t.dst = (bf16*)(ws + WS_WD) + (size_t)lf * DM * DFFP + (size_t)(nb * 32) * DFFP + kb * 64; t.ldt = DFFP; }
            } else { int r = it - N_FFN; const int l = r / PER_L; r %= PER_L;
                if (r < 2368) { const int kb = r / 74, nb = r % 74; t.src = a.in[I_WIN] + (size_t)l * DM * WIN_N + (size_t)(kb * 64) * WIN_N + nb * 32; t.N = WIN_N; t.dst = (bf16*)(ws + WS_WIN) + (size_t)l * LDP * DM + (size_t)(nb * 32) * DM + kb * 64; t.ldt = DM; }
                else if ((r -= 2368) < 256) { const int kb = r / 64, nb = r % 64; t.src = a.in[I_WUKV] + (size_t)l * 256 * 2048 + (size_t)(kb * 64) * 2048 + nb * 32; t.N = 2048; t.dst = (bf16*)(ws + WS_WUKV) + (size_t)l * 2048 * 256 + (size_t)(nb * 32) * 256 + kb * 64; t.ldt = 256; }
                else if ((r -= 256) < 384) { const int kb = r / 48, nb = r % 48; t.src = a.in[I_WUQ] + (size_t)l * 512 * 1536 + (size_t)(kb * 64) * 1536 + nb * 32; t.N = 1536; t.dst = (bf16*)(ws + WS_WUQ) + (size_t)l * 1536 * 512 + (size_t)(nb * 32) * 512 + kb * 64; t.ldt = 512; }
                else { r -= 384; const int kb = r / 64, nb = r % 64; t.src = a.in[I_WOUT] + (size_t)l * DM * DM + (size_t)(kb * 64) * DM + nb * 32; t.N = DM; t.dst = (bf16*)(ws + WS_WOUT) + (size_t)l * DM * DM + (size_t)(nb * 32) * DM + kb * 64; t.ldt = DM; } }
            return t; };
#define TR_LOAD(t, tv) do { _Pragma("unroll") for (int i_ = 0; i_ < 32; ++i_) tv[i_] = (t).src[(size_t)(2 * i_ + (lane >> 5)) * (t).N + (lane & 31)]; } while (0)
#define TR_PROC(t, tv) do { _Pragma("unroll") for (int i_ = 0; i_ < 32; ++i_) scr[(2 * i_ + (lane >> 5)) * 33 + (lane & 31)] = tv[i_]; \
            LDS_WAIT(); asm volatile("" ::: "memory"); const int c_ = lane & 7; \
            _Pragma("unroll") for (int j_ = 0; j_ < 4; ++j_) { const int n_ = (lane >> 3) + 8 * j_; const LAS float* s_ = scr + (8 * c_) * 33 + n_; \
                v4u o_; o_.x = pk2(s_[0 * 33], s_[1 * 33]); o_.y = pk2(s_[2 * 33], s_[3 * 33]); o_.z = pk2(s_[4 * 33], s_[5 * 33]); o_.w = pk2(s_[6 * 33], s_[7 * 33]); \
                *(GAS v4u*)((t).dst + (size_t)n_ * (t).ldt + 8 * c_) = o_; } \
            LDS_WAIT(); asm volatile("" ::: "memory"); } while (0)
        float tvA[32], tvB[32]; TI d0, d1; int it = widx;
        if (it < nv) { d0 = decode(it); TR_LOAD(d0, tvA); }
        while (it < nv) {
            const int it1 = it + nw, it2 = it1 + nw;
            if (it1 < nv) { d1 = decode(it1); TR_LOAD(d1, tvB); }
            TR_PROC(d0, tvA);
            if (it1 < nv) { if (it2 < nv) { d0 = decode(it2); TR_LOAD(d0, tvA); } TR_PROC(d1, tvB); }
            it = it2;
        }
#undef TR_LOAD
#undef TR_PROC
    }
}
__device__ __forceinline__ void prologue(const Args& a, LAS unsigned char* lds, int tid, int lane, int wave) {
    tid = threadIdx.x; asm volatile("" : "+v"(tid)); lane = tid & 63;
    unsigned char* ws = a.ws;
    const int G = gridDim.x, gw = blockIdx.x * NWAVES + wave, NGW = G * NWAVES;
    const int gt = blockIdx.x * (NWAVES * 64) + tid, NGT = G * NWAVES * 64;
    {
        for (int rp = 0; rp < NREP(13); ++rp) transpose_set(a, lds, 0, gw, NGW);
        for (int i = gt; i < 2 * 192 * DM / 8; i += NGT) { const int l = i / (192 * DM / 8), r = i % (192 * DM / 8);
            *(GAS v4u*)((bf16*)(ws + WS_WIN) + (size_t)l * LDP * DM + (size_t)PC_END * DM + (size_t)r * 8) = (v4u){0u, 0u, 0u, 0u}; }
    }
    for (int rpb = 0; rpb < NREP(20); ++rpb) {
        float* rope = (float*)(ws + WS_TAB);
        if (gt < 1024) { const int pos = gt >> 4, i = gt & 15; const float inv = powf(10000.0f, -(float)i / 16.0f), ang = (float)pos * inv; rope[pos * 32 + i] = cosf(ang); rope[pos * 32 + 16 + i] = sinf(ang); }
        if (blockIdx.x == 2 && wave == 0) { float* lamv = (float*)(ws + WS_TAB + 16384);
            for (int l = 0; l < 2; ++l) { const float* lf = a.in[I_LAM] + l * 256;
                const float s1 = wave_sum(lf[lane] * lf[64 + lane]), s2 = wave_sum(lf[128 + lane] * lf[192 + lane]);
                const float li = 0.8f - 0.6f * expf(-0.3f * (float)l); if (lane == 0) { lamv[2 * l] = expf(s1) - expf(s2) + li; lamv[2 * l + 1] = 1.0f - li; } } }
        bf16* dft = (bf16*)(ws + WS_DFT);
        for (int rp = 0; rp < NREP(16); ++rp)
        for (int i = gt; i < 2048 * 512; i += NGT) { const int sp = i >> 9, k = (i & 511) * 8, type = k >> 11, s = k & 2047; unsigned w[4];
#pragma unroll
            for (int j = 0; j < 4; ++j) { float v[2];
#pragma unroll
                for (int e = 0; e < 2; ++e) { const int t = ((s + 2 * j + e) * sp) & 2047; float sn, cs; sincospif((float)t * (1.0f / 1024.0f), &sn, &cs); v[e] = (type ? -sn : cs) * (1.0f / 512.0f); }
                w[j] = pk2(v[0], v[1]); }
            *(GAS v4u*)(dft + (size_t)sp * 4096 + k) = (v4u){w[0], w[1], w[2], w[3]}; }
        bf16* dftc = (bf16*)(ws + WS_DFTC);
        for (int i = gt; i < 256 * 64; i += NGT) { const int sp = i >> 6, k = (i & 63) * 8, type = k >> 8, s = k & 255; unsigned w[4];
#pragma unroll
            for (int j = 0; j < 4; ++j) { float v[2];
#pragma unroll
                for (int e = 0; e < 2; ++e) { const int t = ((s + 2 * j + e) * sp) & 255; float sn, cs; sincospif((float)t * (1.0f / 128.0f), &sn, &cs); v[e] = (type ? -sn : cs) * 0.005524271728019903f; }
                w[j] = pk2(v[0], v[1]); }
            *(GAS v4u*)(dftc + (size_t)sp * 512 + k) = (v4u){w[0], w[1], w[2], w[3]}; }
    }
    __syncthreads();
    {
        LAS float* U = (LAS float*)lds;
        LAS float* T = (LAS float*)(lds + 64 * 129 * 4);
        if (tid < 128) { float sn, cs; sincospif((float)tid * (1.0f / 64.0f), &sn, &cs); T[tid] = cs; T[128 + tid] = sn; }
        for (int rp = 0; rp < NREP(14); ++rp)
        for (int it = blockIdx.x; it < 2 * 4 * 32; it += G) { const int l = it >> 7, g = (it >> 5) & 3, k0 = (it & 31) * 64;
            __syncthreads();
            const float* src = a.in[I_WIN] + (size_t)l * DM * WIN_N + PC_END + g * 128;
            for (int i = tid; i < 64 * 128; i += NWAVES * 64) { const int r = i >> 7, c = i & 127; U[r * 129 + c] = src[(size_t)(k0 + r) * WIN_N + c]; }
            __syncthreads();
            typedef short bx8 __attribute__((ext_vector_type(8))); typedef float fx16 __attribute__((ext_vector_type(16)));
            const int r32 = lane & 31, hi = lane >> 5, cpr = (wave & 3) * 32 + r32; const LAS float* Tt = T + (wave >> 2) * 128;
            fx16 acc0 = {}, acc1 = {};
#pragma unroll 2
            for (int st = 0; st < 8; ++st) { const int c0 = 16 * st + 8 * hi; unsigned aw0[4], aw1[4], bw[4];
#pragma unroll
                for (int e = 0; e < 4; ++e) { aw0[e] = pk2(U[r32 * 129 + c0 + 2 * e], U[r32 * 129 + c0 + 2 * e + 1]); aw1[e] = pk2(U[(32 + r32) * 129 + c0 + 2 * e], U[(32 + r32) * 129 + c0 + 2 * e + 1]);
                    bw[e] = pk2(Tt[((c0 + 2 * e) * cpr) & 127], Tt[((c0 + 2 * e + 1) * cpr) & 127]); }
                const bx8 A0 = __builtin_bit_cast(bx8, (v4u){aw0[0], aw0[1], aw0[2], aw0[3]}), A1 = __builtin_bit_cast(bx8, (v4u){aw1[0], aw1[1], aw1[2], aw1[3]}), B = __builtin_bit_cast(bx8, (v4u){bw[0], bw[1], bw[2], bw[3]});
                acc0 = __builtin_amdgcn_mfma_f32_32x32x16_bf16(A0, B, acc0, 0, 0, 0); acc1 = __builtin_amdgcn_mfma_f32_32x32x16_bf16(A1, B, acc1, 0, 0, 0); }
            bf16* wrow = (bf16*)(ws + WS_WF1) + (size_t)l * 1024 * DM + (size_t)((wave >> 2) * 512 + g * 128 + cpr) * DM + k0 + 4 * hi;
#pragma unroll
            for (int q = 0; q < 4; ++q) { u32x2 w0, w1; w0.x = pk2(acc0[4 * q], acc0[4 * q + 1]); w0.y = pk2(acc0[4 * q + 2], acc0[4 * q + 3]); w1.x = pk2(acc1[4 * q], acc1[4 * q + 1]); w1.y = pk2(acc1[4 * q + 2], acc1[4 * q + 3]);
                *(u32x2*)(wrow + 8 * q) = w0; *(u32x2*)(wrow + 32 + 8 * q) = w1; }
        }
    }
    __syncthreads();
    {
        LAS float* S = (LAS float*)lds;
        LAS float* red = (LAS float*)(lds + 9 * 2048 * 4);
        for (int rps = 0; rps < NREP(21); ++rps)
        for (int i = tid; i < 9 * 2048; i += NWAVES * 64) { const int r = i >> 11, k = i & 2047; const float c = r < 8 ? a.in[I_C][r * DM + k] : a.in[I_CCTX][k]; S[i] = c / (1.0f + expf(-c)); }
        __syncthreads();
        float* mod = (float*)(ws + WS_MOD);
        const int cg = tid % 36, ks = tid / 36;
        for (int rp = 0; rp < NREP(15); ++rp)
        for (int ch = blockIdx.x; ch < 256; ch += G) { const int l = ch >> 7, col0 = (ch & 127) * 144;
            f32x4 acc[9];
#pragma unroll
            for (int r = 0; r < 9; ++r) acc[r] = (f32x4){0.f, 0.f, 0.f, 0.f};
            if (tid < 504) { const float* W = a.in[I_ADAW] + (size_t)l * DM * MODROW + col0 + 4 * cg; const int kbeg = ks * 147, kend = kbeg + 147 < 2048 ? kbeg + 147 : 2048;
#pragma unroll 8
                for (int k = kbeg; k < kend; ++k) { const f32x4 w = *(const f32x4*)(W + (size_t)k * MODROW);
#pragma unroll
                    for (int r = 0; r < 9; ++r) acc[r] += w * S[r * 2048 + k]; } }
#pragma unroll
            for (int p = 0; p < 3; ++p) {
                __syncthreads();
                if (tid < 504) {
#pragma unroll
                    for (int j = 0; j < 3; ++j) *(LAS f32x4*)(red + (size_t)tid * 12 + 4 * j) = acc[3 * p + j]; }
                __syncthreads();
                if (tid < 432) { const int cgo = tid / 12, j = tid % 12; float s = 0.f;
#pragma unroll
                    for (int q = 0; q < 14; ++q) s += red[(q * 36 + cgo) * 12 + j];
                    const int r = 3 * p + (j >> 2), col = col0 + 4 * cgo + (j & 3);
                    float val = s + a.in[I_ADAB][l * MODROW + col]; const int chunk = col >> 11;
                    if (chunk == 1 || chunk == 4 || chunk == 7) val = (1.0f + val) * a.in[I_NORMG][(size_t)(l * 3 + (chunk - 1) / 3) * DM + (col & 2047)];
                    mod[((size_t)l * 9 + r) * MODROW + col] = val; }
            }
        }
    }
    __syncthreads();
}

__device__ __forceinline__ void norm_mod_phase(const float* src_lat, const float* src_ctx, bf16* H, const float* g, const float* modl, int ish, int isc, int nrows,
                                               const bf16* dlat, bf16* xb, const bf16* pend, const float* pgate, float pcoef, float* xout_ctx, int gw, int NGW, int lane) {
    { int t_ = threadIdx.x; asm volatile("" : "+v"(t_)); lane = t_ & 63; }
#define NM_LOAD(r, raw) do { \
        if ((r) < MLAT) { \
            if (dlat != nullptr) { const u32x2* dr_ = (const u32x2*)(dlat + (size_t)(r) * DM); const u32x2* xbr_ = (const u32x2*)(xb + (size_t)(r) * DM); \
                _Pragma("unroll") for (int j = 0; j < 8; ++j) { const u32x2 x_ = xbr_[lane + 64 * j], d_ = dr_[lane + 64 * j]; raw[j] = (v4u){x_.x, x_.y, d_.x, d_.y}; } }     \
            else { const v4u* xr_ = (const v4u*)(src_lat + (size_t)(r) * DM); _Pragma("unroll") for (int j = 0; j < 8; ++j) raw[j] = xr_[lane + 64 * j]; } \
        } else { const v4u* xr_ = (const v4u*)(src_ctx + (size_t)((r) - MLAT) * DM); _Pragma("unroll") for (int j = 0; j < 8; ++j) raw[j] = xr_[lane + 64 * j]; } } while (0)
      \
#define NM_GAIN(r) do { const float* mr_ = modl + (size_t)((r) < MLAT ? ((r) >> 11) : 8) * MODROW; \
        _Pragma("unroll") for (int j = 0; j < 8; ++j) { const int c4 = lane + 64 * j; scv[j] = ((const f32x4*)(mr_ + isc * DM))[c4]; shv[j] = ((const f32x4*)(mr_ + ish * DM))[c4]; } } while (0)
#define NM_FINISH(r, raw) do { f32x4 v[8]; \
        u32x2* o_ = (u32x2*)(H + (((size_t)((r) >> 8) * 32 + (lane >> 4)) * 256 + ((r) & 255)) * 64 + 4 * (lane & 15));     \
        if ((r) < MLAT) { \
            if (dlat != nullptr) { _Pragma("unroll") for (int j = 0; j < 8; ++j) { const v4u w_ = raw[j]; \
                v[j].x = __builtin_bit_cast(float, w_.x << 16) + __builtin_bit_cast(float, w_.z << 16); v[j].y = __builtin_bit_cast(float, w_.x & 0xffff0000u) + __builtin_bit_cast(float, w_.z & 0xffff0000u); \
                v[j].z = __builtin_bit_cast(float, w_.y << 16) + __builtin_bit_cast(float, w_.w << 16); v[j].w = __builtin_bit_cast(float, w_.y & 0xffff0000u) + __builtin_bit_cast(float, w_.w & 0xffff0000u); } } \
            else { _Pragma("unroll") for (int j = 0; j < 8; ++j) v[j] = __builtin_bit_cast(f32x4, raw[j]); } \
            if (dlat == nullptr && xb != nullptr) { u32x2* xbw_ = (u32x2*)(xb + (size_t)(r) * DM); _Pragma("unroll") for (int j = 0; j < 8; ++j) { u32x2 w_; w_.x = pk2(v[j].x, v[j].y); w_.y = pk2(v[j].z, v[j].w); xbw_[lane + 64 * j] = w_; } } \
        } else { _Pragma("unroll") for (int j = 0; j < 8; ++j) v[j] = __builtin_bit_cast(f32x4, raw[j]); if (pend != nullptr) { const size_t ro_ = (size_t)((r) - MLAT) * DM; \
            _Pragma("unroll") for (int j = 0; j < 8; ++j) { const int c4 = lane + 64 * j; f32x4 p_ = (f32x4){0.f, 0.f, 0.f, 0.f}; \
                _Pragma("unroll") for (int q = 0; q < 4; ++q) { const u32x2 e_ = ((const u32x2*)(pend + (size_t)q * MCTX * DM + ro_))[c4]; \
                    p_.x += __builtin_bit_cast(float, e_.x << 16); p_.y += __builtin_bit_cast(float, e_.x & 0xffff0000u); p_.z += __builtin_bit_cast(float, e_.y << 16); p_.w += __builtin_bit_cast(float, e_.y & 0xffff0000u); } \
                v[j] = v[j] + (((const f32x4*)pgate)[c4] * pcoef) * p_; ((f32x4*)(xout_ctx + ro_))[c4] = v[j]; } } } \
        float ss_ = 0.f; \
        _Pragma("unroll") for (int j = 0; j < 8; ++j) ss_ += (v[j].x * v[j].x + v[j].y * v[j].y) + (v[j].z * v[j].z + v[j].w * v[j].w); \
        const float rstd_ = rsqrtf(wave_sum(ss_) * (1.0f / DM) + EPS); \
        _Pragma("unroll") for (int j = 0; j < 8; ++j) { const f32x4 sc_ = scv[j], sh_ = shv[j];     \
            const f32x4 y_ = (v[j] * rstd_) * sc_ + sh_; u32x2 w_; w_.x = pk2(y_.x, y_.y); w_.y = pk2(y_.z, y_.w); o_[(size_t)j * (4 * 256 * 64 / 4)] = w_; } } while (0)
    v4u rawA[8], rawB[8]; f32x4 scv[8], shv[8];
    int r = gw;
    if (r < nrows) NM_LOAD(r, rawA);
    while (r < nrows) {
        const int r1 = r + NGW, r2 = r1 + NGW;
        asm volatile("" ::: "memory");
        NM_GAIN(r);
        asm volatile("" ::: "memory");
        if (r1 < nrows) NM_LOAD(r1, rawB);
        asm volatile("" ::: "memory");
        NM_FINISH(r, rawA);
        if (r1 < nrows) { asm volatile("" ::: "memory"); NM_GAIN(r1); asm volatile("" ::: "memory"); if (r2 < nrows) NM_LOAD(r2, rawA); asm volatile("" ::: "memory"); NM_FINISH(r1, rawB); }
        r = r2;
    }
#undef NM_LOAD
#undef NM_GAIN
#undef NM_FINISH
}
__device__ __forceinline__ void final_norm_phase(const float* X, const bf16* D, float* out, const float* g, int gw, int NGW, int lane) {
    { int t_ = threadIdx.x; asm volatile("" : "+v"(t_)); lane = t_ & 63; }
#define FN_LOAD(r, v, d) do { const f32x4* xr_ = (const f32x4*)(X + (size_t)(r) * DM); const u32x2* dr_ = (const u32x2*)(D + (size_t)(r) * DM); \
        _Pragma("unroll") for (int j = 0; j < 8; ++j) { v[j] = xr_[lane + 64 * j]; d[j] = dr_[lane + 64 * j]; } } while (0)
#define FN_FINISH(r, v, d) do { float ss_ = 0.f; \
        _Pragma("unroll") for (int j = 0; j < 8; ++j) { \
            v[j].x += __builtin_bit_cast(float, d[j].x << 16); v[j].y += __builtin_bit_cast(float, d[j].x & 0xffff0000u); v[j].z += __builtin_bit_cast(float, d[j].y << 16); v[j].w += __builtin_bit_cast(float, d[j].y & 0xffff0000u); \
            ss_ += (v[j].x * v[j].x + v[j].y * v[j].y) + (v[j].z * v[j].z + v[j].w * v[j].w); } \
        const float rstd_ = rsqrtf(wave_sum(ss_) * (1.0f / DM) + EPS); f32x4* o_ = (f32x4*)(out + (size_t)(r) * DM); \
        _Pragma("unroll") for (int j = 0; j < 8; ++j) o_[lane + 64 * j] = (v[j] * rstd_) * gv[j]; } while (0)
    f32x4 va[8], vb[8], gv[8]; u32x2 da[8], db[8];
#pragma unroll
    for (int j = 0; j < 8; ++j) gv[j] = ((const f32x4*)g)[lane + 64 * j];
    int r = gw;
    if (r < MLAT) FN_LOAD(r, va, da);
    while (r < MLAT) {
        const int r1 = r + NGW, r2 = r1 + NGW;
        if (r1 < MLAT) FN_LOAD(r1, vb, db);
        asm volatile("" ::: "memory");
        FN_FINISH(r, va, da);
        if (r1 < MLAT) { if (r2 < MLAT) FN_LOAD(r2, va, da); asm volatile("" ::: "memory"); FN_FINISH(r1, vb, db); }
        r = r2;
    }
#undef FN_LOAD
#undef FN_FINISH
}
__device__ __forceinline__ void postproj_phase(bf16* P, const float* kvn, const float* qn, const float* rope, int nrows, int gw, int NGW, int lane) {
    { int t_ = threadIdx.x; asm volatile("" : "+v"(t_)); lane = t_ & 63; }
#define PP_IDX(t) const int p = lane + 64 * (t), v = p >> 5, q = p & 31, half = q >> 4, i = q & 15; const int cb = v == 0 ? PC_KR : (v <= 8 ? PC_DK + (v - 1) * 64 : PC_DQ + (v - 9) * 64), ia = cb + half * 32 + i
#define PP_LOAD(r, wkv, wq, x1, x2, cs, sn) do { const bf16* pr_ = P + (size_t)(r) * LDP; wkv = ((const u32x2*)(pr_ + PC_CKV))[lane]; wq = ((const v4u*)(pr_ + PC_CQ))[lane]; \
        const bool lat_ = (r) < MLAT; const int s_ = (r) & 2047, prow_ = s_ >> 6, pcol_ = s_ & 63; \
        _Pragma("unroll") for (int t = 0; t < 9; ++t) { PP_IDX(t); const int pos = half ? pcol_ : prow_; \
            if (lat_ && p < 544) { x1[t] = pr_[ia]; x2[t] = pr_[ia + 16]; cs[t] = rope[pos * 32 + i]; sn[t] = rope[pos * 32 + 16 + i]; } else { x1[t] = 0; x2[t] = 0; cs[t] = 0.f; sn[t] = 0.f; } } } while (0)
#define PP_FINISH(r, wkv, wq, x1, x2, cs, sn) do { bf16* pr_ = P + (size_t)(r) * LDP; \
        { const float x0 = bf2f((unsigned short)(wkv.x & 0xffff)), xa = bf2f((unsigned short)(wkv.x >> 16)), xb = bf2f((unsigned short)(wkv.y & 0xffff)), xc = bf2f((unsigned short)(wkv.y >> 16)); \
          const float rstd = rsqrtf(wave_sum((x0 * x0 + xa * xa) + (xb * xb + xc * xc)) * (1.0f / 256.0f) + EPS); \
          u32x2 o; o.x = pk2(x0 * rstd * gkv.x, xa * rstd * gkv.y); o.y = pk2(xb * rstd * gkv.z, xc * rstd * gkv.w); ((u32x2*)(pr_ + PC_CKV))[lane] = o; } \
        { float x[8]; \
          x[0] = bf2f((unsigned short)(wq.x & 0xffff)); x[1] = bf2f((unsigned short)(wq.x >> 16)); x[2] = bf2f((unsigned short)(wq.y & 0xffff)); x[3] = bf2f((unsigned short)(wq.y >> 16)); \
          x[4] = bf2f((unsigned short)(wq.z & 0xffff)); x[5] = bf2f((unsigned short)(wq.z >> 16)); x[6] = bf2f((unsigned short)(wq.w & 0xffff)); x[7] = bf2f((unsigned short)(wq.w >> 16)); \
          float ss = 0.f; \
          _Pragma("unroll") for (int j = 0; j < 8; ++j) ss += x[j] * x[j]; \
          const float rstd = rsqrtf(wave_sum(ss) * (1.0f / 512.0f) + EPS); \
          v4u o; o.x = pk2(x[0] * rstd * gq0.x, x[1] * rstd * gq0.y); o.y = pk2(x[2] * rstd * gq0.z, x[3] * rstd * gq0.w); o.z = pk2(x[4] * rstd * gq1.x, x[5] * rstd * gq1.y); o.w = pk2(x[6] * rstd * gq1.z, x[7] * rstd * gq1.w); \
          ((v4u*)(pr_ + PC_CQ))[lane] = o; } \
        if ((r) < MLAT) { \
            _Pragma("unroll") for (int t = 0; t < 9; ++t) { PP_IDX(t); const float a1 = bf2f(x1[t]), a2 = bf2f(x2[t]); \
                if (p < 544) { pr_[ia] = (bf16)f2bf(a1 * cs[t] - a2 * sn[t]); pr_[ia + 16] = (bf16)f2bf(a1 * sn[t] + a2 * cs[t]); } } } } while (0)
    const f32x4 gkv = ((const f32x4*)kvn)[lane], gq0 = ((const f32x4*)qn)[2 * lane], gq1 = ((const f32x4*)qn)[2 * lane + 1];
    u32x2 wkvA, wkvB; v4u wqA, wqB; unsigned short x1A[9], x2A[9], x1B[9], x2B[9]; float csA[9], snA[9], csB[9], snB[9];
    int r = gw;
    if (r < nrows) PP_LOAD(r, wkvA, wqA, x1A, x2A, csA, snA);
    while (r < nrows) {
        const int r1 = r + NGW, r2 = r1 + NGW;
        if (r1 < nrows) PP_LOAD(r1, wkvB, wqB, x1B, x2B, csB, snB);
        asm volatile("" ::: "memory");
        PP_FINISH(r, wkvA, wqA, x1A, x2A, csA, snA);
        if (r1 < nrows) { if (r2 < nrows) PP_LOAD(r2, wkvA, wqA, x1A, x2A, csA, snA); asm volatile("" ::: "memory"); PP_FINISH(r1, wkvB, wqB, x1B, x2B, csB, snB); }
        r = r2;
    }
#undef PP_IDX
#undef PP_LOAD
#undef PP_FINISH
}
__device__ __forceinline__ void fourier_combine(const float* F2p, const bf16* Ct, bf16* Oo, int gw, int NGW) {
    int lane; { int t_ = threadIdx.x; asm volatile("" : "+v"(t_)); lane = t_ & 63; }
    constexpr int NIT = NB * 1024, PER = 4;
    f32x4 p1[PER][2], p2[PER][2];
#pragma unroll
    for (int q = 0; q < PER; ++q) { const int it = gw + q * NGW; if (it < NIT) { const int b = it >> 10, sp = it & 1023;
        const f32x4* r1 = (const f32x4*)(F2p + (size_t)sp * (NB * 512) + b * 512) + 2 * lane; const f32x4* r2 = (const f32x4*)(F2p + ((size_t)1024 + sp) * (NB * 512) + b * 512) + 2 * lane;
        p1[q][0] = r1[0]; p1[q][1] = r1[1]; p2[q][0] = r2[0]; p2[q][1] = r2[1]; } }
    v4u cv[2][4];
#pragma unroll
    for (int q = 0; q < 2; ++q) { const int it = gw + q * NGW; if (it < NB * 512) { const v4u* src = (const v4u*)(Ct + (size_t)it * 4096) + 4 * lane;
#pragma unroll
        for (int j = 0; j < 4; ++j) cv[q][j] = src[j]; } }
    asm volatile("" ::: "memory");
#pragma unroll
    for (int q = 0; q < PER; ++q) { const int it = gw + q * NGW; if (it < NIT) { const int b = it >> 10, sp = it & 1023;
        const f32x4 a0 = p1[q][0] + p2[q][0], a1 = p1[q][1] + p2[q][1], d0 = p1[q][0] - p2[q][0], d1 = p1[q][1] - p2[q][1];
        v4u w; w.x = pk2(a0.x, a0.y); w.y = pk2(a0.z, a0.w); w.z = pk2(a1.x, a1.y); w.w = pk2(a1.z, a1.w);
        *((v4u*)(Oo + ((size_t)b * SEQ + sp) * DM + 1536) + lane) = w;
        if (sp != 0) { v4u x; x.x = pk2(d0.x, d0.y); x.y = pk2(d0.z, d0.w); x.z = pk2(d1.x, d1.y); x.w = pk2(d1.z, d1.w);
            *((v4u*)(Oo + ((size_t)b * SEQ + (SEQ - sp)) * DM + 1536) + lane) = x; } } }
#pragma unroll
    for (int q = 0; q < 2; ++q) { const int it = gw + q * NGW; if (it < NB * 512) { float sacc = 0.f;
#pragma unroll
        for (int j = 0; j < 4; ++j) { const v4u c = cv[q][j]; const unsigned wds[4] = {c.x, c.y, c.z, c.w};
#pragma unroll
            for (int e = 0; e < 4; ++e) sacc += __builtin_bit_cast(float, wds[e] << 16) - __builtin_bit_cast(float, wds[e] & 0xffff0000u); }
        const float tot = wave_sum(sacc) * (1.0f / 512.0f);
        if (lane == 0) { const int b = it >> 9, n = it & 511; Oo[((size_t)b * SEQ + 1024) * DM + 1536 + n] = (bf16)f2bf(tot); } } }
}
__device__ __forceinline__ void attn_phase(unsigned char* ws, bool with_ctx, char* ldsg, LAS unsigned char* ldsg_las, int vcu, int cv, float lam, float omli, const float* subln) {
    const bf16* P = (const bf16*)(ws + WS_P); const bf16* KV = (const bf16*)(ws + WS_KV); const bf16* Q = (const bf16*)(ws + WS_Q);
    bf16* O = (bf16*)(ws + WS_O);
    for (int rep = 0; rep < 3; ++rep) {
        int b, h, row0, nkeys;
        if (rep < 2) { const int u = vcu + 256 * rep; b = u >> 6; h = (u >> 3) & 7; row0 = b * SEQ + (u & 7) * 256; nkeys = CTXL + SEQ; }
        else { if (!with_ctx || cv < 128 || cv >= 192) break; const int e = cv - 128; b = e >> 3; h = e & 7; row0 = MLAT + b * CTXL; nkeys = CTXL; }
        fa::Src S; S.Q = Q + (size_t)row0 * 1536 + h * 192; S.ldq = 1536; S.Kn = KV + h * 256; S.ldkn = DM; S.Kr = P + PC_KR; S.ldkr = LDP; S.V = KV + h * 256 + 128; S.ldv = DM;
        S.seg0 = MLAT + b * CTXL; S.seg1 = b * SEQ; S.nkeys = nkeys; S.O = O + (size_t)row0 * DM + h * 128; S.ldo = DM;
        S.lam = 0.f; S.omli = 0.f; S.subln = nullptr;
        for (int rp = 0; rp < NREP(17); ++rp) fa::attn_unit_dma<192, 0>(S, ldsg, (LAS unsigned char*)ldsg_las);
    }
    for (int rep = 0; rep < 2; ++rep) {
        int b, hh, row0, nkeys;
        if (rep == 0) { b = vcu >> 5; hh = (vcu >> 3) & 3; row0 = b * SEQ + (vcu & 7) * 256; nkeys = CTXL + SEQ; }
        else { if (!with_ctx || cv < 192 || cv >= 224) break; const int e = cv - 192; b = e >> 2; hh = e & 3; row0 = MLAT + b * CTXL; nkeys = CTXL; }
        fa::Src S; S.Kn = nullptr; S.ldkn = 0; S.ldq = LDP; S.ldkr = LDP; S.V = P + PC_DV + hh * 128; S.ldv = LDP;
        S.seg0 = MLAT + b * CTXL; S.seg1 = b * SEQ; S.nkeys = nkeys; S.O = O + (size_t)row0 * DM + 1024 + hh * 128; S.ldo = DM; S.lam = lam; S.omli = omli; S.subln = subln;
        S.Q = P + (size_t)row0 * LDP + PC_DQ + (2 * hh) * 64; S.Kr = P + PC_DK + (2 * hh) * 64;
        for (int rp = 0; rp < NREP(18); ++rp) {
        fa::attn_unit_dma<64, 1>(S, ldsg, (LAS unsigned char*)ldsg_las);
        S.Q += 64; S.Kr += 64;
        fa::attn_unit_dma<64, 2>(S, ldsg, (LAS unsigned char*)ldsg_las);
        S.Q -= 64; S.Kr -= 64; }
    }
}
#ifndef GSMASK
#define GSMASK 0xffffffffu
#endif
#define GS(n) ((GSMASK >> (n)) & 1u)
__global__ void __launch_bounds__(NWAVES * 64, 2) mega(Args a) {
    extern __shared__ __attribute__((aligned(16))) unsigned char lds_raw[];
    LAS unsigned char* lds = (LAS unsigned char*)lds_raw;
    volatile LAS unsigned* MISC = (volatile LAS unsigned*)(lds + MISC_OFF);
    const int tid = 0, lane = 0;
    const int wave = __builtin_amdgcn_readfirstlane((int)threadIdx.x >> 6);
    const int G = gridDim.x, gw = blockIdx.x * NWAVES + wave, NGW = G * NWAVES;
    unsigned char* ws = a.ws;
    int vcu = (G % 8 == 0) ? (int)(blockIdx.x % 8) * (G / 8) + (int)(blockIdx.x / 8) : (int)blockIdx.x;
    int cv = (int)blockIdx.x;
    for (int u = threadIdx.x; u < (LDS_BYTES - LDSCTL_OFF) / 4; u += NWAVES * 64) ((LAS unsigned*)(lds + LDSCTL_OFF))[u] = 0u;
    __syncthreads();
    const int lo = a.st_lo, hi = a.st_hi;
    XcdBarrier bar; bar.bar = (unsigned*)(ws + WS_CTL) + CW_BAR; bar.x = 0; bar.st = nullptr;
    if (hi - lo > 1) bar = xcd_barrier_post((unsigned*)(ws + WS_CTL) + CW_BAR, MISC + 8);
#define IN(k) (lo <= (k) && (k) < hi)
#define SEAM(k) do { if (hi > (k) + 1) xcd_barrier(bar); else __syncthreads(); } while (0)
#define WSB() ({ unsigned char* p_ = ws; asm volatile("" : "+s"(p_)); p_; })
#define XC ((float*)(WSB() + WS_X))
#define H ((bf16*)(WSB() + WS_H))
#define O ((bf16*)(WSB() + WS_O))
#define ACT ((bf16*)(WSB() + WS_ACT))
#define P ((bf16*)(WSB() + WS_P))
#define KV ((bf16*)(WSB() + WS_KV))
#define Q ((bf16*)(WSB() + WS_Q))
#define OD ((float*)(WSB() + WS_OD))
#define CT ((bf16*)(WSB() + WS_CT))
#define CTC ((bf16*)(WSB() + WS_CTC))
#define PART ((bf16*)(WSB() + WS_PART))
#define F2P ((float*)(WSB() + WS_PART + 32 * MiB))
#define DBUF ((bf16*)(WSB() + WS_S))
#define XB ((bf16*)(WSB() + WS_S + 64 * MiB))
#define MOD ((const float*)(WSB() + WS_MOD))
#define ROPE ((const float*)(WSB() + WS_TAB))
#define LAMV ((const float*)(WSB() + WS_TAB + 16384))
    LAS unsigned char* ring = lds;

#ifndef NO_PRO
    if (IN(0)) for (int rp = 0; rp < NREP(10); ++rp) { prologue(a, lds, tid, lane, wave); SEAM(0); }
    if (lo == 0 && hi > 1 && (G % 8) == 0) {
        if (threadIdx.x == 0) { unsigned* bw = (unsigned*)(ws + WS_CTL) + CW_BAR; unsigned start = 0;
            for (unsigned j = 0; j < 16; ++j) { const unsigned cj = xb_ld(&bw[XB_XCNT(j)]); if (j < bar.x) start += cj; }
            MISC[11] = start + MISC[10]; }
        __syncthreads();
        const int u = __builtin_amdgcn_readfirstlane((int)MISC[11]);
        if (u >= 0 && u < G) { vcu = u; cv = (u % (G / 8)) * 8 + u / (G / 8); }
    }
#endif

    for (int fi = 0; fi < 4; ++fi) {
        const int base = 1 + 16 * fi, l = fi >> 1, f = fi & 1;
        const int Mf = (fi == 3) ? MLAT : MTOT;
        const float* modl = MOD + (size_t)l * 9 * MODROW;
        const float* xin_lat = a.in[I_X]; const float* xin_ctx = (fi == 0) ? a.in[I_CTX] : XC;
        if (IN(base + 0)) for (int rp = 0; rp < (fi == 0 ? NREP(0) : 1); ++rp) { norm_mod_phase(xin_lat, xin_ctx, H, a.in[I_NORMG] + (size_t)(l * 3 + 2 * f) * DM, modl, 6 * f + 0, 6 * f + 1, Mf,
                fi > 0 ? DBUF : nullptr, XB, (fi == 1 || fi == 2) ? PART : nullptr, fi == 1 ? modl + 8 * MODROW + 5 * DM : MOD + 8 * MODROW + 8 * DM  , fi == 1 ? 1.0f : 0.5f, XC, gw, NGW, lane);
            if (fi == 1 && NREP(23) > 1) norm_mod_phase(xin_lat, xin_ctx, H, a.in[I_NORMG] + (size_t)(l * 3 + 2 * f) * DM, modl, 6 * f + 0, 6 * f + 1, MLAT, DBUF, XB, nullptr, nullptr, 0.f, XC, gw, NGW, lane);
            SEAM(base + 0); }
        if (IN(base + 1)) for (int rp = 0; rp < NREP(1); ++rp) {
            pg8::Gemm g{H, (const bf16*)(WSB() + WS_WGU) + (size_t)fi * 2 * DFF * DM, Mf, 2 * DFF, DM, 64, 64, 32768, 32768, (size_t)32 * 32768, (size_t)32 * 32768};     pg8::StaticOrder S; S.init(Mf, 2 * DFF, G, cv);
            pg8::EpiSwiglu E{ACT, DFF / 64, 0};
            if (GS(1)) pg8::gemm_phase<pg8::EpiSwiglu, pg8::StaticOrder, true, true>(ring, g, S, E);
            if (fi < 3 && cv >= 96) { __syncthreads(); transpose_set(a, lds, fi + 1, (cv - 96) * NWAVES + wave, (G - 96) * NWAVES); }
            if (NREP(22) > 1) { __syncthreads(); pg8::EpiSwiglu E2{ACT, DFF / 64, 1}; pg8::gemm_phase<pg8::EpiSwiglu, pg8::StaticOrder, true, true>(ring, g, S, E2); }
            SEAM(base + 1);
        }
        if (IN(base + 2)) for (int rp = 0; rp < (fi == 0 ? NREP(2) : 1); ++rp) {
            { pg8::Gemm g{ACT, (const bf16*)(WSB() + WS_WD) + (size_t)fi * DM * DFFP, MTOT, DM, DFF, 64, DFFP, 32768, 128, (size_t)(DFF / 64) * 32768, (size_t)256 * DFFP * 2};
              pg8::LatCtxOrder S; S.init(G, cv, (DFF / 4 / 64) * 32768, (DFF / 4) * 2, DFF / 4 / 64, fi < 3 ? 1 : 0);
              pg8::EpiLatCtx E{{DBUF, modl + (6 * f + 2) * DM, 0.5f, fi == 0 ? 1 : 0}, {PART, MCTX}};
              for (int r2 = 0; r2 < (fi == 0 ? NREP(11) : 1); ++r2) { if (GS(2)) pg8::gemm_phase<pg8::EpiLatCtx, pg8::LatCtxOrder, true, true>(ring, g, S, E); __syncthreads(); } }
            SEAM(base + 2);
        }
        if (f == 0) {
            const int Mq = (l == 0) ? MTOT : MLAT;
            if (IN(base + 3)) { norm_mod_phase(xin_lat, xin_ctx, H, a.in[I_NORMG] + (size_t)(l * 3 + 1) * DM, modl, 3, 4, MTOT, DBUF, XB, PART, modl + 8 * MODROW + 2 * DM, 0.5f, XC, gw, NGW, lane); SEAM(base + 3); }
            if (IN(base + 4)) for (int rp = 0; rp < NREP(4); ++rp) {
                { pg8::Gemm g{H, (const bf16*)(WSB() + WS_WIN) + (size_t)l * LDP * DM, MTOT, LDP, DM, 64, DM, 32768, 128, (size_t)32 * 32768, (size_t)256 * DM * 2}; pg8::StaticOrder S; S.init(MTOT, LDP, G, cv);
                  pg8::EpiStoreBf16 E{P, LDP};
                  if (GS(3)) pg8::gemm_phase<pg8::EpiStoreBf16, pg8::StaticOrder, true, true>(ring, g, S, E); }
                __syncthreads();
                { pg8::Gemm g{(const bf16*)(WSB() + WS_WF1) + (size_t)l * 1024 * DM, H, 1024, Mq, DM, DM, 64, 128, 32768, (size_t)256 * DM * 2, (size_t)32 * 32768}; pg8::StaticOrder S; S.init(1024, Mq, G, (cv + 48) % G);
                  pg8::EpiF1 E{CT, CTC};
                  if (GS(4)) pg8::gemm_phase<pg8::EpiF1, pg8::StaticOrder, true, true>(ring, g, S, E); }
                SEAM(base + 4);
            }
            if (IN(base + 5)) {
                if (cv >= G / 2) postproj_phase(P, a.in[I_KVN] + l * 256, a.in[I_QN] + l * 512, ROPE, MTOT, (cv - G / 2) * NWAVES + wave, (G - G / 2) * NWAVES, lane);
                { pg8::Gemm g = pg8::mk_gemm((const bf16*)(WSB() + WS_DFT), CT, SEQ / 2, NB * 512, 2048, 4096, 4096); pg8::SplitKOrder S; S.init(SEQ / 2, NB * 512, 2, 2048 * 2, 2048 * 2, G, cv);
                  pg8::EpiPartF32 E{F2P, SEQ / 2, NB * 512};
                  for (int r2 = 0; r2 < NREP(19); ++r2) { if (GS(7)) pg8::gemm_phase<pg8::EpiPartF32, pg8::SplitKOrder, true, true>(ring, g, S, E); __syncthreads(); } }
                if (l == 0) {
                  __syncthreads();
                  pg8::Gemm g = pg8::mk_gemm((const bf16*)(WSB() + WS_DFTC), CTC, CTXL, NB * 512, 512, 512, 512); pg8::StaticOrder S; S.init(CTXL, NB * 512, G, (cv + 112) % G);
                  pg8::EpiF2 E{O, MLAT, CTXL};
                  if (GS(8)) pg8::gemm_phase<pg8::EpiF2, pg8::StaticOrder, true, true>(ring, g, S, E); }
                SEAM(base + 5); }
            if (IN(base + 6)) for (int rp = 0; rp < NREP(6); ++rp) {
                fourier_combine(F2P, CT, O, gw, NGW); __syncthreads();
                { pg8::Gemm g = pg8::mk_gemm(P + PC_CKV, (const bf16*)(WSB() + WS_WUKV) + (size_t)l * 2048 * 256, MTOT, 2048, 256, LDP, 256); pg8::StaticOrder S; S.init(MTOT, 2048, G, cv);
                  pg8::EpiStoreBf16 E{KV, DM};
                  if (GS(5)) pg8::gemm_phase<pg8::EpiStoreBf16, pg8::StaticOrder, true, true>(ring, g, S, E); }
                __syncthreads();
                { pg8::Gemm g = pg8::mk_gemm(P + PC_CQ, (const bf16*)(WSB() + WS_WUQ) + (size_t)l * 1536 * 512, Mq, 1536, 512, LDP, 512); pg8::StaticOrder S; S.init(Mq, 1536, G, (cv + 176) % G);
                  pg8::EpiRopeQ E{Q, 1536, ROPE};
                  if (GS(6)) pg8::gemm_phase<pg8::EpiRopeQ, pg8::StaticOrder, true, true>(ring, g, S, E); }
                SEAM(base + 6);
            }
            if (IN(base + 7)) for (int rp = 0; rp < NREP(7); ++rp) {
                attn_phase(ws, l == 0, (char*)lds_raw, lds, vcu, cv, LAMV[2 * l], LAMV[2 * l + 1], a.in[I_SUBLN] + l * 128);
                SEAM(base + 7);
            }
            if (IN(base + 9)) {
                { pg8::Gemm g = pg8::mk_gemm(O, (const bf16*)(WSB() + WS_WOUT) + (size_t)l * DM * DM, MTOT, DM, DM, DM, DM);
                  pg8::LatCtxOrder S; S.init(G, cv, (DM / 4) * 2, (DM / 4) * 2, DM / 4 / 64, l == 0 ? 1 : 0);
                  pg8::EpiLatCtx E{{DBUF, modl + 5 * DM, 1.0f, 0}, {PART, MCTX}};
                  if (GS(9)) pg8::gemm_phase<pg8::EpiLatCtx, pg8::LatCtxOrder, true, true>(ring, g, S, E); }
                SEAM(base + 9);
            }
        }
    }
    if (IN(65)) final_norm_phase(a.in[I_X], DBUF, a.out, a.in[I_FN], gw, NGW, lane);
#undef IN
#undef SEAM
#undef WSB
#undef XC
#undef H
#undef O
#undef ACT
#undef P
#undef KV
#undef Q
#undef OD
#undef CT
#undef CTC
#undef PART
#undef DBUF
#undef XB
#undef MOD
#undef ROPE
#undef LAMV
}

extern "C" void kernel_launch(void* const* d_in, const int* in_sizes, int n_in, void* d_out, int out_size, void* d_ws, size_t ws_size, hipStream_t stream) {
    static int grid = 0;
    if (grid == 0) {
        if (n_in != 19 || out_size != MLAT * DM || ws_size < WS_END) { fprintf(stderr, "kernel_launch: unexpected shapes (n_in %d, out %d, ws %zu < %zu)\n", n_in, out_size, ws_size, (size_t)WS_END); grid = -1; return; }
        int dev = 0, cus = 0, per_cu = 0;
        if (hipGetDevice(&dev) != hipSuccess || hipDeviceGetAttribute(&cus, hipDeviceAttributeMultiprocessorCount, dev) != hipSuccess) { grid = -1; return; }
        if (hipFuncSetAttribute((const void*)mega, hipFuncAttributeMaxDynamicSharedMemorySize, LDS_BYTES) != hipSuccess) { fprintf(stderr, "kernel_launch: hipFuncSetAttribute failed\n"); grid = -1; return; }
        if (hipOccupancyMaxActiveBlocksPerMultiprocessor(&per_cu, (const void*)mega, NWAVES * 64, LDS_BYTES) != hipSuccess || per_cu < 1) { fprintf(stderr, "kernel_launch: occupancy query says %d\n", per_cu); }
        (void)hipGetLastError();
        grid = cus;
    }
    if (grid < 0) return;
    (void)hipMemsetAsync((char*)d_ws + WS_CTL, 0, CTL_ZERO_BYTES, stream);
    Args a{};
    for (int i = 0; i < 19; ++i) a.in[i] = (const float*)d_in[i];
    a.out = (float*)d_out; a.ws = (unsigned char*)d_ws;
#ifndef MK_ONE_LAUNCH
#define MK_ONE_LAUNCH 1
#endif
    if (MK_ONE_LAUNCH) { a.st_lo = 0; a.st_hi = N_STEPS; hipLaunchKernelGGL(mega, dim3(grid), dim3(NWAVES * 64), LDS_BYTES, stream, a); }
    else {
        int steps[64]; int ns = 0; steps[ns++] = 0;
        for (int fi = 0; fi < 4; ++fi) { const int base = 1 + 16 * fi; for (int k = 0; k < 3; ++k) steps[ns++] = base + k; if ((fi & 1) == 0) for (int k = 3; k < 10; ++k) if (k != 8) steps[ns++] = base + k; }
        steps[ns++] = 65;
        for (int i = 0; i < ns; ++i) { a.st_lo = steps[i]; a.st_hi = steps[i] + 1; hipLaunchKernelGGL(mega, dim3(grid), dim3(NWAVES * 64), LDS_BYTES, stream, a); }
    }
    const hipError_t le = hipPeekAtLastError();
    if (le != hipSuccess) fprintf(stderr, "kernel_launch: launch failed: %s\n", hipGetErrorName(le));
}
```

```cpp
#include <hip/hip_runtime.h>
#include <cstdio>
#include <cstdint>
#ifndef DUPMASK
#define DUPMASK 0u
#endif
#define NREP(k) (1 + (int)((DUPMASK >> (k)) & 1u))
namespace pg8 {
#define PG8_LAS __attribute__((address_space(3)))
typedef unsigned short bf16_t;
typedef short bf16x8 __attribute__((ext_vector_type(8)));
typedef float f32x4 __attribute__((ext_vector_type(4)));
typedef float f32x2 __attribute__((ext_vector_type(2)));
typedef unsigned u32x4 __attribute__((ext_vector_type(4)));
typedef unsigned u32x2 __attribute__((ext_vector_type(2)));
constexpr int BM = 256, BK = 64, HALF = 128, HTB = HALF * BK * 2  , STAGE_BYTES = 8 * HTB, NXCD = 8, WGM = 8;

__host__ __device__ __forceinline__ int lds_byte(int r, int c) { const int st = (r >> 4) * 2 + (c >> 5), rr = r & 15, cc = c & 31, ob = rr * 64 + cc * 2; return st * 1024 + (ob ^ (((ob >> 9) & 1) << 5)); }
__host__ __device__ __forceinline__ void stage_rc(int b, int& R, int& C) { const int st = b / 1024, sb = b % 1024, swz = sb ^ (((sb >> 9) & 1) << 5); R = (st >> 1) * 16 + swz / 64; C = (st & 1) * 32 + (swz % 64) / 2; }
__host__ __device__ __forceinline__ int perm32(int rho) { const int n = rho >> 4, i = rho & 15; return 8 * (i >> 2) + 4 * n + (i & 3); }

struct Unit { int pm, pn, koA, koB, ks, nt; };
struct Gemm { const bf16_t* A; const bf16_t* Bt; int M, N, K, lda, ldb, ksA, ksB; size_t tsA, tsB; };
__host__ __device__ __forceinline__ Gemm mk_gemm(const bf16_t* A, const bf16_t* Bt, int M, int N, int K, int lda, int ldb) { return Gemm{A, Bt, M, N, K, lda, ldb, BK * 2, BK * 2, (size_t)BM * lda * 2, (size_t)BM * ldb * 2}; }

struct StaticOrder {
    int nM, nN, nwg, G, c;
    __host__ __device__ void init(int M, int N, int G_, int c_) { nM = M / BM; nN = N / BM; nwg = nM * nN; G = G_; c = c_; }
    __host__ __device__ bool next(int i, Unit& u) const {
        const long L = (long)i * G + c; if (L >= nwg) return false;
        int wgid = (int)L; { const int q = nwg / NXCD, r = nwg % NXCD, xcd = wgid % NXCD, off = wgid / NXCD; wgid = (xcd < r ? xcd * (q + 1) : r * (q + 1) + (xcd - r) * q) + off; }
        const int nig = WGM * nN, gid = wgid / nig, fm = gid * WGM, gsz = (nM - fm) < WGM ? (nM - fm) : WGM;
        u.pm = fm + ((wgid % nig) % gsz); u.pn = (wgid % nig) / gsz; u.koA = 0; u.koB = 0; u.ks = 0; u.nt = 0; return true;
    }
    __device__ __forceinline__ void a_ready(const Unit&) const {}
    __device__ __forceinline__ void done(const Unit&) const {}
};
struct SplitKOrder {
    int nM, nN, KS, G, c, kpartA, kpartB;
    __host__ __device__ void init(int M, int N, int KS_, int kpartA_, int kpartB_, int G_, int c_) { nM = M / BM; nN = N / BM; KS = KS_; kpartA = kpartA_; kpartB = kpartB_; G = G_; c = c_; }
    __host__ __device__ bool next(int i, Unit& u) const {
        const long L = (long)i * G + c; const int per = nM * nN; if (L >= (long)per * KS) return false;
        const int ks = (int)(L / per), r = (int)(L % per); u.pm = r % nM; u.pn = r / nM; u.ks = ks; u.koA = ks * kpartA; u.koB = ks * kpartB; u.nt = 0; return true;
    }
    __device__ __forceinline__ void a_ready(const Unit&) const {}
    __device__ __forceinline__ void done(const Unit&) const {}
};

struct PanelOrder {
    int nM, nN, G, c;
    __host__ __device__ void init(int M, int N, int G_, int c_) { nM = M / BM; nN = N / BM; G = G_; c = c_; }
    __host__ __device__ bool next(int i, Unit& u) const {
        const int per_x = G / NXCD, xcd = c % NXCD, idx = i * per_x + c / NXCD, pml = idx / nN;
        if (pml >= nM / NXCD) return false;
        u.pm = xcd * (nM / NXCD) + pml; u.pn = idx % nN; u.koA = 0; u.koB = 0; u.ks = 0; u.nt = 0; return true;
    }
    __device__ __forceinline__ void a_ready(const Unit&) const {}
    __device__ __forceinline__ void done(const Unit&) const {}
};
struct LatCtxOrder {
    PanelOrder lat; int G, c, n_lat_rounds, kpartA, kpartB, nt_part, with_ctx;
    __host__ __device__ void init(int G_, int c_, int kpartA_, int kpartB_, int nt_part_, int with_ctx_) { lat.init(16384, 2048, G_, c_); G = G_; c = c_; n_lat_rounds = (64 * 8 + G_ - 1) / G_; kpartA = kpartA_; kpartB = kpartB_; nt_part = nt_part_; with_ctx = with_ctx_; }
    __host__ __device__ bool next(int i, Unit& u) const {
        if (i < n_lat_rounds) { if (lat.next(i, u)) return true; }
        if (!with_ctx) return false;
        const long L = (long)(i - n_lat_rounds) * G + c; if (i < n_lat_rounds || L >= 256) return false;
        const int ks = (int)(L >> 6), r = (int)(L & 63); u.pm = 64 + (r & 7); u.pn = r >> 3; u.ks = ks; u.koA = ks * kpartA; u.koB = ks * kpartB; u.nt = nt_part; return true;
    }
    __device__ __forceinline__ void a_ready(const Unit&) const {}
    __device__ __forceinline__ void done(const Unit&) const {}
};
__device__ __forceinline__ unsigned cvt_pk_bf16(float lo, float hi) { unsigned r; asm volatile("v_cvt_pk_bf16_f32 %0, %1, %2" : "=v"(r) : "v"(lo), "v"(hi)); return r; }
__device__ __forceinline__ float silu_f(float x) { return x * __builtin_amdgcn_rcpf(1.0f + __builtin_amdgcn_exp2f(-x)); }

constexpr int E_DM = 2048, E_MLAT = 16384, E_MODROW = 9 * 2048;

struct EpiSwiglu {
    static constexpr bool PERM = true, AFTER_DRAIN = false;
    bf16_t* O; int nkt; int skip;
    __device__ __forceinline__ void operator()(const f32x4 (&acc)[2][2][4][2], const Unit& u, int wr, int wc, int fr, int fq) const {
        if (skip && acc[0][0][0][0][0] != 1.2345e30f) return;
        bf16_t* base = O + (((size_t)u.pm * nkt + 2 * u.pn + (wc >> 1)) * BM + wr * 64 + fr) * 64 + (wc & 1) * 32 + 8 * fq;
#pragma unroll
        for (int ai = 0; ai < 2; ++ai)
#pragma unroll
            for (int m = 0; m < 4; ++m) { bf16_t* rowp = base + (size_t)(ai * HALF + m * 16) * 64;
                const f32x4 g0 = acc[ai][0][m][0], g1 = acc[ai][0][m][1], u0 = acc[ai][1][m][0], u1 = acc[ai][1][m][1];
                u32x4 w; w.x = cvt_pk_bf16(silu_f(g0[0]) * u0[0], silu_f(g0[1]) * u0[1]); w.y = cvt_pk_bf16(silu_f(g0[2]) * u0[2], silu_f(g0[3]) * u0[3]);
                w.z = cvt_pk_bf16(silu_f(g1[0]) * u1[0], silu_f(g1[1]) * u1[1]); w.w = cvt_pk_bf16(silu_f(g1[2]) * u1[2], silu_f(g1[3]) * u1[3]);
                *(u32x4*)rowp = w; }
    }
};
struct EpiStoreBf16 {
    static constexpr bool PERM = true, AFTER_DRAIN = false;
    bf16_t* O; int ldc;
    __device__ __forceinline__ void operator()(const f32x4 (&acc)[2][2][4][2], const Unit& u, int wr, int wc, int fr, int fq) const {
        const int row0 = u.pm * BM + wr * 64 + fr, col0 = u.pn * BM + wc * 32 + 8 * fq;
#pragma unroll
        for (int ai = 0; ai < 2; ++ai)
#pragma unroll
            for (int m = 0; m < 4; ++m) { bf16_t* rowp = O + (size_t)(row0 + ai * HALF + m * 16) * ldc + col0;
#pragma unroll
                for (int bj = 0; bj < 2; ++bj) { const f32x4 v0 = acc[ai][bj][m][0], v1 = acc[ai][bj][m][1];
                    u32x4 w; w.x = cvt_pk_bf16(v0[0], v0[1]); w.y = cvt_pk_bf16(v0[2], v0[3]); w.z = cvt_pk_bf16(v1[0], v1[1]); w.w = cvt_pk_bf16(v1[2], v1[3]);
                    *(u32x4*)(rowp + bj * HALF) = w; } }
    }
};
struct EpiDelta {
    static constexpr bool PERM = true, AFTER_DRAIN = false;
    bf16_t* D; const float* gate; float coef; int first;
    __device__ __forceinline__ void operator()(const f32x4 (&acc)[2][2][4][2], const Unit& u, int wr, int wc, int fr, int fq) const {
        const int row0 = u.pm * BM + wr * 64 + fr, col0 = u.pn * BM + wc * 32 + 8 * fq; const float* gp = gate + (size_t)(u.pm >> 3) * E_MODROW + col0;
        f32x4 gv[2][2];
#pragma unroll
        for (int bj = 0; bj < 2; ++bj)
#pragma unroll
            for (int n = 0; n < 2; ++n) gv[bj][n] = *(const f32x4*)(gp + bj * HALF + 4 * n) * coef;
#pragma unroll
        for (int ai = 0; ai < 2; ++ai) { u32x4 old[4][2];
            if (!first) {
#pragma unroll
                for (int m = 0; m < 4; ++m)
#pragma unroll
                    for (int bj = 0; bj < 2; ++bj) old[m][bj] = *(const u32x4*)(D + (size_t)(row0 + ai * HALF + m * 16) * E_DM + col0 + bj * HALF);
                asm volatile("" ::: "memory"); }
#pragma unroll
            for (int m = 0; m < 4; ++m) { bf16_t* rowp = D + (size_t)(row0 + ai * HALF + m * 16) * E_DM + col0;
#pragma unroll
                for (int bj = 0; bj < 2; ++bj) { f32x4 v0 = acc[ai][bj][m][0] * gv[bj][0], v1 = acc[ai][bj][m][1] * gv[bj][1];
                    if (!first) { const u32x4 o = old[m][bj];
                        v0[0] += __builtin_bit_cast(float, o.x << 16); v0[1] += __builtin_bit_cast(float, o.x & 0xffff0000u); v0[2] += __builtin_bit_cast(float, o.y << 16); v0[3] += __builtin_bit_cast(float, o.y & 0xffff0000u);
                        v1[0] += __builtin_bit_cast(float, o.z << 16); v1[1] += __builtin_bit_cast(float, o.z & 0xffff0000u); v1[2] += __builtin_bit_cast(float, o.w << 16); v1[3] += __builtin_bit_cast(float, o.w & 0xffff0000u); }
                    u32x4 w; w.x = cvt_pk_bf16(v0[0], v0[1]); w.y = cvt_pk_bf16(v0[2], v0[3]); w.z = cvt_pk_bf16(v1[0], v1[1]); w.w = cvt_pk_bf16(v1[2], v1[3]);
                    *(u32x4*)(rowp + bj * HALF) = w; } }
            asm volatile("" ::: "memory"); }
    }
};
struct EpiPartial {
    static constexpr bool PERM = true, AFTER_DRAIN = false;
    bf16_t* part; int rows;
    __device__ __forceinline__ void operator()(const f32x4 (&acc)[2][2][4][2], const Unit& u, int wr, int wc, int fr, int fq) const {
        bf16_t* out = part + ((size_t)u.ks * rows + (size_t)u.pm * BM + wr * 64 + fr) * E_DM + u.pn * BM + wc * 32 + 8 * fq;
#pragma unroll
        for (int ai = 0; ai < 2; ++ai)
#pragma unroll
            for (int m = 0; m < 4; ++m) { bf16_t* rowp = out + (size_t)(ai * HALF + m * 16) * E_DM;
#pragma unroll
                for (int bj = 0; bj < 2; ++bj) { const f32x4 v0 = acc[ai][bj][m][0], v1 = acc[ai][bj][m][1];
                    u32x4 w; w.x = cvt_pk_bf16(v0[0], v0[1]); w.y = cvt_pk_bf16(v0[2], v0[3]); w.z = cvt_pk_bf16(v1[0], v1[1]); w.w = cvt_pk_bf16(v1[2], v1[3]);
                    *(u32x4*)(rowp + bj * HALF) = w; } }
    }
};
struct EpiLatCtx {
    static constexpr bool PERM = true, AFTER_DRAIN = false;
    EpiDelta lat; EpiPartial ctx;
    __device__ __forceinline__ void operator()(const f32x4 (&acc)[2][2][4][2], const Unit& u, int wr, int wc, int fr, int fq) const {
        if (u.pm < 64) lat(acc, u, wr, wc, fr, fq);
        else { Unit v = u; v.pm = u.pm - 64; ctx(acc, v, wr, wc, fr, fq); }
    }
};
struct EpiF1 {
    static constexpr bool PERM = true, AFTER_DRAIN = false;
    bf16_t* Ct; bf16_t* Ctc;
    __device__ __forceinline__ void operator()(const f32x4 (&acc)[2][2][4][2], const Unit& u, int wr, int wc, int fr, int fq) const {
        const int row0 = u.pm * BM + wr * 64 + fr, cw = wc * 32 + 8 * fq;
#pragma unroll
        for (int ai = 0; ai < 2; ++ai)
#pragma unroll
            for (int m = 0; m < 4; ++m) { const int mr = row0 + ai * HALF + m * 16, type = mr >> 9, n = mr & 511;
                bf16_t* rowp = u.pn < 64 ? Ct + (((size_t)((u.pn >> 3) * 512 + n)) * 2 + type) * 2048 + (u.pn & 7) * 256 + cw
                                         : Ctc + (((size_t)((u.pn - 64) * 512 + n)) * 2 + type) * 256 + cw;
#pragma unroll
                for (int bj = 0; bj < 2; ++bj) { const f32x4 v0 = acc[ai][bj][m][0], v1 = acc[ai][bj][m][1];
                    u32x4 w; w.x = cvt_pk_bf16(v0[0], v0[1]); w.y = cvt_pk_bf16(v0[2], v0[3]); w.z = cvt_pk_bf16(v1[0], v1[1]); w.w = cvt_pk_bf16(v1[2], v1[3]);
                    *(u32x4*)(rowp + bj * HALF) = w; } }
    }
};
struct EpiF2 {
    static constexpr bool PERM = true, AFTER_DRAIN = false;
    bf16_t* O; int rowbase, rows_per_b;
    __device__ __forceinline__ void operator()(const f32x4 (&acc)[2][2][4][2], const Unit& u, int wr, int wc, int fr, int fq) const {
        const int row0 = rowbase + (u.pn >> 1) * rows_per_b + u.pm * BM + wr * 64 + fr, col0 = 1536 + (u.pn & 1) * 256 + wc * 32 + 8 * fq;
#pragma unroll
        for (int ai = 0; ai < 2; ++ai)
#pragma unroll
            for (int m = 0; m < 4; ++m) { bf16_t* rowp = O + (size_t)(row0 + ai * HALF + m * 16) * E_DM + col0;
#pragma unroll
                for (int bj = 0; bj < 2; ++bj) { const f32x4 v0 = acc[ai][bj][m][0], v1 = acc[ai][bj][m][1];
                    u32x4 w; w.x = cvt_pk_bf16(v0[0], v0[1]); w.y = cvt_pk_bf16(v0[2], v0[3]); w.z = cvt_pk_bf16(v1[0], v1[1]); w.w = cvt_pk_bf16(v1[2], v1[3]);
                    *(u32x4*)(rowp + bj * HALF) = w; } }
    }
};
struct EpiPartF32 {
    static constexpr bool PERM = true, AFTER_DRAIN = false, DRAINED = false;
    float* part; int rows, ld;
    __device__ __forceinline__ void operator()(const f32x4 (&acc)[2][2][4][2], const Unit& u, int wr, int wc, int fr, int fq) const {
        float* out = part + ((size_t)u.ks * rows + (size_t)u.pm * BM + wr * 64 + fr) * ld + u.pn * BM + wc * 32 + 8 * fq;
#pragma unroll
        for (int ai = 0; ai < 2; ++ai)
#pragma unroll
            for (int m = 0; m < 4; ++m) { float* rowp = out + (size_t)(ai * HALF + m * 16) * ld;
#pragma unroll
                for (int bj = 0; bj < 2; ++bj) { *(f32x4*)(rowp + bj * HALF) = acc[ai][bj][m][0]; *(f32x4*)(rowp + bj * HALF + 4) = acc[ai][bj][m][1]; } }
    }
};
struct EpiRopeQ {
    static constexpr bool PERM = false, AFTER_DRAIN = false;
    bf16_t* Q; int ldc; const float* rope;
    __device__ __forceinline__ void operator()(const f32x4 (&acc)[2][2][4][2], const Unit& u, int wr, int wc, int fr, int fq) const {
        const int row0 = u.pm * BM + wr * 64 + fr;
#pragma unroll
        for (int bj = 0; bj < 2; ++bj) { const int cg = u.pn * BM + bj * HALF + wc * 32, within = cg % 192; const bool roped = within >= 128 && u.pm < 64; const int half = (within - 128) >> 5;
#pragma unroll
            for (int ai = 0; ai < 2; ++ai)
#pragma unroll
                for (int m = 0; m < 4; ++m) { const int row = row0 + ai * HALF + m * 16, s = row & 2047, pos = half ? (s & 63) : (s >> 6);
                    f32x4 x1 = acc[ai][bj][m][0], x2 = acc[ai][bj][m][1];
                    if (roped) { const f32x4 cs = *(const f32x4*)(rope + pos * 32 + 4 * fq), sn = *(const f32x4*)(rope + pos * 32 + 16 + 4 * fq);
                        const f32x4 o1 = x1 * cs - x2 * sn, o2 = x1 * sn + x2 * cs; x1 = o1; x2 = o2; }
                    bf16_t* p = Q + (size_t)row * ldc + cg + 4 * fq;
                    u32x2 w1, w2; w1.x = cvt_pk_bf16(x1[0], x1[1]); w1.y = cvt_pk_bf16(x1[2], x1[3]); w2.x = cvt_pk_bf16(x2[0], x2[1]); w2.y = cvt_pk_bf16(x2[2], x2[3]);
                    *(u32x2*)p = w1; *(u32x2*)(p + 16) = w2; } }
    }
};

template <class Epi, class Sched, bool ALIGN_EPI = false, bool SP2 = false>
__device__ __forceinline__ void gemm_phase(PG8_LAS unsigned char* lds, const Gemm g, const Sched& S, const Epi& E) {
    int tid_ = threadIdx.x; asm volatile("" : "+v"(tid_));
    const int tid = tid_, wid = __builtin_amdgcn_readfirstlane(tid >> 6), lane = tid & 63, wr = wid >> 2, wc = wid & 3, fr = lane & 15, fq = lane >> 4;
    const int K = g.K, nt0 = K / BK;
    unsigned voffA[2], voffB[2];
#pragma unroll
    for (int i = 0; i < 2; ++i) { int R, C; stage_rc(tid * 16 + i * 8192, R, C); const int Rb = Epi::PERM ? ((R & ~31) + perm32(R & 31)) : R;
        voffA[i] = (unsigned)(R * g.lda + C) * 2u; voffB[i] = (unsigned)(Rb * g.ldb + C) * 2u; }
    const size_t kstepA = (size_t)g.ksA, kstepB = (size_t)g.ksB;
    const size_t hstepA = (size_t)HALF * g.lda * 2, hstepB = (size_t)HALF * g.ldb * 2;
    const size_t tstepA = g.tsA, tstepB = g.tsB;
    const unsigned ldsw = (unsigned)wid * 1024u;
    const int aoff = lds_byte(wr * 64 + fr, fq * 8), boff = lds_byte(wc * 32 + fr, fq * 8);
#define PG8_SA(b, h) (((b) * 2 + (h)) * HTB)
#define PG8_SB(b, h) ((4 + (b) * 2 + (h)) * HTB)
#define PG8_STAGE(bufoff, gbase, voff) do { _Pragma("unroll") for (int _i = 0; _i < 2; ++_i) \
        __builtin_amdgcn_global_load_lds((const unsigned*)((const char*)(gbase) + (voff)[_i]), (PG8_LAS unsigned*)(lds + (bufoff) + ldsw + _i * 8192), 16, 0, 0); } while (0)
#define PG8_LDA(dst, b, h) do { _Pragma("unroll") for (int m = 0; m < 4; ++m) _Pragma("unroll") for (int k = 0; k < 2; ++k) dst[m][k] = *(const PG8_LAS bf16x8*)(lds + PG8_SA(b, h) + aoff + m * 2048 + k * 1024); } while (0)
#define PG8_LDB(dst, b, h) do { _Pragma("unroll") for (int n = 0; n < 2; ++n) _Pragma("unroll") for (int k = 0; k < 2; ++k) dst[n][k] = *(const PG8_LAS bf16x8*)(lds + PG8_SB(b, h) + boff + n * 2048 + k * 1024); } while (0)
#define PG8_MMA(ai, bj, At, Bt) do { __builtin_amdgcn_s_setprio(1); _Pragma("unroll") for (int m = 0; m < 4; ++m) _Pragma("unroll") for (int n = 0; n < 2; ++n) _Pragma("unroll") for (int k = 0; k < 2; ++k) \
        acc[ai][bj][m][n] = __builtin_amdgcn_mfma_f32_16x16x32_bf16(Bt[n][k], At[m][k], acc[ai][bj][m][n], 0, 0, 0); __builtin_amdgcn_s_setprio(0); } while (0)
#define PG8_WAIT_V(n) asm volatile("s_waitcnt vmcnt(" #n ")" ::: "memory")
#define PG8_WAIT_L(n) asm volatile("s_waitcnt lgkmcnt(" #n ")" ::: "memory")
#define PG8_BAR __builtin_amdgcn_s_barrier()
#define PG8_SCHED __builtin_amdgcn_sched_barrier(0)
    Unit cur, nxt; int ui = 0;
    if (!S.next(0, cur)) return;
    f32x4 acc[2][2][4][2];
#pragma unroll
    for (int a = 0; a < 2; ++a)
#pragma unroll
        for (int b = 0; b < 2; ++b)
#pragma unroll
            for (int m = 0; m < 4; ++m)
#pragma unroll
                for (int n = 0; n < 2; ++n) acc[a][b][m][n] = (f32x4){0.f, 0.f, 0.f, 0.f};
    bf16x8 At[4][2], B0[2][2], B1[2][2];
    const char* cA = (const char*)g.A + (size_t)cur.pm * tstepA + cur.koA; const char* cB = (const char*)g.Bt + (size_t)cur.pn * tstepB + cur.koB;
    S.a_ready(cur);
    if constexpr (SP2) {
        PG8_STAGE(PG8_SB(0, 0), cB, voffB); PG8_STAGE(PG8_SB(0, 1), cB + hstepB, voffB); PG8_STAGE(PG8_SA(0, 0), cA, voffA); PG8_STAGE(PG8_SA(0, 1), cA + hstepA, voffA);
        if (wr == 1) PG8_BAR;
        PG8_WAIT_V(2); PG8_BAR;
        PG8_STAGE(PG8_SB(1, 0), cB + kstepB, voffB); PG8_STAGE(PG8_SA(1, 0), cA + kstepA, voffA); PG8_STAGE(PG8_SB(1, 1), cB + hstepB + kstepB, voffB);
        PG8_WAIT_V(6); PG8_BAR;
    } else {
        PG8_STAGE(PG8_SB(0, 0), cB, voffB); PG8_STAGE(PG8_SA(0, 0), cA, voffA); PG8_STAGE(PG8_SB(0, 1), cB + hstepB, voffB); PG8_STAGE(PG8_SA(0, 1), cA + hstepA, voffA);
        if (wr == 1) PG8_BAR;
        PG8_WAIT_V(4); PG8_BAR;
        PG8_STAGE(PG8_SB(1, 0), cB + kstepB, voffB); PG8_STAGE(PG8_SA(1, 0), cA + kstepA, voffA); PG8_STAGE(PG8_SB(1, 1), cB + hstepB + kstepB, voffB);
        PG8_WAIT_V(6); PG8_BAR;
    }
    for (;;) {
        const bool has_next = S.next(ui + 1, nxt);
        const char* nA = has_next ? (const char*)g.A + (size_t)nxt.pm * tstepA + nxt.koA : cA; const char* nB = has_next ? (const char*)g.Bt + (size_t)nxt.pn * tstepB + nxt.koB : cB;
        const int nt = cur.nt ? cur.nt : nt0;
#pragma nounroll
        for (int t = 0; t < nt; t += 2) {
            const bool last = (t == nt - 2);
            const char* a1 = cA + (size_t)(t + 1) * kstepA;
            const char* a2 = last ? nA : cA + (size_t)(t + 2) * kstepA; const char* b2 = last ? nB : cB + (size_t)(t + 2) * kstepB;
            const char* a3 = a2 + kstepA; const char* b3 = b2 + kstepB;
            if (last && has_next) S.a_ready(nxt);
            if constexpr (SP2) {
            PG8_LDB(B0, 0, 0); PG8_LDB(B1, 0, 1); PG8_SCHED; PG8_LDA(At, 0, 0); PG8_STAGE(PG8_SA(1, 1), a1 + hstepA, voffA);
            PG8_WAIT_V(8); PG8_WAIT_L(0); PG8_BAR; PG8_MMA(0, 0, At, B0); PG8_MMA(0, 1, At, B1); PG8_BAR; PG8_SCHED;
            PG8_LDA(At, 0, 1); PG8_STAGE(PG8_SB(0, 0), b2, voffB); PG8_STAGE(PG8_SB(0, 1), b2 + hstepB, voffB); PG8_STAGE(PG8_SA(0, 0), a2, voffA);
            PG8_WAIT_V(8); PG8_WAIT_L(0); PG8_BAR; PG8_MMA(1, 0, At, B0); PG8_MMA(1, 1, At, B1); PG8_BAR; PG8_SCHED;
            PG8_LDB(B0, 1, 0); PG8_LDB(B1, 1, 1); PG8_SCHED; PG8_LDA(At, 1, 0); PG8_STAGE(PG8_SA(0, 1), a2 + hstepA, voffA);
            PG8_WAIT_V(8); PG8_WAIT_L(0); PG8_BAR; PG8_MMA(0, 0, At, B0); PG8_MMA(0, 1, At, B1); PG8_BAR; PG8_SCHED;
            PG8_LDA(At, 1, 1); PG8_STAGE(PG8_SB(1, 0), b3, voffB); PG8_STAGE(PG8_SB(1, 1), b3 + hstepB, voffB); PG8_STAGE(PG8_SA(1, 0), a3, voffA);
            PG8_WAIT_V(8); PG8_WAIT_L(0); PG8_BAR; PG8_MMA(1, 0, At, B0); PG8_MMA(1, 1, At, B1); PG8_BAR; PG8_SCHED;
            } else {
            PG8_LDB(B0, 0, 0); PG8_SCHED; PG8_LDA(At, 0, 0); PG8_STAGE(PG8_SA(1, 1), a1 + hstepA, voffA);
            PG8_WAIT_L(8); PG8_BAR; PG8_WAIT_L(0); PG8_MMA(0, 0, At, B0); PG8_BAR; PG8_SCHED;
            PG8_LDB(B1, 0, 1); PG8_STAGE(PG8_SB(0, 0), b2, voffB);
            PG8_BAR; PG8_WAIT_L(0); PG8_MMA(0, 1, At, B1); PG8_BAR;
            PG8_LDA(At, 0, 1); PG8_STAGE(PG8_SA(0, 0), a2, voffA);
            PG8_BAR; PG8_WAIT_L(0); PG8_MMA(1, 0, At, B0); PG8_BAR; PG8_SCHED;
            PG8_STAGE(PG8_SB(0, 1), b2 + hstepB, voffB);
            PG8_WAIT_V(6); PG8_BAR; PG8_MMA(1, 1, At, B1); PG8_BAR;
            PG8_LDB(B0, 1, 0); PG8_SCHED; PG8_LDA(At, 1, 0); PG8_STAGE(PG8_SA(0, 1), a2 + hstepA, voffA);
            PG8_WAIT_L(8); PG8_BAR; PG8_WAIT_L(0); PG8_MMA(0, 0, At, B0); PG8_BAR; PG8_SCHED;
            PG8_LDB(B1, 1, 1); PG8_STAGE(PG8_SB(1, 0), b3, voffB);
            PG8_BAR; PG8_WAIT_L(0); PG8_MMA(0, 1, At, B1); PG8_BAR;
            PG8_LDA(At, 1, 1); PG8_STAGE(PG8_SA(1, 0), a3, voffA);
            PG8_BAR; PG8_WAIT_L(0); PG8_MMA(1, 0, At, B0); PG8_BAR; PG8_SCHED;
            PG8_STAGE(PG8_SB(1, 1), b3 + hstepB, voffB);
            PG8_WAIT_V(6); PG8_BAR; PG8_MMA(1, 1, At, B1); PG8_BAR;
            }
        }
        if constexpr (ALIGN_EPI) { if (wr == 0) PG8_BAR; }
        if constexpr (!Epi::AFTER_DRAIN) { E(acc, cur, wr, wc, fr, fq); S.done(cur); }
        if (!has_next) break;
#pragma unroll
        for (int a = 0; a < 2; ++a)
#pragma unroll
            for (int b = 0; b < 2; ++b)
#pragma unroll
                for (int m = 0; m < 4; ++m)
#pragma unroll
                    for (int n = 0; n < 2; ++n) acc[a][b][m][n] = (f32x4){0.f, 0.f, 0.f, 0.f};
        cur = nxt; cA = nA; cB = nB; ++ui;
        if constexpr (ALIGN_EPI) { if (wr == 1) PG8_BAR; }
    }
    PG8_WAIT_V(0);
    if constexpr (!ALIGN_EPI) { if (wr == 0) PG8_BAR; }
    PG8_BAR;
    if constexpr (Epi::AFTER_DRAIN) { E.fused(acc, cur, wr, wc, fr, fq, lds, wid, lane); S.done(cur); }
#undef PG8_SA
#undef PG8_SB
#undef PG8_STAGE
#undef PG8_LDA
#undef PG8_LDB
#undef PG8_MMA
#undef PG8_WAIT_V
#undef PG8_WAIT_L
#undef PG8_BAR
#undef PG8_SCHED
}
}

#define GAS __attribute__((address_space(1)))
#define LAS __attribute__((address_space(3)))
typedef unsigned short bf16;
typedef unsigned v4u __attribute__((ext_vector_type(4)));
typedef float f32x4 __attribute__((ext_vector_type(4)));
typedef short bf16x8 __attribute__((ext_vector_type(8)));
typedef GAS unsigned gu32;
typedef GAS unsigned long long gu64;
#define RLX_AGENT __ATOMIC_RELAXED, __HIP_MEMORY_SCOPE_AGENT
#define LDS_WAIT() asm volatile("s_waitcnt lgkmcnt(0)" ::: "memory")
#define VM_WAIT() asm volatile("s_waitcnt vmcnt(0)" ::: "memory")
__device__ __forceinline__ unsigned long long rt() { return __builtin_amdgcn_s_memrealtime(); }
__device__ __forceinline__ unsigned f2bf(float f) { unsigned u = __builtin_bit_cast(unsigned, f); return (u + 0x7fffu + ((u >> 16) & 1u)) >> 16; }
__device__ __forceinline__ unsigned pk2(float lo, float hi) { return f2bf(lo) | (f2bf(hi) << 16); }

#define XB_TMO      128
#define XB_XCNT(j)  (256  + 64 * (j))
#define XB_XSUB(j)  (1280 + 64 * (j))
#define XB_XGEN(j)  (2304 + 64 * (j))
#define XB_TOP      3328
#define XB_TOPGEN   3392
#define XCD_BAR_WORDS 3456
#define XB_SPIN_CAP (1u << 18)

__device__ __forceinline__ unsigned xb_ld(unsigned* p)              { return __hip_atomic_load(p, __ATOMIC_RELAXED, __HIP_MEMORY_SCOPE_AGENT); }
__device__ __forceinline__ unsigned xb_add(unsigned* p, unsigned v) { return __hip_atomic_fetch_add(p, v, __ATOMIC_RELAXED, __HIP_MEMORY_SCOPE_AGENT); }
__device__ __forceinline__ unsigned xb_xcc_id() { return (unsigned)__builtin_amdgcn_s_getreg((3 << 11) | 20) & 0xFu; }
#define XB_SPIN(cond, bar) do { unsigned _sp = 0; while (cond) { __builtin_amdgcn_s_sleep(1); \
    if ((++_sp & 255u) == 0u) { if (xb_ld(&(bar)[XB_TMO])) break; if (_sp > XB_SPIN_CAP) { atomicAdd(&(bar)[XB_TMO], 1u); break; } } } } while (0)

struct XcdBarrier {
    unsigned* bar; unsigned x;
    volatile LAS unsigned* st;
};

__device__ __forceinline__ XcdBarrier xcd_barrier_post(unsigned* bar, volatile LAS unsigned* st) {
    XcdBarrier b; b.bar = bar; b.x = xb_xcc_id(); b.st = st;
    if (threadIdx.x == 0) st[2] = xb_add(&bar[XB_XCNT(b.x)], 1u);
    return b;
}
__device__ __forceinline__ void xcd_barrier_complete(unsigned* bar, unsigned x, unsigned& nloc, unsigned& nx) {
    const unsigned G = gridDim.x * gridDim.y * gridDim.z;
    unsigned sum, cnt, mine, sp = 0u;
    for (;;) {
        sum = 0u; cnt = 0u; mine = 0u;
#pragma unroll
        for (unsigned j = 0; j < 16; ++j) { const unsigned c = xb_ld(&bar[XB_XCNT(j)]); sum += c; cnt += (c > 0u) ? 1u : 0u; mine = (j == x) ? c : mine; }
        if (sum == G) break;
        __builtin_amdgcn_s_sleep(1);
        if ((++sp & 255u) == 0u) { if (xb_ld(&bar[XB_TMO])) break; if (sp > XB_SPIN_CAP) { atomicAdd(&bar[XB_TMO], 1u); break; } }
    }
    nloc = mine > 0u ? mine : 1u; nx = cnt > 0u ? cnt : 1u;
}

__device__ __forceinline__ void xcd_barrier(const XcdBarrier& b) {
    asm volatile("s_waitcnt vmcnt(0)" ::: "memory");
    __syncthreads();
    if (threadIdx.x == 0) {
        unsigned* bar = b.bar; asm volatile("" : "+s"(bar));
        __builtin_amdgcn_s_waitcnt(0);
        unsigned nloc = b.st[0], nx = b.st[1];
        if (nloc == 0u) { xcd_barrier_complete(bar, b.x, nloc, nx); b.st[0] = nloc; b.st[1] = nx; }
        const unsigned old = xb_add(&bar[XB_XSUB(b.x)], 1u);
        const unsigned gen = old / nloc;
        if (old + 1u == (gen + 1u) * nloc) {
            __builtin_amdgcn_fence(__ATOMIC_RELEASE, "agent");
            asm volatile("s_waitcnt vmcnt(0)" ::: "memory");
            const unsigned og = xb_add(&bar[XB_TOP], 1u);
            const unsigned tg = og / nx;
            if (og + 1u == (tg + 1u) * nx) xb_add(&bar[XB_TOPGEN], 1u);
            else XB_SPIN(xb_ld(&bar[XB_TOPGEN]) == tg, bar);
            __builtin_amdgcn_fence(__ATOMIC_ACQUIRE, "agent");
            xb_add(&bar[XB_XGEN(b.x)], 1u);
            asm volatile("s_waitcnt vmcnt(0)" ::: "memory");
        } else {
            XB_SPIN(xb_ld(&bar[XB_XGEN(b.x)]) == gen, bar);
            __builtin_amdgcn_fence(__ATOMIC_ACQUIRE, "agent");
            asm volatile("s_waitcnt vmcnt(0)" ::: "memory");
        }
    }
    __syncthreads();
}

namespace fa {
using bf16 = unsigned short;
using bf16x8 = __attribute__((ext_vector_type(8))) short;
using s16x4  = __attribute__((ext_vector_type(4))) short;
using f32x16 = __attribute__((ext_vector_type(16))) float;
using u32x4  = __attribute__((ext_vector_type(4))) unsigned;
constexpr int NW = 8, QBLK = 32, KVBLK = 64;
constexpr float THR = 8.f;
constexpr int SHM_V = KVBLK * 128 * 2, SHM_KN = KVBLK * 128 * 2, SHM_KR = KVBLK * 64 * 2;
constexpr int OFF_V = 0, OFF_KN = 2 * SHM_V, OFF_KR = OFF_KN + 2 * SHM_KN, OFF_WS = OFF_KR + 2 * SHM_KR, OFF_QR = OFF_WS + NW * 64 * 4, ATTN_LDS = OFF_QR + NW * 4096;
#define FA_KNSWZ(row, colB) ((row) * 256 + ((colB) ^ (((row) & 15) << 4)))
#define FA_KRSWZ(row, c) ((row) * 128 + ((((c) ^ ((row) >> 1)) & 7) << 4))
#define FA_SBAR() __builtin_amdgcn_sched_barrier(0)
__device__ __forceinline__ int crow(int r, int hi) { return (r & 3) + 8 * (r >> 2) + 4 * hi; }
__device__ __forceinline__ unsigned cvtpk(float lo, float hi) { unsigned r; asm volatile("v_cvt_pk_bf16_f32 %0, %1, %2" : "=v"(r) : "v"(lo), "v"(hi)); return r; }

template <int DQK> __device__ __forceinline__ void partialSM(f32x16& p0, f32x16& p1, float& m_reg, float& mn, float& alpha) {
  constexpr float SCALE = (DQK == 192) ? 0.07216878364870322f : 0.125f;
  constexpr float C = SCALE * 1.4426950408889634f;
  float pmax = p0[0];
#pragma unroll
  for (int r = 1; r < 16; ++r) pmax = fmaxf(pmax, p0[r]);
#pragma unroll
  for (int r = 0; r < 16; ++r) pmax = fmaxf(pmax, p1[r]);
  { auto rr = __builtin_amdgcn_permlane32_swap(__float_as_uint(pmax), __float_as_uint(pmax), false, false);
    pmax = fmaxf(__uint_as_float(rr[0]), __uint_as_float(rr[1])); }
  if (__builtin_expect(__all(pmax - m_reg <= THR / SCALE), 1)) { mn = m_reg; alpha = 1.f; }
  else { mn = fmaxf(m_reg, pmax); alpha = __builtin_amdgcn_exp2f((m_reg - mn) * C); m_reg = mn; }
  const float mnC = -mn * C;
#pragma unroll
  for (int r = 0; r < 16; ++r) p0[r] = fmaf(p0[r], C, mnC);
#pragma unroll
  for (int r = 0; r < 16; ++r) p1[r] = fmaf(p1[r], C, mnC);
#pragma unroll
  for (int r = 0; r < 16; ++r) p0[r] = __builtin_amdgcn_exp2f(p0[r]);
}
__device__ __forceinline__ void finishSM(f32x16& p0, f32x16& p1, float alpha, float& l_reg, bf16x8& pa0, bf16x8& pa1, bf16x8& pa2, bf16x8& pa3) {
#pragma unroll
  for (int r = 0; r < 16; ++r) p1[r] = __builtin_amdgcn_exp2f(p1[r]);
  float ps = 0;
#pragma unroll
  for (int r = 0; r < 16; ++r) ps += p0[r];
#pragma unroll
  for (int r = 0; r < 16; ++r) ps += p1[r];
  { auto rr = __builtin_amdgcn_permlane32_swap(__float_as_uint(ps), __float_as_uint(ps), false, false);
    ps = __uint_as_float(rr[0]) + __uint_as_float(rr[1]); }
  l_reg = l_reg * alpha + ps;
#define FA_PK4(P, BASE, OUT) do { unsigned a0 = cvtpk(P[BASE + 0], P[BASE + 1]), a1 = cvtpk(P[BASE + 2], P[BASE + 3]);   \
    unsigned b0 = cvtpk(P[BASE + 4], P[BASE + 5]), b1 = cvtpk(P[BASE + 6], P[BASE + 7]);                              \
    auto r0 = __builtin_amdgcn_permlane32_swap(a0, b0, false, false); auto r1 = __builtin_amdgcn_permlane32_swap(a1, b1, false, false); \
    u32x4 w = {r0[0], r1[0], r0[1], r1[1]}; OUT = *reinterpret_cast<bf16x8*>(&w); } while (0)
  FA_PK4(p0, 0, pa0); FA_PK4(p0, 8, pa1); FA_PK4(p1, 0, pa2); FA_PK4(p1, 8, pa3);
#undef FA_PK4
}
template <int DQK> __device__ __forceinline__ void qkt(f32x16& p0, f32x16& p1, const char* Kn, const char* Kr, const bf16x8* qr, const char* Kn_qbase, int qoff, int r32, int hi) {
  p0 = f32x16{}; p1 = f32x16{};
  constexpr int NKN = (DQK == 192) ? 8 : 0;
#pragma unroll
  for (int d0 = 0; d0 < NKN; ++d0) { const int cb = (d0 * 16 + hi * 8) * 2;
    const bf16x8 b0 = *reinterpret_cast<const bf16x8*>(Kn + FA_KNSWZ(r32, cb));
    const bf16x8 b1 = *reinterpret_cast<const bf16x8*>(Kn + FA_KNSWZ(32 + r32, cb));
    p0 = __builtin_amdgcn_mfma_f32_32x32x16_bf16(b0, qr[d0], p0, 0, 0, 0);
    p1 = __builtin_amdgcn_mfma_f32_32x32x16_bf16(b1, qr[d0], p1, 0, 0, 0); }
  int qo = qoff; asm volatile("" : "+v"(qo));
#pragma unroll
  for (int d0 = 0; d0 < 4; ++d0) { const int c = 2 * d0 + hi;
    const bf16x8 b0 = *reinterpret_cast<const bf16x8*>(Kr + FA_KRSWZ(r32, c));
    const bf16x8 b1 = *reinterpret_cast<const bf16x8*>(Kr + FA_KRSWZ(32 + r32, c));
    bf16x8 q; if constexpr (NKN) q = *reinterpret_cast<const bf16x8*>(Kn_qbase + qo + d0 * 1024); else q = qr[d0];
    p0 = __builtin_amdgcn_mfma_f32_32x32x16_bf16(b0, q, p0, 0, 0, 0);
    p1 = __builtin_amdgcn_mfma_f32_32x32x16_bf16(b1, q, p1, 0, 0, 0); }
}
template <int DQK> __device__ __forceinline__ void qkt_r(f32x16& p0, f32x16& p1, const char* Kn, const char* Kr, const bf16x8* qr, int r32, int hi) {
  p0 = f32x16{}; p1 = f32x16{};
  constexpr int NKN = (DQK == 192) ? 8 : 0;
#pragma unroll
  for (int d0 = 0; d0 < NKN; ++d0) { const int cb = (d0 * 16 + hi * 8) * 2;
    const bf16x8 b0 = *reinterpret_cast<const bf16x8*>(Kn + FA_KNSWZ(r32, cb));
    const bf16x8 b1 = *reinterpret_cast<const bf16x8*>(Kn + FA_KNSWZ(32 + r32, cb));
    p0 = __builtin_amdgcn_mfma_f32_32x32x16_bf16(b0, qr[d0], p0, 0, 0, 0);
    p1 = __builtin_amdgcn_mfma_f32_32x32x16_bf16(b1, qr[d0], p1, 0, 0, 0); }
#pragma unroll
  for (int d0 = 0; d0 < 4; ++d0) { const int c = 2 * d0 + hi;
    const bf16x8 b0 = *reinterpret_cast<const bf16x8*>(Kr + FA_KRSWZ(r32, c));
    const bf16x8 b1 = *reinterpret_cast<const bf16x8*>(Kr + FA_KRSWZ(32 + r32, c));
    p0 = __builtin_amdgcn_mfma_f32_32x32x16_bf16(b0, qr[NKN + d0], p0, 0, 0, 0);
    p1 = __builtin_amdgcn_mfma_f32_32x32x16_bf16(b1, qr[NKN + d0], p1, 0, 0, 0); }
}
__device__ __forceinline__ int v_st(int k, int c) { const int kk = (k & ~0xC) | ((k & 4) << 1) | ((k & 8) >> 1); return ((kk >> 3) * 4 + (c >> 5)) * 512 + ((kk & 7) * 32 + (c & 31)) * 2; }
__device__ __forceinline__ int v_rd_base(int lane) { return ((lane & 3) << 3) | (((lane >> 2) & 3) << 6) | (((lane >> 4) & 1) << 5) | (((lane >> 5) & 1) << 8); }
constexpr int v_rd_off(int d0, int ks, int half) { return d0 * 512 + ks * 4096 + half * 2048; }
template <int OFF> __device__ __forceinline__ s16x4 tr_read(int vb) {
  s16x4 r; asm volatile("ds_read_b64_tr_b16 %0, %1 offset:%2" : "=&v"(r) : "v"(vb), "i"(OFF) : "memory"); return r;
}
template <int D0> __device__ __forceinline__ void pv_one(f32x16& od, int vb, bf16x8 pa0, bf16x8 pa1, bf16x8 pa2, bf16x8 pa3) {
  const s16x4 l0 = tr_read<v_rd_off(D0, 0, 0)>(vb), h0 = tr_read<v_rd_off(D0, 0, 1)>(vb), l1 = tr_read<v_rd_off(D0, 1, 0)>(vb), h1 = tr_read<v_rd_off(D0, 1, 1)>(vb);
  const s16x4 l2 = tr_read<v_rd_off(D0, 2, 0)>(vb), h2 = tr_read<v_rd_off(D0, 2, 1)>(vb), l3 = tr_read<v_rd_off(D0, 3, 0)>(vb), h3 = tr_read<v_rd_off(D0, 3, 1)>(vb);
  asm volatile("s_waitcnt lgkmcnt(0)" ::: "memory"); FA_SBAR();
#define FA_PK(L, H) (bf16x8){L[0], L[1], L[2], L[3], H[0], H[1], H[2], H[3]}
  od = __builtin_amdgcn_mfma_f32_32x32x16_bf16(pa0, FA_PK(l0, h0), od, 0, 0, 0);
  od = __builtin_amdgcn_mfma_f32_32x32x16_bf16(pa1, FA_PK(l1, h1), od, 0, 0, 0);
  od = __builtin_amdgcn_mfma_f32_32x32x16_bf16(pa2, FA_PK(l2, h2), od, 0, 0, 0);
  od = __builtin_amdgcn_mfma_f32_32x32x16_bf16(pa3, FA_PK(l3, h3), od, 0, 0, 0);
#undef FA_PK
}
#define FA_TRLOAD(D0, L0, H0, L1, H1, L2, H2, L3, H3) do { L0 = tr_read<v_rd_off(D0, 0, 0)>(vb); H0 = tr_read<v_rd_off(D0, 0, 1)>(vb); L1 = tr_read<v_rd_off(D0, 1, 0)>(vb); H1 = tr_read<v_rd_off(D0, 1, 1)>(vb); \
    L2 = tr_read<v_rd_off(D0, 2, 0)>(vb); H2 = tr_read<v_rd_off(D0, 2, 1)>(vb); L3 = tr_read<v_rd_off(D0, 3, 0)>(vb); H3 = tr_read<v_rd_off(D0, 3, 1)>(vb); } while (0)
#define FA_PKV(L, H) (bf16x8){L[0], L[1], L[2], L[3], H[0], H[1], H[2], H[3]}
#define FA_PVMMA(OD, L0, H0, L1, H1, L2, H2, L3, H3) do { OD = __builtin_amdgcn_mfma_f32_32x32x16_bf16(pa0, FA_PKV(L0, H0), OD, 0, 0, 0); OD = __builtin_amdgcn_mfma_f32_32x32x16_bf16(pa1, FA_PKV(L1, H1), OD, 0, 0, 0); \
    OD = __builtin_amdgcn_mfma_f32_32x32x16_bf16(pa2, FA_PKV(L2, H2), OD, 0, 0, 0); OD = __builtin_amdgcn_mfma_f32_32x32x16_bf16(pa3, FA_PKV(L3, H3), OD, 0, 0, 0); } while (0)
__device__ __forceinline__ void pv_d0_piped(f32x16* o, int vb, bf16x8 pa0, bf16x8 pa1, bf16x8 pa2, bf16x8 pa3) {
  s16x4 al0, ah0, al1, ah1, al2, ah2, al3, ah3, bl0, bh0, bl1, bh1, bl2, bh2, bl3, bh3;
  FA_TRLOAD(0, al0, ah0, al1, ah1, al2, ah2, al3, ah3);
  FA_TRLOAD(1, bl0, bh0, bl1, bh1, bl2, bh2, bl3, bh3);
  asm volatile("s_waitcnt lgkmcnt(8)" ::: "memory"); FA_SBAR();
  FA_PVMMA(o[0], al0, ah0, al1, ah1, al2, ah2, al3, ah3); FA_SBAR();
  FA_TRLOAD(2, al0, ah0, al1, ah1, al2, ah2, al3, ah3);
  asm volatile("s_waitcnt lgkmcnt(8)" ::: "memory"); FA_SBAR();
  FA_PVMMA(o[1], bl0, bh0, bl1, bh1, bl2, bh2, bl3, bh3); FA_SBAR();
  FA_TRLOAD(3, bl0, bh0, bl1, bh1, bl2, bh2, bl3, bh3);
  asm volatile("s_waitcnt lgkmcnt(8)" ::: "memory"); FA_SBAR();
  FA_PVMMA(o[2], al0, ah0, al1, ah1, al2, ah2, al3, ah3); FA_SBAR();
  asm volatile("s_waitcnt lgkmcnt(0)" ::: "memory"); FA_SBAR();
  FA_PVMMA(o[3], bl0, bh0, bl1, bh1, bl2, bh2, bl3, bh3);
}
#undef FA_TRLOAD
#undef FA_PVMMA
#undef FA_PKV
__device__ __forceinline__ void pv_d0(f32x16* o, int vb, bf16x8 pa0, bf16x8 pa1, bf16x8 pa2, bf16x8 pa3) {
  pv_one<0>(o[0], vb, pa0, pa1, pa2, pa3); pv_one<1>(o[1], vb, pa0, pa1, pa2, pa3); pv_one<2>(o[2], vb, pa0, pa1, pa2, pa3); pv_one<3>(o[3], vb, pa0, pa1, pa2, pa3);
}
template <int DQK> __device__ __forceinline__ void pv_sm(f32x16* o, int vb, bf16x8 pa0, bf16x8 pa1, bf16x8 pa2, bf16x8 pa3, f32x16& p0, f32x16& p1, float& m_reg, float& mn, float& alpha) {
  constexpr float SCALE = (DQK == 192) ? 0.07216878364870322f : 0.125f;
  constexpr float C = SCALE * 1.4426950408889634f;
#define FA_PKV2(L, H) (bf16x8){L[0], L[1], L[2], L[3], H[0], H[1], H[2], H[3]}
#define FA_PVBLK(D0, SLICE) do { \
    const s16x4 l0 = tr_read<v_rd_off(D0, 0, 0)>(vb), h0 = tr_read<v_rd_off(D0, 0, 1)>(vb), l1 = tr_read<v_rd_off(D0, 1, 0)>(vb), h1 = tr_read<v_rd_off(D0, 1, 1)>(vb); \
    const s16x4 l2 = tr_read<v_rd_off(D0, 2, 0)>(vb), h2 = tr_read<v_rd_off(D0, 2, 1)>(vb), l3 = tr_read<v_rd_off(D0, 3, 0)>(vb), h3 = tr_read<v_rd_off(D0, 3, 1)>(vb); \
    SLICE \
    asm volatile("s_waitcnt lgkmcnt(0)" ::: "memory"); FA_SBAR(); \
    o[D0] = __builtin_amdgcn_mfma_f32_32x32x16_bf16(pa0, FA_PKV2(l0, h0), o[D0], 0, 0, 0); o[D0] = __builtin_amdgcn_mfma_f32_32x32x16_bf16(pa1, FA_PKV2(l1, h1), o[D0], 0, 0, 0); \
    o[D0] = __builtin_amdgcn_mfma_f32_32x32x16_bf16(pa2, FA_PKV2(l2, h2), o[D0], 0, 0, 0); o[D0] = __builtin_amdgcn_mfma_f32_32x32x16_bf16(pa3, FA_PKV2(l3, h3), o[D0], 0, 0, 0); } while (0)
  float pmax, mnC;
  FA_PVBLK(0, { pmax = p0[0]; _Pragma("unroll") for (int r = 1; r < 16; ++r) pmax = fmaxf(pmax, p0[r]); _Pragma("unroll") for (int r = 0; r < 16; ++r) pmax = fmaxf(pmax, p1[r]);
      auto rr = __builtin_amdgcn_permlane32_swap(__float_as_uint(pmax), __float_as_uint(pmax), false, false); pmax = fmaxf(__uint_as_float(rr[0]), __uint_as_float(rr[1])); });
  FA_PVBLK(1, { if (__builtin_expect(__all(pmax - m_reg <= THR / SCALE), 1)) { mn = m_reg; alpha = 1.f; } else { mn = fmaxf(m_reg, pmax); alpha = __builtin_amdgcn_exp2f((m_reg - mn) * C); m_reg = mn; }
      mnC = -mn * C; _Pragma("unroll") for (int r = 0; r < 16; ++r) p0[r] = fmaf(p0[r], C, mnC); });
  FA_PVBLK(2, { _Pragma("unroll") for (int r = 0; r < 16; ++r) p1[r] = fmaf(p1[r], C, mnC); _Pragma("unroll") for (int r = 0; r < 8; ++r) p0[r] = __builtin_amdgcn_exp2f(p0[r]); });
  FA_PVBLK(3, { _Pragma("unroll") for (int r = 8; r < 16; ++r) p0[r] = __builtin_amdgcn_exp2f(p0[r]); });
#undef FA_PVBLK
#undef FA_PKV2
}
constexpr float THR2 = 11.541560327111707f;
template <int DQK> __device__ __forceinline__ void qkt_r2(f32x16& p0, f32x16& p1, const f32x16& negm, const char* Kn, const char* Kr, const bf16x8* qr, const char* qlds, int r32, int hi) {
  constexpr int NKN = (DQK == 192) ? 8 : 0;
  if constexpr (NKN) {
#pragma unroll
    for (int d0 = 0; d0 < NKN; ++d0) { const int cb = (d0 * 16 + hi * 8) * 2;
      const bf16x8 b0 = *reinterpret_cast<const bf16x8*>(Kn + FA_KNSWZ(r32, cb));
      const bf16x8 b1 = *reinterpret_cast<const bf16x8*>(Kn + FA_KNSWZ(32 + r32, cb));
      if (d0 == 0) { p0 = __builtin_amdgcn_mfma_f32_32x32x16_bf16(b0, qr[0], negm, 0, 0, 0); p1 = __builtin_amdgcn_mfma_f32_32x32x16_bf16(b1, qr[0], negm, 0, 0, 0); }
      else { p0 = __builtin_amdgcn_mfma_f32_32x32x16_bf16(b0, qr[d0], p0, 0, 0, 0); p1 = __builtin_amdgcn_mfma_f32_32x32x16_bf16(b1, qr[d0], p1, 0, 0, 0); } }
  }
#pragma unroll
  for (int d0 = 0; d0 < 4; ++d0) { const int c = 2 * d0 + hi;
    const bf16x8 b0 = *reinterpret_cast<const bf16x8*>(Kr + FA_KRSWZ(r32, c));
    const bf16x8 b1 = *reinterpret_cast<const bf16x8*>(Kr + FA_KRSWZ(32 + r32, c));
    if (NKN == 0 && d0 == 0) { p0 = __builtin_amdgcn_mfma_f32_32x32x16_bf16(b0, qr[0], negm, 0, 0, 0); p1 = __builtin_amdgcn_mfma_f32_32x32x16_bf16(b1, qr[0], negm, 0, 0, 0); }
    else { bf16x8 q;
      if (NKN != 0 && d0 == 3) { int qo = 0; asm volatile("" : "+v"(qo)); q = *reinterpret_cast<const bf16x8*>(qlds + qo); }
      else q = qr[NKN + d0];
      p0 = __builtin_amdgcn_mfma_f32_32x32x16_bf16(b0, q, p0, 0, 0, 0); p1 = __builtin_amdgcn_mfma_f32_32x32x16_bf16(b1, q, p1, 0, 0, 0); } }
}
__device__ __forceinline__ void sm_shift(f32x16& p0, f32x16& p1, f32x16& negm, float d) {
#pragma unroll
  for (int r = 0; r < 16; ++r) { p0[r] -= d; p1[r] -= d; negm[r] -= d; }
}
template <bool FIRST> __device__ __forceinline__ void partialSM2(f32x16& p0, f32x16& p1, f32x16& negm, float& alpha) {
  float pmax = p0[0];
#pragma unroll
  for (int r = 1; r < 16; ++r) pmax = fmaxf(pmax, p0[r]);
#pragma unroll
  for (int r = 0; r < 16; ++r) pmax = fmaxf(pmax, p1[r]);
  { auto rr = __builtin_amdgcn_permlane32_swap(__float_as_uint(pmax), __float_as_uint(pmax), false, false);
    pmax = fmaxf(__uint_as_float(rr[0]), __uint_as_float(rr[1])); }
  if constexpr (FIRST) { alpha = 0.f; sm_shift(p0, p1, negm, pmax); }
  else { if (__builtin_expect(__all(pmax <= THR2), 1)) alpha = 1.f; else { const float d = fmaxf(pmax, 0.f); alpha = __builtin_amdgcn_exp2f(-d); sm_shift(p0, p1, negm, d); } }
#pragma unroll
  for (int r = 0; r < 16; ++r) p0[r] = __builtin_amdgcn_exp2f(p0[r]);
}
__device__ __forceinline__ void pv_sm2(f32x16* o, int vb, bf16x8 pa0, bf16x8 pa1, bf16x8 pa2, bf16x8 pa3, f32x16& p0, f32x16& p1, f32x16& negm, float& alpha) {
#define FA_PKV2(L, H) (bf16x8){L[0], L[1], L[2], L[3], H[0], H[1], H[2], H[3]}
#define FA_PVBLK(D0, SLICE) do { \
    const s16x4 l0 = tr_read<v_rd_off(D0, 0, 0)>(vb), h0 = tr_read<v_rd_off(D0, 0, 1)>(vb), l1 = tr_read<v_rd_off(D0, 1, 0)>(vb), h1 = tr_read<v_rd_off(D0, 1, 1)>(vb); \
    const s16x4 l2 = tr_read<v_rd_off(D0, 2, 0)>(vb), h2 = tr_read<v_rd_off(D0, 2, 1)>(vb), l3 = tr_read<v_rd_off(D0, 3, 0)>(vb), h3 = tr_read<v_rd_off(D0, 3, 1)>(vb); \
    SLICE \
    asm volatile("s_waitcnt lgkmcnt(0)" ::: "memory"); FA_SBAR(); \
    o[D0] = __builtin_amdgcn_mfma_f32_32x32x16_bf16(pa0, FA_PKV2(l0, h0), o[D0], 0, 0, 0); o[D0] = __builtin_amdgcn_mfma_f32_32x32x16_bf16(pa1, FA_PKV2(l1, h1), o[D0], 0, 0, 0); \
    o[D0] = __builtin_amdgcn_mfma_f32_32x32x16_bf16(pa2, FA_PKV2(l2, h2), o[D0], 0, 0, 0); o[D0] = __builtin_amdgcn_mfma_f32_32x32x16_bf16(pa3, FA_PKV2(l3, h3), o[D0], 0, 0, 0); } while (0)
  float pmax;
  FA_PVBLK(0, { pmax = p0[0]; _Pragma("unroll") for (int r = 1; r < 16; ++r) pmax = fmaxf(pmax, p0[r]); _Pragma("unroll") for (int r = 0; r < 16; ++r) pmax = fmaxf(pmax, p1[r]);
      auto rr = __builtin_amdgcn_permlane32_swap(__float_as_uint(pmax), __float_as_uint(pmax), false, false); pmax = fmaxf(__uint_as_float(rr[0]), __uint_as_float(rr[1])); });
  FA_PVBLK(1, { if (__builtin_expect(__all(pmax <= THR2), 1)) alpha = 1.f; else { const float d = fmaxf(pmax, 0.f); alpha = __builtin_amdgcn_exp2f(-d); sm_shift(p0, p1, negm, d); }
      _Pragma("unroll") for (int r = 0; r < 4; ++r) p0[r] = __builtin_amdgcn_exp2f(p0[r]); });
  FA_PVBLK(2, { _Pragma("unroll") for (int r = 4; r < 10; ++r) p0[r] = __builtin_amdgcn_exp2f(p0[r]); });
  FA_PVBLK(3, { _Pragma("unroll") for (int r = 10; r < 16; ++r) p0[r] = __builtin_amdgcn_exp2f(p0[r]); });
#undef FA_PVBLK
#undef FA_PKV2
}
struct Src {
  const bf16* Q; int ldq;
  const bf16* Kn; int ldkn;
  const bf16* Kr; int ldkr;
  const bf16* V; int ldv;
  int seg0, seg1, nkeys;
  void* O; int ldo;
  float lam, omli; const float* subln;
};
template <int DQK, int SDEPTH, int MODE>
__device__ __forceinline__ void attn_unit(const Src& S, char* lds) {
  int tid_ = threadIdx.x; asm volatile("" : "+v"(tid_));
  const int tid = tid_, wid = tid >> 6, lane = tid & 63, r32 = lane & 31, hi = lane >> 5;
  constexpr int NKN = (DQK == 192) ? 8 : 0, NQ = DQK / 16;
  char* V_lds = lds + OFF_V; char* Kn_lds = lds + OFF_KN; char* Kr_lds = lds + OFF_KR;
  float* wsf = (float*)(lds + OFF_WS) + wid * 64; float* li_l = wsf; float* al_l = wsf + 32;
  constexpr int NQR = NKN ? NKN : 4;
  float m_reg = -1e30f, l_reg = 0; f32x16 o[4] = {}; bf16x8 qr[NQR];
  const bf16* Qw = S.Q + (long)(wid * QBLK + r32) * S.ldq + hi * 8;
  const char* Qr_lds = lds + OFF_QR; const int qoff = wid * 4096 + lane * 16;
#pragma unroll
  for (int d0 = 0; d0 < NQR; ++d0) qr[d0] = *reinterpret_cast<const bf16x8*>(Qw + d0 * 16);
  if constexpr (NKN) {
#pragma unroll
    for (int d0 = 0; d0 < 4; ++d0) *(bf16x8*)(lds + OFF_QR + qoff + d0 * 1024) = *reinterpret_cast<const bf16x8*>(Qw + (NKN + d0) * 16);
  }
  const int sr = tid >> 4, sc = (tid & 15) * 8, vst0 = v_st(sr, sc), vst1 = v_st(32 + sr, sc);
  const int krr = tid >> 3, krc = tid & 7;
  const int vb0 = (int)(uintptr_t)V_lds + v_rd_base(lane);
  struct { bf16x8 vs0, vs1, kn0, kn1, kr; } st_[SDEPTH];
#define FA_ROW(k0) ((k0) < 256 ? S.seg0 + (k0) : S.seg1 + ((k0) - 256))
#define FA_SLOAD(i, k0) do { const long R_ = FA_ROW(k0); \
    st_[i].vs0 = *reinterpret_cast<const bf16x8*>(S.V + (R_ + sr) * S.ldv + sc); st_[i].vs1 = *reinterpret_cast<const bf16x8*>(S.V + (R_ + 32 + sr) * S.ldv + sc); \
    if constexpr (NKN) { st_[i].kn0 = *reinterpret_cast<const bf16x8*>(S.Kn + (R_ + sr) * S.ldkn + sc); st_[i].kn1 = *reinterpret_cast<const bf16x8*>(S.Kn + (R_ + 32 + sr) * S.ldkn + sc); } \
    st_[i].kr = *reinterpret_cast<const bf16x8*>(S.Kr + (R_ + krr) * S.ldkr + krc * 8); } while (0)
#define FA_SWRITE(b, i) do { *(bf16x8*)(V_lds + (b) * SHM_V + vst0) = st_[i].vs0; *(bf16x8*)(V_lds + (b) * SHM_V + vst1) = st_[i].vs1; \
    if constexpr (NKN) { *(bf16x8*)(Kn_lds + (b) * SHM_KN + FA_KNSWZ(sr, sc * 2)) = st_[i].kn0; *(bf16x8*)(Kn_lds + (b) * SHM_KN + FA_KNSWZ(32 + sr, sc * 2)) = st_[i].kn1; } \
    *(bf16x8*)(Kr_lds + (b) * SHM_KR + FA_KRSWZ(krr, krc)) = st_[i].kr; } while (0)
#define FA_SWAIT() do { if constexpr (SDEPTH == 2) { if constexpr (NKN) asm volatile("s_waitcnt vmcnt(5)" ::: "memory"); else asm volatile("s_waitcnt vmcnt(3)" ::: "memory"); } \
    else asm volatile("s_waitcnt vmcnt(0)" ::: "memory"); } while (0)
#define FA_RESC(a) do { if (__any((a) < 1.f)) { if (hi == 0) al_l[r32] = (a); asm volatile("s_waitcnt lgkmcnt(0)" ::: "memory"); \
    _Pragma("unroll") for (int d = 0; d < 4; ++d) _Pragma("unroll") for (int r = 0; r < 16; ++r) o[d][r] *= al_l[crow(r, hi)]; } } while (0)
  f32x16 pA0, pA1, pB0, pB1; float mnA, mnB, alA, alB; bf16x8 pa0, pa1, pa2, pa3; const int NT = S.nkeys / KVBLK;
  constexpr int SE = 0, SO = SDEPTH - 1;
  FA_SLOAD(SE, 0); asm volatile("s_waitcnt vmcnt(0)" ::: "memory"); FA_SWRITE(0, SE); __syncthreads();
  qkt<DQK>(pA0, pA1, Kn_lds, Kr_lds, qr, Qr_lds, qoff, r32, hi); partialSM<DQK>(pA0, pA1, m_reg, mnA, alA);
  FA_SLOAD(SO, KVBLK); if constexpr (SDEPTH == 2) { if (2 < NT) FA_SLOAD(SE, 2 * KVBLK); }
  FA_SWAIT(); FA_SWRITE(1, SO); __syncthreads();
  for (int j = 1; j + 1 < NT; j += 2) {
    FA_SBAR(); qkt<DQK>(pB0, pB1, Kn_lds + SHM_KN, Kr_lds + SHM_KR, qr, Qr_lds, qoff, r32, hi);
    finishSM(pA0, pA1, alA, l_reg, pa0, pa1, pa2, pa3); FA_SBAR();
    FA_SLOAD(SO, (j + SDEPTH) * KVBLK); FA_SBAR();
    if constexpr (DQK == 64) pv_d0_piped(o, vb0, pa0, pa1, pa2, pa3); else pv_d0(o, vb0, pa0, pa1, pa2, pa3); partialSM<DQK>(pB0, pB1, m_reg, mnB, alB);
    __syncthreads(); FA_SWAIT(); FA_SWRITE(0, SE);
    FA_RESC(alB); __syncthreads();
    FA_SBAR(); qkt<DQK>(pA0, pA1, Kn_lds, Kr_lds, qr, Qr_lds, qoff, r32, hi);
    finishSM(pB0, pB1, alB, l_reg, pa0, pa1, pa2, pa3); FA_SBAR();
    if (SDEPTH == 1 || j + 3 < NT) FA_SLOAD(SE, (j + 1 + SDEPTH) * KVBLK); FA_SBAR();
    if constexpr (DQK == 64) pv_d0_piped(o, vb0 + SHM_V, pa0, pa1, pa2, pa3); else pv_d0(o, vb0 + SHM_V, pa0, pa1, pa2, pa3); partialSM<DQK>(pA0, pA1, m_reg, mnA, alA);
    __syncthreads(); FA_SWAIT(); FA_SWRITE(1, SO);
    FA_RESC(alA); __syncthreads();
  }
  FA_SBAR(); qkt<DQK>(pB0, pB1, Kn_lds + SHM_KN, Kr_lds + SHM_KR, qr, Qr_lds, qoff, r32, hi);
  finishSM(pA0, pA1, alA, l_reg, pa0, pa1, pa2, pa3); FA_SBAR();
  if constexpr (DQK == 64) pv_d0_piped(o, vb0, pa0, pa1, pa2, pa3); else pv_d0(o, vb0, pa0, pa1, pa2, pa3); partialSM<DQK>(pB0, pB1, m_reg, mnB, alB);
  __syncthreads(); FA_RESC(alB);
  finishSM(pB0, pB1, alB, l_reg, pa0, pa1, pa2, pa3); FA_SBAR();
  if constexpr (DQK == 64) pv_d0_piped(o, vb0 + SHM_V, pa0, pa1, pa2, pa3); else pv_d0(o, vb0 + SHM_V, pa0, pa1, pa2, pa3);
  if (hi == 0) li_l[r32] = l_reg; asm volatile("s_waitcnt lgkmcnt(0)" ::: "memory");
  float rli[16];
#pragma unroll
  for (int r = 0; r < 16; ++r) rli[r] = __builtin_amdgcn_rcpf(li_l[crow(r, hi)]);
  if constexpr (MODE == 0) {
    bf16* Ow = (bf16*)S.O + (long)(wid * QBLK) * S.ldo;
#pragma unroll
    for (int r = 0; r < 16; ++r) { const int orow = crow(r, hi);
#pragma unroll
      for (int d0 = 0; d0 < 4; ++d0) { const float v = o[d0][r] * rli[r]; const float nb = __int_as_float(__builtin_amdgcn_update_dpp(0, __float_as_int(v), 0xB1, 0xF, 0xF, true));
        if ((lane & 1) == 0) *(unsigned*)(Ow + (long)orow * S.ldo + d0 * 32 + r32) = cvtpk(v, nb); } }
  } else if constexpr (MODE == 1) {
    static_assert(DQK == 64, "the parking area overlays the DQK = 192 buffers");
    char* pk = lds + OFF_KN + tid * 64; char* pq = lds + OFF_QR + tid * 64;
#pragma unroll
    for (int d0 = 0; d0 < 4; ++d0) { u32x4 w0, w1;
      w0[0] = cvtpk(o[d0][0] * rli[0], o[d0][1] * rli[1]); w0[1] = cvtpk(o[d0][2] * rli[2], o[d0][3] * rli[3]); w0[2] = cvtpk(o[d0][4] * rli[4], o[d0][5] * rli[5]); w0[3] = cvtpk(o[d0][6] * rli[6], o[d0][7] * rli[7]);
      w1[0] = cvtpk(o[d0][8] * rli[8], o[d0][9] * rli[9]); w1[1] = cvtpk(o[d0][10] * rli[10], o[d0][11] * rli[11]); w1[2] = cvtpk(o[d0][12] * rli[12], o[d0][13] * rli[13]); w1[3] = cvtpk(o[d0][14] * rli[14], o[d0][15] * rli[15]);
      char* p = (d0 < 2 ? pk : pq) + (d0 & 1) * 32; *(u32x4*)p = w0; *(u32x4*)(p + 16) = w1; }
  } else {
    const char* pk = lds + OFF_KN + tid * 64; const char* pq = lds + OFF_QR + tid * 64;
    float ss[16];
#pragma unroll
    for (int r = 0; r < 16; ++r) ss[r] = 0.f;
#pragma unroll
    for (int d0 = 0; d0 < 4; ++d0) { const char* p = (d0 < 2 ? pk : pq) + (d0 & 1) * 32; const u32x4 w0 = *(const u32x4*)p, w1 = *(const u32x4*)(p + 16);
#pragma unroll
      for (int r = 0; r < 16; ++r) { const unsigned w = (r < 8 ? w0[r >> 1] : w1[(r - 8) >> 1]); const float o1 = __uint_as_float((r & 1) ? (w & 0xffff0000u) : (w << 16));
        const float v = o1 - S.lam * (o[d0][r] * rli[r]); o[d0][r] = v; ss[r] += v * v; } }
#pragma unroll
    for (int r = 0; r < 16; ++r) {
#pragma unroll
      for (int sft = 1; sft < 32; sft <<= 1) ss[r] += __shfl_xor(ss[r], sft);
      ss[r] = rsqrtf(ss[r] * (1.0f / 128.0f) + 1e-6f) * S.omli; }
    bf16* Ow = (bf16*)S.O + (long)(wid * QBLK) * S.ldo;
#pragma unroll
    for (int d0 = 0; d0 < 4; ++d0) { const float gsub = S.subln[d0 * 32 + r32];
#pragma unroll
      for (int r = 0; r < 16; ++r) { const int orow = crow(r, hi); const float v = o[d0][r] * ss[r] * gsub; const float nb = __int_as_float(__builtin_amdgcn_update_dpp(0, __float_as_int(v), 0xB1, 0xF, 0xF, true));
        if ((lane & 1) == 0) *(unsigned*)(Ow + (long)orow * S.ldo + d0 * 32 + r32) = cvtpk(v, nb); } }
  }
  __syncthreads();
#undef FA_ROW
#undef FA_SLOAD
#undef FA_SWRITE
#undef FA_SWAIT
#undef FA_RESC
}
template <int DQK, int MODE>
__device__ __forceinline__ void attn_unit_dma(const Src& S, char* lds, __attribute__((address_space(3))) unsigned char* ldsl) {
  int tid_ = threadIdx.x; asm volatile("" : "+v"(tid_));
  const int tid = tid_, wid = __builtin_amdgcn_readfirstlane(tid >> 6), lane = tid & 63, r32 = lane & 31, hi = lane >> 5;
  if (wid >= 4) __builtin_amdgcn_s_setprio(1);
  constexpr int NKN = (DQK == 192) ? 8 : 0, NQ = DQK / 16;
  char* V_lds = lds + OFF_V; char* Kn_lds = lds + OFF_KN; char* Kr_lds = lds + OFF_KR;
  float* wsf = (float*)(lds + OFF_WS) + wid * 64; float* li_l = wsf; float* al_l = wsf + 32;
  constexpr int NQR = (DQK == 192) ? NQ - 1 : NQ;
  constexpr bool ACC = true;
  float m_reg = -1e30f, l_reg = 0; f32x16 o[4] = {}; f32x16 negm = {}; bf16x8 qr[NQR];
#define FA_QKT(P0, P1, KN, KR) do { if constexpr (ACC) qkt_r2<DQK>(P0, P1, negm, KN, KR, qr, qlds, r32, hi); else qkt_r<DQK>(P0, P1, KN, KR, qr, r32, hi); } while (0)
#define FA_PVSM(VB, P0, P1, MN, AL) do { if constexpr (ACC) pv_sm2(o, VB, pa0, pa1, pa2, pa3, P0, P1, negm, AL); else pv_sm<DQK>(o, VB, pa0, pa1, pa2, pa3, P0, P1, m_reg, MN, AL); } while (0)
  const bf16* Qw = S.Q + (long)(wid * QBLK + r32) * S.ldq + hi * 8;
#pragma unroll
  for (int d0 = 0; d0 < NQR; ++d0) qr[d0] = *reinterpret_cast<const bf16x8*>(Qw + d0 * 16);
  const char* qlds = lds + OFF_QR + wid * 4096 + lane * 16;
  if constexpr (DQK == 192) *(bf16x8*)(lds + OFF_QR + wid * 4096 + lane * 16) = *reinterpret_cast<const bf16x8*>(Qw + (NQ - 1) * 16);
  const int vb0 = (int)(uintptr_t)V_lds + v_rd_base(lane);
  unsigned offV, offKn, offKr;
  { const int sub = 2 * (2 * wid) + (lane >> 5), kk = (sub >> 2) * 8 + ((lane & 31) >> 2), key = (kk & ~0xC) | ((kk & 4) << 1) | ((kk & 8) >> 1), c = (sub & 3) * 32 + (lane & 3) * 8;
    offV = (unsigned)(key * S.ldv + c) * 2u;
    const int r = 4 * (2 * wid) + (lane >> 4), c16 = (lane & 15) ^ (r & 15); offKn = (unsigned)(r * S.ldkn + c16 * 8) * 2u; }
  { const int r = 8 * wid + (lane >> 3), c = (lane & 7) ^ ((r >> 1) & 7); offKr = (unsigned)(r * S.ldkr + c * 8) * 2u; }
#define FA_ROW(k0) ((k0) < 256 ? S.seg0 + (k0) : S.seg1 + ((k0) - 256))
#define FA_GLDS(gp, off) __builtin_amdgcn_global_load_lds((const unsigned*)(gp), (__attribute__((address_space(3))) unsigned*)(ldsl + (off)), 16, 0, 0)
#define FA_DMA_K(t, b) do { const int t_ = (t) < NT ? (t) : NT - 1; const long R_ = FA_ROW(t_ * KVBLK); \
    if constexpr (NKN) { const char* kb_ = (const char*)(S.Kn + R_ * S.ldkn); asm volatile("" : "+s"(kb_)); FA_GLDS(kb_ + offKn, OFF_KN + (b) * SHM_KN + (2 * wid) * 1024); \
      const char* kc_ = kb_ + 8 * S.ldkn; asm volatile("" : "+s"(kc_)); FA_GLDS(kc_ + (offKn ^ 64u), OFF_KN + (b) * SHM_KN + (2 * wid + 1) * 1024); } \
    { const char* rb_ = (const char*)(S.Kr + R_ * S.ldkr); asm volatile("" : "+s"(rb_)); FA_GLDS(rb_ + offKr, OFF_KR + (b) * SHM_KR + wid * 1024); } } while (0)
#define FA_DMA_V(t, b) do { const int t_ = (t) < NT ? (t) : NT - 1; const long R_ = FA_ROW(t_ * KVBLK); const char* vb_ = (const char*)(S.V + R_ * S.ldv); asm volatile("" : "+s"(vb_)); \
    FA_GLDS(vb_ + offV, OFF_V + (b) * SHM_V + (2 * wid) * 1024); FA_GLDS(vb_ + 128 + offV, OFF_V + (b) * SHM_V + (2 * wid + 1) * 1024); } while (0)
#define FA_WBAR() do { asm volatile("s_waitcnt vmcnt(0)" ::: "memory"); __builtin_amdgcn_s_barrier(); asm volatile("" ::: "memory"); } while (0)
#define FA_RESC(a) do { if (__any((a) < 1.f)) { if (hi == 0) al_l[r32] = (a); asm volatile("s_waitcnt lgkmcnt(0)" ::: "memory"); \
    _Pragma("unroll") for (int d = 0; d < 4; ++d) _Pragma("unroll") for (int r = 0; r < 16; ++r) o[d][r] *= al_l[crow(r, hi)]; } } while (0)
#define FA_PV(vb) do { if constexpr (DQK == 64) pv_d0_piped(o, vb, pa0, pa1, pa2, pa3); else pv_d0(o, vb, pa0, pa1, pa2, pa3); } while (0)
  f32x16 pA0, pA1, pB0, pB1; float mnA, mnB, alA, alB; bf16x8 pa0, pa1, pa2, pa3; const int NT = S.nkeys / KVBLK;
  FA_DMA_K(0, 0); FA_DMA_V(0, 0); FA_DMA_K(1, 1);
  FA_WBAR();
  FA_QKT(pA0, pA1, Kn_lds, Kr_lds); if constexpr (ACC) partialSM2<true>(pA0, pA1, negm, alA); else partialSM<DQK>(pA0, pA1, m_reg, mnA, alA);
  FA_WBAR();
  for (int j = 1; j + 1 < NT; j += 2) {
    FA_SBAR(); FA_QKT(pB0, pB1, Kn_lds + SHM_KN, Kr_lds + SHM_KR);
    finishSM(pA0, pA1, alA, l_reg, pa0, pa1, pa2, pa3);
    FA_SBAR(); FA_DMA_V(j, 1); FA_DMA_K(j + 1, 0); FA_RESC(alA); FA_SBAR();
    FA_PVSM(vb0, pB0, pB1, mnB, alB);
    FA_WBAR();
    FA_SBAR(); FA_QKT(pA0, pA1, Kn_lds, Kr_lds);
    finishSM(pB0, pB1, alB, l_reg, pa0, pa1, pa2, pa3);
    FA_SBAR(); FA_DMA_V(j + 1, 0); FA_DMA_K(j + 2, 1); FA_RESC(alB); FA_SBAR();
    FA_PVSM(vb0 + SHM_V, pA0, pA1, mnA, alA);
    FA_WBAR();
  }
  FA_SBAR(); FA_QKT(pB0, pB1, Kn_lds + SHM_KN, Kr_lds + SHM_KR);
  finishSM(pA0, pA1, alA, l_reg, pa0, pa1, pa2, pa3); FA_SBAR();
  FA_DMA_V(NT - 1, 1); FA_RESC(alA); FA_SBAR();
  FA_PVSM(vb0, pB0, pB1, mnB, alB);
  FA_WBAR(); FA_RESC(alB);
  finishSM(pB0, pB1, alB, l_reg, pa0, pa1, pa2, pa3); FA_SBAR();
  FA_PV(vb0 + SHM_V);
  if (hi == 0) li_l[r32] = l_reg; asm volatile("s_waitcnt lgkmcnt(0)" ::: "memory");
  float rli[16];
#pragma unroll
  for (int r = 0; r < 16; ++r) rli[r] = __builtin_amdgcn_rcpf(li_l[crow(r, hi)]);
  if constexpr (MODE == 0) {
    bf16* Ow = (bf16*)S.O + (long)(wid * QBLK) * S.ldo;
#pragma unroll
    for (int r = 0; r < 16; ++r) { const int orow = crow(r, hi);
#pragma unroll
      for (int d0 = 0; d0 < 4; ++d0) { const float v = o[d0][r] * rli[r]; const float nb = __int_as_float(__builtin_amdgcn_update_dpp(0, __float_as_int(v), 0xB1, 0xF, 0xF, true));
        if ((lane & 1) == 0) *(unsigned*)(Ow + (long)orow * S.ldo + d0 * 32 + r32) = cvtpk(v, nb); } }
  } else if constexpr (MODE == 1) {
    static_assert(DQK == 64, "the parking area overlays the DQK = 192 buffers");
    char* pk = lds + OFF_KN + tid * 64; char* pq = lds + OFF_QR + tid * 64;
#pragma unroll
    for (int d0 = 0; d0 < 4; ++d0) { u32x4 w0, w1;
      w0[0] = cvtpk(o[d0][0] * rli[0], o[d0][1] * rli[1]); w0[1] = cvtpk(o[d0][2] * rli[2], o[d0][3] * rli[3]); w0[2] = cvtpk(o[d0][4] * rli[4], o[d0][5] * rli[5]); w0[3] = cvtpk(o[d0][6] * rli[6], o[d0][7] * rli[7]);
      w1[0] = cvtpk(o[d0][8] * rli[8], o[d0][9] * rli[9]); w1[1] = cvtpk(o[d0][10] * rli[10], o[d0][11] * rli[11]); w1[2] = cvtpk(o[d0][12] * rli[12], o[d0][13] * rli[13]); w1[3] = cvtpk(o[d0][14] * rli[14], o[d0][15] * rli[15]);
      char* p = (d0 < 2 ? pk : pq) + (d0 & 1) * 32; *(u32x4*)p = w0; *(u32x4*)(p + 16) = w1; }
  } else {
    const char* pk = lds + OFF_KN + tid * 64; const char* pq = lds + OFF_QR + tid * 64;
    float ss[16];
#pragma unroll
    for (int r = 0; r < 16; ++r) ss[r] = 0.f;
#pragma unroll
    for (int d0 = 0; d0 < 4; ++d0) { const char* p = (d0 < 2 ? pk : pq) + (d0 & 1) * 32; const u32x4 w0 = *(const u32x4*)p, w1 = *(const u32x4*)(p + 16);
#pragma unroll
      for (int r = 0; r < 16; ++r) { const unsigned w = (r < 8 ? w0[r >> 1] : w1[(r - 8) >> 1]); const float o1 = __uint_as_float((r & 1) ? (w & 0xffff0000u) : (w << 16));
        const float v = o1 - S.lam * (o[d0][r] * rli[r]); o[d0][r] = v; ss[r] += v * v; } }
#pragma unroll
    for (int r = 0; r < 16; ++r) {
#pragma unroll
      for (int sft = 1; sft < 32; sft <<= 1) ss[r] += __shfl_xor(ss[r], sft);
      ss[r] = rsqrtf(ss[r] * (1.0f / 128.0f) + 1e-6f) * S.omli; }
    bf16* Ow = (bf16*)S.O + (long)(wid * QBLK) * S.ldo;
#pragma unroll
    for (int d0 = 0; d0 < 4; ++d0) { const float gsub = S.subln[d0 * 32 + r32];
#pragma unroll
      for (int r = 0; r < 16; ++r) { const int orow = crow(r, hi); const float v = o[d0][r] * ss[r] * gsub; const float nb = __int_as_float(__builtin_amdgcn_update_dpp(0, __float_as_int(v), 0xB1, 0xF, 0xF, true));
        if ((lane & 1) == 0) *(unsigned*)(Ow + (long)orow * S.ldo + d0 * 32 + r32) = cvtpk(v, nb); } }
  }
  __builtin_amdgcn_s_setprio(0);
  __syncthreads();
#undef FA_QKT
#undef FA_PVSM
#undef FA_ROW
#undef FA_GLDS
#undef FA_DMA_K
#undef FA_DMA_V
#undef FA_WBAR
#undef FA_RESC
#undef FA_PV
}
}

constexpr int NWAVES = 8;
constexpr int DM = 2048, NB = 8, SEQ = 2048, CTXL = 256, DFF = 5632, NMOD = 9;
constexpr int DFFP = DFF + 64;
constexpr int MLAT = NB * SEQ, MCTX = NB * CTXL, MTOT = MLAT + MCTX;
constexpr int WIN_N = 2880;
constexpr int PC_CKV = 0, PC_KR = 256, PC_DK = 320, PC_DV = 832, PC_CQ = 1344, PC_DQ = 1856, PC_END = 2368, LDP = 2560;
constexpr int MODROW = NMOD * DM;
constexpr float EPS = 1e-6f;
constexpr float MLA_C = 0.07216878364870322f * 1.4426950408889634f;
constexpr float DIFF_C = 0.125f * 1.4426950408889634f;

constexpr size_t MiB = 1u << 20;
constexpr size_t WS_CTL = 0, CTL_ZERO_BYTES = 32768;
constexpr size_t WS_MOD = 1 * MiB;
constexpr size_t WS_TAB = 3 * MiB;
constexpr size_t WS_WGU = 4 * MiB;
constexpr size_t WS_WD = WS_WGU + 176 * MiB;
constexpr size_t WS_WIN = WS_WD + 90 * MiB;
constexpr size_t WS_WF1 = WS_WIN + 20 * MiB;
constexpr size_t WS_WUKV = WS_WF1 + 8 * MiB;
constexpr size_t WS_WUQ = WS_WUKV + 2 * MiB;
constexpr size_t WS_WOUT = WS_WUQ + 3 * MiB;
constexpr size_t WS_DFT = WS_WOUT + 16 * MiB;
constexpr size_t WS_DFTC = WS_DFT + 16 * MiB;
constexpr size_t WS_X = WS_DFTC + 1 * MiB;
constexpr size_t WS_S = WS_X + 16 * MiB;
constexpr size_t WS_H = WS_X + 144 * MiB;
constexpr size_t WS_O = WS_H + 72 * MiB;
constexpr size_t WS_ACT = WS_O + 72 * MiB;
constexpr size_t WS_OD = WS_ACT;
constexpr size_t WS_CT = WS_ACT + 72 * MiB;
constexpr size_t WS_CTC = WS_CT + 32 * MiB;
constexpr size_t WS_P = WS_ACT + 202 * MiB;
constexpr size_t WS_KV = WS_P + 90 * MiB;
constexpr size_t WS_Q = WS_KV + 72 * MiB;
constexpr size_t WS_PART = WS_Q + 54 * MiB;
constexpr size_t WS_END = WS_PART + 64 * MiB;
static_assert(WS_CTC + 4 * MiB <= WS_P && (size_t)MTOT * DFFP * 2 <= 202 * MiB && (size_t)MTOT * LDP * 2 <= 90 * MiB, "ws map");
constexpr int CW_BAR = 4096;
constexpr int N_STEPS = 66;

constexpr int RING_BYTES = 131072;
constexpr int LDSCTL_OFF = RING_BYTES, MISC_OFF = LDSCTL_OFF + 320;
constexpr int LDS_BYTES = 147456;

typedef unsigned u32x2 __attribute__((ext_vector_type(2)));
typedef float f32x2 __attribute__((ext_vector_type(2)));
__device__ __forceinline__ float bf2f(unsigned short b) { return __builtin_bit_cast(float, ((unsigned)b) << 16); }
__device__ __forceinline__ float wave_sum(float v) {
#pragma unroll
    for (int o = 1; o < 64; o <<= 1) v += __shfl_xor(v, o);
    return v;
}
__device__ __forceinline__ float wave_max(float v) {
#pragma unroll
    for (int o = 1; o < 64; o <<= 1) v = fmaxf(v, __shfl_xor(v, o));
    return v;
}

__device__ __forceinline__ void transpose_item(const float* W, int N, bf16* WT, int ldt, int dest_row0, LAS float* scr, int k0, int n0, int lane) {
    float tv[32];
#pragma unroll
    for (int i = 0; i < 32; ++i) tv[i] = W[(size_t)(k0 + 2 * i + (lane >> 5)) * N + n0 + (lane & 31)];
    asm volatile("" ::: "memory");
#pragma unroll
    for (int i = 0; i < 32; ++i) scr[(2 * i + (lane >> 5)) * 33 + (lane & 31)] = tv[i];
    LDS_WAIT(); asm volatile("" ::: "memory");
    const int c = lane & 7;
#pragma unroll
    for (int j = 0; j < 4; ++j) { const int n = (lane >> 3) + 8 * j; const LAS float* s = scr + (8 * c) * 33 + n;
        v4u o; o.x = pk2(s[0 * 33], s[1 * 33]); o.y = pk2(s[2 * 33], s[3 * 33]); o.z = pk2(s[4 * 33], s[5 * 33]); o.w = pk2(s[6 * 33], s[7 * 33]);
        *(GAS v4u*)(WT + (size_t)(dest_row0 + n) * ldt + k0 + 8 * c) = o; }
    LDS_WAIT(); asm volatile("" ::: "memory");
}

struct Args { const float* in[19]; float* out; unsigned char* ws; int st_lo, st_hi; };
enum { I_X = 0, I_C, I_CTX, I_CCTX, I_ADAW, I_ADAB, I_NORMG, I_WG, I_WU, I_WD, I_WIN, I_QN, I_KVN, I_WUQ, I_WUKV, I_LAM, I_SUBLN, I_WOUT, I_FN };

__device__ __forceinline__ void transpose_set(const Args& a, LAS unsigned char* lds, int set, int widx, int nw) {
    unsigned char* ws = a.ws; int lane, wave; { int t_ = threadIdx.x; asm volatile("" : "+v"(t_)); lane = t_ & 63; wave = __builtin_amdgcn_readfirstlane(t_ >> 6); }
    {
        LAS float* scr = (LAS float*)(lds + wave * 8704);
        constexpr int PER_LF = 3 * 5632, N_FFN = 4 * PER_LF, PER_L = 2368 + 256 + 384 + 2048;
        const int nv = (set == 0) ? 2 * 5632 + PER_L : (set == 1) ? PER_LF + 5632 : (set == 2) ? PER_LF + PER_L : PER_LF;
        struct TI { const float* src; bf16* dst; int N, ldt; float sc; };
        auto decode = [&](int v) -> TI { TI t; t.sc = 1.0f; const int it = (set == 0) ? (v < 2 * 5632 ? v : N_FFN + (v - 2 * 5632))
                                                            : (v < PER_LF ? set * PER_LF + v : (set == 1 ? 2 * 5632 + (v - PER_LF) : N_FFN + PER_L + (v - PER_LF)));
            if (it < N_FFN) { const int lf = it / PER_LF, r = it % PER_LF, which = r / 5632, q = r % 5632;
                if (which < 2) { const int kb = q / 176, nb = q % 176, n0 = nb * 32;
                    t.src = (which == 0 ? a.in[I_WG] : a.in[I_WU]) + (size_t)lf * DM * DFF + (size_t)(kb * 64) * DFF + n0; t.N = DFF; t.sc = (which == 0) ? 1.4426950408889634f : 0.6931471805599453f;
                    t.dst = (bf16*)(ws + WS_WGU) + (size_t)lf * 2 * DFF * DM + ((size_t)((n0 >> 7) * 32 + kb) * 256 + which * 128 + (n0 & 127)) * 64; t.ldt = 64;
                } else { const int kb = q / 64, nb = q % 64;
                    t.src = a.in[I_WD] + (size_t)lf * DFF * DM + (size_t)(kb * 64) * DM + nb * 32; t.N = DM;
                    t.dst = (bf16*)(ws + WS_WD) + (size_t)lf * DM * DFFP + (size_t)(nb * 32) * DFFP + kb * 64; t.ldt = DFFP; }
            } else { int r = it - N_FFN; const int l = r / PER_L; r %= PER_L;
                if (r < 2368) { const int kb = r / 74, nb = r % 74; if (nb >= 58) t.sc = 0.18033688011112042f;     t.src = a.in[I_WIN] + (size_t)l * DM * WIN_N + (size_t)(kb * 64) * WIN_N + nb * 32; t.N = WIN_N; t.dst = (bf16*)(ws + WS_WIN) + (size_t)l * LDP * DM + (size_t)(nb * 32) * DM + kb * 64; t.ldt = DM; }
                else if ((r -= 2368) < 256) { const int kb = r / 64, nb = r % 64; t.src = a.in[I_WUKV] + (size_t)l * 256 * 2048 + (size_t)(kb * 64) * 2048 + nb * 32; t.N = 2048; t.dst = (bf16*)(ws + WS_WUKV) + (size_t)l * 2048 * 256 + (size_t)(nb * 32) * 256 + kb * 64; t.ldt = 256; }
                else if ((r -= 256) < 384) { const int kb = r / 48, nb = r % 48; t.sc = 0.10411754627697264f;     t.src = a.in[I_WUQ] + (size_t)l * 512 * 1536 + (size_t)(kb * 64) * 1536 + nb * 32; t.N = 1536; t.dst = (bf16*)(ws + WS_WUQ) + (size_t)l * 1536 * 512 + (size_t)(nb * 32) * 512 + kb * 64; t.ldt = 512; }
                else { r -= 384; const int kb = r / 64, nb = r % 64; t.src = a.in[I_WOUT] + (size_t)l * DM * DM + (size_t)(kb * 64) * DM + nb * 32; t.N = DM; t.dst = (bf16*)(ws + WS_WOUT) + (size_t)l * DM * DM + (size_t)(nb * 32) * DM + kb * 64; t.ldt = DM; } }
            return t; };
#define TR_LOAD(t, tv) do { _Pragma("unroll") for (int i_ = 0; i_ < 32; ++i_) tv[i_] = (t).src[(size_t)(2 * i_ + (lane >> 5)) * (t).N + (lane & 31)]; } while (0)
#define TR_PROC(t, tv) do { _Pragma("unroll") for (int i_ = 0; i_ < 32; ++i_) scr[(2 * i_ + (lane >> 5)) * 33 + (lane & 31)] = tv[i_]; \
            LDS_WAIT(); asm volatile("" ::: "memory"); const int c_ = lane & 7; \
            _Pragma("unroll") for (int j_ = 0; j_ < 4; ++j_) { const int n_ = (lane >> 3) + 8 * j_; const LAS float* s_ = scr + (8 * c_) * 33 + n_; \
                const float k_ = (t).sc; v4u o_; o_.x = pk2(s_[0 * 33] * k_, s_[1 * 33] * k_); o_.y = pk2(s_[2 * 33] * k_, s_[3 * 33] * k_); o_.z = pk2(s_[4 * 33] * k_, s_[5 * 33] * k_); o_.w = pk2(s_[6 * 33] * k_, s_[7 * 33] * k_); \
                *(GAS v4u*)((t).dst + (size_t)n_ * (t).ldt + 8 * c_) = o_; } \
            LDS_WAIT(); asm volatile("" ::: "memory"); } while (0)
        float tvA[32], tvB[32]; TI d0, d1; int it = widx;
        if (it < nv) { d0 = decode(it); TR_LOAD(d0, tvA); }
        while (it < nv) {
            const int it1 = it + nw, it2 = it1 + nw;
            if (it1 < nv) { d1 = decode(it1); TR_LOAD(d1, tvB); }
            TR_PROC(d0, tvA);
            if (it1 < nv) { if (it2 < nv) { d0 = decode(it2); TR_LOAD(d0, tvA); } TR_PROC(d1, tvB); }
            it = it2;
        }
#undef TR_LOAD
#undef TR_PROC
    }
}
__device__ __forceinline__ void prologue(const Args& a, LAS unsigned char* lds, int tid, int lane, int wave) {
    tid = threadIdx.x; asm volatile("" : "+v"(tid)); lane = tid & 63;
    unsigned char* ws = a.ws;
    const int G = gridDim.x, gw = blockIdx.x * NWAVES + wave, NGW = G * NWAVES;
    const int gt = blockIdx.x * (NWAVES * 64) + tid, NGT = G * NWAVES * 64;
    {
        for (int rp = 0; rp < NREP(13); ++rp) transpose_set(a, lds, 0, gw, NGW);
        for (int i = gt; i < 2 * 192 * DM / 8; i += NGT) { const int l = i / (192 * DM / 8), r = i % (192 * DM / 8);
            *(GAS v4u*)((bf16*)(ws + WS_WIN) + (size_t)l * LDP * DM + (size_t)PC_END * DM + (size_t)r * 8) = (v4u){0u, 0u, 0u, 0u}; }
    }
    for (int rpb = 0; rpb < NREP(20); ++rpb) {
        float* rope = (float*)(ws + WS_TAB);
        if (gt < 1024) { const int pos = gt >> 4, i = gt & 15; const float inv = powf(10000.0f, -(float)i / 16.0f), ang = (float)pos * inv; rope[pos * 32 + i] = cosf(ang); rope[pos * 32 + 16 + i] = sinf(ang); }
        if (blockIdx.x == 2 && wave == 0) { float* lamv = (float*)(ws + WS_TAB + 16384);
            for (int l = 0; l < 2; ++l) { const float* lf = a.in[I_LAM] + l * 256;
                const float s1 = wave_sum(lf[lane] * lf[64 + lane]), s2 = wave_sum(lf[128 + lane] * lf[192 + lane]);
                const float li = 0.8f - 0.6f * expf(-0.3f * (float)l); if (lane == 0) { lamv[2 * l] = expf(s1) - expf(s2) + li; lamv[2 * l + 1] = 1.0f - li; } } }
        bf16* dft = (bf16*)(ws + WS_DFT);
        for (int rp = 0; rp < NREP(16); ++rp)
        for (int i = gt; i < 2048 * 512; i += NGT) { const int sp = i >> 9, k = (i & 511) * 8, type = k >> 11, s = k & 2047; unsigned w[4];
#pragma unroll
            for (int j = 0; j < 4; ++j) { float v[2];
#pragma unroll
                for (int e = 0; e < 2; ++e) { const int t = ((s + 2 * j + e) * sp) & 2047; float sn, cs; sincospif((float)t * (1.0f / 1024.0f), &sn, &cs); v[e] = (type ? -sn : cs) * (1.0f / 512.0f); }
                w[j] = pk2(v[0], v[1]); }
            *(GAS v4u*)(dft + (size_t)sp * 4096 + k) = (v4u){w[0], w[1], w[2], w[3]}; }
        bf16* dftc = (bf16*)(ws + WS_DFTC);
        for (int i = gt; i < 256 * 64; i += NGT) { const int sp = i >> 6, k = (i & 63) * 8, type = k >> 8, s = k & 255; unsigned w[4];
#pragma unroll
            for (int j = 0; j < 4; ++j) { float v[2];
#pragma unroll
                for (int e = 0; e < 2; ++e) { const int t = ((s + 2 * j + e) * sp) & 255; float sn, cs; sincospif((float)t * (1.0f / 128.0f), &sn, &cs); v[e] = (type ? -sn : cs) * 0.005524271728019903f; }
                w[j] = pk2(v[0], v[1]); }
            *(GAS v4u*)(dftc + (size_t)sp * 512 + k) = (v4u){w[0], w[1], w[2], w[3]}; }
    }
    __syncthreads();
    {
        LAS float* U = (LAS float*)lds;
        LAS float* T = (LAS float*)(lds + 64 * 129 * 4);
        if (tid < 128) { float sn, cs; sincospif((float)tid * (1.0f / 64.0f), &sn, &cs); T[tid] = cs; T[128 + tid] = sn; }
        for (int rp = 0; rp < NREP(14); ++rp)
        for (int it = blockIdx.x; it < 2 * 4 * 32; it += G) { const int l = it >> 7, g = (it >> 5) & 3, k0 = (it & 31) * 64;
            __syncthreads();
            const float* src = a.in[I_WIN] + (size_t)l * DM * WIN_N + PC_END + g * 128;
            for (int i = tid; i < 64 * 128; i += NWAVES * 64) { const int r = i >> 7, c = i & 127; U[r * 129 + c] = src[(size_t)(k0 + r) * WIN_N + c]; }
            __syncthreads();
            typedef short bx8 __attribute__((ext_vector_type(8))); typedef float fx16 __attribute__((ext_vector_type(16)));
            const int r32 = lane & 31, hi = lane >> 5, cpr = (wave & 3) * 32 + r32; const LAS float* Tt = T + (wave >> 2) * 128;
            fx16 acc0 = {}, acc1 = {};
#pragma unroll 2
            for (int st = 0; st < 8; ++st) { const int c0 = 16 * st + 8 * hi; unsigned aw0[4], aw1[4], bw[4];
#pragma unroll
                for (int e = 0; e < 4; ++e) { aw0[e] = pk2(U[r32 * 129 + c0 + 2 * e], U[r32 * 129 + c0 + 2 * e + 1]); aw1[e] = pk2(U[(32 + r32) * 129 + c0 + 2 * e], U[(32 + r32) * 129 + c0 + 2 * e + 1]);
                    bw[e] = pk2(Tt[((c0 + 2 * e) * cpr) & 127], Tt[((c0 + 2 * e + 1) * cpr) & 127]); }
                const bx8 A0 = __builtin_bit_cast(bx8, (v4u){aw0[0], aw0[1], aw0[2], aw0[3]}), A1 = __builtin_bit_cast(bx8, (v4u){aw1[0], aw1[1], aw1[2], aw1[3]}), B = __builtin_bit_cast(bx8, (v4u){bw[0], bw[1], bw[2], bw[3]});
                acc0 = __builtin_amdgcn_mfma_f32_32x32x16_bf16(A0, B, acc0, 0, 0, 0); acc1 = __builtin_amdgcn_mfma_f32_32x32x16_bf16(A1, B, acc1, 0, 0, 0); }
            bf16* wrow = (bf16*)(ws + WS_WF1) + (size_t)l * 1024 * DM + (size_t)((wave >> 2) * 512 + g * 128 + cpr) * DM + k0 + 4 * hi;
#pragma unroll
            for (int q = 0; q < 4; ++q) { u32x2 w0, w1; w0.x = pk2(acc0[4 * q], acc0[4 * q + 1]); w0.y = pk2(acc0[4 * q + 2], acc0[4 * q + 3]); w1.x = pk2(acc1[4 * q], acc1[4 * q + 1]); w1.y = pk2(acc1[4 * q + 2], acc1[4 * q + 3]);
                *(u32x2*)(wrow + 8 * q) = w0; *(u32x2*)(wrow + 32 + 8 * q) = w1; }
        }
    }
    __syncthreads();
    {
        LAS float* S = (LAS float*)lds;
        LAS float* red = (LAS float*)(lds + 9 * 2048 * 4);
        for (int rps = 0; rps < NREP(21); ++rps)
        for (int i = tid; i < 9 * 2048; i += NWAVES * 64) { const int r = i >> 11, k = i & 2047; const float c = r < 8 ? a.in[I_C][r * DM + k] : a.in[I_CCTX][k]; S[i] = c / (1.0f + expf(-c)); }
        __syncthreads();
        float* mod = (float*)(ws + WS_MOD);
        const int cg = tid % 36, ks = tid / 36;
        for (int rp = 0; rp < NREP(15); ++rp)
        for (int ch = blockIdx.x; ch < 256; ch += G) { const int l = ch >> 7, col0 = (ch & 127) * 144;
            f32x4 acc[9];
#pragma unroll
            for (int r = 0; r < 9; ++r) acc[r] = (f32x4){0.f, 0.f, 0.f, 0.f};
            if (tid < 504) { const float* W = a.in[I_ADAW] + (size_t)l * DM * MODROW + col0 + 4 * cg; const int kbeg = ks * 147, kend = kbeg + 147 < 2048 ? kbeg + 147 : 2048;
#pragma unroll 8
                for (int k = kbeg; k < kend; ++k) { const f32x4 w = *(const f32x4*)(W + (size_t)k * MODROW);
#pragma unroll
                    for (int r = 0; r < 9; ++r) acc[r] += w * S[r * 2048 + k]; } }
#pragma unroll
            for (int p = 0; p < 3; ++p) {
                __syncthreads();
                if (tid < 504) {
#pragma unroll
                    for (int j = 0; j < 3; ++j) *(LAS f32x4*)(red + (size_t)tid * 12 + 4 * j) = acc[3 * p + j]; }
                __syncthreads();
                if (tid < 432) { const int cgo = tid / 12, j = tid % 12; float s = 0.f;
#pragma unroll
                    for (int q = 0; q < 14; ++q) s += red[(q * 36 + cgo) * 12 + j];
                    const int r = 3 * p + (j >> 2), col = col0 + 4 * cgo + (j & 3);
                    float val = s + a.in[I_ADAB][l * MODROW + col]; const int chunk = col >> 11;
                    if (chunk == 1 || chunk == 4 || chunk == 7) val = (1.0f + val) * a.in[I_NORMG][(size_t)(l * 3 + (chunk - 1) / 3) * DM + (col & 2047)];
                    mod[((size_t)l * 9 + r) * MODROW + col] = val; }
            }
        }
    }
    __syncthreads();
}

__device__ __forceinline__ void norm_mod_phase(const float* src_lat, const float* src_ctx, bf16* H, const float* g, const float* modl, int ish, int isc, int nrows,
                                               const bf16* dlat, bf16* xb, const bf16* pend, const float* pgate, float pcoef, float* xout_ctx, int gw, int NGW, int lane) {
    { int t_ = threadIdx.x; asm volatile("" : "+v"(t_)); lane = t_ & 63; }
#define NM_LOAD(r, raw) do { \
        if ((r) < MLAT) { \
            if (dlat != nullptr) { const u32x2* dr_ = (const u32x2*)(dlat + (size_t)(r) * DM); const u32x2* xbr_ = (const u32x2*)(xb + (size_t)(r) * DM); \
                _Pragma("unroll") for (int j = 0; j < 8; ++j) { const u32x2 x_ = xbr_[lane + 64 * j], d_ = dr_[lane + 64 * j]; raw[j] = (v4u){x_.x, x_.y, d_.x, d_.y}; } }     \
            else { const v4u* xr_ = (const v4u*)(src_lat + (size_t)(r) * DM); _Pragma("unroll") for (int j = 0; j < 8; ++j) raw[j] = xr_[lane + 64 * j]; } \
        } else { const v4u* xr_ = (const v4u*)(src_ctx + (size_t)((r) - MLAT) * DM); _Pragma("unroll") for (int j = 0; j < 8; ++j) raw[j] = xr_[lane + 64 * j]; } } while (0)
      \
#define NM_GAIN(r) do { const float* mr_ = modl + (size_t)((r) < MLAT ? ((r) >> 11) : 8) * MODROW; \
        _Pragma("unroll") for (int j = 0; j < 8; ++j) { const int c4 = lane + 64 * j; scv[j] = ((const f32x4*)(mr_ + isc * DM))[c4]; shv[j] = ((const f32x4*)(mr_ + ish * DM))[c4]; } } while (0)
#define NM_FINISH(r, raw) do { f32x4 v[8]; \
        u32x2* o_ = (u32x2*)(H + (((size_t)((r) >> 8) * 32 + (lane >> 4)) * 256 + ((r) & 255)) * 64 + 4 * (lane & 15));     \
        if ((r) < MLAT) { \
            if (dlat != nullptr) { _Pragma("unroll") for (int j = 0; j < 8; ++j) { const v4u w_ = raw[j]; \
                v[j].x = __builtin_bit_cast(float, w_.x << 16) + __builtin_bit_cast(float, w_.z << 16); v[j].y = __builtin_bit_cast(float, w_.x & 0xffff0000u) + __builtin_bit_cast(float, w_.z & 0xffff0000u); \
                v[j].z = __builtin_bit_cast(float, w_.y << 16) + __builtin_bit_cast(float, w_.w << 16); v[j].w = __builtin_bit_cast(float, w_.y & 0xffff0000u) + __builtin_bit_cast(float, w_.w & 0xffff0000u); } } \
            else { _Pragma("unroll") for (int j = 0; j < 8; ++j) v[j] = __builtin_bit_cast(f32x4, raw[j]); } \
            if (dlat == nullptr && xb != nullptr) { u32x2* xbw_ = (u32x2*)(xb + (size_t)(r) * DM); _Pragma("unroll") for (int j = 0; j < 8; ++j) { u32x2 w_; w_.x = pk2(v[j].x, v[j].y); w_.y = pk2(v[j].z, v[j].w); xbw_[lane + 64 * j] = w_; } } \
        } else { _Pragma("unroll") for (int j = 0; j < 8; ++j) v[j] = __builtin_bit_cast(f32x4, raw[j]); if (pend != nullptr) { const size_t ro_ = (size_t)((r) - MLAT) * DM; int ln_ = lane; asm volatile("" : "+v"(ln_));     \
            _Pragma("unroll") for (int j = 0; j < 8; ++j) { const int c4 = ln_ + 64 * j; f32x4 p_ = (f32x4){0.f, 0.f, 0.f, 0.f}; \
                _Pragma("unroll") for (int q = 0; q < 4; ++q) { const u32x2 e_ = ((const u32x2*)(pend + (size_t)q * MCTX * DM + ro_))[c4]; \
                    p_.x += __builtin_bit_cast(float, e_.x << 16); p_.y += __builtin_bit_cast(float, e_.x & 0xffff0000u); p_.z += __builtin_bit_cast(float, e_.y << 16); p_.w += __builtin_bit_cast(float, e_.y & 0xffff0000u); } \
                v[j] = v[j] + (((const f32x4*)pgate)[c4] * pcoef) * p_; ((f32x4*)(xout_ctx + ro_))[c4] = v[j]; } } } \
        float ss_ = 0.f; \
        _Pragma("unroll") for (int j = 0; j < 8; ++j) ss_ += (v[j].x * v[j].x + v[j].y * v[j].y) + (v[j].z * v[j].z + v[j].w * v[j].w); \
        const float rstd_ = rsqrtf(wave_sum(ss_) * (1.0f / DM) + EPS); \
        _Pragma("unroll") for (int j = 0; j < 8; ++j) { const f32x4 sc_ = scv[j], sh_ = shv[j];     \
            const f32x4 y_ = (v[j] * rstd_) * sc_ + sh_; u32x2 w_; w_.x = pk2(y_.x, y_.y); w_.y = pk2(y_.z, y_.w); o_[(size_t)j * (4 * 256 * 64 / 4)] = w_; } } while (0)
    v4u rawA[8], rawB[8]; f32x4 scv[8], shv[8];
    int r = gw < nrows ? gw + ((nrows - 1 - gw) / NGW) * NGW : -1;
    if (r >= 0) NM_LOAD(r, rawA);
    while (r >= 0) {
        const int r1 = r - NGW, r2 = r1 - NGW;
        asm volatile("" ::: "memory");
        NM_GAIN(r);
        asm volatile("" ::: "memory");
        if (r1 >= 0) NM_LOAD(r1, rawB);
        asm volatile("" ::: "memory");
        NM_FINISH(r, rawA);
        if (r1 >= 0) { asm volatile("" ::: "memory"); NM_GAIN(r1); asm volatile("" ::: "memory"); if (r2 >= 0) NM_LOAD(r2, rawA); asm volatile("" ::: "memory"); NM_FINISH(r1, rawB); }
        r = r2;
    }
#undef NM_LOAD
#undef NM_GAIN
#undef NM_FINISH
}
__device__ __forceinline__ void final_norm_phase(const float* X, const bf16* D, float* out, const float* g, int gw, int NGW, int lane) {
    { int t_ = threadIdx.x; asm volatile("" : "+v"(t_)); lane = t_ & 63; }
#define FN_LOAD(r, v, d) do { const f32x4* xr_ = (const f32x4*)(X + (size_t)(r) * DM); const u32x2* dr_ = (const u32x2*)(D + (size_t)(r) * DM); \
        _Pragma("unroll") for (int j = 0; j < 8; ++j) { v[j] = xr_[lane + 64 * j]; d[j] = dr_[lane + 64 * j]; } } while (0)
#define FN_FINISH(r, v, d) do { float ss_ = 0.f; \
        _Pragma("unroll") for (int j = 0; j < 8; ++j) { \
            v[j].x += __builtin_bit_cast(float, d[j].x << 16); v[j].y += __builtin_bit_cast(float, d[j].x & 0xffff0000u); v[j].z += __builtin_bit_cast(float, d[j].y << 16); v[j].w += __builtin_bit_cast(float, d[j].y & 0xffff0000u); \
            ss_ += (v[j].x * v[j].x + v[j].y * v[j].y) + (v[j].z * v[j].z + v[j].w * v[j].w); } \
        const float rstd_ = rsqrtf(wave_sum(ss_) * (1.0f / DM) + EPS); f32x4* o_ = (f32x4*)(out + (size_t)(r) * DM); \
        _Pragma("unroll") for (int j = 0; j < 8; ++j) o_[lane + 64 * j] = (v[j] * rstd_) * gv[j]; } while (0)
    f32x4 va[8], vb[8], gv[8]; u32x2 da[8], db[8];
#pragma unroll
    for (int j = 0; j < 8; ++j) gv[j] = ((const f32x4*)g)[lane + 64 * j];
    int r = gw;
    if (r < MLAT) FN_LOAD(r, va, da);
    while (r < MLAT) {
        const int r1 = r + NGW, r2 = r1 + NGW;
        if (r1 < MLAT) FN_LOAD(r1, vb, db);
        asm volatile("" ::: "memory");
        FN_FINISH(r, va, da);
        if (r1 < MLAT) { if (r2 < MLAT) FN_LOAD(r2, va, da); asm volatile("" ::: "memory"); FN_FINISH(r1, vb, db); }
        r = r2;
    }
#undef FN_LOAD
#undef FN_FINISH
}
__device__ __forceinline__ void postproj_phase(bf16* P, const float* kvn, const float* qn, const float* rope, int nrows, int gw, int NGW, int lane) {
    { int t_ = threadIdx.x; asm volatile("" : "+v"(t_)); lane = t_ & 63; }
#define PP_IDX(t) const int p = lane + 64 * (t), v = p >> 5, q = p & 31, half = q >> 4, i = q & 15; const int cb = v == 0 ? PC_KR : (v <= 8 ? PC_DK + (v - 1) * 64 : PC_DQ + (v - 9) * 64), ia = cb + half * 32 + i
#define PP_LOAD(r, wkv, wq, x1, x2, cs, sn) do { const bf16* pr_ = P + (size_t)(r) * LDP; wkv = ((const u32x2*)(pr_ + PC_CKV))[lane]; wq = ((const v4u*)(pr_ + PC_CQ))[lane]; \
        const bool lat_ = (r) < MLAT; const int s_ = (r) & 2047, prow_ = s_ >> 6, pcol_ = s_ & 63; \
        _Pragma("unroll") for (int t = 0; t < 9; ++t) { PP_IDX(t); const int pos = half ? pcol_ : prow_; \
            if (lat_ && p < 544) { x1[t] = pr_[ia]; x2[t] = pr_[ia + 16]; cs[t] = rope[pos * 32 + i]; sn[t] = rope[pos * 32 + 16 + i]; } else { x1[t] = 0; x2[t] = 0; cs[t] = 0.f; sn[t] = 0.f; } } } while (0)
#define PP_FINISH(r, wkv, wq, x1, x2, cs, sn) do { bf16* pr_ = P + (size_t)(r) * LDP; \
        { const float x0 = bf2f((unsigned short)(wkv.x & 0xffff)), xa = bf2f((unsigned short)(wkv.x >> 16)), xb = bf2f((unsigned short)(wkv.y & 0xffff)), xc = bf2f((unsigned short)(wkv.y >> 16)); \
          const float rstd = rsqrtf(wave_sum((x0 * x0 + xa * xa) + (xb * xb + xc * xc)) * (1.0f / 256.0f) + EPS); \
          u32x2 o; o.x = pk2(x0 * rstd * gkv.x, xa * rstd * gkv.y); o.y = pk2(xb * rstd * gkv.z, xc * rstd * gkv.w); ((u32x2*)(pr_ + PC_CKV))[lane] = o; } \
        { float x[8]; \
          x[0] = bf2f((unsigned short)(wq.x & 0xffff)); x[1] = bf2f((unsigned short)(wq.x >> 16)); x[2] = bf2f((unsigned short)(wq.y & 0xffff)); x[3] = bf2f((unsigned short)(wq.y >> 16)); \
          x[4] = bf2f((unsigned short)(wq.z & 0xffff)); x[5] = bf2f((unsigned short)(wq.z >> 16)); x[6] = bf2f((unsigned short)(wq.w & 0xffff)); x[7] = bf2f((unsigned short)(wq.w >> 16)); \
          float ss = 0.f; \
          _Pragma("unroll") for (int j = 0; j < 8; ++j) ss += x[j] * x[j]; \
          const float rstd = rsqrtf(wave_sum(ss) * (1.0f / 512.0f) + EPS); \
          v4u o; o.x = pk2(x[0] * rstd * gq0.x, x[1] * rstd * gq0.y); o.y = pk2(x[2] * rstd * gq0.z, x[3] * rstd * gq0.w); o.z = pk2(x[4] * rstd * gq1.x, x[5] * rstd * gq1.y); o.w = pk2(x[6] * rstd * gq1.z, x[7] * rstd * gq1.w); \
          ((v4u*)(pr_ + PC_CQ))[lane] = o; } \
        if ((r) < MLAT) { \
            _Pragma("unroll") for (int t = 0; t < 9; ++t) { PP_IDX(t); const float a1 = bf2f(x1[t]), a2 = bf2f(x2[t]); \
                if (p < 544) { pr_[ia] = (bf16)f2bf(a1 * cs[t] - a2 * sn[t]); pr_[ia + 16] = (bf16)f2bf(a1 * sn[t] + a2 * cs[t]); } } } } while (0)
    const f32x4 gkv = ((const f32x4*)kvn)[lane], gq0 = ((const f32x4*)qn)[2 * lane], gq1 = ((const f32x4*)qn)[2 * lane + 1];
    u32x2 wkvA, wkvB; v4u wqA, wqB; unsigned short x1A[9], x2A[9], x1B[9], x2B[9]; float csA[9], snA[9], csB[9], snB[9];
    int r = gw;
    if (r < nrows) PP_LOAD(r, wkvA, wqA, x1A, x2A, csA, snA);
    while (r < nrows) {
        const int r1 = r + NGW, r2 = r1 + NGW;
        if (r1 < nrows) PP_LOAD(r1, wkvB, wqB, x1B, x2B, csB, snB);
        asm volatile("" ::: "memory");
        PP_FINISH(r, wkvA, wqA, x1A, x2A, csA, snA);
        if (r1 < nrows) { if (r2 < nrows) PP_LOAD(r2, wkvA, wqA, x1A, x2A, csA, snA); asm volatile("" ::: "memory"); PP_FINISH(r1, wkvB, wqB, x1B, x2B, csB, snB); }
        r = r2;
    }
#undef PP_IDX
#undef PP_LOAD
#undef PP_FINISH
}
__device__ __forceinline__ void fourier_combine(const float* F2p, const bf16* Ct, bf16* Oo, int gw, int NGW) {
    int lane; { int t_ = threadIdx.x; asm volatile("" : "+v"(t_)); lane = t_ & 63; }
    constexpr int NIT = NB * 1024, PER = 4;
    f32x4 p1[PER][2], p2[PER][2];
#pragma unroll
    for (int q = 0; q < PER; ++q) { const int it = gw + q * NGW; if (it < NIT) { const int b = it >> 10, sp = it & 1023;
        const f32x4* r1 = (const f32x4*)(F2p + (size_t)sp * (NB * 512) + b * 512) + 2 * lane; const f32x4* r2 = (const f32x4*)(F2p + ((size_t)1024 + sp) * (NB * 512) + b * 512) + 2 * lane;
        p1[q][0] = r1[0]; p1[q][1] = r1[1]; p2[q][0] = r2[0]; p2[q][1] = r2[1]; } }
    v4u cv[2][4];
#pragma unroll
    for (int q = 0; q < 2; ++q) { const int it = gw + q * NGW; if (it < NB * 512) { const v4u* src = (const v4u*)(Ct + (size_t)it * 4096) + 4 * lane;
#pragma unroll
        for (int j = 0; j < 4; ++j) cv[q][j] = src[j]; } }
    asm volatile("" ::: "memory");
#pragma unroll
    for (int q = 0; q < PER; ++q) { const int it = gw + q * NGW; if (it < NIT) { const int b = it >> 10, sp = it & 1023;
        const f32x4 a0 = p1[q][0] + p2[q][0], a1 = p1[q][1] + p2[q][1], d0 = p1[q][0] - p2[q][0], d1 = p1[q][1] - p2[q][1];
        v4u w; w.x = pk2(a0.x, a0.y); w.y = pk2(a0.z, a0.w); w.z = pk2(a1.x, a1.y); w.w = pk2(a1.z, a1.w);
        *((v4u*)(Oo + ((size_t)b * SEQ + sp) * DM + 1536) + lane) = w;
        if (sp != 0) { v4u x; x.x = pk2(d0.x, d0.y); x.y = pk2(d0.z, d0.w); x.z = pk2(d1.x, d1.y); x.w = pk2(d1.z, d1.w);
            *((v4u*)(Oo + ((size_t)b * SEQ + (SEQ - sp)) * DM + 1536) + lane) = x; } } }
#pragma unroll
    for (int q = 0; q < 2; ++q) { const int it = gw + q * NGW; if (it < NB * 512) { float sacc = 0.f;
#pragma unroll
        for (int j = 0; j < 4; ++j) { const v4u c = cv[q][j]; const unsigned wds[4] = {c.x, c.y, c.z, c.w};
#pragma unroll
            for (int e = 0; e < 4; ++e) sacc += __builtin_bit_cast(float, wds[e] << 16) - __builtin_bit_cast(float, wds[e] & 0xffff0000u); }
        const float tot = wave_sum(sacc) * (1.0f / 512.0f);
        if (lane == 0) { const int b = it >> 9, n = it & 511; Oo[((size_t)b * SEQ + 1024) * DM + 1536 + n] = (bf16)f2bf(tot); } } }
}
__device__ __forceinline__ void attn_phase(unsigned char* ws, bool with_ctx, char* ldsg, LAS unsigned char* ldsg_las, int vcu, int cv, float lam, float omli, const float* subln) {
    const bf16* P = (const bf16*)(ws + WS_P); const bf16* KV = (const bf16*)(ws + WS_KV); const bf16* Q = (const bf16*)(ws + WS_Q);
    bf16* O = (bf16*)(ws + WS_O);
    for (int rep = 0; rep < 3; ++rep) {
        int b, h, row0, nkeys;
        if (rep < 2) { const int u = vcu + 256 * rep; b = u >> 6; h = (u >> 3) & 7; row0 = b * SEQ + (u & 7) * 256; nkeys = CTXL + SEQ; }
        else { if (!with_ctx || cv < 128 || cv >= 192) break; const int e = cv - 128; b = e >> 3; h = e & 7; row0 = MLAT + b * CTXL; nkeys = CTXL; }
        fa::Src S; S.Q = Q + (size_t)row0 * 1536 + h * 192; S.ldq = 1536; S.Kn = KV + h * 256; S.ldkn = DM; S.Kr = P + PC_KR; S.ldkr = LDP; S.V = KV + h * 256 + 128; S.ldv = DM;
        S.seg0 = MLAT + b * CTXL; S.seg1 = b * SEQ; S.nkeys = nkeys; S.O = O + (size_t)row0 * DM + h * 128; S.ldo = DM;
        S.lam = 0.f; S.omli = 0.f; S.subln = nullptr;
        for (int rp = 0; rp < NREP(17); ++rp) fa::attn_unit_dma<192, 0>(S, ldsg, (LAS unsigned char*)ldsg_las);
    }
    for (int rep = 0; rep < 2; ++rep) {
        int b, hh, row0, nkeys;
        if (rep == 0) { b = vcu >> 5; hh = (vcu >> 3) & 3; row0 = b * SEQ + (vcu & 7) * 256; nkeys = CTXL + SEQ; }
        else { if (!with_ctx || cv < 192 || cv >= 224) break; const int e = cv - 192; b = e >> 2; hh = e & 3; row0 = MLAT + b * CTXL; nkeys = CTXL; }
        fa::Src S; S.Kn = nullptr; S.ldkn = 0; S.ldq = LDP; S.ldkr = LDP; S.V = P + PC_DV + hh * 128; S.ldv = LDP;
        S.seg0 = MLAT + b * CTXL; S.seg1 = b * SEQ; S.nkeys = nkeys; S.O = O + (size_t)row0 * DM + 1024 + hh * 128; S.ldo = DM; S.lam = lam; S.omli = omli; S.subln = subln;
        S.Q = P + (size_t)row0 * LDP + PC_DQ + (2 * hh) * 64; S.Kr = P + PC_DK + (2 * hh) * 64;
        for (int rp = 0; rp < NREP(18); ++rp) {
        fa::attn_unit_dma<64, 1>(S, ldsg, (LAS unsigned char*)ldsg_las);
        S.Q += 64; S.Kr += 64;
        fa::attn_unit_dma<64, 2>(S, ldsg, (LAS unsigned char*)ldsg_las);
        S.Q -= 64; S.Kr -= 64; }
    }
}
#ifndef GSMASK
#define GSMASK 0xffffffffu
#endif
#define GS(n) ((GSMASK >> (n)) & 1u)
__global__ void __launch_bounds__(NWAVES * 64, 2) mega(Args a) {
    extern __shared__ __attribute__((aligned(16))) unsigned char lds_raw[];
    LAS unsigned char* lds = (LAS unsigned char*)lds_raw;
    volatile LAS unsigned* MISC = (volatile LAS unsigned*)(lds + MISC_OFF);
    const int tid = 0, lane = 0;
    const int wave = __builtin_amdgcn_readfirstlane((int)threadIdx.x >> 6);
    const int G = gridDim.x, gw = blockIdx.x * NWAVES + wave, NGW = G * NWAVES;
    unsigned char* ws = a.ws;
    int vcu = (G % 8 == 0) ? (int)(blockIdx.x % 8) * (G / 8) + (int)(blockIdx.x / 8) : (int)blockIdx.x;
    int cv = (int)blockIdx.x;
    for (int u = threadIdx.x; u < (LDS_BYTES - LDSCTL_OFF) / 4; u += NWAVES * 64) ((LAS unsigned*)(lds + LDSCTL_OFF))[u] = 0u;
    __syncthreads();
    const int lo = a.st_lo, hi = a.st_hi;
    XcdBarrier bar; bar.bar = (unsigned*)(ws + WS_CTL) + CW_BAR; bar.x = 0; bar.st = nullptr;
    if (hi - lo > 1) bar = xcd_barrier_post((unsigned*)(ws + WS_CTL) + CW_BAR, MISC + 8);
#define IN(k) (lo <= (k) && (k) < hi)
#define SEAM(k) do { if (hi > (k) + 1) xcd_barrier(bar); else __syncthreads(); } while (0)
#define WSB() ({ unsigned char* p_ = ws; asm volatile("" : "+s"(p_)); p_; })
#define XC ((float*)(WSB() + WS_X))
#define H ((bf16*)(WSB() + WS_H))
#define O ((bf16*)(WSB() + WS_O))
#define ACT ((bf16*)(WSB() + WS_ACT))
#define P ((bf16*)(WSB() + WS_P))
#define KV ((bf16*)(WSB() + WS_KV))
#define Q ((bf16*)(WSB() + WS_Q))
#define OD ((float*)(WSB() + WS_OD))
#define CT ((bf16*)(WSB() + WS_CT))
#define CTC ((bf16*)(WSB() + WS_CTC))
#define PART ((bf16*)(WSB() + WS_PART))
#define F2P ((float*)(WSB() + WS_PART + 32 * MiB))
#define DBUF ((bf16*)(WSB() + WS_S))
#define XB ((bf16*)(WSB() + WS_S + 64 * MiB))
#define MOD ((const float*)(WSB() + WS_MOD))
#define ROPE ((const float*)(WSB() + WS_TAB))
#define LAMV ((const float*)(WSB() + WS_TAB + 16384))
    LAS unsigned char* ring = lds;

#ifndef NO_PRO
    if (IN(0)) for (int rp = 0; rp < NREP(10); ++rp) { prologue(a, lds, tid, lane, wave); SEAM(0); }
    if (lo == 0 && hi > 1 && (G % 8) == 0) {
        if (threadIdx.x == 0) { unsigned* bw = (unsigned*)(ws + WS_CTL) + CW_BAR; unsigned start = 0;
            for (unsigned j = 0; j < 16; ++j) { const unsigned cj = xb_ld(&bw[XB_XCNT(j)]); if (j < bar.x) start += cj; }
            MISC[11] = start + MISC[10]; }
        __syncthreads();
        const int u = __builtin_amdgcn_readfirstlane((int)MISC[11]);
        if (u >= 0 && u < G) { vcu = u; cv = (u % (G / 8)) * 8 + u / (G / 8); }
    }
#endif

    for (int fi = 0; fi < 4; ++fi) {
        const int base = 1 + 16 * fi, l = fi >> 1, f = fi & 1;
        const int Mf = (fi == 3) ? MLAT : MTOT;
        const float* modl = MOD + (size_t)l * 9 * MODROW;
        const float* xin_lat = a.in[I_X]; const float* xin_ctx = (fi == 0) ? a.in[I_CTX] : XC;
        if (IN(base + 0)) for (int rp = 0; rp < (fi == 0 ? NREP(0) : 1); ++rp) { norm_mod_phase(xin_lat, xin_ctx, H, a.in[I_NORMG] + (size_t)(l * 3 + 2 * f) * DM, modl, 6 * f + 0, 6 * f + 1, Mf,
                fi > 0 ? DBUF : nullptr, XB, (fi == 1 || fi == 2) ? PART : nullptr, fi == 1 ? modl + 8 * MODROW + 5 * DM : MOD + 8 * MODROW + 8 * DM  , fi == 1 ? 1.0f : 0.5f, XC, gw, NGW, lane);
            if (fi == 1 && NREP(23) > 1) norm_mod_phase(xin_lat, xin_ctx, H, a.in[I_NORMG] + (size_t)(l * 3 + 2 * f) * DM, modl, 6 * f + 0, 6 * f + 1, MLAT, DBUF, XB, nullptr, nullptr, 0.f, XC, gw, NGW, lane);
            SEAM(base + 0); }
        if (IN(base + 1)) for (int rp = 0; rp < NREP(1); ++rp) {
            pg8::Gemm g{H, (const bf16*)(WSB() + WS_WGU) + (size_t)fi * 2 * DFF * DM, Mf, 2 * DFF, DM, 64, 64, 32768, 32768, (size_t)32 * 32768, (size_t)32 * 32768};     pg8::StaticOrder S; S.init(Mf, 2 * DFF, G, cv);
            pg8::EpiSwiglu E{ACT, DFF / 64, 0};
            if (GS(1)) pg8::gemm_phase<pg8::EpiSwiglu, pg8::StaticOrder, true, true>(ring, g, S, E);
            if (fi < 3 && cv >= 96) { __syncthreads(); transpose_set(a, lds, fi + 1, (cv - 96) * NWAVES + wave, (G - 96) * NWAVES); }
            if (NREP(22) > 1) { __syncthreads(); pg8::EpiSwiglu E2{ACT, DFF / 64, 1}; pg8::gemm_phase<pg8::EpiSwiglu, pg8::StaticOrder, true, true>(ring, g, S, E2); }
            SEAM(base + 1);
        }
        if (IN(base + 2)) for (int rp = 0; rp < (fi == 0 ? NREP(2) : 1); ++rp) {
            { pg8::Gemm g{ACT, (const bf16*)(WSB() + WS_WD) + (size_t)fi * DM * DFFP, MTOT, DM, DFF, 64, DFFP, 32768, 128, (size_t)(DFF / 64) * 32768, (size_t)256 * DFFP * 2};
              pg8::LatCtxOrder S; S.init(G, cv, (DFF / 4 / 64) * 32768, (DFF / 4) * 2, DFF / 4 / 64, fi < 3 ? 1 : 0);
              pg8::EpiLatCtx E{{DBUF, modl + (6 * f + 2) * DM, 0.5f, fi == 0 ? 1 : 0}, {PART, MCTX}};
              for (int r2 = 0; r2 < (fi == 0 ? NREP(11) : 1); ++r2) { if (GS(2)) pg8::gemm_phase<pg8::EpiLatCtx, pg8::LatCtxOrder, true, true>(ring, g, S, E); __syncthreads(); } }
            SEAM(base + 2);
        }
        if (f == 0) {
            const int Mq = (l == 0) ? MTOT : MLAT;
            if (IN(base + 3)) { norm_mod_phase(xin_lat, xin_ctx, H, a.in[I_NORMG] + (size_t)(l * 3 + 1) * DM, modl, 3, 4, MTOT, DBUF, XB, PART, modl + 8 * MODROW + 2 * DM, 0.5f, XC, gw, NGW, lane); SEAM(base + 3); }
            if (IN(base + 4)) for (int rp = 0; rp < NREP(4); ++rp) {
                { pg8::Gemm g{H, (const bf16*)(WSB() + WS_WIN) + (size_t)l * LDP * DM, MTOT, LDP, DM, 64, DM, 32768, 128, (size_t)32 * 32768, (size_t)256 * DM * 2}; pg8::StaticOrder S; S.init(MTOT, LDP, G, cv);
                  pg8::EpiStoreBf16 E{P, LDP};
                  if (GS(3)) pg8::gemm_phase<pg8::EpiStoreBf16, pg8::StaticOrder, true, true>(ring, g, S, E); }
                __syncthreads();
                { pg8::Gemm g{(const bf16*)(WSB() + WS_WF1) + (size_t)l * 1024 * DM, H, 1024, Mq, DM, DM, 64, 128, 32768, (size_t)256 * DM * 2, (size_t)32 * 32768}; pg8::StaticOrder S; S.init(1024, Mq, G, (cv + 48) % G);
                  pg8::EpiF1 E{CT, CTC};
                  if (GS(4)) pg8::gemm_phase<pg8::EpiF1, pg8::StaticOrder, true, true>(ring, g, S, E); }
                SEAM(base + 4);
            }
            if (IN(base + 5)) {
                if (cv >= G / 2) postproj_phase(P, a.in[I_KVN] + l * 256, a.in[I_QN] + l * 512, ROPE, MTOT, (cv - G / 2) * NWAVES + wave, (G - G / 2) * NWAVES, lane);
                { pg8::Gemm g = pg8::mk_gemm((const bf16*)(WSB() + WS_DFT), CT, SEQ / 2, NB * 512, 2048, 4096, 4096); pg8::SplitKOrder S; S.init(SEQ / 2, NB * 512, 2, 2048 * 2, 2048 * 2, G, cv);
                  pg8::EpiPartF32 E{F2P, SEQ / 2, NB * 512};
                  for (int r2 = 0; r2 < NREP(19); ++r2) { if (GS(7)) pg8::gemm_phase<pg8::EpiPartF32, pg8::SplitKOrder, true, true>(ring, g, S, E); __syncthreads(); } }
                if (l == 0) {
                  __syncthreads();
                  pg8::Gemm g = pg8::mk_gemm((const bf16*)(WSB() + WS_DFTC), CTC, CTXL, NB * 512, 512, 512, 512); pg8::StaticOrder S; S.init(CTXL, NB * 512, G, (cv + 112) % G);
                  pg8::EpiF2 E{O, MLAT, CTXL};
                  if (GS(8)) pg8::gemm_phase<pg8::EpiF2, pg8::StaticOrder, true, true>(ring, g, S, E); }
                SEAM(base + 5); }
            if (IN(base + 6)) for (int rp = 0; rp < NREP(6); ++rp) {
                fourier_combine(F2P, CT, O, gw, NGW); __syncthreads();
                { pg8::Gemm g = pg8::mk_gemm(P + PC_CKV, (const bf16*)(WSB() + WS_WUKV) + (size_t)l * 2048 * 256, MTOT, 2048, 256, LDP, 256); pg8::StaticOrder S; S.init(MTOT, 2048, G, cv);
                  pg8::EpiStoreBf16 E{KV, DM};
                  if (GS(5)) pg8::gemm_phase<pg8::EpiStoreBf16, pg8::StaticOrder, true, true>(ring, g, S, E); }
                __syncthreads();
                { pg8::Gemm g = pg8::mk_gemm(P + PC_CQ, (const bf16*)(WSB() + WS_WUQ) + (size_t)l * 1536 * 512, Mq, 1536, 512, LDP, 512); pg8::StaticOrder S; S.init(Mq, 1536, G, (cv + 176) % G);
                  pg8::EpiRopeQ E{Q, 1536, ROPE};
                  if (GS(6)) pg8::gemm_phase<pg8::EpiRopeQ, pg8::StaticOrder, true, true>(ring, g, S, E); }
                SEAM(base + 6);
            }
            if (IN(base + 7)) for (int rp = 0; rp < NREP(7); ++rp) {
                attn_phase(ws, l == 0, (char*)lds_raw, lds, vcu, cv, LAMV[2 * l], LAMV[2 * l + 1], a.in[I_SUBLN] + l * 128);
                SEAM(base + 7);
            }
            if (IN(base + 9)) {
                { pg8::Gemm g = pg8::mk_gemm(O, (const bf16*)(WSB() + WS_WOUT) + (size_t)l * DM * DM, MTOT, DM, DM, DM, DM);
                  pg8::LatCtxOrder S; S.init(G, cv, (DM / 4) * 2, (DM / 4) * 2, DM / 4 / 64, l == 0 ? 1 : 0);
                  pg8::EpiLatCtx E{{DBUF, modl + 5 * DM, 1.0f, 0}, {PART, MCTX}};
                  if (GS(9)) pg8::gemm_phase<pg8::EpiLatCtx, pg8::LatCtxOrder, true, true>(ring, g, S, E); }
                SEAM(base + 9);
            }
        }
    }
    if (IN(65)) final_norm_phase(a.in[I_X], DBUF, a.out, a.in[I_FN], gw, NGW, lane);
#undef IN
#undef SEAM
#undef WSB
#undef XC
#undef H
#undef O
#undef ACT
#undef P
#undef KV
#undef Q
#undef OD
#undef CT
#undef CTC
#undef PART
#undef DBUF
#undef XB
#undef MOD
#undef ROPE
#undef LAMV
}

extern "C" void kernel_launch(void* const* d_in, const int* in_sizes, int n_in, void* d_out, int out_size, void* d_ws, size_t ws_size, hipStream_t stream) {
    static int grid = 0;
    if (grid == 0) {
        if (n_in != 19 || out_size != MLAT * DM || ws_size < WS_END) { fprintf(stderr, "kernel_launch: unexpected shapes (n_in %d, out %d, ws %zu < %zu)\n", n_in, out_size, ws_size, (size_t)WS_END); grid = -1; return; }
        int dev = 0, cus = 0, per_cu = 0;
        if (hipGetDevice(&dev) != hipSuccess || hipDeviceGetAttribute(&cus, hipDeviceAttributeMultiprocessorCount, dev) != hipSuccess) { grid = -1; return; }
        if (hipFuncSetAttribute((const void*)mega, hipFuncAttributeMaxDynamicSharedMemorySize, LDS_BYTES) != hipSuccess) { fprintf(stderr, "kernel_launch: hipFuncSetAttribute failed\n"); grid = -1; return; }
        if (hipOccupancyMaxActiveBlocksPerMultiprocessor(&per_cu, (const void*)mega, NWAVES * 64, LDS_BYTES) != hipSuccess || per_cu < 1) { fprintf(stderr, "kernel_launch: occupancy query says %d\n", per_cu); }
        (void)hipGetLastError();
        grid = cus;
    }
    if (grid < 0) return;
    (void)hipMemsetAsync((char*)d_ws + WS_CTL, 0, CTL_ZERO_BYTES, stream);
    Args a{};
    for (int i = 0; i < 19; ++i) a.in[i] = (const float*)d_in[i];
    a.out = (float*)d_out; a.ws = (unsigned char*)d_ws;
#ifndef MK_ONE_LAUNCH
#define MK_ONE_LAUNCH 1
#endif
    if (MK_ONE_LAUNCH) { a.st_lo = 0; a.st_hi = N_STEPS; hipLaunchKernelGGL(mega, dim3(grid), dim3(NWAVES * 64), LDS_BYTES, stream, a); }
    else {
        int steps[64]; int ns = 0; steps[ns++] = 0;
        for (int fi = 0; fi < 4; ++fi) { const int base = 1 + 16 * fi; for (int k = 0; k < 3; ++k) steps[ns++] = base + k; if ((fi & 1) == 0) for (int k = 3; k < 10; ++k) if (k != 8) steps[ns++] = base + k; }
        steps[ns++] = 65;
        for (int i = 0; i < ns; ++i) { a.st_lo = steps[i]; a.st_hi = steps[i] + 1; hipLaunchKernelGGL(mega, dim3(grid), dim3(NWAVES * 64), LDS_BYTES, stream, a); }
    }
    const hipError_t le = hipPeekAtLastError();
    if (le != hipSuccess) fprintf(stderr, "kernel_launch: launch failed: %s\n", hipGetErrorName(le));
}
```
